# Optimizing an MI355X kernel written in HIP

```python
import jax
import jax.numpy as jnp
from jax import lax
import numpy as np

D_MODEL = 1024
BATCH = 8
SEQ = 4096
DEPTH = 1

HEAD_DIM = 64
N_Q_HEADS = 8
N_KV_HEADS = 2
Q_PER_KV = N_Q_HEADS // N_KV_HEADS
ATTN_WIDTH = N_Q_HEADS * HEAD_DIM
ATTN_KV_WIDTH = N_KV_HEADS * HEAD_DIM
ATTN_COLS = ATTN_WIDTH + 2 * ATTN_KV_WIDTH
WINDOW = 128
ATTN_BLOCK = 128
ROPE_THETA = 10000.0
N_RWKV_HEADS = 8
RWKV_WIDTH = N_RWKV_HEADS * HEAD_DIM
DECAY_RANK = 32
ICLR_RANK = 32
GATE_RANK = 96
RWKV_COLS = 3 * RWKV_WIDTH + 2 * DECAY_RANK + 2 * ICLR_RANK + GATE_RANK
IN_COLS = ATTN_COLS + RWKV_COLS
MIX_WIDTH = ATTN_WIDTH + RWKV_WIDTH
RWKV_GN_EPS = 64e-5
PEER_HEADS = 8
PEER_NKEYS = 128
PEER_EXPERTS = PEER_NKEYS * PEER_NKEYS
PEER_QDIM = 256
PEER_HALF = PEER_QDIM // 2
PEER_TOPK = 16
PEER_CHUNK = 128
LN_EPS = 1e-5
DEEPNORM_ALPHA = (2.0 * DEPTH) ** 0.25
DEEPNORM_BETA = (8.0 * DEPTH) ** -0.25

kernel_name = 'hybrid_attn_rwkv7_peer_encoder_layer'


def layer_norm(x, g, b):
    xf = x.astype(jnp.float32)
    mu = jnp.mean(xf, -1, keepdims=True)
    var = jnp.mean(jnp.square(xf - mu), -1, keepdims=True)
    y = (xf - mu) * lax.rsqrt(var + LN_EPS) * g.astype(jnp.float32) + b.astype(jnp.float32)
    return y.astype(x.dtype)


def rotary(t):
    s = t.shape[1]
    pos = jnp.arange(s, dtype=jnp.float32)
    inv_freq = ROPE_THETA ** (-jnp.arange(0, HEAD_DIM, 2, dtype=jnp.float32) / HEAD_DIM)
    ang = pos[:, None] * inv_freq[None, :]
    ang = jnp.concatenate([ang, ang], -1)[:, None, :]
    tf = t.astype(jnp.float32)
    t1, t2 = jnp.split(tf, 2, -1)
    rot = jnp.concatenate([-t2, t1], -1)
    return (tf * jnp.cos(ang) + rot * jnp.sin(ang)).astype(t.dtype)


def banded_window_attention(q, k, v, sink):
    b, s = q.shape[:2]
    nb = s // ATTN_BLOCK
    qb = q.reshape(b, nb, ATTN_BLOCK, N_KV_HEADS, Q_PER_KV, HEAD_DIM)

    def neighbours(t):
        tp = jnp.pad(t, ((0, 0), (ATTN_BLOCK, ATTN_BLOCK), (0, 0), (0, 0)))
        tb = tp.reshape(b, nb + 2, ATTN_BLOCK, N_KV_HEADS, HEAD_DIM)
        return jnp.concatenate([tb[:, :-2], tb[:, 1:-1], tb[:, 2:]], axis=2)

    kw = neighbours(k)
    vw = neighbours(v)
    logits = jnp.einsum('bnqhgd,bnkhd->bnhgqk', qb, kw).astype(jnp.float32) * (HEAD_DIM ** -0.5)
    qpos = jnp.arange(s).reshape(nb, ATTN_BLOCK)
    kpos = (jnp.arange(nb)[:, None] - 1) * ATTN_BLOCK + jnp.arange(3 * ATTN_BLOCK)[None, :]
    valid = ((jnp.abs(qpos[:, :, None] - kpos[:, None, :]) <= WINDOW)
             & (kpos[:, None, :] >= 0) & (kpos[:, None, :] < s))
    logits = jnp.where(valid[None, :, None, None], logits, -1e30)
    sink_l = sink.astype(jnp.float32).reshape(N_KV_HEADS, Q_PER_KV)[None, None, :, :, None, None]
    m = jnp.maximum(jnp.max(logits, -1, keepdims=True), sink_l)
    e = jnp.exp(logits - m)
    probs = e / (jnp.sum(e, -1, keepdims=True) + jnp.exp(sink_l - m))
    out = jnp.einsum('bnhgqk,bnkhd->bnqhgd', probs.astype(v.dtype), vw)
    return out.reshape(b, s, ATTN_WIDTH)


def centred_token_shift(p, mu_prev, mu_next):
    zero = jnp.zeros_like(p[:, :1])
    p_prev = jnp.concatenate([zero, p[:, :-1]], 1)
    p_next = jnp.concatenate([p[:, 1:], zero], 1)
    return p + mu_prev * (p_prev - p) + mu_next * (p_next - p)


def wkv7_step(state, inp):
    r, w, k, v, kk, a = inp
    sa = jnp.einsum('bhvk,bhk->bhv', state, -kk)
    state = (state * w[:, :, None, :]
             + sa[..., :, None] * (kk * a)[:, :, None, :]
             + v[..., :, None] * k[:, :, None, :])
    y = jnp.einsum('bhvk,bhk->bhv', state, r)
    return state, y


def wkv7_scan(r, w, k, v, kk, a, reverse):
    def tm(t):
        return jnp.moveaxis(t, 1, 0)
    s0 = jnp.zeros((r.shape[0], N_RWKV_HEADS, HEAD_DIM, HEAD_DIM), jnp.float32)
    _, y = lax.scan(wkv7_step, s0, (tm(r), tm(w), tm(k), tm(v), tm(kk), tm(a)), reverse=reverse)
    return jnp.moveaxis(y, 0, 1)


def rwkv7_bidirectional(p, mu_prev, mu_next, w0, w2, a0, a2, g2, k_k, k_a, r_k, lnx_g, lnx_b):
    f32 = jnp.float32
    b, s, _ = p.shape
    p = centred_token_shift(p.astype(f32), mu_prev.astype(f32), mu_next.astype(f32))
    cuts = np.cumsum([RWKV_WIDTH, RWKV_WIDTH, RWKV_WIDTH, 2 * DECAY_RANK, 2 * ICLR_RANK]).tolist()
    r, k, v, wd, ad, gd = jnp.split(p, cuts, -1)
    wd = wd.reshape(b, s, 2, DECAY_RANK)
    ad = ad.reshape(b, s, 2, ICLR_RANK)
    w_log = -jax.nn.softplus(-(w0.astype(f32) + jnp.einsum('bsdr,drc->bsdc', jnp.tanh(wd), w2.astype(f32)))) - 0.5
    decay = jnp.exp(-jnp.exp(w_log))
    a = jax.nn.sigmoid(a0.astype(f32) + jnp.einsum('bsdr,drc->bsdc', ad, a2.astype(f32)))
    g = jax.nn.sigmoid(gd) @ g2.astype(f32)

    def heads(t):
        return t.reshape(t.shape[:-1] + (N_RWKV_HEADS, HEAD_DIM))

    kk = heads(k * k_k.astype(f32))
    kk = kk * lax.rsqrt(jnp.maximum(jnp.sum(jnp.square(kk), -1, keepdims=True), 1e-24))
    k_dir = k[:, :, None, :] * (1.0 + (a - 1.0) * k_a.astype(f32))
    rh = heads(r)
    vh = heads(v)
    y = (wkv7_scan(rh, heads(decay[:, :, 0]), heads(k_dir[:, :, 0]), vh, kk, heads(a[:, :, 0]), False)
         + wkv7_scan(rh, heads(decay[:, :, 1]), heads(k_dir[:, :, 1]), vh, kk, heads(a[:, :, 1]), True))
    mu = jnp.mean(y, -1, keepdims=True)
    var = jnp.mean(jnp.square(y - mu), -1, keepdims=True)
    y = ((y - mu) * lax.rsqrt(var + RWKV_GN_EPS)).reshape(b, s, RWKV_WIDTH)
    y = y * lnx_g.astype(f32) + lnx_b.astype(f32)
    k_mean = heads(0.5 * (k_dir[:, :, 0] + k_dir[:, :, 1]))
    bonus = jnp.sum(rh * k_mean * r_k.astype(f32), -1, keepdims=True) * vh
    return (y + bonus.reshape(b, s, RWKV_WIDTH)) * g


def peer_ffn(h, wq, keys, u, v):
    b, s, d = h.shape
    t = b * s
    ht = h.reshape(t, d)
    q = (ht @ wq).reshape(t, PEER_HEADS, 2, PEER_HALF).astype(jnp.float32)
    sc = jnp.einsum('thpc,hpnc->thpn', q, keys.astype(jnp.float32))
    s1, i1 = lax.top_k(sc[:, :, 0], PEER_TOPK)
    s2, i2 = lax.top_k(sc[:, :, 1], PEER_TOPK)
    cand = (s1[..., :, None] + s2[..., None, :]).reshape(t, PEER_HEADS, PEER_TOPK * PEER_TOPK)
    cs, ci = lax.top_k(cand, PEER_TOPK)
    idx = (jnp.take_along_axis(i1, ci // PEER_TOPK, -1) * PEER_NKEYS
           + jnp.take_along_axis(i2, ci % PEER_TOPK, -1))
    gate = jax.nn.softmax(cs, -1).astype(h.dtype)
    n_chunks = t // PEER_CHUNK
    n_sel = PEER_HEADS * PEER_TOPK

    def chunk(args):
        hc, ic, gc = args
        z = jnp.einsum('cd,ced->ce', hc, u[ic])
        return jnp.einsum('ce,ced->cd', gc * jax.nn.gelu(z, approximate=False), v[ic])

    y = lax.map(chunk, (ht.reshape(n_chunks, PEER_CHUNK, d),
                        idx.reshape(n_chunks, PEER_CHUNK, n_sel),
                        gate.reshape(n_chunks, PEER_CHUNK, n_sel)))
    return y.reshape(b, s, d)


def setup_inputs(seed: int = 0) -> dict:
    key = jax.random.key(seed)
    ks = jax.random.split(key, 26)
    f32 = jnp.float32
    L = DEPTH

    def nrm(k, shape, scale):
        return jax.random.normal(k, shape, f32) * scale

    x = nrm(ks[0], (BATCH, SEQ, D_MODEL), 1.0)
    col_scale = jnp.ones((IN_COLS,), f32)
    col_scale = col_scale.at[ATTN_WIDTH + ATTN_KV_WIDTH:ATTN_COLS].set(DEEPNORM_BETA)
    col_scale = col_scale.at[ATTN_COLS + 2 * RWKV_WIDTH:ATTN_COLS + 3 * RWKV_WIDTH].set(DEEPNORM_BETA)
    w_in = nrm(ks[1], (L, D_MODEL, IN_COLS), D_MODEL ** -0.5) * col_scale
    mu_prev = jax.random.uniform(ks[2], (L, RWKV_COLS), f32, 0.0, 0.4)
    mu_next = jax.random.uniform(ks[3], (L, RWKV_COLS), f32, 0.0, 0.4)
    w0 = jax.random.uniform(ks[4], (L, 2, RWKV_WIDTH), f32, -4.0, 1.0)
    w2 = nrm(ks[5], (L, 2, DECAY_RANK, RWKV_WIDTH), 0.3 * DECAY_RANK ** -0.5)
    a0 = nrm(ks[6], (L, 2, RWKV_WIDTH), 0.5)
    a2 = nrm(ks[7], (L, 2, ICLR_RANK, RWKV_WIDTH), ICLR_RANK ** -0.5)
    g2 = nrm(ks[8], (L, GATE_RANK, RWKV_WIDTH), GATE_RANK ** -0.5)
    k_k = 0.85 + nrm(ks[9], (L, RWKV_WIDTH), 0.05)
    k_a = 1.0 + nrm(ks[10], (L, RWKV_WIDTH), 0.05)
    r_k = nrm(ks[11], (L, N_RWKV_HEADS, HEAD_DIM), 0.1)
    lnx_g = 1.0 + nrm(ks[12], (L, RWKV_WIDTH), 0.05)
    lnx_b = nrm(ks[13], (L, RWKV_WIDTH), 0.02)
    sink = nrm(ks[14], (L, N_Q_HEADS), 0.5)
    w_out = nrm(ks[15], (L, MIX_WIDTH, D_MODEL), DEEPNORM_BETA * MIX_WIDTH ** -0.5)
    ln1_g = 1.0 + nrm(ks[16], (L, D_MODEL), 0.05)
    ln1_b = nrm(ks[17], (L, D_MODEL), 0.02)
    peer_wq = nrm(ks[18], (L, D_MODEL, PEER_HEADS * PEER_QDIM), D_MODEL ** -0.5)
    peer_keys = nrm(ks[19], (L, PEER_HEADS, 2, PEER_NKEYS, PEER_HALF), PEER_HALF ** -0.5)
    peer_u = nrm(ks[20], (L, PEER_EXPERTS, D_MODEL), DEEPNORM_BETA * D_MODEL ** -0.5)
    peer_v = nrm(ks[21], (L, PEER_EXPERTS, D_MODEL), DEEPNORM_BETA)
    ln2_g = 1.0 + nrm(ks[22], (L, D_MODEL), 0.05)
    ln2_b = nrm(ks[23], (L, D_MODEL), 0.02)
    return {'x': x, 'w_in': w_in, 'mu_prev': mu_prev, 'mu_next': mu_next,
            'w0': w0, 'w2': w2, 'a0': a0, 'a2': a2, 'g2': g2,
            'k_k': k_k, 'k_a': k_a, 'r_k': r_k, 'lnx_g': lnx_g, 'lnx_b': lnx_b,
            'sink': sink, 'w_out': w_out, 'ln1_g': ln1_g, 'ln1_b': ln1_b,
            'peer_wq': peer_wq, 'peer_keys': peer_keys, 'peer_u': peer_u, 'peer_v': peer_v,
            'ln2_g': ln2_g, 'ln2_b': ln2_b}


def reference(x, w_in, mu_prev, mu_next, w0, w2, a0, a2, g2, k_k, k_a, r_k, lnx_g, lnx_b,
              sink, w_out, ln1_g, ln1_b, peer_wq, peer_keys, peer_u, peer_v, ln2_g, ln2_b):
    b, s, _ = x.shape
    h = x
    for l in range(DEPTH):
        proj = h @ w_in[l]
        q, k, v, pr = jnp.split(proj, [ATTN_WIDTH, ATTN_WIDTH + ATTN_KV_WIDTH, ATTN_COLS], -1)
        q = rotary(q.reshape(b, s, N_Q_HEADS, HEAD_DIM))
        k = rotary(k.reshape(b, s, N_KV_HEADS, HEAD_DIM))
        v = v.reshape(b, s, N_KV_HEADS, HEAD_DIM)
        y_attn = banded_window_attention(q, k, v, sink[l])
        y_rwkv = rwkv7_bidirectional(pr, mu_prev[l], mu_next[l], w0[l], w2[l], a0[l], a2[l], g2[l],
                                     k_k[l], k_a[l], r_k[l], lnx_g[l], lnx_b[l]).astype(h.dtype)
        mix = jnp.concatenate([y_attn, y_rwkv], -1) @ w_out[l]
        h = layer_norm(DEEPNORM_ALPHA * h + mix, ln1_g[l], ln1_b[l])
        f = peer_ffn(h, peer_wq[l], peer_keys[l], peer_u[l], peer_v[l])
        h = layer_norm(DEEPNORM_ALPHA * h + f, ln2_g[l], ln2_b[l])
    return h
```

```cpp
#include <hip/hip_runtime.h>
#include <hip/hip_cooperative_groups.h>
#include <cstdio>
#include <cstdint>
#include <cmath>
namespace cg = cooperative_groups;

constexpr int BATCH = 8, SEQ = 4096, DM = 1024, NTOK = BATCH * SEQ;
constexpr int IN_COLS = 2528, IN_PAD = 2560;
constexpr int C_Q = 0, C_K = 512, C_V = 640, C_P = 768;
constexpr int P_R = 0, P_KK = 512, P_VV = 1024, P_WD = 1536, P_AD = 1600, P_GD = 1664, RW_COLS = 1760;
constexpr int NEXP = 16384, PEER_Q = 2048;
constexpr float LN_EPS = 1e-5f, GN_EPS = 64e-5f;
constexpr float DN_ALPHA = 1.189207115002721f;

typedef unsigned short bf16;
__device__ __forceinline__ float bf2f(bf16 v) { return __uint_as_float(((unsigned)v) << 16); }
__device__ __forceinline__ bf16 f2bf(float f) { unsigned u = __float_as_uint(f); return (bf16)((u + 0x7fffu + ((u >> 16) & 1u)) >> 16); }
__device__ __forceinline__ unsigned pk2bf(float lo, float hi) { return (unsigned)f2bf(lo) | ((unsigned)f2bf(hi) << 16); }
__device__ __forceinline__ float wave_sum(float v) {
#pragma unroll
    for (int o = 1; o < 64; o <<= 1) v += __shfl_xor(v, o);
    return v;
}
__device__ __forceinline__ float sigmoidf_(float x) { return 1.f / (1.f + __expf(-x)); }
namespace pg8 {
#define PG8_LAS __attribute__((address_space(3)))
typedef unsigned short bf16_t;
typedef short bf16x8 __attribute__((ext_vector_type(8)));
typedef float f32x4 __attribute__((ext_vector_type(4)));
typedef unsigned u32x4 __attribute__((ext_vector_type(4)));
constexpr int BM = 256, BK = 64, HALF = 128, HTB = HALF * BK * 2  , STAGE_BYTES = 8 * HTB, NXCD = 8, WGM = 8;

__host__ __device__ __forceinline__ int lds_byte(int r, int c) { const int st = (r >> 4) * 2 + (c >> 5), rr = r & 15, cc = c & 31, ob = rr * 64 + cc * 2; return st * 1024 + (ob ^ (((ob >> 9) & 1) << 5)); }
__host__ __device__ __forceinline__ void stage_rc(int b, int& R, int& C) { const int st = b / 1024, sb = b % 1024, swz = sb ^ (((sb >> 9) & 1) << 5); R = (st >> 1) * 16 + swz / 64; C = (st & 1) * 32 + (swz % 64) / 2; }
__host__ __device__ __forceinline__ int perm32(int rho) { const int n = rho >> 4, i = rho & 15; return 8 * (i >> 2) + 4 * n + (i & 3); }

struct Unit { int pm, pn; };
struct Gemm { const bf16_t* A; const bf16_t* Bt; int M, N, K; };

struct StaticOrder {
    int nM, nN, nwg, G, c;
    __host__ __device__ void init(int M, int N, int G_, int c_) { nM = M / BM; nN = N / BM; nwg = nM * nN; G = G_; c = c_; }
    __host__ __device__ bool next(int i, Unit& u) const {
        const long L = (long)i * G + c; if (L >= nwg) return false;
        int wgid = (int)L; { const int q = nwg / NXCD, r = nwg % NXCD, xcd = wgid % NXCD, off = wgid / NXCD; wgid = (xcd < r ? xcd * (q + 1) : r * (q + 1) + (xcd - r) * q) + off; }
        const int nig = WGM * nN, gid = wgid / nig, fm = gid * WGM, gsz = (nM - fm) < WGM ? (nM - fm) : WGM;
        u.pm = fm + ((wgid % nig) % gsz); u.pn = (wgid % nig) / gsz; return true;
    }
    __device__ __forceinline__ void a_ready(const Unit&) const {}
    __device__ __forceinline__ void done(const Unit&) const {}
};

__device__ __forceinline__ unsigned cvt_pk_bf16(float lo, float hi) { unsigned r; asm volatile("v_cvt_pk_bf16_f32 %0, %1, %2" : "=v"(r) : "v"(lo), "v"(hi)); return r; }
typedef float f32x2 __attribute__((ext_vector_type(2)));
__device__ __forceinline__ f32x2 gelu_pk(f32x2 v) {
    const f32x2 av = __builtin_elementwise_abs(v), d = av * 0.2316418882f + 1.0f;
    f32x2 t; t.x = __builtin_amdgcn_rcpf(d.x); t.y = __builtin_amdgcn_rcpf(d.y);
    f32x2 q = t * 0.5307027145f + (-0.7265760135f); q = q * t + 0.7107068705f; q = q * t + (-0.142248368f); q = q * t + 0.127414796f; q = q * t;
    const f32x2 s = (v * v) * (-0.72134752044f);
    f32x2 e; e.x = __builtin_amdgcn_exp2f(s.x); e.y = __builtin_amdgcn_exp2f(s.y);
    const f32x2 m = v * (q * e), r = v - m;
    f32x2 o; o.x = v.x < 0.f ? m.x : r.x; o.y = v.y < 0.f ? m.y : r.y; return o;
}

template <int ACT  > struct EpiBf16 {
    static constexpr bool PERM = true, AFTER_DRAIN = false; static_assert(ACT == 0 || ACT == 1, "EpiBf16: ACT is 0 (none) or 1 (gelu_pk)");
    bf16_t* O; int ldc; const float* bias; int split_cols; size_t split_stride; float scale0;
    __device__ __forceinline__ void operator()(const f32x4 (&acc)[2][2][4][2], const Unit& u, int wr, int wc, int fr, int fq) const {
        const int row0 = u.pm * BM + wr * 64 + fr; int colt = u.pn * BM; bf16_t* base = O;
        float sc = 1.f; if (split_cols) { const int t = colt / split_cols; base += (size_t)t * split_stride; colt -= t * split_cols; if (t == 0) sc = scale0; }
        const int col0 = colt + wc * 32 + 8 * fq, bcol0 = u.pn * BM + wc * 32 + 8 * fq;
        f32x4 bv[2][2];
#pragma unroll
        for (int bj = 0; bj < 2; ++bj)
#pragma unroll
            for (int n = 0; n < 2; ++n) bv[bj][n] = bias ? *(const f32x4*)(bias + bcol0 + bj * HALF + 4 * n) : (f32x4){0.f, 0.f, 0.f, 0.f};
#pragma unroll
        for (int ai = 0; ai < 2; ++ai)
#pragma unroll
            for (int m = 0; m < 4; ++m) { bf16_t* rowp = base + (size_t)(row0 + ai * HALF + m * 16) * ldc + col0;
#pragma unroll
                for (int bj = 0; bj < 2; ++bj) { f32x4 v0 = acc[ai][bj][m][0] + bv[bj][0], v1 = acc[ai][bj][m][1] + bv[bj][1];
                    if (ACT == 1) { f32x2 a = gelu_pk((f32x2){v0[0], v0[1]}), b = gelu_pk((f32x2){v0[2], v0[3]}), c = gelu_pk((f32x2){v1[0], v1[1]}), d = gelu_pk((f32x2){v1[2], v1[3]});
                        v0 = (f32x4){a.x, a.y, b.x, b.y}; v1 = (f32x4){c.x, c.y, d.x, d.y}; }
                    v0 = v0 * sc; v1 = v1 * sc; u32x4 w; w.x = cvt_pk_bf16(v0[0], v0[1]); w.y = cvt_pk_bf16(v0[2], v0[3]); w.z = cvt_pk_bf16(v1[0], v1[1]); w.w = cvt_pk_bf16(v1[2], v1[3]);
                    *(u32x4*)(rowp + bj * HALF) = w; } }
    }
};

struct PanelStats {
    unsigned* xbuf;
    unsigned* cnt;
    unsigned* tmo;
    int ntn; float eps;
    unsigned code;
    __device__ __forceinline__ bool run(const f32x4 (&v)[2][2][4][2], const Unit& u, int wr, int wc, int fr, int fq, PG8_LAS unsigned char* lds, int wid, int lane) const {
        typedef float f32x2v __attribute__((ext_vector_type(2)));
        PG8_LAS f32x2v* P = (PG8_LAS f32x2v*)lds;
        PG8_LAS f32x2v* S = (PG8_LAS f32x2v*)(lds + 8192);
        PG8_LAS unsigned* flag = (PG8_LAS unsigned*)(lds + 8192 + 2048);
#pragma unroll
        for (int ai = 0; ai < 2; ++ai)
#pragma unroll
            for (int m = 0; m < 4; ++m) {
                float s = 0.f;
#pragma unroll
                for (int bj = 0; bj < 2; ++bj)
#pragma unroll
                    for (int n = 0; n < 2; ++n) { const f32x4 x = v[ai][bj][m][n]; s += (x[0] + x[1]) + (x[2] + x[3]); }
                s += __shfl_xor(s, 16); s += __shfl_xor(s, 32);
                const float mw = s * (1.0f / 64.0f); float q = 0.f;
#pragma unroll
                for (int bj = 0; bj < 2; ++bj)
#pragma unroll
                    for (int n = 0; n < 2; ++n) { const f32x4 d = v[ai][bj][m][n] - mw; q += (d[0] * d[0] + d[1] * d[1]) + (d[2] * d[2] + d[3] * d[3]); }
                q += __shfl_xor(q, 16); q += __shfl_xor(q, 32);
                if (fq == 0) P[(ai * HALF + wr * 64 + m * 16 + fr) * 4 + wc] = (f32x2v){mw, q};
            }
        asm volatile("s_waitcnt lgkmcnt(0)" ::: "memory"); __builtin_amdgcn_s_barrier(); asm volatile("" ::: "memory");
#if defined(BROKEN_EXCHANGE_NO_WAIT)
#warning BROKEN CONTROL BUILD: the row-statistics exchange does not wait; results are wrong by design
        if (blockIdx.x >= 64) { const long long t0_ = clock64(); while (clock64() - t0_ < 60000) __builtin_amdgcn_s_sleep(8); }
#endif
        const int row = wid * 32 + (lane & 31);
        if (lane < 32) {
            const f32x2v a = P[row * 4 + 0], b = P[row * 4 + 1], c = P[row * 4 + 2], d = P[row * 4 + 3];
            const float mt = (a.x + b.x + c.x + d.x) * 0.25f;
            const float da = a.x - mt, db = b.x - mt, dc = c.x - mt, dd = d.x - mt;
            const float m2 = (a.y + b.y) + (c.y + d.y) + 64.0f * ((da * da + db * db) + (dc * dc + dd * dd));
            unsigned long long* slot = (unsigned long long*)xbuf + ((size_t)(u.pm * BM + row) * 4 + u.pn);
            __hip_atomic_store(slot, ((unsigned long long)__float_as_uint(m2) << 32) | __float_as_uint(mt), __ATOMIC_RELAXED, __HIP_MEMORY_SCOPE_AGENT);
        }
        asm volatile("s_waitcnt vmcnt(0)" ::: "memory");
        if (lane == 0) __hip_atomic_fetch_add(cnt + 64 * u.pm, 1u, __ATOMIC_RELAXED, __HIP_MEMORY_SCOPE_AGENT);
        if (wid == 0) {
            bool dead = false; const unsigned long long t0 = __builtin_amdgcn_s_memrealtime(); const unsigned want = 8u * (unsigned)ntn;
            for (;;) {
#if defined(BROKEN_EXCHANGE_NO_WAIT)
                break;
#endif
                if ((unsigned)__builtin_amdgcn_readfirstlane(__hip_atomic_load(cnt + 64 * u.pm, __ATOMIC_RELAXED, __HIP_MEMORY_SCOPE_AGENT)) >= want) break;
                if (__builtin_amdgcn_s_memrealtime() - t0 > 2000000ull) {
                    if (lane == 0) { unsigned expect = 0u; __hip_atomic_compare_exchange_strong(tmo + 1, &expect, code | (unsigned)(u.pm & 0xff), __ATOMIC_RELAXED, __ATOMIC_RELAXED, __HIP_MEMORY_SCOPE_AGENT);
                                     __hip_atomic_store(tmo, 1u, __ATOMIC_RELAXED, __HIP_MEMORY_SCOPE_AGENT); }
                    dead = true; break; }
                __builtin_amdgcn_s_sleep(2);
            }
            __builtin_amdgcn_fence(__ATOMIC_ACQUIRE, "agent");
            if (lane == 0) flag[0] = dead ? 1u : 0u;
        }
        asm volatile("s_waitcnt vmcnt(0) lgkmcnt(0)" ::: "memory"); __builtin_amdgcn_s_barrier(); asm volatile("" ::: "memory");
        const bool bad = flag[0] != 0u;
        if (lane < 32) {
            const unsigned long long* slot = (const unsigned long long*)xbuf + (size_t)(u.pm * BM + row) * 4; float mt[4], m2[4]; float ms = 0.f;
#pragma unroll
            for (int t = 0; t < 4; ++t) { if (t < ntn) { const unsigned long long w = __hip_atomic_load(slot + t, __ATOMIC_RELAXED, __HIP_MEMORY_SCOPE_AGENT); mt[t] = __uint_as_float((unsigned)w); m2[t] = __uint_as_float((unsigned)(w >> 32)); } else { mt[t] = 0.f; m2[t] = 0.f; } ms += mt[t]; }
            const float mean = ms / (float)ntn; float q = 0.f;
#pragma unroll
            for (int t = 0; t < 4; ++t) if (t < ntn) { const float dm = mt[t] - mean; q += m2[t] + 256.0f * dm * dm; }
            S[row] = (f32x2v){mean, 1.0f / sqrtf(q / (256.0f * (float)ntn) + eps)};
        }
        asm volatile("s_waitcnt lgkmcnt(0)" ::: "memory"); __builtin_amdgcn_s_barrier(); asm volatile("" ::: "memory");
        return bad;
    }
};
struct EpiLnRes {
    static constexpr bool PERM = false, AFTER_DRAIN = true;
    const float* base; float* out; int ldc; const float* bias; PanelStats st; unsigned poison;
    __device__ __forceinline__ void fused(f32x4 (&acc)[2][2][4][2], const Unit& u, int wr, int wc, int fr, int fq, PG8_LAS unsigned char* lds, int wid, int lane) const {
        typedef float f32x2v __attribute__((ext_vector_type(2)));
        const PG8_LAS f32x2v* S = (const PG8_LAS f32x2v*)(lds + 8192);
        const int col0 = u.pn * BM + wc * 32 + 4 * fq;
#pragma unroll
        for (int bj = 0; bj < 2; ++bj)
#pragma unroll
            for (int n = 0; n < 2; ++n) { const f32x4 bv = bias ? *(const f32x4*)(bias + col0 + bj * HALF + n * 16) : (f32x4){0.f, 0.f, 0.f, 0.f};
#pragma unroll
                for (int ai = 0; ai < 2; ++ai)
#pragma unroll
                    for (int m = 0; m < 4; ++m) acc[ai][bj][m][n] += bv; }
        f32x4 pre[4][2][2];
#pragma unroll
        for (int m = 0; m < 4; ++m) { const size_t off = (size_t)(u.pm * BM + wr * 64 + m * 16 + fr) * ldc + col0;
#pragma unroll
            for (int bj = 0; bj < 2; ++bj)
#pragma unroll
                for (int n = 0; n < 2; ++n) pre[m][bj][n] = *(const f32x4*)(base + off + bj * HALF + n * 16); }
        const bool bad = st.run(acc, u, wr, wc, fr, fq, lds, wid, lane) || poison != 0u;
        const float qnan = __builtin_nanf("");
#pragma unroll
        for (int ai = 0; ai < 2; ++ai)
#pragma unroll
            for (int m = 0; m < 4; ++m) { const int r = ai * HALF + wr * 64 + m * 16 + fr; const f32x2v sr = S[r]; const size_t off = (size_t)(u.pm * BM + r) * ldc + col0;
#pragma unroll
                for (int bj = 0; bj < 2; ++bj)
#pragma unroll
                    for (int n = 0; n < 2; ++n) { const f32x4 bs = ai == 0 ? pre[m][bj][n] : *(const f32x4*)(base + off + bj * HALF + n * 16); f32x4 o = bs + (acc[ai][bj][m][n] - sr.x) * sr.y;
                        if (bad) o = (f32x4){qnan, qnan, qnan, qnan}; *(f32x4*)(out + off + bj * HALF + n * 16) = o; }
                if (m & 1) asm volatile("" ::: "memory"); }
    }
};
struct EpiLnResLn {
    static constexpr bool PERM = false, AFTER_DRAIN = true;
    const float* base; float* out; bf16_t* xn; int ldc; const float* bias; PanelStats st1, st2; unsigned poison;
    __device__ __forceinline__ void fused(f32x4 (&acc)[2][2][4][2], const Unit& u, int wr, int wc, int fr, int fq, PG8_LAS unsigned char* lds, int wid, int lane) const {
        typedef float f32x2v __attribute__((ext_vector_type(2))); typedef unsigned u32x2v __attribute__((ext_vector_type(2)));
        const PG8_LAS f32x2v* S = (const PG8_LAS f32x2v*)(lds + 8192);
        const int col0 = u.pn * BM + wc * 32 + 4 * fq;
#pragma unroll
        for (int bj = 0; bj < 2; ++bj)
#pragma unroll
            for (int n = 0; n < 2; ++n) { const f32x4 bv = bias ? *(const f32x4*)(bias + col0 + bj * HALF + n * 16) : (f32x4){0.f, 0.f, 0.f, 0.f};
#pragma unroll
                for (int ai = 0; ai < 2; ++ai)
#pragma unroll
                    for (int m = 0; m < 4; ++m) acc[ai][bj][m][n] += bv; }
        bool bad = st1.run(acc, u, wr, wc, fr, fq, lds, wid, lane) || poison != 0u;
        const float qnan = __builtin_nanf("");
#pragma unroll
        for (int ai = 0; ai < 2; ++ai)
#pragma unroll
            for (int m = 0; m < 4; ++m) { const int r = ai * HALF + wr * 64 + m * 16 + fr; const f32x2v sr = S[r]; const size_t off = (size_t)(u.pm * BM + r) * ldc + col0;
#pragma unroll
                for (int bj = 0; bj < 2; ++bj)
#pragma unroll
                    for (int n = 0; n < 2; ++n) { const f32x4 bs = *(const f32x4*)(base + off + bj * HALF + n * 16); acc[ai][bj][m][n] = bs + (acc[ai][bj][m][n] - sr.x) * sr.y; }
                asm volatile("" : "+v"(acc[ai][0][m][0]), "+v"(acc[ai][0][m][1]), "+v"(acc[ai][1][m][0]), "+v"(acc[ai][1][m][1]));
                if (m & 1) asm volatile("" ::: "memory"); }
        const bool bad1 = bad;
        bad = st2.run(acc, u, wr, wc, fr, fq, lds, wid, lane) || bad;
#pragma unroll
        for (int ai = 0; ai < 2; ++ai)
#pragma unroll
            for (int m = 0; m < 4; ++m) { const int r = ai * HALF + wr * 64 + m * 16 + fr; const f32x2v sr = S[r]; const size_t off = (size_t)(u.pm * BM + r) * ldc + col0;
#pragma unroll
                for (int bj = 0; bj < 2; ++bj)
#pragma unroll
                    for (int n = 0; n < 2; ++n) { const f32x4 x1 = acc[ai][bj][m][n]; *(f32x4*)(out + off + bj * HALF + n * 16) = bad1 ? (f32x4){qnan, qnan, qnan, qnan} : x1;
                        const f32x4 o = (x1 - sr.x) * sr.y; u32x2v w; w.x = cvt_pk_bf16(o[0], o[1]); w.y = cvt_pk_bf16(o[2], o[3]);
                        if (bad) { w.x = 0x7fc07fc0u; w.y = 0x7fc07fc0u; } *(u32x2v*)(xn + off + bj * HALF + n * 16) = w; }
                asm volatile("" ::: "memory"); }
    }
};

template <class Epi, class Sched, bool ALIGN_EPI = false, bool SP2 = false>
__device__ __forceinline__ void gemm_phase(PG8_LAS unsigned char* lds, const Gemm g, const Sched& S, const Epi& E) {
    const int tid = threadIdx.x, wid = __builtin_amdgcn_readfirstlane(tid >> 6), lane = tid & 63, wr = wid >> 2, wc = wid & 3, fr = lane & 15, fq = lane >> 4;
    const int K = g.K, nt = K / BK;
    unsigned voffA[2], voffB[2];
#pragma unroll
    for (int i = 0; i < 2; ++i) { int R, C; stage_rc(tid * 16 + i * 8192, R, C); const int Rb = Epi::PERM ? ((R & ~31) + perm32(R & 31)) : R;
        voffA[i] = (unsigned)(R * K + C) * 2u; voffB[i] = (unsigned)(Rb * K + C) * 2u; }
    const size_t kstep = (size_t)(BK * 2);
    const size_t hstep = (size_t)HALF * K * 2;
    const size_t tstep = 2 * hstep;
    const unsigned ldsw = (unsigned)wid * 1024u;
    const int aoff = lds_byte(wr * 64 + fr, fq * 8), boff = lds_byte(wc * 32 + fr, fq * 8);
#define PG8_SA(b, h) (((b) * 2 + (h)) * HTB)
#define PG8_SB(b, h) ((4 + (b) * 2 + (h)) * HTB)
#define PG8_STAGE(bufoff, gbase, voff) do { _Pragma("unroll") for (int _i = 0; _i < 2; ++_i) \
        __builtin_amdgcn_global_load_lds((const unsigned*)((const char*)(gbase) + (voff)[_i]), (PG8_LAS unsigned*)(lds + (bufoff) + ldsw + _i * 8192), 16, 0, 0); } while (0)
#define PG8_LDA(dst, b, h) do { _Pragma("unroll") for (int m = 0; m < 4; ++m) _Pragma("unroll") for (int k = 0; k < 2; ++k) dst[m][k] = *(const PG8_LAS bf16x8*)(lds + PG8_SA(b, h) + aoff + m * 2048 + k * 1024); } while (0)
#define PG8_LDB(dst, b, h) do { _Pragma("unroll") for (int n = 0; n < 2; ++n) _Pragma("unroll") for (int k = 0; k < 2; ++k) dst[n][k] = *(const PG8_LAS bf16x8*)(lds + PG8_SB(b, h) + boff + n * 2048 + k * 1024); } while (0)
#define PG8_MMA(ai, bj, At, Bt) do { __builtin_amdgcn_s_setprio(1); _Pragma("unroll") for (int m = 0; m < 4; ++m) _Pragma("unroll") for (int n = 0; n < 2; ++n) _Pragma("unroll") for (int k = 0; k < 2; ++k) \
        acc[ai][bj][m][n] = __builtin_amdgcn_mfma_f32_16x16x32_bf16(Bt[n][k], At[m][k], acc[ai][bj][m][n], 0, 0, 0); __builtin_amdgcn_s_setprio(0); } while (0)
#define PG8_WAIT_V(n) asm volatile("s_waitcnt vmcnt(" #n ")" ::: "memory")
#define PG8_WAIT_L(n) asm volatile("s_waitcnt lgkmcnt(" #n ")" ::: "memory")
#define PG8_BAR __builtin_amdgcn_s_barrier()
#define PG8_SCHED __builtin_amdgcn_sched_barrier(0)
    Unit cur, nxt; int ui = 0;
    if (!S.next(0, cur)) return;
    f32x4 acc[2][2][4][2];
#pragma unroll
    for (int a = 0; a < 2; ++a)
#pragma unroll
        for (int b = 0; b < 2; ++b)
#pragma unroll
            for (int m = 0; m < 4; ++m)
#pragma unroll
                for (int n = 0; n < 2; ++n) acc[a][b][m][n] = (f32x4){0.f, 0.f, 0.f, 0.f};
    bf16x8 At[4][2], B0[2][2], B1[2][2];
    const char* cA = (const char*)g.A + (size_t)cur.pm * tstep; const char* cB = (const char*)g.Bt + (size_t)cur.pn * tstep;
    S.a_ready(cur);
    if constexpr (SP2) {
        PG8_STAGE(PG8_SB(0, 0), cB, voffB); PG8_STAGE(PG8_SB(0, 1), cB + hstep, voffB); PG8_STAGE(PG8_SA(0, 0), cA, voffA); PG8_STAGE(PG8_SA(0, 1), cA + hstep, voffA);
        if (wr == 1) PG8_BAR;
        PG8_WAIT_V(2); PG8_BAR;
        PG8_STAGE(PG8_SB(1, 0), cB + kstep, voffB); PG8_STAGE(PG8_SA(1, 0), cA + kstep, voffA); PG8_STAGE(PG8_SB(1, 1), cB + hstep + kstep, voffB);
        PG8_WAIT_V(6); PG8_BAR;
    } else {
        PG8_STAGE(PG8_SB(0, 0), cB, voffB); PG8_STAGE(PG8_SA(0, 0), cA, voffA); PG8_STAGE(PG8_SB(0, 1), cB + hstep, voffB); PG8_STAGE(PG8_SA(0, 1), cA + hstep, voffA);
        if (wr == 1) PG8_BAR;
        PG8_WAIT_V(4); PG8_BAR;
        PG8_STAGE(PG8_SB(1, 0), cB + kstep, voffB); PG8_STAGE(PG8_SA(1, 0), cA + kstep, voffA); PG8_STAGE(PG8_SB(1, 1), cB + hstep + kstep, voffB);
        PG8_WAIT_V(6); PG8_BAR;
    }
    for (;;) {
        const bool has_next = S.next(ui + 1, nxt);
        const char* nA = has_next ? (const char*)g.A + (size_t)nxt.pm * tstep : cA; const char* nB = has_next ? (const char*)g.Bt + (size_t)nxt.pn * tstep : cB;
        for (int t = 0; t < nt; t += 2) {
            const bool last = (t == nt - 2);
            const char* a1 = cA + (size_t)(t + 1) * kstep;
            const char* a2 = last ? nA : cA + (size_t)(t + 2) * kstep; const char* b2 = last ? nB : cB + (size_t)(t + 2) * kstep;
            const char* a3 = a2 + kstep; const char* b3 = b2 + kstep;
            if (last && has_next) S.a_ready(nxt);
            if constexpr (SP2) {
            PG8_LDB(B0, 0, 0); PG8_LDB(B1, 0, 1); PG8_SCHED; PG8_LDA(At, 0, 0); PG8_STAGE(PG8_SA(1, 1), a1 + hstep, voffA);
            PG8_WAIT_V(8); PG8_WAIT_L(0); PG8_BAR; PG8_MMA(0, 0, At, B0); PG8_MMA(0, 1, At, B1); PG8_BAR; PG8_SCHED;
            PG8_LDA(At, 0, 1); PG8_STAGE(PG8_SB(0, 0), b2, voffB); PG8_STAGE(PG8_SB(0, 1), b2 + hstep, voffB); PG8_STAGE(PG8_SA(0, 0), a2, voffA);
            PG8_WAIT_V(8); PG8_WAIT_L(0); PG8_BAR; PG8_MMA(1, 0, At, B0); PG8_MMA(1, 1, At, B1); PG8_BAR; PG8_SCHED;
            PG8_LDB(B0, 1, 0); PG8_LDB(B1, 1, 1); PG8_SCHED; PG8_LDA(At, 1, 0); PG8_STAGE(PG8_SA(0, 1), a2 + hstep, voffA);
            PG8_WAIT_V(8); PG8_WAIT_L(0); PG8_BAR; PG8_MMA(0, 0, At, B0); PG8_MMA(0, 1, At, B1); PG8_BAR; PG8_SCHED;
            PG8_LDA(At, 1, 1); PG8_STAGE(PG8_SB(1, 0), b3, voffB); PG8_STAGE(PG8_SB(1, 1), b3 + hstep, voffB); PG8_STAGE(PG8_SA(1, 0), a3, voffA);
            PG8_WAIT_V(8); PG8_WAIT_L(0); PG8_BAR; PG8_MMA(1, 0, At, B0); PG8_MMA(1, 1, At, B1); PG8_BAR; PG8_SCHED;
            } else {
            PG8_LDB(B0, 0, 0); PG8_SCHED; PG8_LDA(At, 0, 0); PG8_STAGE(PG8_SA(1, 1), a1 + hstep, voffA);
            PG8_WAIT_L(8); PG8_BAR; PG8_WAIT_L(0); PG8_MMA(0, 0, At, B0); PG8_BAR; PG8_SCHED;
            PG8_LDB(B1, 0, 1); PG8_STAGE(PG8_SB(0, 0), b2, voffB);
            PG8_BAR; PG8_WAIT_L(0); PG8_MMA(0, 1, At, B1); PG8_BAR;
            PG8_LDA(At, 0, 1); PG8_STAGE(PG8_SA(0, 0), a2, voffA);
            PG8_BAR; PG8_WAIT_L(0); PG8_MMA(1, 0, At, B0); PG8_BAR; PG8_SCHED;
            PG8_STAGE(PG8_SB(0, 1), b2 + hstep, voffB);
            PG8_WAIT_V(6); PG8_BAR; PG8_MMA(1, 1, At, B1); PG8_BAR;
            PG8_LDB(B0, 1, 0); PG8_SCHED; PG8_LDA(At, 1, 0); PG8_STAGE(PG8_SA(0, 1), a2 + hstep, voffA);
            PG8_WAIT_L(8); PG8_BAR; PG8_WAIT_L(0); PG8_MMA(0, 0, At, B0); PG8_BAR; PG8_SCHED;
            PG8_LDB(B1, 1, 1); PG8_STAGE(PG8_SB(1, 0), b3, voffB);
            PG8_BAR; PG8_WAIT_L(0); PG8_MMA(0, 1, At, B1); PG8_BAR;
            PG8_LDA(At, 1, 1); PG8_STAGE(PG8_SA(1, 0), a3, voffA);
            PG8_BAR; PG8_WAIT_L(0); PG8_MMA(1, 0, At, B0); PG8_BAR; PG8_SCHED;
            PG8_STAGE(PG8_SB(1, 1), b3 + hstep, voffB);
            PG8_WAIT_V(6); PG8_BAR; PG8_MMA(1, 1, At, B1); PG8_BAR;
            }
        }
        if constexpr (ALIGN_EPI) { if (wr == 0) PG8_BAR; }
        if constexpr (!Epi::AFTER_DRAIN) { E(acc, cur, wr, wc, fr, fq); S.done(cur); }
        if (!has_next) break;
#pragma unroll
        for (int a = 0; a < 2; ++a)
#pragma unroll
            for (int b = 0; b < 2; ++b)
#pragma unroll
                for (int m = 0; m < 4; ++m)
#pragma unroll
                    for (int n = 0; n < 2; ++n) acc[a][b][m][n] = (f32x4){0.f, 0.f, 0.f, 0.f};
        cur = nxt; cA = nA; cB = nB; ++ui;
        if constexpr (ALIGN_EPI) { if (wr == 1) PG8_BAR; }
    }
    PG8_WAIT_V(0);
    if constexpr (!ALIGN_EPI) { if (wr == 0) PG8_BAR; }
    PG8_BAR;
    if constexpr (Epi::AFTER_DRAIN) { E.fused(acc, cur, wr, wc, fr, fq, lds, wid, lane); S.done(cur); }
#undef PG8_SA
#undef PG8_SB
#undef PG8_STAGE
#undef PG8_LDA
#undef PG8_LDB
#undef PG8_MMA
#undef PG8_WAIT_V
#undef PG8_WAIT_L
#undef PG8_BAR
#undef PG8_SCHED
}
}
namespace nv {
typedef float f32x4 __attribute__((ext_vector_type(4)));

__global__ void k_cvt_bf16(const float* __restrict__ in, bf16* __restrict__ out, size_t n4) {
    size_t i = (size_t)blockIdx.x * blockDim.x + threadIdx.x, st = (size_t)gridDim.x * blockDim.x;
    for (; i < n4; i += st) { f32x4 v = ((const f32x4*)in)[i]; uint2 o; o.x = pk2bf(v.x, v.y); o.y = pk2bf(v.z, v.w); ((uint2*)out)[i] = o; }
}
__global__ void k_transpose_w(const float* __restrict__ W, int K, int N, bf16* __restrict__ WT) {
    __shared__ float t[32][33];
    const int n0 = blockIdx.x * 32, k0 = blockIdx.y * 32, tx = threadIdx.x, ty = threadIdx.y;
    for (int i = ty; i < 32; i += 8) { const int n = n0 + tx; t[i][tx] = (n < N) ? W[(size_t)(k0 + i) * N + n] : 0.f; }
    __syncthreads();
    for (int i = ty; i < 32; i += 8) WT[(size_t)(n0 + i) * K + k0 + tx] = f2bf(t[tx][i]);
}
__global__ void k_rope_table(float2* __restrict__ tab) {
    const int id = blockIdx.x * blockDim.x + threadIdx.x; if (id >= SEQ * 32) return;
    const int pos = id >> 5, i = id & 31;
    const float inv = (float)pow(10000.0, -(double)i / 32.0);
    const float ang = (float)pos * inv;
    tab[id] = make_float2((float)cos((double)ang), (float)sin((double)ang));
}
__global__ void k_rotary(const bf16* __restrict__ proj, const float2* __restrict__ tab, bf16* __restrict__ qr, bf16* __restrict__ kr) {
    const size_t id = (size_t)blockIdx.x * blockDim.x + threadIdx.x; if (id >= (size_t)NTOK * 10 * 32) return;
    const int d = id & 31, hh = (id >> 5) % 10; const size_t t = id / 320; const int pos = (int)(t % SEQ);
    const float2 cs = tab[pos * 32 + d];
    const bf16* src = proj + t * IN_PAD + hh * 64;
    const float t1 = bf2f(src[d]), t2 = bf2f(src[d + 32]);
    const float o1 = t1 * cs.x - t2 * cs.y, o2 = t2 * cs.x + t1 * cs.y;
    bf16* dst = (hh < 8) ? (qr + t * 512 + hh * 64) : (kr + t * 128 + (hh - 8) * 64);
    dst[d] = f2bf(o1); dst[d + 32] = f2bf(o2);
}
__global__ void __launch_bounds__(128) k_attn(const bf16* __restrict__ qr, const bf16* __restrict__ kr, const bf16* __restrict__ proj, const float* __restrict__ sink, bf16* __restrict__ mix) {
    const int id = blockIdx.x * blockDim.x + threadIdx.x; if (id >= NTOK * 8) return;
    const int hq = id & 7, t = id >> 3, b = t / SEQ, i = t % SEQ, kvh = hq >> 2;
    float q[64], acc[64];
#pragma unroll
    for (int d = 0; d < 64; ++d) { q[d] = bf2f(qr[(size_t)t * 512 + hq * 64 + d]) * 0.125f; acc[d] = 0.f; }
    float m = sink[hq], l = 1.f;
    const int j0 = max(0, i - 128), j1 = min(SEQ - 1, i + 128);
    for (int j = j0; j <= j1; ++j) {
        const size_t tj = (size_t)b * SEQ + j;
        const uint4* kp = (const uint4*)(kr + tj * 128 + kvh * 64);
        float s = 0.f;
#pragma unroll
        for (int c = 0; c < 8; ++c) { const uint4 w = kp[c]; const unsigned ww[4] = {w.x, w.y, w.z, w.w};
#pragma unroll
            for (int e = 0; e < 4; ++e) { s += q[c * 8 + 2 * e] * __uint_as_float(ww[e] << 16) + q[c * 8 + 2 * e + 1] * __uint_as_float(ww[e] & 0xffff0000u); } }
        if (s > m) { const float f = __expf(m - s); l *= f;
#pragma unroll
            for (int d = 0; d < 64; ++d) acc[d] *= f;
            m = s; }
        const float p = __expf(s - m); l += p;
        const uint4* vp = (const uint4*)(proj + tj * IN_PAD + C_V + kvh * 64);
#pragma unroll
        for (int c = 0; c < 8; ++c) { const uint4 w = vp[c]; const unsigned ww[4] = {w.x, w.y, w.z, w.w};
#pragma unroll
            for (int e = 0; e < 4; ++e) { acc[c * 8 + 2 * e] += p * __uint_as_float(ww[e] << 16); acc[c * 8 + 2 * e + 1] += p * __uint_as_float(ww[e] & 0xffff0000u); } }
    }
    const float il = 1.f / l;
#pragma unroll
    for (int d = 0; d < 64; d += 2) *(unsigned*)(mix + (size_t)t * DM + hq * 64 + d) = pk2bf(acc[d] * il, acc[d + 1] * il);
}

__global__ void __launch_bounds__(64) k_scan(const bf16* __restrict__ proj, const float* __restrict__ mu_prev, const float* __restrict__ mu_next,
                                             const float* __restrict__ w0, const float* __restrict__ w2, const float* __restrict__ a0, const float* __restrict__ a2,
                                             const float* __restrict__ k_k, const float* __restrict__ k_a, float* __restrict__ ydir) {
    const int unit = blockIdx.x, b = unit >> 4, h = (unit >> 1) & 7, d = unit & 1, lane = threadIdx.x, ch = h * 64 + lane;
    __shared__ float sh[6][64];
    const int colx = lane < 32 ? (P_WD + d * 32 + lane) : (P_AD + d * 32 + lane - 32);
    const int cols[4] = {P_R + ch, P_KK + ch, P_VV + ch, colx};
    float mp[4], mn[4];
#pragma unroll
    for (int c = 0; c < 4; ++c) { mp[c] = mu_prev[cols[c]]; mn[c] = mu_next[cols[c]]; }
    float w2c[32], a2c[32];
#pragma unroll
    for (int j = 0; j < 32; ++j) { w2c[j] = w2[(size_t)(d * 32 + j) * 512 + ch]; a2c[j] = a2[(size_t)(d * 32 + j) * 512 + ch]; }
    const float w0c = w0[d * 512 + ch], a0c = a0[d * 512 + ch], kkc = k_k[ch], kac = k_a[ch];
    float S[64];
#pragma unroll
    for (int k = 0; k < 64; ++k) S[k] = 0.f;
    const int sgn = d ? -1 : 1; int t = d ? SEQ - 1 : 0;
    const bf16* pb = proj + (size_t)b * SEQ * IN_PAD + C_P;
    float behind[4], cur[4], ahead[4];
#pragma unroll
    for (int c = 0; c < 4; ++c) { behind[c] = 0.f; cur[c] = bf2f(pb[(size_t)t * IN_PAD + cols[c]]); ahead[c] = bf2f(pb[(size_t)(t + sgn) * IN_PAD + cols[c]]); }
    for (int step = 0; step < SEQ; ++step, t += sgn) {
        float ahead2[4]; const int t2 = t + 2 * sgn; const bool ok2 = (t2 >= 0 && t2 < SEQ);
#pragma unroll
        for (int c = 0; c < 4; ++c) ahead2[c] = ok2 ? bf2f(pb[(size_t)t2 * IN_PAD + cols[c]]) : 0.f;
        float sv[4];
#pragma unroll
        for (int c = 0; c < 4; ++c) { const float prv = d ? ahead[c] : behind[c], nxt = d ? behind[c] : ahead[c]; sv[c] = cur[c] + mp[c] * (prv - cur[c]) + mn[c] * (nxt - cur[c]); }
        const float r = sv[0], k = sv[1], v = sv[2];
        sh[5][lane] = lane < 32 ? tanhf(sv[3]) : sv[3];
        __syncthreads();
        float ws = w0c, as = a0c;
#pragma unroll
        for (int j = 0; j < 32; ++j) { ws += sh[5][j] * w2c[j]; as += sh[5][32 + j] * a2c[j]; }
        const float nsp = -ws; const float sp = (nsp > 20.f) ? nsp : log1pf(__expf(nsp));
        const float wlog = -sp - 0.5f; const float decay = __expf(-__expf(wlog));
        const float a = sigmoidf_(as);
        float kk = k * kkc; const float ss = wave_sum(kk * kk); kk = kk * rsqrtf(fmaxf(ss, 1e-24f));
        const float kd = k * (1.f + (a - 1.f) * kac);
        sh[0][lane] = decay; sh[1][lane] = kk * a; sh[2][lane] = kd; sh[3][lane] = r; sh[4][lane] = kk;
        __syncthreads();
        float sa = 0.f;
#pragma unroll
        for (int q = 0; q < 64; ++q) sa -= S[q] * sh[4][q];
        float y = 0.f;
#pragma unroll
        for (int q = 0; q < 64; ++q) { S[q] = S[q] * sh[0][q] + sa * sh[1][q] + v * sh[2][q]; y += S[q] * sh[3][q]; }
        ydir[((size_t)d * NTOK + (size_t)b * SEQ + t) * 512 + ch] = y;
        __syncthreads();
#pragma unroll
        for (int c = 0; c < 4; ++c) { behind[c] = cur[c]; cur[c] = ahead[c]; ahead[c] = ahead2[c]; }
    }
}
__global__ void __launch_bounds__(512) k_rwkv_out(const bf16* __restrict__ proj, const float* __restrict__ ydir, const float* __restrict__ mu_prev, const float* __restrict__ mu_next,
                                                  const float* __restrict__ a0, const float* __restrict__ a2, const float* __restrict__ g2, const float* __restrict__ k_a, const float* __restrict__ r_k,
                                                  const float* __restrict__ lnx_g, const float* __restrict__ lnx_b, bf16* __restrict__ mix) {
    const int t = blockIdx.x, i = t % SEQ, ch = threadIdx.x;
    __shared__ float sad[64], sgd[96];
    const bf16* p0 = proj + (size_t)t * IN_PAD + C_P;
    auto shifted = [&](int col) -> float {
        const float c = bf2f(p0[col]);
        const float pv = (i > 0) ? bf2f(p0[col - IN_PAD]) : 0.f, nx = (i < SEQ - 1) ? bf2f(p0[col + IN_PAD]) : 0.f;
        return c + mu_prev[col] * (pv - c) + mu_next[col] * (nx - c);
    };
    if (ch < 64) sad[ch] = shifted(P_AD + ch);
    else if (ch < 160) sgd[ch - 64] = sigmoidf_(shifted(P_GD + ch - 64));
    const float r = shifted(P_R + ch), k = shifted(P_KK + ch), v = shifted(P_VV + ch);
    __syncthreads();
    float as0 = a0[ch], as1 = a0[512 + ch];
    for (int j = 0; j < 32; ++j) { as0 += sad[j] * a2[(size_t)j * 512 + ch]; as1 += sad[32 + j] * a2[(size_t)(32 + j) * 512 + ch]; }
    const float am = 0.5f * (sigmoidf_(as0) + sigmoidf_(as1));
    float g = 0.f;
    for (int j = 0; j < 96; ++j) g += sgd[j] * g2[(size_t)j * 512 + ch];
    const float y = ydir[(size_t)t * 512 + ch] + ydir[((size_t)NTOK + t) * 512 + ch];
    const float mu = wave_sum(y) * (1.f / 64.f); const float dy = y - mu; const float var = wave_sum(dy * dy) * (1.f / 64.f);
    const float yn = dy * rsqrtf(var + GN_EPS) * lnx_g[ch] + lnx_b[ch];
    const float kmean = k * (1.f + (am - 1.f) * k_a[ch]);
    const float bonus = wave_sum(r * kmean * r_k[ch]) * v;
    mix[(size_t)t * DM + 512 + ch] = f2bf((yn + bonus) * g);
}
__global__ void __launch_bounds__(256) k_ln1(const float* y1, const float* __restrict__ g, const float* __restrict__ bta, float* h1f, bf16* __restrict__ h1b) {
    const int row = blockIdx.x * 4 + (threadIdx.x >> 6), lane = threadIdx.x & 63;
    const f32x4* xr = (const f32x4*)(y1 + (size_t)row * DM) + lane;
    f32x4 v[4]; float s = 0.f;
#pragma unroll
    for (int j = 0; j < 4; ++j) { v[j] = xr[64 * j]; s += (v[j].x + v[j].y) + (v[j].z + v[j].w); }
    const float mean = wave_sum(s) * (1.f / DM); float s2 = 0.f;
#pragma unroll
    for (int j = 0; j < 4; ++j) { v[j] = v[j] - mean; s2 += (v[j].x * v[j].x + v[j].y * v[j].y) + (v[j].z * v[j].z + v[j].w * v[j].w); }
    const float rstd = rsqrtf(wave_sum(s2) * (1.f / DM) + LN_EPS);
#pragma unroll
    for (int j = 0; j < 4; ++j) { const f32x4 gg = ((const f32x4*)g)[64 * j + lane], bb = ((const f32x4*)bta)[64 * j + lane];
        const f32x4 o = v[j] * rstd * gg + bb;
        ((f32x4*)(h1f + (size_t)row * DM))[64 * j + lane] = o;
        uint2 w; w.x = pk2bf(o.x, o.y); w.y = pk2bf(o.z, o.w); ((uint2*)(h1b + (size_t)row * DM))[64 * j + lane] = w; }
}
constexpr int TK_TPB = 512;
__global__ void __launch_bounds__(256) k_peer_topk(const bf16* __restrict__ qb, const float* __restrict__ keys, int* __restrict__ idx, float* __restrict__ gate) {
    extern __shared__ __attribute__((aligned(16))) float sm[];
    float* keysT = sm;
    float* sq = sm + 2 * 128 * 128;
    float* sc = sq + 256;
    float* s12 = sc + 256;
    int* i12 = (int*)(s12 + 32);
    const int h = blockIdx.y, tid = threadIdx.x, lane = tid & 63, wave = tid >> 6;
    for (int e = tid; e < 2 * 128 * 128; e += 256) { const int p = e >> 14, n = (e >> 7) & 127, c = e & 127; keysT[(p * 128 + c) * 128 + n] = keys[(size_t)h * 32768 + e]; }
    __syncthreads();
    for (int tt = 0; tt < TK_TPB; ++tt) {
        const size_t t = (size_t)blockIdx.x * TK_TPB + tt;
        sq[tid] = bf2f(qb[t * PEER_Q + h * 256 + tid]);
        __syncthreads();
        { const int p = tid >> 7, n = tid & 127; float s = 0.f; const float* kt = keysT + p * 16384 + n; const float* qq = sq + p * 128;
            for (int c = 0; c < 128; ++c) s += qq[c] * kt[c * 128];
            sc[tid] = s; }
        __syncthreads();
        if (wave < 2) {
            float v0 = sc[wave * 128 + lane], v1 = sc[wave * 128 + 64 + lane];
            for (int r = 0; r < 16; ++r) {
                float bv; int bi; if (v1 > v0) { bv = v1; bi = lane + 64; } else { bv = v0; bi = lane; }
#pragma unroll
                for (int o = 1; o < 64; o <<= 1) { const float ov = __shfl_xor(bv, o); const int oi = __shfl_xor(bi, o); if (ov > bv || (ov == bv && oi < bi)) { bv = ov; bi = oi; } }
                if (lane == 0) { s12[wave * 16 + r] = bv; i12[wave * 16 + r] = bi; }
                if (bi == lane) v0 = -INFINITY; if (bi == lane + 64) v1 = -INFINITY;
            }
        }
        __syncthreads();
        if (wave == 0) {
            float cv[4];
#pragma unroll
            for (int j = 0; j < 4; ++j) { const int f = lane + 64 * j; cv[j] = s12[f >> 4] + s12[16 + (f & 15)]; }
            float mycs = 0.f; int myid = 0;
            for (int r = 0; r < 16; ++r) {
                float bv = cv[0]; int bi = lane;
#pragma unroll
                for (int j = 1; j < 4; ++j) if (cv[j] > bv) { bv = cv[j]; bi = lane + 64 * j; }
#pragma unroll
                for (int o = 1; o < 64; o <<= 1) { const float ov = __shfl_xor(bv, o); const int oi = __shfl_xor(bi, o); if (ov > bv || (ov == bv && oi < bi)) { bv = ov; bi = oi; } }
                if (lane == r) { mycs = bv; myid = i12[bi >> 4] * 128 + i12[16 + (bi & 15)]; }
#pragma unroll
                for (int j = 0; j < 4; ++j) if (bi == lane + 64 * j) cv[j] = -INFINITY;
            }
            float mx = (lane < 16) ? mycs : -INFINITY;
#pragma unroll
            for (int o = 1; o < 64; o <<= 1) mx = fmaxf(mx, __shfl_xor(mx, o));
            const float e = (lane < 16) ? __expf(mycs - mx) : 0.f; const float den = wave_sum(e);
            if (lane < 16) { idx[t * 128 + h * 16 + lane] = myid; gate[t * 128 + h * 16 + lane] = e / den; }
        }
        __syncthreads();
    }
}
__global__ void __launch_bounds__(256) k_peer_gather(const float* __restrict__ h1f, const int* __restrict__ idx, const float* __restrict__ gate, const float* __restrict__ u, const float* __restrict__ v,
                                                     const float* __restrict__ g, const float* __restrict__ bta, float* __restrict__ out) {
    const int t = blockIdx.x * 4 + (threadIdx.x >> 6), lane = threadIdx.x & 63;
    f32x4 hv[4], f[4];
#pragma unroll
    for (int j = 0; j < 4; ++j) { hv[j] = ((const f32x4*)(h1f + (size_t)t * DM))[64 * j + lane]; f[j] = (f32x4){0.f, 0.f, 0.f, 0.f}; }
    for (int e = 0; e < 128; ++e) {
        const int id = idx[(size_t)t * 128 + e]; const float gt = gate[(size_t)t * 128 + e];
        const f32x4* ur = (const f32x4*)(u + (size_t)id * DM); const f32x4* vr = (const f32x4*)(v + (size_t)id * DM);
        float z = 0.f;
#pragma unroll
        for (int j = 0; j < 4; ++j) { const f32x4 w = ur[64 * j + lane]; z += (w.x * hv[j].x + w.y * hv[j].y) + (w.z * hv[j].z + w.w * hv[j].w); }
        z = wave_sum(z);
        const float act = gt * 0.5f * z * (1.f + erff(z * 0.70710678118654752f));
#pragma unroll
        for (int j = 0; j < 4; ++j) { const f32x4 w = vr[64 * j + lane]; f[j] += act * w; }
    }
    float s = 0.f;
#pragma unroll
    for (int j = 0; j < 4; ++j) { f[j] = DN_ALPHA * hv[j] + f[j]; s += (f[j].x + f[j].y) + (f[j].z + f[j].w); }
    const float mean = wave_sum(s) * (1.f / DM); float s2 = 0.f;
#pragma unroll
    for (int j = 0; j < 4; ++j) { f[j] = f[j] - mean; s2 += (f[j].x * f[j].x + f[j].y * f[j].y) + (f[j].z * f[j].z + f[j].w * f[j].w); }
    const float rstd = rsqrtf(wave_sum(s2) * (1.f / DM) + LN_EPS);
#pragma unroll
    for (int j = 0; j < 4; ++j) { const f32x4 gg = ((const f32x4*)g)[64 * j + lane], bb = ((const f32x4*)bta)[64 * j + lane];
        ((f32x4*)(out + (size_t)t * DM))[64 * j + lane] = f[j] * rstd * gg + bb; }
}
}
namespace pg8 {
struct EpiResF32 {
    static constexpr bool PERM = false, AFTER_DRAIN = false;
    const float* base; float* out; int ldc; float alpha;
    __device__ __forceinline__ void operator()(const f32x4 (&acc)[2][2][4][2], const Unit& u, int wr, int wc, int fr, int fq) const {
        const int col0 = u.pn * BM + wc * 32 + 4 * fq;
#pragma unroll
        for (int ai = 0; ai < 2; ++ai)
#pragma unroll
            for (int m = 0; m < 4; ++m) { const int r = ai * HALF + wr * 64 + m * 16 + fr; const size_t off = (size_t)(u.pm * BM + r) * ldc + col0;
#pragma unroll
                for (int bj = 0; bj < 2; ++bj)
#pragma unroll
                    for (int n = 0; n < 2; ++n) { const f32x4 bs = *(const f32x4*)(base + off + bj * HALF + n * 16); *(f32x4*)(out + off + bj * HALF + n * 16) = bs * alpha + acc[ai][bj][m][n]; } }
    }
};
}
template <class Epi>
__global__ void __launch_bounds__(512, 2) k_gemm(pg8::Gemm g, Epi E) {
    extern __shared__ __attribute__((aligned(16))) unsigned char lds[];
    pg8::StaticOrder S; S.init(g.M, g.N, (int)gridDim.x, (int)blockIdx.x);
    pg8::gemm_phase<Epi, pg8::StaticOrder, true, true>((PG8_LAS unsigned char*)lds, g, S, E);
}

constexpr size_t MiB = 1u << 20;
extern "C" void kernel_launch(void* const* d_in, const int* in_sizes, int n_in, void* d_out, int out_size, void* d_ws, size_t ws_size, hipStream_t stream) {
    static int inited = 0;
    if (!inited) {
        if (n_in != 24 || in_sizes[0] != NTOK * DM || out_size != NTOK * DM || ws_size < 496 * MiB) { fprintf(stderr, "kernel_launch: unexpected shapes/ws (n_in %d, ws %zu)\n", n_in, ws_size); inited = -1; return; }
        hipFuncSetAttribute((const void*)k_gemm<pg8::EpiBf16<0>>, hipFuncAttributeMaxDynamicSharedMemorySize, 131072);
        hipFuncSetAttribute((const void*)k_gemm<pg8::EpiResF32>, hipFuncAttributeMaxDynamicSharedMemorySize, 131072);
        hipFuncSetAttribute((const void*)nv::k_peer_topk, hipFuncAttributeMaxDynamicSharedMemorySize, 140000);
        inited = 1;
    }
    if (inited < 0) return;
    const float* x = (const float*)d_in[0]; const float* w_in = (const float*)d_in[1]; const float* mu_prev = (const float*)d_in[2]; const float* mu_next = (const float*)d_in[3];
    const float* w0 = (const float*)d_in[4]; const float* w2 = (const float*)d_in[5]; const float* a0 = (const float*)d_in[6]; const float* a2 = (const float*)d_in[7];
    const float* g2 = (const float*)d_in[8]; const float* k_k = (const float*)d_in[9]; const float* k_a = (const float*)d_in[10]; const float* r_k = (const float*)d_in[11];
    const float* lnx_g = (const float*)d_in[12]; const float* lnx_b = (const float*)d_in[13]; const float* sink = (const float*)d_in[14]; const float* w_out = (const float*)d_in[15];
    const float* ln1_g = (const float*)d_in[16]; const float* ln1_b = (const float*)d_in[17]; const float* wq = (const float*)d_in[18]; const float* keys = (const float*)d_in[19];
    const float* pu = (const float*)d_in[20]; const float* pv = (const float*)d_in[21]; const float* ln2_g = (const float*)d_in[22]; const float* ln2_b = (const float*)d_in[23];
    float* out = (float*)d_out; unsigned char* ws = (unsigned char*)d_ws;
    float2* rope = (float2*)(ws + 1 * MiB);
    bf16* w_in_t = (bf16*)(ws + 4 * MiB); bf16* w_out_t = (bf16*)(ws + 10 * MiB); bf16* wq_t = (bf16*)(ws + 12 * MiB);
    bf16* xb = (bf16*)(ws + 16 * MiB); bf16* qr = (bf16*)(ws + 16 * MiB); bf16* kr = (bf16*)(ws + 48 * MiB);
    bf16* proj = (bf16*)(ws + 80 * MiB); float* y1 = (float*)(ws + 80 * MiB); int* idx = (int*)(ws + 208 * MiB); float* gate = (float*)(ws + 224 * MiB);
    bf16* mix = (bf16*)(ws + 240 * MiB); float* ydir = (float*)(ws + 304 * MiB); bf16* qb = (bf16*)(ws + 304 * MiB); bf16* h1b = (bf16*)(ws + 432 * MiB);

    nv::k_cvt_bf16<<<2048, 256, 0, stream>>>(x, xb, (size_t)NTOK * DM / 4);
    nv::k_transpose_w<<<dim3(IN_PAD / 32, DM / 32), dim3(32, 8), 0, stream>>>(w_in, DM, IN_COLS, w_in_t);
    nv::k_transpose_w<<<dim3(DM / 32, DM / 32), dim3(32, 8), 0, stream>>>(w_out, DM, DM, w_out_t);
    nv::k_transpose_w<<<dim3(PEER_Q / 32, DM / 32), dim3(32, 8), 0, stream>>>(wq, DM, PEER_Q, wq_t);
    nv::k_rope_table<<<SEQ * 32 / 256, 256, 0, stream>>>(rope);
    { pg8::Gemm g{xb, w_in_t, NTOK, IN_PAD, DM}; pg8::EpiBf16<0> E{proj, IN_PAD, nullptr, 0, 0, 1.f};
      k_gemm<pg8::EpiBf16<0>><<<256, 512, 131072, stream>>>(g, E); }
    nv::k_rotary<<<(unsigned)(((size_t)NTOK * 320 + 255) / 256), 256, 0, stream>>>(proj, rope, qr, kr);
    nv::k_attn<<<NTOK * 8 / 128, 128, 0, stream>>>(qr, kr, proj, sink, mix);
    nv::k_scan<<<128, 64, 0, stream>>>(proj, mu_prev, mu_next, w0, w2, a0, a2, k_k, k_a, ydir);
    nv::k_rwkv_out<<<NTOK, 512, 0, stream>>>(proj, ydir, mu_prev, mu_next, a0, a2, g2, k_a, r_k, lnx_g, lnx_b, mix);
    { pg8::Gemm g{mix, w_out_t, NTOK, DM, DM}; pg8::EpiResF32 E{x, y1, DM, DN_ALPHA};
      k_gemm<pg8::EpiResF32><<<256, 512, 131072, stream>>>(g, E); }
    nv::k_ln1<<<NTOK / 4, 256, 0, stream>>>(y1, ln1_g, ln1_b, y1, h1b);
    { pg8::Gemm g{h1b, wq_t, NTOK, PEER_Q, DM}; pg8::EpiBf16<0> E{qb, PEER_Q, nullptr, 0, 0, 1.f};
      k_gemm<pg8::EpiBf16<0>><<<256, 512, 131072, stream>>>(g, E); }
    nv::k_peer_topk<<<dim3(NTOK / nv::TK_TPB, 8), 256, 133376, stream>>>(qb, keys, idx, gate);
    nv::k_peer_gather<<<NTOK / 4, 256, 0, stream>>>(y1, idx, gate, pu, pv, ln2_g, ln2_b, out);
}
```

```cpp
#include <hip/hip_runtime.h>
#include <hip/hip_cooperative_groups.h>
#include <cstdio>
#include <cstdint>
#include <cmath>
namespace cg = cooperative_groups;

constexpr int BATCH = 8, SEQ = 4096, DM = 1024, NTOK = BATCH * SEQ;
constexpr int IN_COLS = 2528, IN_PAD = 2560;
constexpr int C_Q = 0, C_K = 512, C_V = 640, C_P = 768;
constexpr int P_R = 0, P_KK = 512, P_VV = 1024, P_WD = 1536, P_AD = 1600, P_GD = 1664, RW_COLS = 1760;
constexpr int NEXP = 16384, PEER_Q = 2048;
constexpr float LN_EPS = 1e-5f, GN_EPS = 64e-5f;
constexpr float DN_ALPHA = 1.189207115002721f;

typedef unsigned short bf16;
__device__ __forceinline__ float bf2f(bf16 v) { return __uint_as_float(((unsigned)v) << 16); }
__device__ __forceinline__ bf16 f2bf(float f) { unsigned u = __float_as_uint(f); return (bf16)((u + 0x7fffu + ((u >> 16) & 1u)) >> 16); }
__device__ __forceinline__ unsigned pk2bf(float lo, float hi) { return (unsigned)f2bf(lo) | ((unsigned)f2bf(hi) << 16); }
__device__ __forceinline__ float wave_sum(float v) {
#pragma unroll
    for (int o = 1; o < 64; o <<= 1) v += __shfl_xor(v, o);
    return v;
}
__device__ __forceinline__ float sigmoidf_(float x) { return 1.f / (1.f + __expf(-x)); }
namespace pg8 {
#define PG8_LAS __attribute__((address_space(3)))
typedef unsigned short bf16_t;
typedef short bf16x8 __attribute__((ext_vector_type(8)));
typedef float f32x4 __attribute__((ext_vector_type(4)));
typedef unsigned u32x4 __attribute__((ext_vector_type(4)));
constexpr int BM = 256, BK = 64, HALF = 128, HTB = HALF * BK * 2  , STAGE_BYTES = 8 * HTB, NXCD = 8, WGM = 8;

__host__ __device__ __forceinline__ int lds_byte(int r, int c) { const int st = (r >> 4) * 2 + (c >> 5), rr = r & 15, cc = c & 31, ob = rr * 64 + cc * 2; return st * 1024 + (ob ^ (((ob >> 9) & 1) << 5)); }
__host__ __device__ __forceinline__ void stage_rc(int b, int& R, int& C) { const int st = b / 1024, sb = b % 1024, swz = sb ^ (((sb >> 9) & 1) << 5); R = (st >> 1) * 16 + swz / 64; C = (st & 1) * 32 + (swz % 64) / 2; }
__host__ __device__ __forceinline__ int perm32(int rho) { const int n = rho >> 4, i = rho & 15; return 8 * (i >> 2) + 4 * n + (i & 3); }

struct Unit { int pm, pn; };
struct Gemm { const bf16_t* A; const bf16_t* Bt; int M, N, K; };

struct StaticOrder {
    int nM, nN, nwg, G, c;
    __host__ __device__ void init(int M, int N, int G_, int c_) { nM = M / BM; nN = N / BM; nwg = nM * nN; G = G_; c = c_; }
    __host__ __device__ bool next(int i, Unit& u) const {
        const long L = (long)i * G + c; if (L >= nwg) return false;
        int wgid = (int)L; { const int q = nwg / NXCD, r = nwg % NXCD, xcd = wgid % NXCD, off = wgid / NXCD; wgid = (xcd < r ? xcd * (q + 1) : r * (q + 1) + (xcd - r) * q) + off; }
        const int nig = WGM * nN, gid = wgid / nig, fm = gid * WGM, gsz = (nM - fm) < WGM ? (nM - fm) : WGM;
        u.pm = fm + ((wgid % nig) % gsz); u.pn = (wgid % nig) / gsz; return true;
    }
    __device__ __forceinline__ void a_ready(const Unit&) const {}
    __device__ __forceinline__ void done(const Unit&) const {}
};

__device__ __forceinline__ unsigned cvt_pk_bf16(float lo, float hi) { unsigned r; asm volatile("v_cvt_pk_bf16_f32 %0, %1, %2" : "=v"(r) : "v"(lo), "v"(hi)); return r; }
typedef float f32x2 __attribute__((ext_vector_type(2)));
__device__ __forceinline__ f32x2 gelu_pk(f32x2 v) {
    const f32x2 av = __builtin_elementwise_abs(v), d = av * 0.2316418882f + 1.0f;
    f32x2 t; t.x = __builtin_amdgcn_rcpf(d.x); t.y = __builtin_amdgcn_rcpf(d.y);
    f32x2 q = t * 0.5307027145f + (-0.7265760135f); q = q * t + 0.7107068705f; q = q * t + (-0.142248368f); q = q * t + 0.127414796f; q = q * t;
    const f32x2 s = (v * v) * (-0.72134752044f);
    f32x2 e; e.x = __builtin_amdgcn_exp2f(s.x); e.y = __builtin_amdgcn_exp2f(s.y);
    const f32x2 m = v * (q * e), r = v - m;
    f32x2 o; o.x = v.x < 0.f ? m.x : r.x; o.y = v.y < 0.f ? m.y : r.y; return o;
}

template <int ACT  > struct EpiBf16 {
    static constexpr bool PERM = true, AFTER_DRAIN = false; static_assert(ACT == 0 || ACT == 1, "EpiBf16: ACT is 0 (none) or 1 (gelu_pk)");
    bf16_t* O; int ldc; const float* bias; int split_cols; size_t split_stride; float scale0;
    __device__ __forceinline__ void operator()(const f32x4 (&acc)[2][2][4][2], const Unit& u, int wr, int wc, int fr, int fq) const {
        const int row0 = u.pm * BM + wr * 64 + fr; int colt = u.pn * BM; bf16_t* base = O;
        float sc = 1.f; if (split_cols) { const int t = colt / split_cols; base += (size_t)t * split_stride; colt -= t * split_cols; if (t == 0) sc = scale0; }
        const int col0 = colt + wc * 32 + 8 * fq, bcol0 = u.pn * BM + wc * 32 + 8 * fq;
        f32x4 bv[2][2];
#pragma unroll
        for (int bj = 0; bj < 2; ++bj)
#pragma unroll
            for (int n = 0; n < 2; ++n) bv[bj][n] = bias ? *(const f32x4*)(bias + bcol0 + bj * HALF + 4 * n) : (f32x4){0.f, 0.f, 0.f, 0.f};
#pragma unroll
        for (int ai = 0; ai < 2; ++ai)
#pragma unroll
            for (int m = 0; m < 4; ++m) { bf16_t* rowp = base + (size_t)(row0 + ai * HALF + m * 16) * ldc + col0;
#pragma unroll
                for (int bj = 0; bj < 2; ++bj) { f32x4 v0 = acc[ai][bj][m][0] + bv[bj][0], v1 = acc[ai][bj][m][1] + bv[bj][1];
                    if (ACT == 1) { f32x2 a = gelu_pk((f32x2){v0[0], v0[1]}), b = gelu_pk((f32x2){v0[2], v0[3]}), c = gelu_pk((f32x2){v1[0], v1[1]}), d = gelu_pk((f32x2){v1[2], v1[3]});
                        v0 = (f32x4){a.x, a.y, b.x, b.y}; v1 = (f32x4){c.x, c.y, d.x, d.y}; }
                    v0 = v0 * sc; v1 = v1 * sc; u32x4 w; w.x = cvt_pk_bf16(v0[0], v0[1]); w.y = cvt_pk_bf16(v0[2], v0[3]); w.z = cvt_pk_bf16(v1[0], v1[1]); w.w = cvt_pk_bf16(v1[2], v1[3]);
                    *(u32x4*)(rowp + bj * HALF) = w; } }
    }
};

struct PanelStats {
    unsigned* xbuf;
    unsigned* cnt;
    unsigned* tmo;
    int ntn; float eps;
    unsigned code;
    __device__ __forceinline__ bool run(const f32x4 (&v)[2][2][4][2], const Unit& u, int wr, int wc, int fr, int fq, PG8_LAS unsigned char* lds, int wid, int lane) const {
        typedef float f32x2v __attribute__((ext_vector_type(2)));
        PG8_LAS f32x2v* P = (PG8_LAS f32x2v*)lds;
        PG8_LAS f32x2v* S = (PG8_LAS f32x2v*)(lds + 8192);
        PG8_LAS unsigned* flag = (PG8_LAS unsigned*)(lds + 8192 + 2048);
#pragma unroll
        for (int ai = 0; ai < 2; ++ai)
#pragma unroll
            for (int m = 0; m < 4; ++m) {
                float s = 0.f;
#pragma unroll
                for (int bj = 0; bj < 2; ++bj)
#pragma unroll
                    for (int n = 0; n < 2; ++n) { const f32x4 x = v[ai][bj][m][n]; s += (x[0] + x[1]) + (x[2] + x[3]); }
                s += __shfl_xor(s, 16); s += __shfl_xor(s, 32);
                const float mw = s * (1.0f / 64.0f); float q = 0.f;
#pragma unroll
                for (int bj = 0; bj < 2; ++bj)
#pragma unroll
                    for (int n = 0; n < 2; ++n) { const f32x4 d = v[ai][bj][m][n] - mw; q += (d[0] * d[0] + d[1] * d[1]) + (d[2] * d[2] + d[3] * d[3]); }
                q += __shfl_xor(q, 16); q += __shfl_xor(q, 32);
                if (fq == 0) P[(ai * HALF + wr * 64 + m * 16 + fr) * 4 + wc] = (f32x2v){mw, q};
            }
        asm volatile("s_waitcnt lgkmcnt(0)" ::: "memory"); __builtin_amdgcn_s_barrier(); asm volatile("" ::: "memory");
#if defined(BROKEN_EXCHANGE_NO_WAIT)
#warning BROKEN CONTROL BUILD: the row-statistics exchange does not wait; results are wrong by design
        if (blockIdx.x >= 64) { const long long t0_ = clock64(); while (clock64() - t0_ < 60000) __builtin_amdgcn_s_sleep(8); }
#endif
        const int row = wid * 32 + (lane & 31);
        if (lane < 32) {
            const f32x2v a = P[row * 4 + 0], b = P[row * 4 + 1], c = P[row * 4 + 2], d = P[row * 4 + 3];
            const float mt = (a.x + b.x + c.x + d.x) * 0.25f;
            const float da = a.x - mt, db = b.x - mt, dc = c.x - mt, dd = d.x - mt;
            const float m2 = (a.y + b.y) + (c.y + d.y) + 64.0f * ((da * da + db * db) + (dc * dc + dd * dd));
            unsigned long long* slot = (unsigned long long*)xbuf + ((size_t)(u.pm * BM + row) * 4 + u.pn);
            __hip_atomic_store(slot, ((unsigned long long)__float_as_uint(m2) << 32) | __float_as_uint(mt), __ATOMIC_RELAXED, __HIP_MEMORY_SCOPE_AGENT);
        }
        asm volatile("s_waitcnt vmcnt(0)" ::: "memory");
        if (lane == 0) __hip_atomic_fetch_add(cnt + 64 * u.pm, 1u, __ATOMIC_RELAXED, __HIP_MEMORY_SCOPE_AGENT);
        if (wid == 0) {
            bool dead = false; const unsigned long long t0 = __builtin_amdgcn_s_memrealtime(); const unsigned want = 8u * (unsigned)ntn;
            for (;;) {
#if defined(BROKEN_EXCHANGE_NO_WAIT)
                break;
#endif
                if ((unsigned)__builtin_amdgcn_readfirstlane(__hip_atomic_load(cnt + 64 * u.pm, __ATOMIC_RELAXED, __HIP_MEMORY_SCOPE_AGENT)) >= want) break;
                if (__builtin_amdgcn_s_memrealtime() - t0 > 2000000ull) {
                    if (lane == 0) { unsigned expect = 0u; __hip_atomic_compare_exchange_strong(tmo + 1, &expect, code | (unsigned)(u.pm & 0xff), __ATOMIC_RELAXED, __ATOMIC_RELAXED, __HIP_MEMORY_SCOPE_AGENT);
                                     __hip_atomic_store(tmo, 1u, __ATOMIC_RELAXED, __HIP_MEMORY_SCOPE_AGENT); }
                    dead = true; break; }
                __builtin_amdgcn_s_sleep(2);
            }
            __builtin_amdgcn_fence(__ATOMIC_ACQUIRE, "agent");
            if (lane == 0) flag[0] = dead ? 1u : 0u;
        }
        asm volatile("s_waitcnt vmcnt(0) lgkmcnt(0)" ::: "memory"); __builtin_amdgcn_s_barrier(); asm volatile("" ::: "memory");
        const bool bad = flag[0] != 0u;
        if (lane < 32) {
            const unsigned long long* slot = (const unsigned long long*)xbuf + (size_t)(u.pm * BM + row) * 4; float mt[4], m2[4]; float ms = 0.f;
#pragma unroll
            for (int t = 0; t < 4; ++t) { if (t < ntn) { const unsigned long long w = __hip_atomic_load(slot + t, __ATOMIC_RELAXED, __HIP_MEMORY_SCOPE_AGENT); mt[t] = __uint_as_float((unsigned)w); m2[t] = __uint_as_float((unsigned)(w >> 32)); } else { mt[t] = 0.f; m2[t] = 0.f; } ms += mt[t]; }
            const float mean = ms / (float)ntn; float q = 0.f;
#pragma unroll
            for (int t = 0; t < 4; ++t) if (t < ntn) { const float dm = mt[t] - mean; q += m2[t] + 256.0f * dm * dm; }
            S[row] = (f32x2v){mean, 1.0f / sqrtf(q / (256.0f * (float)ntn) + eps)};
        }
        asm volatile("s_waitcnt lgkmcnt(0)" ::: "memory"); __builtin_amdgcn_s_barrier(); asm volatile("" ::: "memory");
        return bad;
    }
};
struct EpiLnRes {
    static constexpr bool PERM = false, AFTER_DRAIN = true;
    const float* base; float* out; int ldc; const float* bias; PanelStats st; unsigned poison;
    __device__ __forceinline__ void fused(f32x4 (&acc)[2][2][4][2], const Unit& u, int wr, int wc, int fr, int fq, PG8_LAS unsigned char* lds, int wid, int lane) const {
        typedef float f32x2v __attribute__((ext_vector_type(2)));
        const PG8_LAS f32x2v* S = (const PG8_LAS f32x2v*)(lds + 8192);
        const int col0 = u.pn * BM + wc * 32 + 4 * fq;
#pragma unroll
        for (int bj = 0; bj < 2; ++bj)
#pragma unroll
            for (int n = 0; n < 2; ++n) { const f32x4 bv = bias ? *(const f32x4*)(bias + col0 + bj * HALF + n * 16) : (f32x4){0.f, 0.f, 0.f, 0.f};
#pragma unroll
                for (int ai = 0; ai < 2; ++ai)
#pragma unroll
                    for (int m = 0; m < 4; ++m) acc[ai][bj][m][n] += bv; }
        f32x4 pre[4][2][2];
#pragma unroll
        for (int m = 0; m < 4; ++m) { const size_t off = (size_t)(u.pm * BM + wr * 64 + m * 16 + fr) * ldc + col0;
#pragma unroll
            for (int bj = 0; bj < 2; ++bj)
#pragma unroll
                for (int n = 0; n < 2; ++n) pre[m][bj][n] = *(const f32x4*)(base + off + bj * HALF + n * 16); }
        const bool bad = st.run(acc, u, wr, wc, fr, fq, lds, wid, lane) || poison != 0u;
        const float qnan = __builtin_nanf("");
#pragma unroll
        for (int ai = 0; ai < 2; ++ai)
#pragma unroll
            for (int m = 0; m < 4; ++m) { const int r = ai * HALF + wr * 64 + m * 16 + fr; const f32x2v sr = S[r]; const size_t off = (size_t)(u.pm * BM + r) * ldc + col0;
#pragma unroll
                for (int bj = 0; bj < 2; ++bj)
#pragma unroll
                    for (int n = 0; n < 2; ++n) { const f32x4 bs = ai == 0 ? pre[m][bj][n] : *(const f32x4*)(base + off + bj * HALF + n * 16); f32x4 o = bs + (acc[ai][bj][m][n] - sr.x) * sr.y;
                        if (bad) o = (f32x4){qnan, qnan, qnan, qnan}; *(f32x4*)(out + off + bj * HALF + n * 16) = o; }
                if (m & 1) asm volatile("" ::: "memory"); }
    }
};
struct EpiLnResLn {
    static constexpr bool PERM = false, AFTER_DRAIN = true;
    const float* base; float* out; bf16_t* xn; int ldc; const float* bias; PanelStats st1, st2; unsigned poison;
    __device__ __forceinline__ void fused(f32x4 (&acc)[2][2][4][2], const Unit& u, int wr, int wc, int fr, int fq, PG8_LAS unsigned char* lds, int wid, int lane) const {
        typedef float f32x2v __attribute__((ext_vector_type(2))); typedef unsigned u32x2v __attribute__((ext_vector_type(2)));
        const PG8_LAS f32x2v* S = (const PG8_LAS f32x2v*)(lds + 8192);
        const int col0 = u.pn * BM + wc * 32 + 4 * fq;
#pragma unroll
        for (int bj = 0; bj < 2; ++bj)
#pragma unroll
            for (int n = 0; n < 2; ++n) { const f32x4 bv = bias ? *(const f32x4*)(bias + col0 + bj * HALF + n * 16) : (f32x4){0.f, 0.f, 0.f, 0.f};
#pragma unroll
                for (int ai = 0; ai < 2; ++ai)
#pragma unroll
                    for (int m = 0; m < 4; ++m) acc[ai][bj][m][n] += bv; }
        bool bad = st1.run(acc, u, wr, wc, fr, fq, lds, wid, lane) || poison != 0u;
        const float qnan = __builtin_nanf("");
#pragma unroll
        for (int ai = 0; ai < 2; ++ai)
#pragma unroll
            for (int m = 0; m < 4; ++m) { const int r = ai * HALF + wr * 64 + m * 16 + fr; const f32x2v sr = S[r]; const size_t off = (size_t)(u.pm * BM + r) * ldc + col0;
#pragma unroll
                for (int bj = 0; bj < 2; ++bj)
#pragma unroll
                    for (int n = 0; n < 2; ++n) { const f32x4 bs = *(const f32x4*)(base + off + bj * HALF + n * 16); acc[ai][bj][m][n] = bs + (acc[ai][bj][m][n] - sr.x) * sr.y; }
                asm volatile("" : "+v"(acc[ai][0][m][0]), "+v"(acc[ai][0][m][1]), "+v"(acc[ai][1][m][0]), "+v"(acc[ai][1][m][1]));
                if (m & 1) asm volatile("" ::: "memory"); }
        const bool bad1 = bad;
        bad = st2.run(acc, u, wr, wc, fr, fq, lds, wid, lane) || bad;
#pragma unroll
        for (int ai = 0; ai < 2; ++ai)
#pragma unroll
            for (int m = 0; m < 4; ++m) { const int r = ai * HALF + wr * 64 + m * 16 + fr; const f32x2v sr = S[r]; const size_t off = (size_t)(u.pm * BM + r) * ldc + col0;
#pragma unroll
                for (int bj = 0; bj < 2; ++bj)
#pragma unroll
                    for (int n = 0; n < 2; ++n) { const f32x4 x1 = acc[ai][bj][m][n]; *(f32x4*)(out + off + bj * HALF + n * 16) = bad1 ? (f32x4){qnan, qnan, qnan, qnan} : x1;
                        const f32x4 o = (x1 - sr.x) * sr.y; u32x2v w; w.x = cvt_pk_bf16(o[0], o[1]); w.y = cvt_pk_bf16(o[2], o[3]);
                        if (bad) { w.x = 0x7fc07fc0u; w.y = 0x7fc07fc0u; } *(u32x2v*)(xn + off + bj * HALF + n * 16) = w; }
                asm volatile("" ::: "memory"); }
    }
};

template <class Epi, class Sched, bool ALIGN_EPI = false, bool SP2 = false>
__device__ __forceinline__ void gemm_phase(PG8_LAS unsigned char* lds, const Gemm g, const Sched& S, const Epi& E) {
    const int tid = threadIdx.x, wid = __builtin_amdgcn_readfirstlane(tid >> 6), lane = tid & 63, wr = wid >> 2, wc = wid & 3, fr = lane & 15, fq = lane >> 4;
    const int K = g.K, nt = K / BK;
    unsigned voffA[2], voffB[2];
#pragma unroll
    for (int i = 0; i < 2; ++i) { int R, C; stage_rc(tid * 16 + i * 8192, R, C); const int Rb = Epi::PERM ? ((R & ~31) + perm32(R & 31)) : R;
        voffA[i] = (unsigned)(R * K + C) * 2u; voffB[i] = (unsigned)(Rb * K + C) * 2u; }
    const size_t kstep = (size_t)(BK * 2);
    const size_t hstep = (size_t)HALF * K * 2;
    const size_t tstep = 2 * hstep;
    const unsigned ldsw = (unsigned)wid * 1024u;
    const int aoff = lds_byte(wr * 64 + fr, fq * 8), boff = lds_byte(wc * 32 + fr, fq * 8);
#define PG8_SA(b, h) (((b) * 2 + (h)) * HTB)
#define PG8_SB(b, h) ((4 + (b) * 2 + (h)) * HTB)
#define PG8_STAGE(bufoff, gbase, voff) do { _Pragma("unroll") for (int _i = 0; _i < 2; ++_i) \
        __builtin_amdgcn_global_load_lds((const unsigned*)((const char*)(gbase) + (voff)[_i]), (PG8_LAS unsigned*)(lds + (bufoff) + ldsw + _i * 8192), 16, 0, 0); } while (0)
#define PG8_LDA(dst, b, h) do { _Pragma("unroll") for (int m = 0; m < 4; ++m) _Pragma("unroll") for (int k = 0; k < 2; ++k) dst[m][k] = *(const PG8_LAS bf16x8*)(lds + PG8_SA(b, h) + aoff + m * 2048 + k * 1024); } while (0)
#define PG8_LDB(dst, b, h) do { _Pragma("unroll") for (int n = 0; n < 2; ++n) _Pragma("unroll") for (int k = 0; k < 2; ++k) dst[n][k] = *(const PG8_LAS bf16x8*)(lds + PG8_SB(b, h) + boff + n * 2048 + k * 1024); } while (0)
#define PG8_MMA(ai, bj, At, Bt) do { __builtin_amdgcn_s_setprio(1); _Pragma("unroll") for (int m = 0; m < 4; ++m) _Pragma("unroll") for (int n = 0; n < 2; ++n) _Pragma("unroll") for (int k = 0; k < 2; ++k) \
        acc[ai][bj][m][n] = __builtin_amdgcn_mfma_f32_16x16x32_bf16(Bt[n][k], At[m][k], acc[ai][bj][m][n], 0, 0, 0); __builtin_amdgcn_s_setprio(0); } while (0)
#define PG8_WAIT_V(n) asm volatile("s_waitcnt vmcnt(" #n ")" ::: "memory")
#define PG8_WAIT_L(n) asm volatile("s_waitcnt lgkmcnt(" #n ")" ::: "memory")
#define PG8_BAR __builtin_amdgcn_s_barrier()
#define PG8_SCHED __builtin_amdgcn_sched_barrier(0)
    Unit cur, nxt; int ui = 0;
    if (!S.next(0, cur)) return;
    f32x4 acc[2][2][4][2];
#pragma unroll
    for (int a = 0; a < 2; ++a)
#pragma unroll
        for (int b = 0; b < 2; ++b)
#pragma unroll
            for (int m = 0; m < 4; ++m)
#pragma unroll
                for (int n = 0; n < 2; ++n) acc[a][b][m][n] = (f32x4){0.f, 0.f, 0.f, 0.f};
    bf16x8 At[4][2], B0[2][2], B1[2][2];
    const char* cA = (const char*)g.A + (size_t)cur.pm * tstep; const char* cB = (const char*)g.Bt + (size_t)cur.pn * tstep;
    S.a_ready(cur);
    if constexpr (SP2) {
        PG8_STAGE(PG8_SB(0, 0), cB, voffB); PG8_STAGE(PG8_SB(0, 1), cB + hstep, voffB); PG8_STAGE(PG8_SA(0, 0), cA, voffA); PG8_STAGE(PG8_SA(0, 1), cA + hstep, voffA);
        if (wr == 1) PG8_BAR;
        PG8_WAIT_V(2); PG8_BAR;
        PG8_STAGE(PG8_SB(1, 0), cB + kstep, voffB); PG8_STAGE(PG8_SA(1, 0), cA + kstep, voffA); PG8_STAGE(PG8_SB(1, 1), cB + hstep + kstep, voffB);
        PG8_WAIT_V(6); PG8_BAR;
    } else {
        PG8_STAGE(PG8_SB(0, 0), cB, voffB); PG8_STAGE(PG8_SA(0, 0), cA, voffA); PG8_STAGE(PG8_SB(0, 1), cB + hstep, voffB); PG8_STAGE(PG8_SA(0, 1), cA + hstep, voffA);
        if (wr == 1) PG8_BAR;
        PG8_WAIT_V(4); PG8_BAR;
        PG8_STAGE(PG8_SB(1, 0), cB + kstep, voffB); PG8_STAGE(PG8_SA(1, 0), cA + kstep, voffA); PG8_STAGE(PG8_SB(1, 1), cB + hstep + kstep, voffB);
        PG8_WAIT_V(6); PG8_BAR;
    }
    for (;;) {
        const bool has_next = S.next(ui + 1, nxt);
        const char* nA = has_next ? (const char*)g.A + (size_t)nxt.pm * tstep : cA; const char* nB = has_next ? (const char*)g.Bt + (size_t)nxt.pn * tstep : cB;
        for (int t = 0; t < nt; t += 2) {
            const bool last = (t == nt - 2);
            const char* a1 = cA + (size_t)(t + 1) * kstep;
            const char* a2 = last ? nA : cA + (size_t)(t + 2) * kstep; const char* b2 = last ? nB : cB + (size_t)(t + 2) * kstep;
            const char* a3 = a2 + kstep; const char* b3 = b2 + kstep;
            if (last && has_next) S.a_ready(nxt);
            if constexpr (SP2) {
            PG8_LDB(B0, 0, 0); PG8_LDB(B1, 0, 1); PG8_SCHED; PG8_LDA(At, 0, 0); PG8_STAGE(PG8_SA(1, 1), a1 + hstep, voffA);
            PG8_WAIT_V(8); PG8_WAIT_L(0); PG8_BAR; PG8_MMA(0, 0, At, B0); PG8_MMA(0, 1, At, B1); PG8_BAR; PG8_SCHED;
            PG8_LDA(At, 0, 1); PG8_STAGE(PG8_SB(0, 0), b2, voffB); PG8_STAGE(PG8_SB(0, 1), b2 + hstep, voffB); PG8_STAGE(PG8_SA(0, 0), a2, voffA);
            PG8_WAIT_V(8); PG8_WAIT_L(0); PG8_BAR; PG8_MMA(1, 0, At, B0); PG8_MMA(1, 1, At, B1); PG8_BAR; PG8_SCHED;
            PG8_LDB(B0, 1, 0); PG8_LDB(B1, 1, 1); PG8_SCHED; PG8_LDA(At, 1, 0); PG8_STAGE(PG8_SA(0, 1), a2 + hstep, voffA);
            PG8_WAIT_V(8); PG8_WAIT_L(0); PG8_BAR; PG8_MMA(0, 0, At, B0); PG8_MMA(0, 1, At, B1); PG8_BAR; PG8_SCHED;
            PG8_LDA(At, 1, 1); PG8_STAGE(PG8_SB(1, 0), b3, voffB); PG8_STAGE(PG8_SB(1, 1), b3 + hstep, voffB); PG8_STAGE(PG8_SA(1, 0), a3, voffA);
            PG8_WAIT_V(8); PG8_WAIT_L(0); PG8_BAR; PG8_MMA(1, 0, At, B0); PG8_MMA(1, 1, At, B1); PG8_BAR; PG8_SCHED;
            } else {
            PG8_LDB(B0, 0, 0); PG8_SCHED; PG8_LDA(At, 0, 0); PG8_STAGE(PG8_SA(1, 1), a1 + hstep, voffA);
            PG8_WAIT_L(8); PG8_BAR; PG8_WAIT_L(0); PG8_MMA(0, 0, At, B0); PG8_BAR; PG8_SCHED;
            PG8_LDB(B1, 0, 1); PG8_STAGE(PG8_SB(0, 0), b2, voffB);
            PG8_BAR; PG8_WAIT_L(0); PG8_MMA(0, 1, At, B1); PG8_BAR;
            PG8_LDA(At, 0, 1); PG8_STAGE(PG8_SA(0, 0), a2, voffA);
            PG8_BAR; PG8_WAIT_L(0); PG8_MMA(1, 0, At, B0); PG8_BAR; PG8_SCHED;
            PG8_STAGE(PG8_SB(0, 1), b2 + hstep, voffB);
            PG8_WAIT_V(6); PG8_BAR; PG8_MMA(1, 1, At, B1); PG8_BAR;
            PG8_LDB(B0, 1, 0); PG8_SCHED; PG8_LDA(At, 1, 0); PG8_STAGE(PG8_SA(0, 1), a2 + hstep, voffA);
            PG8_WAIT_L(8); PG8_BAR; PG8_WAIT_L(0); PG8_MMA(0, 0, At, B0); PG8_BAR; PG8_SCHED;
            PG8_LDB(B1, 1, 1); PG8_STAGE(PG8_SB(1, 0), b3, voffB);
            PG8_BAR; PG8_WAIT_L(0); PG8_MMA(0, 1, At, B1); PG8_BAR;
            PG8_LDA(At, 1, 1); PG8_STAGE(PG8_SA(1, 0), a3, voffA);
            PG8_BAR; PG8_WAIT_L(0); PG8_MMA(1, 0, At, B0); PG8_BAR; PG8_SCHED;
            PG8_STAGE(PG8_SB(1, 1), b3 + hstep, voffB);
            PG8_WAIT_V(6); PG8_BAR; PG8_MMA(1, 1, At, B1); PG8_BAR;
            }
        }
        if constexpr (ALIGN_EPI) { if (wr == 0) PG8_BAR; }
        if constexpr (!Epi::AFTER_DRAIN) { E(acc, cur, wr, wc, fr, fq); S.done(cur); }
        if (!has_next) break;
#pragma unroll
        for (int a = 0; a < 2; ++a)
#pragma unroll
            for (int b = 0; b < 2; ++b)
#pragma unroll
                for (int m = 0; m < 4; ++m)
#pragma unroll
                    for (int n = 0; n < 2; ++n) acc[a][b][m][n] = (f32x4){0.f, 0.f, 0.f, 0.f};
        cur = nxt; cA = nA; cB = nB; ++ui;
        if constexpr (ALIGN_EPI) { if (wr == 1) PG8_BAR; }
    }
    PG8_WAIT_V(0);
    if constexpr (!ALIGN_EPI) { if (wr == 0) PG8_BAR; }
    PG8_BAR;
    if constexpr (Epi::AFTER_DRAIN) { E.fused(acc, cur, wr, wc, fr, fq, lds, wid, lane); S.done(cur); }
#undef PG8_SA
#undef PG8_SB
#undef PG8_STAGE
#undef PG8_LDA
#undef PG8_LDB
#undef PG8_MMA
#undef PG8_WAIT_V
#undef PG8_WAIT_L
#undef PG8_BAR
#undef PG8_SCHED
}
}
#define LAS __attribute__((address_space(3)))
typedef float f32x4 __attribute__((ext_vector_type(4)));
struct Ctx { int tid, lane, wave, bid, nb, gw, ngw; unsigned char* lds; };

namespace nv {
__device__ __forceinline__ void d_cvt_bf16(const Ctx& c, const float* __restrict__ in, bf16* __restrict__ out, size_t n4) {
    for (size_t i = (size_t)c.bid * 512 + c.tid; i < n4; i += (size_t)c.nb * 512) { f32x4 v = ((const f32x4*)in)[i]; uint2 o; o.x = pk2bf(v.x, v.y); o.y = pk2bf(v.z, v.w); ((uint2*)out)[i] = o; }
}
__device__ __forceinline__ void d_transpose_w(const Ctx& c, const float* __restrict__ W, int K, int N, int Npad, bf16* __restrict__ WT) {
    float* t = (float*)(c.lds) + c.wave * (32 * 33);
    const int tx = c.lane & 31, ty = c.lane >> 5, nbn = Npad / 32, ntile = nbn * (K / 32);
    for (int it = c.gw; it < ntile; it += c.ngw) {
        const int n0 = (it % nbn) * 32, k0 = (it / nbn) * 32;
        for (int i = ty; i < 32; i += 2) { const int n = n0 + tx; t[i * 33 + tx] = (n < N) ? W[(size_t)(k0 + i) * N + n] : 0.f; }
        __builtin_amdgcn_fence(__ATOMIC_RELEASE, "workgroup"); __builtin_amdgcn_wave_barrier();
        for (int i = ty; i < 32; i += 2) WT[(size_t)(n0 + i) * K + k0 + tx] = f2bf(t[tx * 33 + i]);
        __builtin_amdgcn_fence(__ATOMIC_RELEASE, "workgroup"); __builtin_amdgcn_wave_barrier();
    }
}
__device__ __forceinline__ void d_rope_table(const Ctx& c, float2* __restrict__ tab) {
    for (int id = c.bid * 512 + c.tid; id < SEQ * 32; id += c.nb * 512) {
        const int pos = id >> 5, i = id & 31;
        const float inv = (float)pow(10000.0, -(double)i / 32.0);
        const float ang = (float)pos * inv;
        tab[id] = make_float2((float)cos((double)ang), (float)sin((double)ang));
    }
}
__device__ __forceinline__ void d_rotary(const Ctx& c, const bf16* __restrict__ proj, const float2* __restrict__ tab, bf16* __restrict__ qr, bf16* __restrict__ kr) {
    for (size_t id = (size_t)c.bid * 512 + c.tid; id < (size_t)NTOK * 320; id += (size_t)c.nb * 512) {
        const int d = id & 31, hh = (id >> 5) % 10; const size_t t = id / 320; const int pos = (int)(t % SEQ);
        const float2 cs = tab[pos * 32 + d];
        const bf16* src = proj + t * IN_PAD + hh * 64;
        const float t1 = bf2f(src[d]), t2 = bf2f(src[d + 32]);
        const float o1 = t1 * cs.x - t2 * cs.y, o2 = t2 * cs.x + t1 * cs.y;
        bf16* dst = (hh < 8) ? (qr + t * 512 + hh * 64) : (kr + t * 128 + (hh - 8) * 64);
        dst[d] = f2bf(o1); dst[d + 32] = f2bf(o2);
    }
}
__device__ __forceinline__ void d_attn(const Ctx& c, const bf16* __restrict__ qr, const bf16* __restrict__ kr, const bf16* __restrict__ proj, const float* __restrict__ sink, bf16* __restrict__ mix) {
    for (int id = c.bid * 512 + c.tid; id < NTOK * 8; id += c.nb * 512) {
        const int hq = id & 7, t = id >> 3, b = t / SEQ, i = t % SEQ, kvh = hq >> 2;
        float q[64], acc[64];
#pragma unroll
        for (int d = 0; d < 64; ++d) { q[d] = bf2f(qr[(size_t)t * 512 + hq * 64 + d]) * 0.125f; acc[d] = 0.f; }
        float m = sink[hq], l = 1.f;
        const int j0 = max(0, i - 128), j1 = min(SEQ - 1, i + 128);
        for (int j = j0; j <= j1; ++j) {
            const size_t tj = (size_t)b * SEQ + j;
            const uint4* kp = (const uint4*)(kr + tj * 128 + kvh * 64);
            float s = 0.f;
#pragma unroll
            for (int cc = 0; cc < 8; ++cc) { const uint4 w = kp[cc]; const unsigned ww[4] = {w.x, w.y, w.z, w.w};
#pragma unroll
                for (int e = 0; e < 4; ++e) { s += q[cc * 8 + 2 * e] * __uint_as_float(ww[e] << 16) + q[cc * 8 + 2 * e + 1] * __uint_as_float(ww[e] & 0xffff0000u); } }
            if (s > m) { const float f = __expf(m - s); l *= f;
#pragma unroll
                for (int d = 0; d < 64; ++d) acc[d] *= f;
                m = s; }
            const float p = __expf(s - m); l += p;
            const uint4* vp = (const uint4*)(proj + tj * IN_PAD + C_V + kvh * 64);
#pragma unroll
            for (int cc = 0; cc < 8; ++cc) { const uint4 w = vp[cc]; const unsigned ww[4] = {w.x, w.y, w.z, w.w};
#pragma unroll
                for (int e = 0; e < 4; ++e) { acc[cc * 8 + 2 * e] += p * __uint_as_float(ww[e] << 16); acc[cc * 8 + 2 * e + 1] += p * __uint_as_float(ww[e] & 0xffff0000u); } }
        }
        const float il = 1.f / l;
#pragma unroll
        for (int d = 0; d < 64; d += 2) *(unsigned*)(mix + (size_t)t * DM + hq * 64 + d) = pk2bf(acc[d] * il, acc[d + 1] * il);
    }
}
__device__ __forceinline__ void d_scan(const Ctx& c, const bf16* __restrict__ proj, const float* __restrict__ mu_prev, const float* __restrict__ mu_next,
                                       const float* __restrict__ w0, const float* __restrict__ w2, const float* __restrict__ a0, const float* __restrict__ a2,
                                       const float* __restrict__ k_k, const float* __restrict__ k_a, float* __restrict__ ydir) {
    if (c.wave != 0) return;
    for (int unit = c.bid; unit < 128; unit += c.nb) {
    const int b = unit >> 4, h = (unit >> 1) & 7, d = unit & 1, lane = c.lane, ch = h * 64 + lane;
    float (*sh)[64] = (float (*)[64])c.lds;
    const int colx = lane < 32 ? (P_WD + d * 32 + lane) : (P_AD + d * 32 + lane - 32);
    const int cols[4] = {P_R + ch, P_KK + ch, P_VV + ch, colx};
    float mp[4], mn[4];
#pragma unroll
    for (int q = 0; q < 4; ++q) { mp[q] = mu_prev[cols[q]]; mn[q] = mu_next[cols[q]]; }
    float* w2c = (float*)c.lds + 6 * 64 + lane; float* a2c = w2c + 32 * 64;
    for (int j = 0; j < 32; ++j) { w2c[j * 64] = w2[(size_t)(d * 32 + j) * 512 + ch]; a2c[j * 64] = a2[(size_t)(d * 32 + j) * 512 + ch]; }
    const float w0c = w0[d * 512 + ch], a0c = a0[d * 512 + ch], kkc = k_k[ch], kac = k_a[ch];
    float S[64];
#pragma unroll
    for (int k = 0; k < 64; ++k) S[k] = 0.f;
    const int sgn = d ? -1 : 1; int t = d ? SEQ - 1 : 0;
    const bf16* pb = proj + (size_t)b * SEQ * IN_PAD + C_P;
    float behind[4], cur[4], ahead[4];
#pragma unroll
    for (int q = 0; q < 4; ++q) { behind[q] = 0.f; cur[q] = bf2f(pb[(size_t)t * IN_PAD + cols[q]]); ahead[q] = bf2f(pb[(size_t)(t + sgn) * IN_PAD + cols[q]]); }
    for (int step = 0; step < SEQ; ++step, t += sgn) {
        float ahead2[4]; const int t2 = t + 2 * sgn; const bool ok2 = (t2 >= 0 && t2 < SEQ);
#pragma unroll
        for (int q = 0; q < 4; ++q) ahead2[q] = ok2 ? bf2f(pb[(size_t)t2 * IN_PAD + cols[q]]) : 0.f;
        float sv[4];
#pragma unroll
        for (int q = 0; q < 4; ++q) { const float prv = d ? ahead[q] : behind[q], nxt = d ? behind[q] : ahead[q]; sv[q] = cur[q] + mp[q] * (prv - cur[q]) + mn[q] * (nxt - cur[q]); }
        const float r = sv[0], k = sv[1], v = sv[2];
        sh[5][lane] = lane < 32 ? tanhf(sv[3]) : sv[3];
        __builtin_amdgcn_fence(__ATOMIC_RELEASE, "workgroup"); __builtin_amdgcn_wave_barrier();
        float ws = w0c, as = a0c;
#pragma unroll
        for (int j = 0; j < 32; ++j) { ws += sh[5][j] * w2c[j * 64]; as += sh[5][32 + j] * a2c[j * 64]; }
        const float nsp = -ws; const float sp = (nsp > 20.f) ? nsp : log1pf(__expf(nsp));
        const float wlog = -sp - 0.5f; const float decay = __expf(-__expf(wlog));
        const float a = sigmoidf_(as);
        float kk = k * kkc; const float ss = wave_sum(kk * kk); kk = kk * rsqrtf(fmaxf(ss, 1e-24f));
        const float kd = k * (1.f + (a - 1.f) * kac);
        sh[0][lane] = decay; sh[1][lane] = kk * a; sh[2][lane] = kd; sh[3][lane] = r; sh[4][lane] = kk;
        __builtin_amdgcn_fence(__ATOMIC_RELEASE, "workgroup"); __builtin_amdgcn_wave_barrier();
        float sa = 0.f;
#pragma unroll
        for (int q = 0; q < 64; ++q) sa -= S[q] * sh[4][q];
        float y = 0.f;
#pragma unroll
        for (int q = 0; q < 64; ++q) { S[q] = S[q] * sh[0][q] + sa * sh[1][q] + v * sh[2][q]; y += S[q] * sh[3][q]; }
        ydir[((size_t)d * NTOK + (size_t)b * SEQ + t) * 512 + ch] = y;
        __builtin_amdgcn_fence(__ATOMIC_RELEASE, "workgroup"); __builtin_amdgcn_wave_barrier();
#pragma unroll
        for (int q = 0; q < 4; ++q) { behind[q] = cur[q]; cur[q] = ahead[q]; ahead[q] = ahead2[q]; }
    }
    }
}
__device__ __forceinline__ void d_rwkv_out(const Ctx& c, const bf16* __restrict__ proj, const float* __restrict__ ydir, const float* __restrict__ mu_prev, const float* __restrict__ mu_next,
                                           const float* __restrict__ a0, const float* __restrict__ a2, const float* __restrict__ g2, const float* __restrict__ k_a, const float* __restrict__ r_k,
                                           const float* __restrict__ lnx_g, const float* __restrict__ lnx_b, bf16* __restrict__ mix) {
    float* sad = (float*)c.lds; float* sgd = sad + 64; const int ch = c.tid;
    const float mpr = mu_prev[P_R + ch], mnr = mu_next[P_R + ch], mpk = mu_prev[P_KK + ch], mnk = mu_next[P_KK + ch], mpv = mu_prev[P_VV + ch], mnv = mu_next[P_VV + ch];
    const int cx = (ch < 64) ? (P_AD + ch) : (ch < 160 ? P_GD + ch - 64 : 0); const float mpx = mu_prev[cx], mnx = mu_next[cx];
    for (int t = c.bid; t < NTOK; t += c.nb) {
        const int i = t % SEQ; const bf16* p0 = proj + (size_t)t * IN_PAD + C_P;
        const bool hp = i > 0, hn = i < SEQ - 1;
#define SHF(col, mp_, mn_) ({ const float c_ = bf2f(p0[col]); const float pv_ = hp ? bf2f(p0[(col) - IN_PAD]) : 0.f, nx_ = hn ? bf2f(p0[(col) + IN_PAD]) : 0.f; c_ + (mp_) * (pv_ - c_) + (mn_) * (nx_ - c_); })
        if (ch < 64) sad[ch] = SHF(cx, mpx, mnx);
        else if (ch < 160) sgd[ch - 64] = sigmoidf_(SHF(cx, mpx, mnx));
        const float r = SHF(P_R + ch, mpr, mnr), k = SHF(P_KK + ch, mpk, mnk), v = SHF(P_VV + ch, mpv, mnv);
#undef SHF
        __syncthreads();
        asm volatile("" ::: "memory");
        float as0 = a0[ch], as1 = a0[512 + ch];
#pragma unroll 4
        for (int j = 0; j < 32; ++j) { as0 += sad[j] * a2[(size_t)j * 512 + ch]; as1 += sad[32 + j] * a2[(size_t)(32 + j) * 512 + ch]; }
        const float am = 0.5f * (sigmoidf_(as0) + sigmoidf_(as1));
        float g = 0.f;
#pragma unroll 4
        for (int j = 0; j < 96; ++j) g += sgd[j] * g2[(size_t)j * 512 + ch];
        const float y = ydir[(size_t)t * 512 + ch] + ydir[((size_t)NTOK + t) * 512 + ch];
        const float mu = wave_sum(y) * (1.f / 64.f); const float dy = y - mu; const float var = wave_sum(dy * dy) * (1.f / 64.f);
        const float yn = dy * rsqrtf(var + GN_EPS) * lnx_g[ch] + lnx_b[ch];
        const float kmean = k * (1.f + (am - 1.f) * k_a[ch]);
        const float bonus = wave_sum(r * kmean * r_k[ch]) * v;
        mix[(size_t)t * DM + 512 + ch] = f2bf((yn + bonus) * g);
        __syncthreads();
    }
}
__device__ __forceinline__ void d_ln1(const Ctx& c, const float* y1, const float* __restrict__ g, const float* __restrict__ bta, float* h1f, bf16* __restrict__ h1b) {
    for (int row = c.gw; row < NTOK; row += c.ngw) {
        const int lane = c.lane;
        const f32x4* xr = (const f32x4*)(y1 + (size_t)row * DM) + lane;
        f32x4 v[4]; float s = 0.f;
#pragma unroll
        for (int j = 0; j < 4; ++j) { v[j] = xr[64 * j]; s += (v[j].x + v[j].y) + (v[j].z + v[j].w); }
        const float mean = wave_sum(s) * (1.f / DM); float s2 = 0.f;
#pragma unroll
        for (int j = 0; j < 4; ++j) { v[j] = v[j] - mean; s2 += (v[j].x * v[j].x + v[j].y * v[j].y) + (v[j].z * v[j].z + v[j].w * v[j].w); }
        const float rstd = rsqrtf(wave_sum(s2) * (1.f / DM) + LN_EPS);
#pragma unroll
        for (int j = 0; j < 4; ++j) { const f32x4 gg = ((const f32x4*)g)[64 * j + lane], bb = ((const f32x4*)bta)[64 * j + lane];
            const f32x4 o = v[j] * rstd * gg + bb;
            ((f32x4*)(h1f + (size_t)row * DM))[64 * j + lane] = o;
            uint2 w; w.x = pk2bf(o.x, o.y); w.y = pk2bf(o.z, o.w); ((uint2*)(h1b + (size_t)row * DM))[64 * j + lane] = w; }
    }
}
__device__ __forceinline__ void d_peer_topk(const Ctx& c, const bf16* __restrict__ qb, const float* __restrict__ keys, int* __restrict__ idx, float* __restrict__ gate) {
    float* keysT = (float*)c.lds; float* sq = keysT + 2 * 128 * 128; float* sc = sq + 256; float* s12 = sc + 256; int* i12 = (int*)(s12 + 32);
    const int tid = c.tid, lane = c.lane, wave = c.wave;
    for (int item = c.bid; item < 8 * 64; item += c.nb) {
        const int h = item & 7, grp = item >> 3;
        __syncthreads();
        for (int e = tid; e < 2 * 128 * 128; e += 512) { const int p = e >> 14, n = (e >> 7) & 127, cc = e & 127; keysT[(p * 128 + cc) * 128 + n] = keys[(size_t)h * 32768 + e]; }
        __syncthreads();
        for (int tt = 0; tt < 512; ++tt) {
            const size_t t = (size_t)grp * 512 + tt;
            if (tid < 256) sq[tid] = bf2f(qb[t * PEER_Q + h * 256 + tid]);
            __syncthreads();
            if (tid < 256) { const int p = tid >> 7, n = tid & 127; float s = 0.f; const float* kt = keysT + p * 16384 + n; const float* qq = sq + p * 128;
                for (int cc = 0; cc < 128; ++cc) s += qq[cc] * kt[cc * 128];
                sc[tid] = s; }
            __syncthreads();
            if (wave < 2) {
                float v0 = sc[wave * 128 + lane], v1 = sc[wave * 128 + 64 + lane];
                for (int r = 0; r < 16; ++r) {
                    float bv; int bi; if (v1 > v0) { bv = v1; bi = lane + 64; } else { bv = v0; bi = lane; }
#pragma unroll
                    for (int o = 1; o < 64; o <<= 1) { const float ov = __shfl_xor(bv, o); const int oi = __shfl_xor(bi, o); if (ov > bv || (ov == bv && oi < bi)) { bv = ov; bi = oi; } }
                    if (lane == 0) { s12[wave * 16 + r] = bv; i12[wave * 16 + r] = bi; }
                    if (bi == lane) v0 = -INFINITY; if (bi == lane + 64) v1 = -INFINITY;
                }
            }
            __syncthreads();
            if (wave == 0) {
                float cv[4];
#pragma unroll
                for (int j = 0; j < 4; ++j) { const int f = lane + 64 * j; cv[j] = s12[f >> 4] + s12[16 + (f & 15)]; }
                float mycs = 0.f; int myid = 0;
                for (int r = 0; r < 16; ++r) {
                    float bv = cv[0]; int bi = lane;
#pragma unroll
                    for (int j = 1; j < 4; ++j) if (cv[j] > bv) { bv = cv[j]; bi = lane + 64 * j; }
#pragma unroll
                    for (int o = 1; o < 64; o <<= 1) { const float ov = __shfl_xor(bv, o); const int oi = __shfl_xor(bi, o); if (ov > bv || (ov == bv && oi < bi)) { bv = ov; bi = oi; } }
                    if (lane == r) { mycs = bv; myid = i12[bi >> 4] * 128 + i12[16 + (bi & 15)]; }
#pragma unroll
                    for (int j = 0; j < 4; ++j) if (bi == lane + 64 * j) cv[j] = -INFINITY;
                }
                float mx = (lane < 16) ? mycs : -INFINITY;
#pragma unroll
                for (int o = 1; o < 64; o <<= 1) mx = fmaxf(mx, __shfl_xor(mx, o));
                const float e = (lane < 16) ? __expf(mycs - mx) : 0.f; const float den = wave_sum(e);
                if (lane < 16) { idx[t * 128 + h * 16 + lane] = myid; gate[t * 128 + h * 16 + lane] = e / den; }
            }
            __syncthreads();
        }
    }
}
__device__ __forceinline__ void d_peer_gather(const Ctx& c, const float* __restrict__ h1f, const int* __restrict__ idx, const float* __restrict__ gate, const float* __restrict__ u, const float* __restrict__ v,
                                              const float* __restrict__ g, const float* __restrict__ bta, float* __restrict__ out) {
    const int lane = c.lane;
    for (int t = c.gw; t < NTOK; t += c.ngw) {
        f32x4 hv[4], f[4];
#pragma unroll
        for (int j = 0; j < 4; ++j) { hv[j] = ((const f32x4*)(h1f + (size_t)t * DM))[64 * j + lane]; f[j] = (f32x4){0.f, 0.f, 0.f, 0.f}; }
        for (int e = 0; e < 128; ++e) {
            const int id = idx[(size_t)t * 128 + e]; const float gt = gate[(size_t)t * 128 + e];
            const f32x4* ur = (const f32x4*)(u + (size_t)id * DM); const f32x4* vr = (const f32x4*)(v + (size_t)id * DM);
            float z = 0.f;
#pragma unroll
            for (int j = 0; j < 4; ++j) { const f32x4 w = ur[64 * j + lane]; z += (w.x * hv[j].x + w.y * hv[j].y) + (w.z * hv[j].z + w.w * hv[j].w); }
            z = wave_sum(z);
            const float act = gt * 0.5f * z * (1.f + erff(z * 0.70710678118654752f));
#pragma unroll
            for (int j = 0; j < 4; ++j) { const f32x4 w = vr[64 * j + lane]; f[j] += act * w; }
        }
        float s = 0.f;
#pragma unroll
        for (int j = 0; j < 4; ++j) { f[j] = DN_ALPHA * hv[j] + f[j]; s += (f[j].x + f[j].y) + (f[j].z + f[j].w); }
        const float mean = wave_sum(s) * (1.f / DM); float s2 = 0.f;
#pragma unroll
        for (int j = 0; j < 4; ++j) { f[j] = f[j] - mean; s2 += (f[j].x * f[j].x + f[j].y * f[j].y) + (f[j].z * f[j].z + f[j].w * f[j].w); }
        const float rstd = rsqrtf(wave_sum(s2) * (1.f / DM) + LN_EPS);
#pragma unroll
        for (int j = 0; j < 4; ++j) { const f32x4 gg = ((const f32x4*)g)[64 * j + lane], bb = ((const f32x4*)bta)[64 * j + lane];
            ((f32x4*)(out + (size_t)t * DM))[64 * j + lane] = f[j] * rstd * gg + bb; }
    }
}
}
namespace pg8 {
struct EpiResF32 {
    static constexpr bool PERM = false, AFTER_DRAIN = false;
    const float* base; float* out; int ldc; float alpha;
    __device__ __forceinline__ void operator()(const f32x4 (&acc)[2][2][4][2], const Unit& u, int wr, int wc, int fr, int fq) const {
        const int col0 = u.pn * BM + wc * 32 + 4 * fq;
#pragma unroll
        for (int ai = 0; ai < 2; ++ai)
#pragma unroll
            for (int m = 0; m < 4; ++m) { const int r = ai * HALF + wr * 64 + m * 16 + fr; const size_t off = (size_t)(u.pm * BM + r) * ldc + col0;
#pragma unroll
                for (int bj = 0; bj < 2; ++bj)
#pragma unroll
                    for (int n = 0; n < 2; ++n) { const f32x4 bs = *(const f32x4*)(base + off + bj * HALF + n * 16); *(f32x4*)(out + off + bj * HALF + n * 16) = bs * alpha + acc[ai][bj][m][n]; } }
    }
};
}
constexpr size_t MiB = 1u << 20;
constexpr int LDS_BYTES = 147456;
constexpr int NPHASE = 11;
struct Params { const float* in[24]; float* out; unsigned char* ws; int ph_lo, ph_hi; };

__global__ void __launch_bounds__(512, 2) mega(Params p) {
    extern __shared__ __attribute__((aligned(16))) unsigned char lds[];
    cg::grid_group grid = cg::this_grid();
    Ctx c; c.tid = threadIdx.x; c.lane = c.tid & 63; c.wave = __builtin_amdgcn_readfirstlane(c.tid >> 6); c.bid = blockIdx.x; c.nb = gridDim.x; c.gw = c.bid * 8 + c.wave; c.ngw = c.nb * 8; c.lds = lds;
    const float* x = p.in[0]; const float* w_in = p.in[1]; const float* mu_prev = p.in[2]; const float* mu_next = p.in[3];
    const float* w0 = p.in[4]; const float* w2 = p.in[5]; const float* a0 = p.in[6]; const float* a2 = p.in[7];
    const float* g2 = p.in[8]; const float* k_k = p.in[9]; const float* k_a = p.in[10]; const float* r_k = p.in[11];
    const float* lnx_g = p.in[12]; const float* lnx_b = p.in[13]; const float* sink = p.in[14]; const float* w_out = p.in[15];
    const float* ln1_g = p.in[16]; const float* ln1_b = p.in[17]; const float* wq = p.in[18]; const float* keys = p.in[19];
    const float* pu = p.in[20]; const float* pv = p.in[21]; const float* ln2_g = p.in[22]; const float* ln2_b = p.in[23];
    float* out = p.out; unsigned char* ws = p.ws;
    float2* rope = (float2*)(ws + 1 * MiB);
    bf16* w_in_t = (bf16*)(ws + 4 * MiB); bf16* w_out_t = (bf16*)(ws + 10 * MiB); bf16* wq_t = (bf16*)(ws + 12 * MiB);
    bf16* xb = (bf16*)(ws + 16 * MiB); bf16* qr = (bf16*)(ws + 16 * MiB); bf16* kr = (bf16*)(ws + 48 * MiB);
    bf16* proj = (bf16*)(ws + 80 * MiB); float* y1 = (float*)(ws + 80 * MiB); int* idx = (int*)(ws + 208 * MiB); float* gate = (float*)(ws + 224 * MiB);
    bf16* mix = (bf16*)(ws + 240 * MiB); float* ydir = (float*)(ws + 304 * MiB); bf16* qb = (bf16*)(ws + 304 * MiB); bf16* h1b = (bf16*)(ws + 432 * MiB);
    const int lo = p.ph_lo, hi = p.ph_hi;
#ifndef PH_MASK
#define PH_MASK 0xFFFF
#endif
#define IN(k) (((PH_MASK >> (k)) & 1) && lo <= (k) && (k) < hi)
#define SEAM(k) do { if (IN(k) && IN((k) + 1)) grid.sync(); } while (0)
    if (IN(0)) {
        nv::d_cvt_bf16(c, x, xb, (size_t)NTOK * DM / 4);
        nv::d_transpose_w(c, w_in, DM, IN_COLS, IN_PAD, w_in_t);
        nv::d_transpose_w(c, w_out, DM, DM, DM, w_out_t);
        nv::d_transpose_w(c, wq, DM, PEER_Q, PEER_Q, wq_t);
        nv::d_rope_table(c, rope);
    }
    SEAM(0);
    if (IN(1)) { pg8::Gemm g{xb, w_in_t, NTOK, IN_PAD, DM}; pg8::StaticOrder S; S.init(NTOK, IN_PAD, c.nb, c.bid); pg8::EpiBf16<0> E{proj, IN_PAD, nullptr, 0, 0, 1.f};
        pg8::gemm_phase<pg8::EpiBf16<0>, pg8::StaticOrder, true, true>((PG8_LAS unsigned char*)lds, g, S, E); }
    SEAM(1);
    if (IN(2)) nv::d_rotary(c, proj, rope, qr, kr);
    SEAM(2);
    if (IN(3)) nv::d_attn(c, qr, kr, proj, sink, mix);
    SEAM(3);
    if (IN(4)) nv::d_scan(c, proj, mu_prev, mu_next, w0, w2, a0, a2, k_k, k_a, ydir);
    SEAM(4);
    if (IN(5)) nv::d_rwkv_out(c, proj, ydir, mu_prev, mu_next, a0, a2, g2, k_a, r_k, lnx_g, lnx_b, mix);
    SEAM(5);
    if (IN(6)) { pg8::Gemm g{mix, w_out_t, NTOK, DM, DM}; pg8::StaticOrder S; S.init(NTOK, DM, c.nb, c.bid); pg8::EpiResF32 E{x, y1, DM, DN_ALPHA};
        pg8::gemm_phase<pg8::EpiResF32, pg8::StaticOrder, true, true>((PG8_LAS unsigned char*)lds, g, S, E); }
    SEAM(6);
    if (IN(7)) nv::d_ln1(c, y1, ln1_g, ln1_b, y1, h1b);
    SEAM(7);
    if (IN(8)) { pg8::Gemm g{h1b, wq_t, NTOK, PEER_Q, DM}; pg8::StaticOrder S; S.init(NTOK, PEER_Q, c.nb, c.bid); pg8::EpiBf16<0> E{qb, PEER_Q, nullptr, 0, 0, 1.f};
        pg8::gemm_phase<pg8::EpiBf16<0>, pg8::StaticOrder, true, true>((PG8_LAS unsigned char*)lds, g, S, E); }
    SEAM(8);
    if (IN(9)) nv::d_peer_topk(c, qb, keys, idx, gate);
    SEAM(9);
    if (IN(10)) nv::d_peer_gather(c, y1, idx, gate, pu, pv, ln2_g, ln2_b, out);
#undef IN
#undef SEAM
}

#ifndef N_LAUNCHES
#define N_LAUNCHES 1
#endif
extern "C" void kernel_launch(void* const* d_in, const int* in_sizes, int n_in, void* d_out, int out_size, void* d_ws, size_t ws_size, hipStream_t stream) {
    static int grid = 0;
    if (grid == 0) {
        if (n_in != 24 || in_sizes[0] != NTOK * DM || out_size != NTOK * DM || ws_size < 496 * MiB) { fprintf(stderr, "kernel_launch: unexpected shapes/ws (n_in %d, ws %zu)\n", n_in, ws_size); grid = -1; return; }
        int dev = 0, cus = 0, per_cu = 0;
        if (hipGetDevice(&dev) != hipSuccess || hipDeviceGetAttribute(&cus, hipDeviceAttributeMultiprocessorCount, dev) != hipSuccess) { grid = -1; return; }
        if (hipFuncSetAttribute((const void*)mega, hipFuncAttributeMaxDynamicSharedMemorySize, LDS_BYTES) != hipSuccess) { fprintf(stderr, "kernel_launch: hipFuncSetAttribute failed\n"); grid = -1; return; }
        if (hipOccupancyMaxActiveBlocksPerMultiprocessor(&per_cu, (const void*)mega, 512, LDS_BYTES) != hipSuccess || per_cu < 1) { fprintf(stderr, "kernel_launch: occupancy query failed (%d)\n", per_cu); (void)hipGetLastError(); grid = -1; return; }
        grid = cus * per_cu;
        fprintf(stderr, "kernel_launch: cus %d per_cu %d grid %d\n", cus, per_cu, grid);
    }
    if (grid < 0) return;
    Params p{};
    for (int i = 0; i < 24; ++i) p.in[i] = (const float*)d_in[i];
    p.out = (float*)d_out; p.ws = (unsigned char*)d_ws;
#if N_LAUNCHES == 1
    p.ph_lo = 0; p.ph_hi = NPHASE;
    void* args[] = {&p};
    hipError_t e = hipLaunchCooperativeKernel((const void*)mega, dim3(grid), dim3(512), args, LDS_BYTES, stream);
    if (e != hipSuccess) fprintf(stderr, "cooperative launch failed: %s (grid %d)\n", hipGetErrorString(e), grid);
#else
    for (int k = 0; k < NPHASE; ++k) { p.ph_lo = k; p.ph_hi = k + 1; hipLaunchKernelGGL(mega, dim3(grid), dim3(512), LDS_BYTES, stream, p); }
#endif
}
```

```cpp
#include <hip/hip_runtime.h>
#include <hip/hip_cooperative_groups.h>
#include <cstdio>
#include <cstdint>
#include <cmath>
namespace cg = cooperative_groups;

constexpr int BATCH = 8, SEQ = 4096, DM = 1024, NTOK = BATCH * SEQ;
constexpr int IN_COLS = 2528, IN_PAD = 2560;
constexpr int C_Q = 0, C_K = 512, C_V = 640, C_P = 768;
constexpr int P_R = 0, P_KK = 512, P_VV = 1024, P_WD = 1536, P_AD = 1600, P_GD = 1664, RW_COLS = 1760;
constexpr int NEXP = 16384, PEER_Q = 2048;
constexpr float LN_EPS = 1e-5f, GN_EPS = 64e-5f;
constexpr float DN_ALPHA = 1.189207115002721f;

typedef unsigned short bf16;
__device__ __forceinline__ float bf2f(bf16 v) { return __uint_as_float(((unsigned)v) << 16); }
__device__ __forceinline__ bf16 f2bf(float f) { unsigned u = __float_as_uint(f); return (bf16)((u + 0x7fffu + ((u >> 16) & 1u)) >> 16); }
__device__ __forceinline__ unsigned pk2bf(float lo, float hi) { return (unsigned)f2bf(lo) | ((unsigned)f2bf(hi) << 16); }
__device__ __forceinline__ float wave_sum(float v) {
#pragma unroll
    for (int o = 1; o < 64; o <<= 1) v += __shfl_xor(v, o);
    return v;
}
__device__ __forceinline__ float sigmoidf_(float x) { return 1.f / (1.f + __expf(-x)); }
namespace pg8 {
#define PG8_LAS __attribute__((address_space(3)))
typedef unsigned short bf16_t;
typedef short bf16x8 __attribute__((ext_vector_type(8)));
typedef float f32x4 __attribute__((ext_vector_type(4)));
typedef unsigned u32x4 __attribute__((ext_vector_type(4)));
constexpr int BM = 256, BK = 64, HALF = 128, HTB = HALF * BK * 2  , STAGE_BYTES = 8 * HTB, NXCD = 8, WGM = 8;

__host__ __device__ __forceinline__ int lds_byte(int r, int c) { const int st = (r >> 4) * 2 + (c >> 5), rr = r & 15, cc = c & 31, ob = rr * 64 + cc * 2; return st * 1024 + (ob ^ (((ob >> 9) & 1) << 5)); }
__host__ __device__ __forceinline__ void stage_rc(int b, int& R, int& C) { const int st = b / 1024, sb = b % 1024, swz = sb ^ (((sb >> 9) & 1) << 5); R = (st >> 1) * 16 + swz / 64; C = (st & 1) * 32 + (swz % 64) / 2; }
__host__ __device__ __forceinline__ int perm32(int rho) { const int n = rho >> 4, i = rho & 15; return 8 * (i >> 2) + 4 * n + (i & 3); }

struct Unit { int pm, pn; };
struct Gemm { const bf16_t* A; const bf16_t* Bt; int M, N, K; };

struct StaticOrder {
    int nM, nN, nwg, G, c;
    __host__ __device__ void init(int M, int N, int G_, int c_) { nM = M / BM; nN = N / BM; nwg = nM * nN; G = G_; c = c_; }
    __host__ __device__ bool next(int i, Unit& u) const {
        const long L = (long)i * G + c; if (L >= nwg) return false;
        int wgid = (int)L; { const int q = nwg / NXCD, r = nwg % NXCD, xcd = wgid % NXCD, off = wgid / NXCD; wgid = (xcd < r ? xcd * (q + 1) : r * (q + 1) + (xcd - r) * q) + off; }
        const int nig = WGM * nN, gid = wgid / nig, fm = gid * WGM, gsz = (nM - fm) < WGM ? (nM - fm) : WGM;
        u.pm = fm + ((wgid % nig) % gsz); u.pn = (wgid % nig) / gsz; return true;
    }
    __device__ __forceinline__ void a_ready(const Unit&) const {}
    __device__ __forceinline__ void done(const Unit&) const {}
};

__device__ __forceinline__ unsigned cvt_pk_bf16(float lo, float hi) { unsigned r; asm volatile("v_cvt_pk_bf16_f32 %0, %1, %2" : "=v"(r) : "v"(lo), "v"(hi)); return r; }
typedef float f32x2 __attribute__((ext_vector_type(2)));
__device__ __forceinline__ f32x2 gelu_pk(f32x2 v) {
    const f32x2 av = __builtin_elementwise_abs(v), d = av * 0.2316418882f + 1.0f;
    f32x2 t; t.x = __builtin_amdgcn_rcpf(d.x); t.y = __builtin_amdgcn_rcpf(d.y);
    f32x2 q = t * 0.5307027145f + (-0.7265760135f); q = q * t + 0.7107068705f; q = q * t + (-0.142248368f); q = q * t + 0.127414796f; q = q * t;
    const f32x2 s = (v * v) * (-0.72134752044f);
    f32x2 e; e.x = __builtin_amdgcn_exp2f(s.x); e.y = __builtin_amdgcn_exp2f(s.y);
    const f32x2 m = v * (q * e), r = v - m;
    f32x2 o; o.x = v.x < 0.f ? m.x : r.x; o.y = v.y < 0.f ? m.y : r.y; return o;
}

template <int ACT  > struct EpiBf16 {
    static constexpr bool PERM = true, AFTER_DRAIN = false; static_assert(ACT == 0 || ACT == 1, "EpiBf16: ACT is 0 (none) or 1 (gelu_pk)");
    bf16_t* O; int ldc; const float* bias; int split_cols; size_t split_stride; float scale0;
    __device__ __forceinline__ void operator()(const f32x4 (&acc)[2][2][4][2], const Unit& u, int wr, int wc, int fr, int fq) const {
        const int row0 = u.pm * BM + wr * 64 + fr; int colt = u.pn * BM; bf16_t* base = O;
        float sc = 1.f; if (split_cols) { const int t = colt / split_cols; base += (size_t)t * split_stride; colt -= t * split_cols; if (t == 0) sc = scale0; }
        const int col0 = colt + wc * 32 + 8 * fq, bcol0 = u.pn * BM + wc * 32 + 8 * fq;
        f32x4 bv[2][2];
#pragma unroll
        for (int bj = 0; bj < 2; ++bj)
#pragma unroll
            for (int n = 0; n < 2; ++n) bv[bj][n] = bias ? *(const f32x4*)(bias + bcol0 + bj * HALF + 4 * n) : (f32x4){0.f, 0.f, 0.f, 0.f};
#pragma unroll
        for (int ai = 0; ai < 2; ++ai)
#pragma unroll
            for (int m = 0; m < 4; ++m) { bf16_t* rowp = base + (size_t)(row0 + ai * HALF + m * 16) * ldc + col0;
#pragma unroll
                for (int bj = 0; bj < 2; ++bj) { f32x4 v0 = acc[ai][bj][m][0] + bv[bj][0], v1 = acc[ai][bj][m][1] + bv[bj][1];
                    if (ACT == 1) { f32x2 a = gelu_pk((f32x2){v0[0], v0[1]}), b = gelu_pk((f32x2){v0[2], v0[3]}), c = gelu_pk((f32x2){v1[0], v1[1]}), d = gelu_pk((f32x2){v1[2], v1[3]});
                        v0 = (f32x4){a.x, a.y, b.x, b.y}; v1 = (f32x4){c.x, c.y, d.x, d.y}; }
                    v0 = v0 * sc; v1 = v1 * sc; u32x4 w; w.x = cvt_pk_bf16(v0[0], v0[1]); w.y = cvt_pk_bf16(v0[2], v0[3]); w.z = cvt_pk_bf16(v1[0], v1[1]); w.w = cvt_pk_bf16(v1[2], v1[3]);
                    *(u32x4*)(rowp + bj * HALF) = w; } }
    }
};

struct PanelStats {
    unsigned* xbuf;
    unsigned* cnt;
    unsigned* tmo;
    int ntn; float eps;
    unsigned code;
    __device__ __forceinline__ bool run(const f32x4 (&v)[2][2][4][2], const Unit& u, int wr, int wc, int fr, int fq, PG8_LAS unsigned char* lds, int wid, int lane) const {
        typedef float f32x2v __attribute__((ext_vector_type(2)));
        PG8_LAS f32x2v* P = (PG8_LAS f32x2v*)lds;
        PG8_LAS f32x2v* S = (PG8_LAS f32x2v*)(lds + 8192);
        PG8_LAS unsigned* flag = (PG8_LAS unsigned*)(lds + 8192 + 2048);
#pragma unroll
        for (int ai = 0; ai < 2; ++ai)
#pragma unroll
            for (int m = 0; m < 4; ++m) {
                float s = 0.f;
#pragma unroll
                for (int bj = 0; bj < 2; ++bj)
#pragma unroll
                    for (int n = 0; n < 2; ++n) { const f32x4 x = v[ai][bj][m][n]; s += (x[0] + x[1]) + (x[2] + x[3]); }
                s += __shfl_xor(s, 16); s += __shfl_xor(s, 32);
                const float mw = s * (1.0f / 64.0f); float q = 0.f;
#pragma unroll
                for (int bj = 0; bj < 2; ++bj)
#pragma unroll
                    for (int n = 0; n < 2; ++n) { const f32x4 d = v[ai][bj][m][n] - mw; q += (d[0] * d[0] + d[1] * d[1]) + (d[2] * d[2] + d[3] * d[3]); }
                q += __shfl_xor(q, 16); q += __shfl_xor(q, 32);
                if (fq == 0) P[(ai * HALF + wr * 64 + m * 16 + fr) * 4 + wc] = (f32x2v){mw, q};
            }
        asm volatile("s_waitcnt lgkmcnt(0)" ::: "memory"); __builtin_amdgcn_s_barrier(); asm volatile("" ::: "memory");
#if defined(BROKEN_EXCHANGE_NO_WAIT)
#warning BROKEN CONTROL BUILD: the row-statistics exchange does not wait; results are wrong by design
        if (blockIdx.x >= 64) { const long long t0_ = clock64(); while (clock64() - t0_ < 60000) __builtin_amdgcn_s_sleep(8); }
#endif
        const int row = wid * 32 + (lane & 31);
        if (lane < 32) {
            const f32x2v a = P[row * 4 + 0], b = P[row * 4 + 1], c = P[row * 4 + 2], d = P[row * 4 + 3];
            const float mt = (a.x + b.x + c.x + d.x) * 0.25f;
            const float da = a.x - mt, db = b.x - mt, dc = c.x - mt, dd = d.x - mt;
            const float m2 = (a.y + b.y) + (c.y + d.y) + 64.0f * ((da * da + db * db) + (dc * dc + dd * dd));
            unsigned long long* slot = (unsigned long long*)xbuf + ((size_t)(u.pm * BM + row) * 4 + u.pn);
            __hip_atomic_store(slot, ((unsigned long long)__float_as_uint(m2) << 32) | __float_as_uint(mt), __ATOMIC_RELAXED, __HIP_MEMORY_SCOPE_AGENT);
        }
        asm volatile("s_waitcnt vmcnt(0)" ::: "memory");
        if (lane == 0) __hip_atomic_fetch_add(cnt + 64 * u.pm, 1u, __ATOMIC_RELAXED, __HIP_MEMORY_SCOPE_AGENT);
        if (wid == 0) {
            bool dead = false; const unsigned long long t0 = __builtin_amdgcn_s_memrealtime(); const unsigned want = 8u * (unsigned)ntn;
            for (;;) {
#if defined(BROKEN_EXCHANGE_NO_WAIT)
                break;
#endif
                if ((unsigned)__builtin_amdgcn_readfirstlane(__hip_atomic_load(cnt + 64 * u.pm, __ATOMIC_RELAXED, __HIP_MEMORY_SCOPE_AGENT)) >= want) break;
                if (__builtin_amdgcn_s_memrealtime() - t0 > 2000000ull) {
                    if (lane == 0) { unsigned expect = 0u; __hip_atomic_compare_exchange_strong(tmo + 1, &expect, code | (unsigned)(u.pm & 0xff), __ATOMIC_RELAXED, __ATOMIC_RELAXED, __HIP_MEMORY_SCOPE_AGENT);
                                     __hip_atomic_store(tmo, 1u, __ATOMIC_RELAXED, __HIP_MEMORY_SCOPE_AGENT); }
                    dead = true; break; }
                __builtin_amdgcn_s_sleep(2);
            }
            __builtin_amdgcn_fence(__ATOMIC_ACQUIRE, "agent");
            if (lane == 0) flag[0] = dead ? 1u : 0u;
        }
        asm volatile("s_waitcnt vmcnt(0) lgkmcnt(0)" ::: "memory"); __builtin_amdgcn_s_barrier(); asm volatile("" ::: "memory");
        const bool bad = flag[0] != 0u;
        if (lane < 32) {
            const unsigned long long* slot = (const unsigned long long*)xbuf + (size_t)(u.pm * BM + row) * 4; float mt[4], m2[4]; float ms = 0.f;
#pragma unroll
            for (int t = 0; t < 4; ++t) { if (t < ntn) { const unsigned long long w = __hip_atomic_load(slot + t, __ATOMIC_RELAXED, __HIP_MEMORY_SCOPE_AGENT); mt[t] = __uint_as_float((unsigned)w); m2[t] = __uint_as_float((unsigned)(w >> 32)); } else { mt[t] = 0.f; m2[t] = 0.f; } ms += mt[t]; }
            const float mean = ms / (float)ntn; float q = 0.f;
#pragma unroll
            for (int t = 0; t < 4; ++t) if (t < ntn) { const float dm = mt[t] - mean; q += m2[t] + 256.0f * dm * dm; }
            S[row] = (f32x2v){mean, 1.0f / sqrtf(q / (256.0f * (float)ntn) + eps)};
        }
        asm volatile("s_waitcnt lgkmcnt(0)" ::: "memory"); __builtin_amdgcn_s_barrier(); asm volatile("" ::: "memory");
        return bad;
    }
};
struct EpiLnRes {
    static constexpr bool PERM = false, AFTER_DRAIN = true;
    const float* base; float* out; int ldc; const float* bias; PanelStats st; unsigned poison;
    __device__ __forceinline__ void fused(f32x4 (&acc)[2][2][4][2], const Unit& u, int wr, int wc, int fr, int fq, PG8_LAS unsigned char* lds, int wid, int lane) const {
        typedef float f32x2v __attribute__((ext_vector_type(2)));
        const PG8_LAS f32x2v* S = (const PG8_LAS f32x2v*)(lds + 8192);
        const int col0 = u.pn * BM + wc * 32 + 4 * fq;
#pragma unroll
        for (int bj = 0; bj < 2; ++bj)
#pragma unroll
            for (int n = 0; n < 2; ++n) { const f32x4 bv = bias ? *(const f32x4*)(bias + col0 + bj * HALF + n * 16) : (f32x4){0.f, 0.f, 0.f, 0.f};
#pragma unroll
                for (int ai = 0; ai < 2; ++ai)
#pragma unroll
                    for (int m = 0; m < 4; ++m) acc[ai][bj][m][n] += bv; }
        f32x4 pre[4][2][2];
#pragma unroll
        for (int m = 0; m < 4; ++m) { const size_t off = (size_t)(u.pm * BM + wr * 64 + m * 16 + fr) * ldc + col0;
#pragma unroll
            for (int bj = 0; bj < 2; ++bj)
#pragma unroll
                for (int n = 0; n < 2; ++n) pre[m][bj][n] = *(const f32x4*)(base + off + bj * HALF + n * 16); }
        const bool bad = st.run(acc, u, wr, wc, fr, fq, lds, wid, lane) || poison != 0u;
        const float qnan = __builtin_nanf("");
#pragma unroll
        for (int ai = 0; ai < 2; ++ai)
#pragma unroll
            for (int m = 0; m < 4; ++m) { const int r = ai * HALF + wr * 64 + m * 16 + fr; const f32x2v sr = S[r]; const size_t off = (size_t)(u.pm * BM + r) * ldc + col0;
#pragma unroll
                for (int bj = 0; bj < 2; ++bj)
#pragma unroll
                    for (int n = 0; n < 2; ++n) { const f32x4 bs = ai == 0 ? pre[m][bj][n] : *(const f32x4*)(base + off + bj * HALF + n * 16); f32x4 o = bs + (acc[ai][bj][m][n] - sr.x) * sr.y;
                        if (bad) o = (f32x4){qnan, qnan, qnan, qnan}; *(f32x4*)(out + off + bj * HALF + n * 16) = o; }
                if (m & 1) asm volatile("" ::: "memory"); }
    }
};
struct EpiLnResLn {
    static constexpr bool PERM = false, AFTER_DRAIN = true;
    const float* base; float* out; bf16_t* xn; int ldc; const float* bias; PanelStats st1, st2; unsigned poison;
    __device__ __forceinline__ void fused(f32x4 (&acc)[2][2][4][2], const Unit& u, int wr, int wc, int fr, int fq, PG8_LAS unsigned char* lds, int wid, int lane) const {
        typedef float f32x2v __attribute__((ext_vector_type(2))); typedef unsigned u32x2v __attribute__((ext_vector_type(2)));
        const PG8_LAS f32x2v* S = (const PG8_LAS f32x2v*)(lds + 8192);
        const int col0 = u.pn * BM + wc * 32 + 4 * fq;
#pragma unroll
        for (int bj = 0; bj < 2; ++bj)
#pragma unroll
            for (int n = 0; n < 2; ++n) { const f32x4 bv = bias ? *(const f32x4*)(bias + col0 + bj * HALF + n * 16) : (f32x4){0.f, 0.f, 0.f, 0.f};
#pragma unroll
                for (int ai = 0; ai < 2; ++ai)
#pragma unroll
                    for (int m = 0; m < 4; ++m) acc[ai][bj][m][n] += bv; }
        bool bad = st1.run(acc, u, wr, wc, fr, fq, lds, wid, lane) || poison != 0u;
        const float qnan = __builtin_nanf("");
#pragma unroll
        for (int ai = 0; ai < 2; ++ai)
#pragma unroll
            for (int m = 0; m < 4; ++m) { const int r = ai * HALF + wr * 64 + m * 16 + fr; const f32x2v sr = S[r]; const size_t off = (size_t)(u.pm * BM + r) * ldc + col0;
#pragma unroll
                for (int bj = 0; bj < 2; ++bj)
#pragma unroll
                    for (int n = 0; n < 2; ++n) { const f32x4 bs = *(const f32x4*)(base + off + bj * HALF + n * 16); acc[ai][bj][m][n] = bs + (acc[ai][bj][m][n] - sr.x) * sr.y; }
                asm volatile("" : "+v"(acc[ai][0][m][0]), "+v"(acc[ai][0][m][1]), "+v"(acc[ai][1][m][0]), "+v"(acc[ai][1][m][1]));
                if (m & 1) asm volatile("" ::: "memory"); }
        const bool bad1 = bad;
        bad = st2.run(acc, u, wr, wc, fr, fq, lds, wid, lane) || bad;
#pragma unroll
        for (int ai = 0; ai < 2; ++ai)
#pragma unroll
            for (int m = 0; m < 4; ++m) { const int r = ai * HALF + wr * 64 + m * 16 + fr; const f32x2v sr = S[r]; const size_t off = (size_t)(u.pm * BM + r) * ldc + col0;
#pragma unroll
                for (int bj = 0; bj < 2; ++bj)
#pragma unroll
                    for (int n = 0; n < 2; ++n) { const f32x4 x1 = acc[ai][bj][m][n]; *(f32x4*)(out + off + bj * HALF + n * 16) = bad1 ? (f32x4){qnan, qnan, qnan, qnan} : x1;
                        const f32x4 o = (x1 - sr.x) * sr.y; u32x2v w; w.x = cvt_pk_bf16(o[0], o[1]); w.y = cvt_pk_bf16(o[2], o[3]);
                        if (bad) { w.x = 0x7fc07fc0u; w.y = 0x7fc07fc0u; } *(u32x2v*)(xn + off + bj * HALF + n * 16) = w; }
                asm volatile("" ::: "memory"); }
    }
};

template <class Epi, class Sched, bool ALIGN_EPI = false, bool SP2 = false>
__device__ __forceinline__ void gemm_phase(PG8_LAS unsigned char* lds, const Gemm g, const Sched& S, const Epi& E) {
    const int tid = threadIdx.x, wid = __builtin_amdgcn_readfirstlane(tid >> 6), lane = tid & 63, wr = wid >> 2, wc = wid & 3, fr = lane & 15, fq = lane >> 4;
    const int K = g.K, nt = K / BK;
    unsigned voffA[2], voffB[2];
#pragma unroll
    for (int i = 0; i < 2; ++i) { int R, C; stage_rc(tid * 16 + i * 8192, R, C); const int Rb = Epi::PERM ? ((R & ~31) + perm32(R & 31)) : R;
        voffA[i] = (unsigned)(R * K + C) * 2u; voffB[i] = (unsigned)(Rb * K + C) * 2u; }
    const size_t kstep = (size_t)(BK * 2);
    const size_t hstep = (size_t)HALF * K * 2;
    const size_t tstep = 2 * hstep;
    const unsigned ldsw = (unsigned)wid * 1024u;
    const int aoff = lds_byte(wr * 64 + fr, fq * 8), boff = lds_byte(wc * 32 + fr, fq * 8);
#define PG8_SA(b, h) (((b) * 2 + (h)) * HTB)
#define PG8_SB(b, h) ((4 + (b) * 2 + (h)) * HTB)
#define PG8_STAGE(bufoff, gbase, voff) do { _Pragma("unroll") for (int _i = 0; _i < 2; ++_i) \
        __builtin_amdgcn_global_load_lds((const unsigned*)((const char*)(gbase) + (voff)[_i]), (PG8_LAS unsigned*)(lds + (bufoff) + ldsw + _i * 8192), 16, 0, 0); } while (0)
#define PG8_LDA(dst, b, h) do { _Pragma("unroll") for (int m = 0; m < 4; ++m) _Pragma("unroll") for (int k = 0; k < 2; ++k) dst[m][k] = *(const PG8_LAS bf16x8*)(lds + PG8_SA(b, h) + aoff + m * 2048 + k * 1024); } while (0)
#define PG8_LDB(dst, b, h) do { _Pragma("unroll") for (int n = 0; n < 2; ++n) _Pragma("unroll") for (int k = 0; k < 2; ++k) dst[n][k] = *(const PG8_LAS bf16x8*)(lds + PG8_SB(b, h) + boff + n * 2048 + k * 1024); } while (0)
#define PG8_MMA(ai, bj, At, Bt) do { __builtin_amdgcn_s_setprio(1); _Pragma("unroll") for (int m = 0; m < 4; ++m) _Pragma("unroll") for (int n = 0; n < 2; ++n) _Pragma("unroll") for (int k = 0; k < 2; ++k) \
        acc[ai][bj][m][n] = __builtin_amdgcn_mfma_f32_16x16x32_bf16(Bt[n][k], At[m][k], acc[ai][bj][m][n], 0, 0, 0); __builtin_amdgcn_s_setprio(0); } while (0)
#define PG8_WAIT_V(n) asm volatile("s_waitcnt vmcnt(" #n ")" ::: "memory")
#define PG8_WAIT_L(n) asm volatile("s_waitcnt lgkmcnt(" #n ")" ::: "memory")
#define PG8_BAR __builtin_amdgcn_s_barrier()
#define PG8_SCHED __builtin_amdgcn_sched_barrier(0)
    Unit cur, nxt; int ui = 0;
    if (!S.next(0, cur)) return;
    f32x4 acc[2][2][4][2];
#pragma unroll
    for (int a = 0; a < 2; ++a)
#pragma unroll
        for (int b = 0; b < 2; ++b)
#pragma unroll
            for (int m = 0; m < 4; ++m)
#pragma unroll
                for (int n = 0; n < 2; ++n) acc[a][b][m][n] = (f32x4){0.f, 0.f, 0.f, 0.f};
    bf16x8 At[4][2], B0[2][2], B1[2][2];
    const char* cA = (const char*)g.A + (size_t)cur.pm * tstep; const char* cB = (const char*)g.Bt + (size_t)cur.pn * tstep;
    S.a_ready(cur);
    if constexpr (SP2) {
        PG8_STAGE(PG8_SB(0, 0), cB, voffB); PG8_STAGE(PG8_SB(0, 1), cB + hstep, voffB); PG8_STAGE(PG8_SA(0, 0), cA, voffA); PG8_STAGE(PG8_SA(0, 1), cA + hstep, voffA);
        if (wr == 1) PG8_BAR;
        PG8_WAIT_V(2); PG8_BAR;
        PG8_STAGE(PG8_SB(1, 0), cB + kstep, voffB); PG8_STAGE(PG8_SA(1, 0), cA + kstep, voffA); PG8_STAGE(PG8_SB(1, 1), cB + hstep + kstep, voffB);
        PG8_WAIT_V(6); PG8_BAR;
    } else {
        PG8_STAGE(PG8_SB(0, 0), cB, voffB); PG8_STAGE(PG8_SA(0, 0), cA, voffA); PG8_STAGE(PG8_SB(0, 1), cB + hstep, voffB); PG8_STAGE(PG8_SA(0, 1), cA + hstep, voffA);
        if (wr == 1) PG8_BAR;
        PG8_WAIT_V(4); PG8_BAR;
        PG8_STAGE(PG8_SB(1, 0), cB + kstep, voffB); PG8_STAGE(PG8_SA(1, 0), cA + kstep, voffA); PG8_STAGE(PG8_SB(1, 1), cB + hstep + kstep, voffB);
        PG8_WAIT_V(6); PG8_BAR;
    }
    for (;;) {
        const bool has_next = S.next(ui + 1, nxt);
        const char* nA = has_next ? (const char*)g.A + (size_t)nxt.pm * tstep : cA; const char* nB = has_next ? (const char*)g.Bt + (size_t)nxt.pn * tstep : cB;
        for (int t = 0; t < nt; t += 2) {
            const bool last = (t == nt - 2);
            const char* a1 = cA + (size_t)(t + 1) * kstep;
            const char* a2 = last ? nA : cA + (size_t)(t + 2) * kstep; const char* b2 = last ? nB : cB + (size_t)(t + 2) * kstep;
            const char* a3 = a2 + kstep; const char* b3 = b2 + kstep;
            if (last && has_next) S.a_ready(nxt);
            if constexpr (SP2) {
            PG8_LDB(B0, 0, 0); PG8_LDB(B1, 0, 1); PG8_SCHED; PG8_LDA(At, 0, 0); PG8_STAGE(PG8_SA(1, 1), a1 + hstep, voffA);
            PG8_WAIT_V(8); PG8_WAIT_L(0); PG8_BAR; PG8_MMA(0, 0, At, B0); PG8_MMA(0, 1, At, B1); PG8_BAR; PG8_SCHED;
            PG8_LDA(At, 0, 1); PG8_STAGE(PG8_SB(0, 0), b2, voffB); PG8_STAGE(PG8_SB(0, 1), b2 + hstep, voffB); PG8_STAGE(PG8_SA(0, 0), a2, voffA);
            PG8_WAIT_V(8); PG8_WAIT_L(0); PG8_BAR; PG8_MMA(1, 0, At, B0); PG8_MMA(1, 1, At, B1); PG8_BAR; PG8_SCHED;
            PG8_LDB(B0, 1, 0); PG8_LDB(B1, 1, 1); PG8_SCHED; PG8_LDA(At, 1, 0); PG8_STAGE(PG8_SA(0, 1), a2 + hstep, voffA);
            PG8_WAIT_V(8); PG8_WAIT_L(0); PG8_BAR; PG8_MMA(0, 0, At, B0); PG8_MMA(0, 1, At, B1); PG8_BAR; PG8_SCHED;
            PG8_LDA(At, 1, 1); PG8_STAGE(PG8_SB(1, 0), b3, voffB); PG8_STAGE(PG8_SB(1, 1), b3 + hstep, voffB); PG8_STAGE(PG8_SA(1, 0), a3, voffA);
            PG8_WAIT_V(8); PG8_WAIT_L(0); PG8_BAR; PG8_MMA(1, 0, At, B0); PG8_MMA(1, 1, At, B1); PG8_BAR; PG8_SCHED;
            } else {
            PG8_LDB(B0, 0, 0); PG8_SCHED; PG8_LDA(At, 0, 0); PG8_STAGE(PG8_SA(1, 1), a1 + hstep, voffA);
            PG8_WAIT_L(8); PG8_BAR; PG8_WAIT_L(0); PG8_MMA(0, 0, At, B0); PG8_BAR; PG8_SCHED;
            PG8_LDB(B1, 0, 1); PG8_STAGE(PG8_SB(0, 0), b2, voffB);
            PG8_BAR; PG8_WAIT_L(0); PG8_MMA(0, 1, At, B1); PG8_BAR;
            PG8_LDA(At, 0, 1); PG8_STAGE(PG8_SA(0, 0), a2, voffA);
            PG8_BAR; PG8_WAIT_L(0); PG8_MMA(1, 0, At, B0); PG8_BAR; PG8_SCHED;
            PG8_STAGE(PG8_SB(0, 1), b2 + hstep, voffB);
            PG8_WAIT_V(6); PG8_BAR; PG8_MMA(1, 1, At, B1); PG8_BAR;
            PG8_LDB(B0, 1, 0); PG8_SCHED; PG8_LDA(At, 1, 0); PG8_STAGE(PG8_SA(0, 1), a2 + hstep, voffA);
            PG8_WAIT_L(8); PG8_BAR; PG8_WAIT_L(0); PG8_MMA(0, 0, At, B0); PG8_BAR; PG8_SCHED;
            PG8_LDB(B1, 1, 1); PG8_STAGE(PG8_SB(1, 0), b3, voffB);
            PG8_BAR; PG8_WAIT_L(0); PG8_MMA(0, 1, At, B1); PG8_BAR;
            PG8_LDA(At, 1, 1); PG8_STAGE(PG8_SA(1, 0), a3, voffA);
            PG8_BAR; PG8_WAIT_L(0); PG8_MMA(1, 0, At, B0); PG8_BAR; PG8_SCHED;
            PG8_STAGE(PG8_SB(1, 1), b3 + hstep, voffB);
            PG8_WAIT_V(6); PG8_BAR; PG8_MMA(1, 1, At, B1); PG8_BAR;
            }
        }
        if constexpr (ALIGN_EPI) { if (wr == 0) PG8_BAR; }
        if constexpr (!Epi::AFTER_DRAIN) { E(acc, cur, wr, wc, fr, fq); S.done(cur); }
        if (!has_next) break;
#pragma unroll
        for (int a = 0; a < 2; ++a)
#pragma unroll
            for (int b = 0; b < 2; ++b)
#pragma unroll
                for (int m = 0; m < 4; ++m)
#pragma unroll
                    for (int n = 0; n < 2; ++n) acc[a][b][m][n] = (f32x4){0.f, 0.f, 0.f, 0.f};
        cur = nxt; cA = nA; cB = nB; ++ui;
        if constexpr (ALIGN_EPI) { if (wr == 1) PG8_BAR; }
    }
    PG8_WAIT_V(0);
    if constexpr (!ALIGN_EPI) { if (wr == 0) PG8_BAR; }
    PG8_BAR;
    if constexpr (Epi::AFTER_DRAIN) { E.fused(acc, cur, wr, wc, fr, fq, lds, wid, lane); S.done(cur); }
#undef PG8_SA
#undef PG8_SB
#undef PG8_STAGE
#undef PG8_LDA
#undef PG8_LDB
#undef PG8_MMA
#undef PG8_WAIT_V
#undef PG8_WAIT_L
#undef PG8_BAR
#undef PG8_SCHED
}
}
#define LAS __attribute__((address_space(3)))
typedef float f32x4 __attribute__((ext_vector_type(4)));
struct Ctx { int tid, lane, wave, bid, nb, gw, ngw; unsigned char* lds; };

namespace nv {
__device__ __forceinline__ void d_cvt_bf16(const Ctx& c, const float* __restrict__ in, bf16* __restrict__ out, size_t n4) {
    for (size_t i = (size_t)c.bid * 512 + c.tid; i < n4; i += (size_t)c.nb * 512) { f32x4 v = ((const f32x4*)in)[i]; uint2 o; o.x = pk2bf(v.x, v.y); o.y = pk2bf(v.z, v.w); ((uint2*)out)[i] = o; }
}
__device__ __forceinline__ void d_transpose_w(const Ctx& c, const float* __restrict__ W, int K, int N, int Npad, bf16* __restrict__ WT) {
    float* t = (float*)(c.lds) + c.wave * (32 * 33);
    const int tx = c.lane & 31, ty = c.lane >> 5, nbn = Npad / 32, ntile = nbn * (K / 32);
    for (int it = c.gw; it < ntile; it += c.ngw) {
        const int n0 = (it % nbn) * 32, k0 = (it / nbn) * 32;
        for (int i = ty; i < 32; i += 2) { const int n = n0 + tx; t[i * 33 + tx] = (n < N) ? W[(size_t)(k0 + i) * N + n] : 0.f; }
        __builtin_amdgcn_fence(__ATOMIC_RELEASE, "workgroup"); __builtin_amdgcn_wave_barrier();
        for (int i = ty; i < 32; i += 2) WT[(size_t)(n0 + i) * K + k0 + tx] = f2bf(t[tx * 33 + i]);
        __builtin_amdgcn_fence(__ATOMIC_RELEASE, "workgroup"); __builtin_amdgcn_wave_barrier();
    }
}
__device__ __forceinline__ void d_rope_table(const Ctx& c, float2* __restrict__ tab) {
    for (int id = c.bid * 512 + c.tid; id < SEQ * 32; id += c.nb * 512) {
        const int pos = id >> 5, i = id & 31;
        const float inv = (float)pow(10000.0, -(double)i / 32.0);
        const float ang = (float)pos * inv;
        tab[id] = make_float2((float)cos((double)ang), (float)sin((double)ang));
    }
}
__device__ __forceinline__ void d_rotary(const Ctx& c, const bf16* __restrict__ proj, const float2* __restrict__ tab, bf16* __restrict__ qr, bf16* __restrict__ kr) {
    for (size_t id = (size_t)c.bid * 512 + c.tid; id < (size_t)NTOK * 320; id += (size_t)c.nb * 512) {
        const int d = id & 31, hh = (id >> 5) % 10; const size_t t = id / 320; const int pos = (int)(t % SEQ);
        const float2 cs = tab[pos * 32 + d];
        const bf16* src = proj + t * IN_PAD + hh * 64;
        const float t1 = bf2f(src[d]), t2 = bf2f(src[d + 32]);
        const float o1 = t1 * cs.x - t2 * cs.y, o2 = t2 * cs.x + t1 * cs.y;
        bf16* dst = (hh < 8) ? (qr + t * 512 + hh * 64) : (kr + t * 128 + (hh - 8) * 64);
        dst[d] = f2bf(o1); dst[d + 32] = f2bf(o2);
    }
}
__device__ __forceinline__ void d_attn(const Ctx& c, const bf16* __restrict__ qr, const bf16* __restrict__ kr, const bf16* __restrict__ proj, const float* __restrict__ sink, bf16* __restrict__ mix) {
    for (int id = c.bid * 512 + c.tid; id < NTOK * 8; id += c.nb * 512) {
        const int hq = id & 7, t = id >> 3, b = t / SEQ, i = t % SEQ, kvh = hq >> 2;
        float q[64], acc[64];
#pragma unroll
        for (int d = 0; d < 64; ++d) { q[d] = bf2f(qr[(size_t)t * 512 + hq * 64 + d]) * 0.125f; acc[d] = 0.f; }
        float m = sink[hq], l = 1.f;
        const int j0 = max(0, i - 128), j1 = min(SEQ - 1, i + 128);
        for (int j = j0; j <= j1; ++j) {
            const size_t tj = (size_t)b * SEQ + j;
            const uint4* kp = (const uint4*)(kr + tj * 128 + kvh * 64);
            float s = 0.f;
#pragma unroll
            for (int cc = 0; cc < 8; ++cc) { const uint4 w = kp[cc]; const unsigned ww[4] = {w.x, w.y, w.z, w.w};
#pragma unroll
                for (int e = 0; e < 4; ++e) { s += q[cc * 8 + 2 * e] * __uint_as_float(ww[e] << 16) + q[cc * 8 + 2 * e + 1] * __uint_as_float(ww[e] & 0xffff0000u); } }
            if (s > m) { const float f = __expf(m - s); l *= f;
#pragma unroll
                for (int d = 0; d < 64; ++d) acc[d] *= f;
                m = s; }
            const float p = __expf(s - m); l += p;
            const uint4* vp = (const uint4*)(proj + tj * IN_PAD + C_V + kvh * 64);
#pragma unroll
            for (int cc = 0; cc < 8; ++cc) { const uint4 w = vp[cc]; const unsigned ww[4] = {w.x, w.y, w.z, w.w};
#pragma unroll
                for (int e = 0; e < 4; ++e) { acc[cc * 8 + 2 * e] += p * __uint_as_float(ww[e] << 16); acc[cc * 8 + 2 * e + 1] += p * __uint_as_float(ww[e] & 0xffff0000u); } }
        }
        const float il = 1.f / l;
#pragma unroll
        for (int d = 0; d < 64; d += 2) *(unsigned*)(mix + (size_t)t * DM + hq * 64 + d) = pk2bf(acc[d] * il, acc[d + 1] * il);
    }
}
__device__ __forceinline__ void d_scan(const Ctx& c, const bf16* __restrict__ proj, const float* __restrict__ mu_prev, const float* __restrict__ mu_next,
                                       const float* __restrict__ w0, const float* __restrict__ w2, const float* __restrict__ a0, const float* __restrict__ a2,
                                       const float* __restrict__ k_k, const float* __restrict__ k_a, float* __restrict__ ydir) {
    if (c.wave != 0) return;
    for (int unit = c.bid; unit < 128; unit += c.nb) {
    const int b = unit >> 4, h = (unit >> 1) & 7, d = unit & 1, lane = c.lane, ch = h * 64 + lane;
    float (*sh)[64] = (float (*)[64])c.lds;
    const int colx = lane < 32 ? (P_WD + d * 32 + lane) : (P_AD + d * 32 + lane - 32);
    const int cols[4] = {P_R + ch, P_KK + ch, P_VV + ch, colx};
    float mp[4], mn[4];
#pragma unroll
    for (int q = 0; q < 4; ++q) { mp[q] = mu_prev[cols[q]]; mn[q] = mu_next[cols[q]]; }
    float* w2c = (float*)c.lds + 6 * 64 + lane; float* a2c = w2c + 32 * 64;
    for (int j = 0; j < 32; ++j) { w2c[j * 64] = w2[(size_t)(d * 32 + j) * 512 + ch]; a2c[j * 64] = a2[(size_t)(d * 32 + j) * 512 + ch]; }
    const float w0c = w0[d * 512 + ch], a0c = a0[d * 512 + ch], kkc = k_k[ch], kac = k_a[ch];
    float S[64];
#pragma unroll
    for (int k = 0; k < 64; ++k) S[k] = 0.f;
    const int sgn = d ? -1 : 1; int t = d ? SEQ - 1 : 0;
    const bf16* pb = proj + (size_t)b * SEQ * IN_PAD + C_P;
    float behind[4], cur[4], ahead[4];
#pragma unroll
    for (int q = 0; q < 4; ++q) { behind[q] = 0.f; cur[q] = bf2f(pb[(size_t)t * IN_PAD + cols[q]]); ahead[q] = bf2f(pb[(size_t)(t + sgn) * IN_PAD + cols[q]]); }
    for (int step = 0; step < SEQ; ++step, t += sgn) {
        float ahead2[4]; const int t2 = t + 2 * sgn; const bool ok2 = (t2 >= 0 && t2 < SEQ);
#pragma unroll
        for (int q = 0; q < 4; ++q) ahead2[q] = ok2 ? bf2f(pb[(size_t)t2 * IN_PAD + cols[q]]) : 0.f;
        float sv[4];
#pragma unroll
        for (int q = 0; q < 4; ++q) { const float prv = d ? ahead[q] : behind[q], nxt = d ? behind[q] : ahead[q]; sv[q] = cur[q] + mp[q] * (prv - cur[q]) + mn[q] * (nxt - cur[q]); }
        const float r = sv[0], k = sv[1], v = sv[2];
        sh[5][lane] = lane < 32 ? tanhf(sv[3]) : sv[3];
        __builtin_amdgcn_fence(__ATOMIC_RELEASE, "workgroup"); __builtin_amdgcn_wave_barrier();
        float ws = w0c, as = a0c;
#pragma unroll
        for (int j = 0; j < 32; ++j) { ws += sh[5][j] * w2c[j * 64]; as += sh[5][32 + j] * a2c[j * 64]; }
        const float nsp = -ws; const float sp = (nsp > 20.f) ? nsp : log1pf(__expf(nsp));
        const float wlog = -sp - 0.5f; const float decay = __expf(-__expf(wlog));
        const float a = sigmoidf_(as);
        float kk = k * kkc; const float ss = wave_sum(kk * kk); kk = kk * rsqrtf(fmaxf(ss, 1e-24f));
        const float kd = k * (1.f + (a - 1.f) * kac);
        sh[0][lane] = decay; sh[1][lane] = kk * a; sh[2][lane] = kd; sh[3][lane] = r; sh[4][lane] = kk;
        __builtin_amdgcn_fence(__ATOMIC_RELEASE, "workgroup"); __builtin_amdgcn_wave_barrier();
        float sa = 0.f;
#pragma unroll
        for (int q = 0; q < 64; ++q) sa -= S[q] * sh[4][q];
        float y = 0.f;
#pragma unroll
        for (int q = 0; q < 64; ++q) { S[q] = S[q] * sh[0][q] + sa * sh[1][q] + v * sh[2][q]; y += S[q] * sh[3][q]; }
        ydir[((size_t)d * NTOK + (size_t)b * SEQ + t) * 512 + ch] = y;
        __builtin_amdgcn_fence(__ATOMIC_RELEASE, "workgroup"); __builtin_amdgcn_wave_barrier();
#pragma unroll
        for (int q = 0; q < 4; ++q) { behind[q] = cur[q]; cur[q] = ahead[q]; ahead[q] = ahead2[q]; }
    }
    }
}
__device__ __forceinline__ void d_rwkv_out(const Ctx& c, const bf16* __restrict__ proj, const float* __restrict__ ydir, const float* __restrict__ mu_prev, const float* __restrict__ mu_next,
                                           const float* __restrict__ a0, const float* __restrict__ a2, const float* __restrict__ g2, const float* __restrict__ k_a, const float* __restrict__ r_k,
                                           const float* __restrict__ lnx_g, const float* __restrict__ lnx_b, bf16* __restrict__ mix) {
    float* sad = (float*)c.lds; float* sgd = sad + 64; const int ch = c.tid;
    const float mpr = mu_prev[P_R + ch], mnr = mu_next[P_R + ch], mpk = mu_prev[P_KK + ch], mnk = mu_next[P_KK + ch], mpv = mu_prev[P_VV + ch], mnv = mu_next[P_VV + ch];
    const int cx = (ch < 64) ? (P_AD + ch) : (ch < 160 ? P_GD + ch - 64 : 0); const float mpx = mu_prev[cx], mnx = mu_next[cx];
    for (int t = c.bid; t < NTOK; t += c.nb) {
        const int i = t % SEQ; const bf16* p0 = proj + (size_t)t * IN_PAD + C_P;
        const bool hp = i > 0, hn = i < SEQ - 1;
#define SHF(col, mp_, mn_) ({ const float c_ = bf2f(p0[col]); const float pv_ = hp ? bf2f(p0[(col) - IN_PAD]) : 0.f, nx_ = hn ? bf2f(p0[(col) + IN_PAD]) : 0.f; c_ + (mp_) * (pv_ - c_) + (mn_) * (nx_ - c_); })
        if (ch < 64) sad[ch] = SHF(cx, mpx, mnx);
        else if (ch < 160) sgd[ch - 64] = sigmoidf_(SHF(cx, mpx, mnx));
        const float r = SHF(P_R + ch, mpr, mnr), k = SHF(P_KK + ch, mpk, mnk), v = SHF(P_VV + ch, mpv, mnv);
#undef SHF
        __syncthreads();
        asm volatile("" ::: "memory");
        float as0 = a0[ch], as1 = a0[512 + ch];
#pragma unroll 4
        for (int j = 0; j < 32; ++j) { as0 += sad[j] * a2[(size_t)j * 512 + ch]; as1 += sad[32 + j] * a2[(size_t)(32 + j) * 512 + ch]; }
        const float am = 0.5f * (sigmoidf_(as0) + sigmoidf_(as1));
        float g = 0.f;
#pragma unroll 4
        for (int j = 0; j < 96; ++j) g += sgd[j] * g2[(size_t)j * 512 + ch];
        const float y = ydir[(size_t)t * 512 + ch] + ydir[((size_t)NTOK + t) * 512 + ch];
        const float mu = wave_sum(y) * (1.f / 64.f); const float dy = y - mu; const float var = wave_sum(dy * dy) * (1.f / 64.f);
        const float yn = dy * rsqrtf(var + GN_EPS) * lnx_g[ch] + lnx_b[ch];
        const float kmean = k * (1.f + (am - 1.f) * k_a[ch]);
        const float bonus = wave_sum(r * kmean * r_k[ch]) * v;
        mix[(size_t)t * DM + 512 + ch] = f2bf((yn + bonus) * g);
        __syncthreads();
    }
}
__device__ __forceinline__ void d_ln1(const Ctx& c, const float* y1, const float* __restrict__ g, const float* __restrict__ bta, float* h1f, bf16* __restrict__ h1b) {
    for (int row = c.gw; row < NTOK; row += c.ngw) {
        const int lane = c.lane;
        const f32x4* xr = (const f32x4*)(y1 + (size_t)row * DM) + lane;
        f32x4 v[4]; float s = 0.f;
#pragma unroll
        for (int j = 0; j < 4; ++j) { v[j] = xr[64 * j]; s += (v[j].x + v[j].y) + (v[j].z + v[j].w); }
        const float mean = wave_sum(s) * (1.f / DM); float s2 = 0.f;
#pragma unroll
        for (int j = 0; j < 4; ++j) { v[j] = v[j] - mean; s2 += (v[j].x * v[j].x + v[j].y * v[j].y) + (v[j].z * v[j].z + v[j].w * v[j].w); }
        const float rstd = rsqrtf(wave_sum(s2) * (1.f / DM) + LN_EPS);
#pragma unroll
        for (int j = 0; j < 4; ++j) { const f32x4 gg = ((const f32x4*)g)[64 * j + lane], bb = ((const f32x4*)bta)[64 * j + lane];
            const f32x4 o = v[j] * rstd * gg + bb;
            ((f32x4*)(h1f + (size_t)row * DM))[64 * j + lane] = o;
            uint2 w; w.x = pk2bf(o.x, o.y); w.y = pk2bf(o.z, o.w); ((uint2*)(h1b + (size_t)row * DM))[64 * j + lane] = w; }
    }
}
__device__ __forceinline__ void d_peer_topk(const Ctx& c, const bf16* __restrict__ qb, const float* __restrict__ keys, int* __restrict__ idx, float* __restrict__ gate) {
    float* keysT = (float*)c.lds; float* sq = keysT + 2 * 128 * 128; float* sc = sq + 256; float* s12 = sc + 256; int* i12 = (int*)(s12 + 32);
    const int tid = c.tid, lane = c.lane, wave = c.wave;
    for (int item = c.bid; item < 8 * 64; item += c.nb) {
        const int h = item & 7, grp = item >> 3;
        __syncthreads();
        for (int e = tid; e < 2 * 128 * 128; e += 512) { const int p = e >> 14, n = (e >> 7) & 127, cc = e & 127; keysT[(p * 128 + cc) * 128 + n] = keys[(size_t)h * 32768 + e]; }
        __syncthreads();
        for (int tt = 0; tt < 512; ++tt) {
            const size_t t = (size_t)grp * 512 + tt;
            if (tid < 256) sq[tid] = bf2f(qb[t * PEER_Q + h * 256 + tid]);
            __syncthreads();
            if (tid < 256) { const int p = tid >> 7, n = tid & 127; float s = 0.f; const float* kt = keysT + p * 16384 + n; const float* qq = sq + p * 128;
                for (int cc = 0; cc < 128; ++cc) s += qq[cc] * kt[cc * 128];
                sc[tid] = s; }
            __syncthreads();
            if (wave < 2) {
                float v0 = sc[wave * 128 + lane], v1 = sc[wave * 128 + 64 + lane];
                for (int r = 0; r < 16; ++r) {
                    float bv; int bi; if (v1 > v0) { bv = v1; bi = lane + 64; } else { bv = v0; bi = lane; }
#pragma unroll
                    for (int o = 1; o < 64; o <<= 1) { const float ov = __shfl_xor(bv, o); const int oi = __shfl_xor(bi, o); if (ov > bv || (ov == bv && oi < bi)) { bv = ov; bi = oi; } }
                    if (lane == 0) { s12[wave * 16 + r] = bv; i12[wave * 16 + r] = bi; }
                    if (bi == lane) v0 = -INFINITY; if (bi == lane + 64) v1 = -INFINITY;
                }
            }
            __syncthreads();
            if (wave == 0) {
                float cv[4];
#pragma unroll
                for (int j = 0; j < 4; ++j) { const int f = lane + 64 * j; cv[j] = s12[f >> 4] + s12[16 + (f & 15)]; }
                float mycs = 0.f; int myid = 0;
                for (int r = 0; r < 16; ++r) {
                    float bv = cv[0]; int bi = lane;
#pragma unroll
                    for (int j = 1; j < 4; ++j) if (cv[j] > bv) { bv = cv[j]; bi = lane + 64 * j; }
#pragma unroll
                    for (int o = 1; o < 64; o <<= 1) { const float ov = __shfl_xor(bv, o); const int oi = __shfl_xor(bi, o); if (ov > bv || (ov == bv && oi < bi)) { bv = ov; bi = oi; } }
                    if (lane == r) { mycs = bv; myid = i12[bi >> 4] * 128 + i12[16 + (bi & 15)]; }
#pragma unroll
                    for (int j = 0; j < 4; ++j) if (bi == lane + 64 * j) cv[j] = -INFINITY;
                }
                float mx = (lane < 16) ? mycs : -INFINITY;
#pragma unroll
                for (int o = 1; o < 64; o <<= 1) mx = fmaxf(mx, __shfl_xor(mx, o));
                const float e = (lane < 16) ? __expf(mycs - mx) : 0.f; const float den = wave_sum(e);
                if (lane < 16) { idx[t * 128 + h * 16 + lane] = myid; gate[t * 128 + h * 16 + lane] = e / den; }
            }
            __syncthreads();
        }
    }
}
__device__ __forceinline__ void d_peer_gather(const Ctx& c, const float* __restrict__ h1f, const int* __restrict__ idx, const float* __restrict__ gate, const float* __restrict__ u, const float* __restrict__ v,
                                              const float* __restrict__ g, const float* __restrict__ bta, float* __restrict__ out) {
    const int lane = c.lane;
    for (int t = c.gw; t < NTOK; t += c.ngw) {
        f32x4 hv[4], f[4];
#pragma unroll
        for (int j = 0; j < 4; ++j) { hv[j] = ((const f32x4*)(h1f + (size_t)t * DM))[64 * j + lane]; f[j] = (f32x4){0.f, 0.f, 0.f, 0.f}; }
        for (int e = 0; e < 128; ++e) {
            const int id = idx[(size_t)t * 128 + e]; const float gt = gate[(size_t)t * 128 + e];
            const f32x4* ur = (const f32x4*)(u + (size_t)id * DM); const f32x4* vr = (const f32x4*)(v + (size_t)id * DM);
            float z = 0.f;
#pragma unroll
            for (int j = 0; j < 4; ++j) { const f32x4 w = ur[64 * j + lane]; z += (w.x * hv[j].x + w.y * hv[j].y) + (w.z * hv[j].z + w.w * hv[j].w); }
            z = wave_sum(z);
            const float act = gt * 0.5f * z * (1.f + erff(z * 0.70710678118654752f));
#pragma unroll
            for (int j = 0; j < 4; ++j) { const f32x4 w = vr[64 * j + lane]; f[j] += act * w; }
        }
        float s = 0.f;
#pragma unroll
        for (int j = 0; j < 4; ++j) { f[j] = DN_ALPHA * hv[j] + f[j]; s += (f[j].x + f[j].y) + (f[j].z + f[j].w); }
        const float mean = wave_sum(s) * (1.f / DM); float s2 = 0.f;
#pragma unroll
        for (int j = 0; j < 4; ++j) { f[j] = f[j] - mean; s2 += (f[j].x * f[j].x + f[j].y * f[j].y) + (f[j].z * f[j].z + f[j].w * f[j].w); }
        const float rstd = rsqrtf(wave_sum(s2) * (1.f / DM) + LN_EPS);
#pragma unroll
        for (int j = 0; j < 4; ++j) { const f32x4 gg = ((const f32x4*)g)[64 * j + lane], bb = ((const f32x4*)bta)[64 * j + lane];
            ((f32x4*)(out + (size_t)t * DM))[64 * j + lane] = f[j] * rstd * gg + bb; }
    }
}
}
namespace pe {
typedef __bf16 bf16x2_t __attribute__((ext_vector_type(2)));
__device__ __forceinline__ float dot2(unsigned a, unsigned b, float c) { return __builtin_amdgcn_fdot2_f32_bf16(__builtin_bit_cast(bf16x2_t, a), __builtin_bit_cast(bf16x2_t, b), c, false); }
__device__ __forceinline__ float gelu_erf(float z) { return 0.5f * z * (1.f + erff(z * 0.70710678118654752f)); }
constexpr int GE = 4;
struct Rows { uint4 a[GE], b[GE]; };
__device__ __forceinline__ void load_rows(Rows& r, const bf16* __restrict__ tab, int i0, int i1, int lane, int g) {
#pragma unroll
    for (int j = 0; j < GE; ++j) { const int e = g * GE + j; const int id = __builtin_amdgcn_readlane((e & 64) ? i1 : i0, e & 63);
        const uint4* p = (const uint4*)(tab + (size_t)id * DM) + lane; r.a[j] = p[0]; r.b[j] = p[64]; }
}
__device__ __forceinline__ void d_peer_gather(const Ctx& c, const bf16* __restrict__ h1b, const int* __restrict__ idx, const float* __restrict__ gate, const bf16* __restrict__ ub, const bf16* __restrict__ vb,
                                              const float* __restrict__ g, const float* __restrict__ bta, float* __restrict__ out) {
    const int lane = c.lane;
    for (int t = c.gw; t < NTOK; t += c.ngw) {
        const uint4* hp = (const uint4*)(h1b + (size_t)t * DM) + lane; const uint4 h0 = hp[0], h1 = hp[64];
        const unsigned hw[8] = {h0.x, h0.y, h0.z, h0.w, h1.x, h1.y, h1.z, h1.w};
        const int i0 = idx[(size_t)t * 128 + lane], i1 = idx[(size_t)t * 128 + 64 + lane];
        const float g0 = gate[(size_t)t * 128 + lane], g1 = gate[(size_t)t * 128 + 64 + lane];
        float f[16];
#pragma unroll
        for (int i = 0; i < 16; ++i) f[i] = 0.f;
        Rows U, V, Un;
        load_rows(U, ub, i0, i1, lane, 0);
        for (int grp = 0; grp < 128 / GE; ++grp) {
            load_rows(V, vb, i0, i1, lane, grp);
            if (grp + 1 < 128 / GE) load_rows(Un, ub, i0, i1, lane, grp + 1);
            float z[GE];
#pragma unroll
            for (int j = 0; j < GE; ++j) { const unsigned uw[8] = {U.a[j].x, U.a[j].y, U.a[j].z, U.a[j].w, U.b[j].x, U.b[j].y, U.b[j].z, U.b[j].w}; float s = 0.f;
#pragma unroll
                for (int i = 0; i < 8; ++i) s = dot2(uw[i], hw[i], s);
                z[j] = s; }
            { const bool b0 = lane & 1; float k0 = b0 ? z[1] : z[0], s0 = b0 ? z[0] : z[1], k1 = b0 ? z[3] : z[2], s1 = b0 ? z[2] : z[3];
              k0 += __shfl_xor(s0, 1); k1 += __shfl_xor(s1, 1);
              const bool b1 = lane & 2; float kk = b1 ? k1 : k0, ss = b1 ? k0 : k1; kk += __shfl_xor(ss, 2);
              kk += __shfl_xor(kk, 4); kk += __shfl_xor(kk, 8); kk += __shfl_xor(kk, 16); kk += __shfl_xor(kk, 32);
              z[0] = kk; }
            const int e_me = grp * GE + (lane & 3);
            const float gt = __shfl((e_me & 64) ? g1 : g0, e_me & 63);
            const float act = gt * gelu_erf(z[0]);
            const unsigned actb = (unsigned)f2bf(act);
#pragma unroll
            for (int j = 0; j < GE; ++j) { const unsigned alo = __builtin_amdgcn_readlane(actb, j), ahi = alo << 16;
                const unsigned vw[8] = {V.a[j].x, V.a[j].y, V.a[j].z, V.a[j].w, V.b[j].x, V.b[j].y, V.b[j].z, V.b[j].w};
#pragma unroll
                for (int i = 0; i < 8; ++i) { f[2 * i] = dot2(vw[i], alo, f[2 * i]); f[2 * i + 1] = dot2(vw[i], ahi, f[2 * i + 1]); } }
            U = Un;
        }
        float s = 0.f;
#pragma unroll
        for (int i = 0; i < 8; ++i) { f[2 * i] += DN_ALPHA * __uint_as_float(hw[i] << 16); f[2 * i + 1] += DN_ALPHA * __uint_as_float(hw[i] & 0xffff0000u); s += f[2 * i] + f[2 * i + 1]; }
        const float mean = wave_sum(s) * (1.f / DM); float s2 = 0.f;
#pragma unroll
        for (int i = 0; i < 16; ++i) { f[i] -= mean; s2 += f[i] * f[i]; }
        const float rstd = rsqrtf(wave_sum(s2) * (1.f / DM) + LN_EPS);
#pragma unroll
        for (int hh = 0; hh < 2; ++hh) {
            const int e0 = hh * 512 + 8 * lane;
            const f32x4 ga = *(const f32x4*)(g + e0), gb = *(const f32x4*)(g + e0 + 4), ba = *(const f32x4*)(bta + e0), bb = *(const f32x4*)(bta + e0 + 4);
            f32x4 oa, ob;
            oa.x = f[hh * 8 + 0] * rstd * ga.x + ba.x; oa.y = f[hh * 8 + 1] * rstd * ga.y + ba.y; oa.z = f[hh * 8 + 2] * rstd * ga.z + ba.z; oa.w = f[hh * 8 + 3] * rstd * ga.w + ba.w;
            ob.x = f[hh * 8 + 4] * rstd * gb.x + bb.x; ob.y = f[hh * 8 + 5] * rstd * gb.y + bb.y; ob.z = f[hh * 8 + 6] * rstd * gb.z + bb.z; ob.w = f[hh * 8 + 7] * rstd * gb.w + bb.w;
            *(f32x4*)(out + (size_t)t * DM + e0) = oa; *(f32x4*)(out + (size_t)t * DM + e0 + 4) = ob;
        }
    }
}
}
namespace pg8 {
struct EpiResF32 {
    static constexpr bool PERM = false, AFTER_DRAIN = false;
    const float* base; float* out; int ldc; float alpha;
    __device__ __forceinline__ void operator()(const f32x4 (&acc)[2][2][4][2], const Unit& u, int wr, int wc, int fr, int fq) const {
        const int col0 = u.pn * BM + wc * 32 + 4 * fq;
#pragma unroll
        for (int ai = 0; ai < 2; ++ai)
#pragma unroll
            for (int m = 0; m < 4; ++m) { const int r = ai * HALF + wr * 64 + m * 16 + fr; const size_t off = (size_t)(u.pm * BM + r) * ldc + col0;
#pragma unroll
                for (int bj = 0; bj < 2; ++bj)
#pragma unroll
                    for (int n = 0; n < 2; ++n) { const f32x4 bs = *(const f32x4*)(base + off + bj * HALF + n * 16); *(f32x4*)(out + off + bj * HALF + n * 16) = bs * alpha + acc[ai][bj][m][n]; } }
    }
};
}
constexpr size_t MiB = 1u << 20;
constexpr int LDS_BYTES = 147456;
constexpr int NPHASE = 11;
struct Params { const float* in[24]; float* out; unsigned char* ws; int ph_lo, ph_hi; };

__global__ void __launch_bounds__(512, 2) mega(Params p) {
    extern __shared__ __attribute__((aligned(16))) unsigned char lds[];
    cg::grid_group grid = cg::this_grid();
    Ctx c; c.tid = threadIdx.x; c.lane = c.tid & 63; c.wave = __builtin_amdgcn_readfirstlane(c.tid >> 6); c.bid = blockIdx.x; c.nb = gridDim.x; c.gw = c.bid * 8 + c.wave; c.ngw = c.nb * 8; c.lds = lds;
    const float* x = p.in[0]; const float* w_in = p.in[1]; const float* mu_prev = p.in[2]; const float* mu_next = p.in[3];
    const float* w0 = p.in[4]; const float* w2 = p.in[5]; const float* a0 = p.in[6]; const float* a2 = p.in[7];
    const float* g2 = p.in[8]; const float* k_k = p.in[9]; const float* k_a = p.in[10]; const float* r_k = p.in[11];
    const float* lnx_g = p.in[12]; const float* lnx_b = p.in[13]; const float* sink = p.in[14]; const float* w_out = p.in[15];
    const float* ln1_g = p.in[16]; const float* ln1_b = p.in[17]; const float* wq = p.in[18]; const float* keys = p.in[19];
    const float* pu = p.in[20]; const float* pv = p.in[21]; const float* ln2_g = p.in[22]; const float* ln2_b = p.in[23];
    float* out = p.out; unsigned char* ws = p.ws;
    float2* rope = (float2*)(ws + 1 * MiB);
    bf16* w_in_t = (bf16*)(ws + 4 * MiB); bf16* w_out_t = (bf16*)(ws + 10 * MiB); bf16* wq_t = (bf16*)(ws + 12 * MiB);
    bf16* xb = (bf16*)(ws + 16 * MiB); bf16* qr = (bf16*)(ws + 16 * MiB); bf16* kr = (bf16*)(ws + 48 * MiB);
    bf16* proj = (bf16*)(ws + 80 * MiB); float* y1 = (float*)(ws + 80 * MiB); int* idx = (int*)(ws + 208 * MiB); float* gate = (float*)(ws + 224 * MiB);
    bf16* mix = (bf16*)(ws + 240 * MiB); float* ydir = (float*)(ws + 304 * MiB); bf16* qb = (bf16*)(ws + 304 * MiB); bf16* h1b = (bf16*)(ws + 432 * MiB); bf16* ub = (bf16*)(ws + 16 * MiB); bf16* vb = (bf16*)(ws + 48 * MiB);
    const int lo = p.ph_lo, hi = p.ph_hi;
#ifndef PH_MASK
#define PH_MASK 0xFFFF
#endif
#define IN(k) (((PH_MASK >> (k)) & 1) && lo <= (k) && (k) < hi)
#define SEAM(k) do { if (IN(k) && IN((k) + 1)) grid.sync(); } while (0)
    if (IN(0)) {
        nv::d_cvt_bf16(c, x, xb, (size_t)NTOK * DM / 4);
        nv::d_transpose_w(c, w_in, DM, IN_COLS, IN_PAD, w_in_t);
        nv::d_transpose_w(c, w_out, DM, DM, DM, w_out_t);
        nv::d_transpose_w(c, wq, DM, PEER_Q, PEER_Q, wq_t);
        nv::d_rope_table(c, rope);
    }
    SEAM(0);
    if (IN(1)) { pg8::Gemm g{xb, w_in_t, NTOK, IN_PAD, DM}; pg8::StaticOrder S; S.init(NTOK, IN_PAD, c.nb, c.bid); pg8::EpiBf16<0> E{proj, IN_PAD, nullptr, 0, 0, 1.f};
        pg8::gemm_phase<pg8::EpiBf16<0>, pg8::StaticOrder, true, true>((PG8_LAS unsigned char*)lds, g, S, E); }
    SEAM(1);
    if (IN(2)) nv::d_rotary(c, proj, rope, qr, kr);
    SEAM(2);
    if (IN(3)) nv::d_attn(c, qr, kr, proj, sink, mix);
    SEAM(3);
    if (IN(4)) nv::d_scan(c, proj, mu_prev, mu_next, w0, w2, a0, a2, k_k, k_a, ydir);
    SEAM(4);
    if (IN(5)) nv::d_rwkv_out(c, proj, ydir, mu_prev, mu_next, a0, a2, g2, k_a, r_k, lnx_g, lnx_b, mix);
    SEAM(5);
    if (IN(6)) { pg8::Gemm g{mix, w_out_t, NTOK, DM, DM}; pg8::StaticOrder S; S.init(NTOK, DM, c.nb, c.bid); pg8::EpiResF32 E{x, y1, DM, DN_ALPHA};
        pg8::gemm_phase<pg8::EpiResF32, pg8::StaticOrder, true, true>((PG8_LAS unsigned char*)lds, g, S, E); }
    SEAM(6);
    if (IN(7)) { nv::d_ln1(c, y1, ln1_g, ln1_b, y1, h1b); nv::d_cvt_bf16(c, pu, ub, (size_t)NEXP * DM / 4); nv::d_cvt_bf16(c, pv, vb, (size_t)NEXP * DM / 4); }
    SEAM(7);
    if (IN(8)) { pg8::Gemm g{h1b, wq_t, NTOK, PEER_Q, DM}; pg8::StaticOrder S; S.init(NTOK, PEER_Q, c.nb, c.bid); pg8::EpiBf16<0> E{qb, PEER_Q, nullptr, 0, 0, 1.f};
        pg8::gemm_phase<pg8::EpiBf16<0>, pg8::StaticOrder, true, true>((PG8_LAS unsigned char*)lds, g, S, E); }
    SEAM(8);
    if (IN(9)) nv::d_peer_topk(c, qb, keys, idx, gate);
    SEAM(9);
    if (IN(10)) pe::d_peer_gather(c, h1b, idx, gate, ub, vb, ln2_g, ln2_b, out);
#undef IN
#undef SEAM
}

#ifndef N_LAUNCHES
#define N_LAUNCHES 1
#endif
extern "C" void kernel_launch(void* const* d_in, const int* in_sizes, int n_in, void* d_out, int out_size, void* d_ws, size_t ws_size, hipStream_t stream) {
    static int grid = 0;
    if (grid == 0) {
        if (n_in != 24 || in_sizes[0] != NTOK * DM || out_size != NTOK * DM || ws_size < 496 * MiB) { fprintf(stderr, "kernel_launch: unexpected shapes/ws (n_in %d, ws %zu)\n", n_in, ws_size); grid = -1; return; }
        int dev = 0, cus = 0, per_cu = 0;
        if (hipGetDevice(&dev) != hipSuccess || hipDeviceGetAttribute(&cus, hipDeviceAttributeMultiprocessorCount, dev) != hipSuccess) { grid = -1; return; }
        if (hipFuncSetAttribute((const void*)mega, hipFuncAttributeMaxDynamicSharedMemorySize, LDS_BYTES) != hipSuccess) { fprintf(stderr, "kernel_launch: hipFuncSetAttribute failed\n"); grid = -1; return; }
        if (hipOccupancyMaxActiveBlocksPerMultiprocessor(&per_cu, (const void*)mega, 512, LDS_BYTES) != hipSuccess || per_cu < 1) { fprintf(stderr, "kernel_launch: occupancy query failed (%d)\n", per_cu); (void)hipGetLastError(); grid = -1; return; }
        grid = cus * per_cu;
        fprintf(stderr, "kernel_launch: cus %d per_cu %d grid %d\n", cus, per_cu, grid);
    }
    if (grid < 0) return;
    Params p{};
    for (int i = 0; i < 24; ++i) p.in[i] = (const float*)d_in[i];
    p.out = (float*)d_out; p.ws = (unsigned char*)d_ws;
#if N_LAUNCHES == 1
    p.ph_lo = 0; p.ph_hi = NPHASE;
    void* args[] = {&p};
    hipError_t e = hipLaunchCooperativeKernel((const void*)mega, dim3(grid), dim3(512), args, LDS_BYTES, stream);
    if (e != hipSuccess) fprintf(stderr, "cooperative launch failed: %s (grid %d)\n", hipGetErrorString(e), grid);
#else
    for (int k = 0; k < NPHASE; ++k) { p.ph_lo = k; p.ph_hi = k + 1; hipLaunchKernelGGL(mega, dim3(grid), dim3(512), LDS_BYTES, stream, p); }
#endif
}
```

```cpp
#include <hip/hip_runtime.h>
#include <hip/hip_cooperative_groups.h>
#include <cstdio>
#include <cstdint>
#include <cmath>
namespace cg = cooperative_groups;

constexpr int BATCH = 8, SEQ = 4096, DM = 1024, NTOK = BATCH * SEQ;
constexpr int IN_COLS = 2528, IN_PAD = 2560;
constexpr int C_Q = 0, C_K = 512, C_V = 640, C_P = 768;
constexpr int P_R = 0, P_KK = 512, P_VV = 1024, P_WD = 1536, P_AD = 1600, P_GD = 1664, RW_COLS = 1760;
constexpr int NEXP = 16384, PEER_Q = 2048;
constexpr float LN_EPS = 1e-5f, GN_EPS = 64e-5f;
constexpr float DN_ALPHA = 1.189207115002721f;

typedef unsigned short bf16;
__device__ __forceinline__ float bf2f(bf16 v) { return __uint_as_float(((unsigned)v) << 16); }
__device__ __forceinline__ bf16 f2bf(float f) { unsigned u = __float_as_uint(f); return (bf16)((u + 0x7fffu + ((u >> 16) & 1u)) >> 16); }
__device__ __forceinline__ unsigned pk2bf(float lo, float hi) { return (unsigned)f2bf(lo) | ((unsigned)f2bf(hi) << 16); }
__device__ __forceinline__ float wave_sum(float v) {
#pragma unroll
    for (int o = 1; o < 64; o <<= 1) v += __shfl_xor(v, o);
    return v;
}
__device__ __forceinline__ float sigmoidf_(float x) { return 1.f / (1.f + __expf(-x)); }
namespace pg8 {
#define PG8_LAS __attribute__((address_space(3)))
typedef unsigned short bf16_t;
typedef short bf16x8 __attribute__((ext_vector_type(8)));
typedef float f32x4 __attribute__((ext_vector_type(4)));
typedef unsigned u32x4 __attribute__((ext_vector_type(4)));
constexpr int BM = 256, BK = 64, HALF = 128, HTB = HALF * BK * 2  , STAGE_BYTES = 8 * HTB, NXCD = 8, WGM = 8;

__host__ __device__ __forceinline__ int lds_byte(int r, int c) { const int st = (r >> 4) * 2 + (c >> 5), rr = r & 15, cc = c & 31, ob = rr * 64 + cc * 2; return st * 1024 + (ob ^ (((ob >> 9) & 1) << 5)); }
__host__ __device__ __forceinline__ void stage_rc(int b, int& R, int& C) { const int st = b / 1024, sb = b % 1024, swz = sb ^ (((sb >> 9) & 1) << 5); R = (st >> 1) * 16 + swz / 64; C = (st & 1) * 32 + (swz % 64) / 2; }
__host__ __device__ __forceinline__ int perm32(int rho) { const int n = rho >> 4, i = rho & 15; return 8 * (i >> 2) + 4 * n + (i & 3); }

struct Unit { int pm, pn; };
struct Gemm { const bf16_t* A; const bf16_t* Bt; int M, N, K; };

struct StaticOrder {
    int nM, nN, nwg, G, c;
    __host__ __device__ void init(int M, int N, int G_, int c_) { nM = M / BM; nN = N / BM; nwg = nM * nN; G = G_; c = c_; }
    __host__ __device__ bool next(int i, Unit& u) const {
        const long L = (long)i * G + c; if (L >= nwg) return false;
        int wgid = (int)L; { const int q = nwg / NXCD, r = nwg % NXCD, xcd = wgid % NXCD, off = wgid / NXCD; wgid = (xcd < r ? xcd * (q + 1) : r * (q + 1) + (xcd - r) * q) + off; }
        const int nig = WGM * nN, gid = wgid / nig, fm = gid * WGM, gsz = (nM - fm) < WGM ? (nM - fm) : WGM;
        u.pm = fm + ((wgid % nig) % gsz); u.pn = (wgid % nig) / gsz; return true;
    }
    __device__ __forceinline__ void a_ready(const Unit&) const {}
    __device__ __forceinline__ void done(const Unit&) const {}
};

__device__ __forceinline__ unsigned cvt_pk_bf16(float lo, float hi) { unsigned r; asm volatile("v_cvt_pk_bf16_f32 %0, %1, %2" : "=v"(r) : "v"(lo), "v"(hi)); return r; }
typedef float f32x2 __attribute__((ext_vector_type(2)));
__device__ __forceinline__ f32x2 gelu_pk(f32x2 v) {
    const f32x2 av = __builtin_elementwise_abs(v), d = av * 0.2316418882f + 1.0f;
    f32x2 t; t.x = __builtin_amdgcn_rcpf(d.x); t.y = __builtin_amdgcn_rcpf(d.y);
    f32x2 q = t * 0.5307027145f + (-0.7265760135f); q = q * t + 0.7107068705f; q = q * t + (-0.142248368f); q = q * t + 0.127414796f; q = q * t;
    const f32x2 s = (v * v) * (-0.72134752044f);
    f32x2 e; e.x = __builtin_amdgcn_exp2f(s.x); e.y = __builtin_amdgcn_exp2f(s.y);
    const f32x2 m = v * (q * e), r = v - m;
    f32x2 o; o.x = v.x < 0.f ? m.x : r.x; o.y = v.y < 0.f ? m.y : r.y; return o;
}

template <int ACT  > struct EpiBf16 {
    static constexpr bool PERM = true, AFTER_DRAIN = false; static_assert(ACT == 0 || ACT == 1, "EpiBf16: ACT is 0 (none) or 1 (gelu_pk)");
    bf16_t* O; int ldc; const float* bias; int split_cols; size_t split_stride; float scale0;
    __device__ __forceinline__ void operator()(const f32x4 (&acc)[2][2][4][2], const Unit& u, int wr, int wc, int fr, int fq) const {
        const int row0 = u.pm * BM + wr * 64 + fr; int colt = u.pn * BM; bf16_t* base = O;
        float sc = 1.f; if (split_cols) { const int t = colt / split_cols; base += (size_t)t * split_stride; colt -= t * split_cols; if (t == 0) sc = scale0; }
        const int col0 = colt + wc * 32 + 8 * fq, bcol0 = u.pn * BM + wc * 32 + 8 * fq;
        f32x4 bv[2][2];
#pragma unroll
        for (int bj = 0; bj < 2; ++bj)
#pragma unroll
            for (int n = 0; n < 2; ++n) bv[bj][n] = bias ? *(const f32x4*)(bias + bcol0 + bj * HALF + 4 * n) : (f32x4){0.f, 0.f, 0.f, 0.f};
#pragma unroll
        for (int ai = 0; ai < 2; ++ai)
#pragma unroll
            for (int m = 0; m < 4; ++m) { bf16_t* rowp = base + (size_t)(row0 + ai * HALF + m * 16) * ldc + col0;
#pragma unroll
                for (int bj = 0; bj < 2; ++bj) { f32x4 v0 = acc[ai][bj][m][0] + bv[bj][0], v1 = acc[ai][bj][m][1] + bv[bj][1];
                    if (ACT == 1) { f32x2 a = gelu_pk((f32x2){v0[0], v0[1]}), b = gelu_pk((f32x2){v0[2], v0[3]}), c = gelu_pk((f32x2){v1[0], v1[1]}), d = gelu_pk((f32x2){v1[2], v1[3]});
                        v0 = (f32x4){a.x, a.y, b.x, b.y}; v1 = (f32x4){c.x, c.y, d.x, d.y}; }
                    v0 = v0 * sc; v1 = v1 * sc; u32x4 w; w.x = cvt_pk_bf16(v0[0], v0[1]); w.y = cvt_pk_bf16(v0[2], v0[3]); w.z = cvt_pk_bf16(v1[0], v1[1]); w.w = cvt_pk_bf16(v1[2], v1[3]);
                    *(u32x4*)(rowp + bj * HALF) = w; } }
    }
};

struct PanelStats {
    unsigned* xbuf;
    unsigned* cnt;
    unsigned* tmo;
    int ntn; float eps;
    unsigned code;
    __device__ __forceinline__ bool run(const f32x4 (&v)[2][2][4][2], const Unit& u, int wr, int wc, int fr, int fq, PG8_LAS unsigned char* lds, int wid, int lane) const {
        typedef float f32x2v __attribute__((ext_vector_type(2)));
        PG8_LAS f32x2v* P = (PG8_LAS f32x2v*)lds;
        PG8_LAS f32x2v* S = (PG8_LAS f32x2v*)(lds + 8192);
        PG8_LAS unsigned* flag = (PG8_LAS unsigned*)(lds + 8192 + 2048);
#pragma unroll
        for (int ai = 0; ai < 2; ++ai)
#pragma unroll
            for (int m = 0; m < 4; ++m) {
                float s = 0.f;
#pragma unroll
                for (int bj = 0; bj < 2; ++bj)
#pragma unroll
                    for (int n = 0; n < 2; ++n) { const f32x4 x = v[ai][bj][m][n]; s += (x[0] + x[1]) + (x[2] + x[3]); }
                s += __shfl_xor(s, 16); s += __shfl_xor(s, 32);
                const float mw = s * (1.0f / 64.0f); float q = 0.f;
#pragma unroll
                for (int bj = 0; bj < 2; ++bj)
#pragma unroll
                    for (int n = 0; n < 2; ++n) { const f32x4 d = v[ai][bj][m][n] - mw; q += (d[0] * d[0] + d[1] * d[1]) + (d[2] * d[2] + d[3] * d[3]); }
                q += __shfl_xor(q, 16); q += __shfl_xor(q, 32);
                if (fq == 0) P[(ai * HALF + wr * 64 + m * 16 + fr) * 4 + wc] = (f32x2v){mw, q};
            }
        asm volatile("s_waitcnt lgkmcnt(0)" ::: "memory"); __builtin_amdgcn_s_barrier(); asm volatile("" ::: "memory");
#if defined(BROKEN_EXCHANGE_NO_WAIT)
#warning BROKEN CONTROL BUILD: the row-statistics exchange does not wait; results are wrong by design
        if (blockIdx.x >= 64) { const long long t0_ = clock64(); while (clock64() - t0_ < 60000) __builtin_amdgcn_s_sleep(8); }
#endif
        const int row = wid * 32 + (lane & 31);
        if (lane < 32) {
            const f32x2v a = P[row * 4 + 0], b = P[row * 4 + 1], c = P[row * 4 + 2], d = P[row * 4 + 3];
            const float mt = (a.x + b.x + c.x + d.x) * 0.25f;
            const float da = a.x - mt, db = b.x - mt, dc = c.x - mt, dd = d.x - mt;
            const float m2 = (a.y + b.y) + (c.y + d.y) + 64.0f * ((da * da + db * db) + (dc * dc + dd * dd));
            unsigned long long* slot = (unsigned long long*)xbuf + ((size_t)(u.pm * BM + row) * 4 + u.pn);
            __hip_atomic_store(slot, ((unsigned long long)__float_as_uint(m2) << 32) | __float_as_uint(mt), __ATOMIC_RELAXED, __HIP_MEMORY_SCOPE_AGENT);
        }
        asm volatile("s_waitcnt vmcnt(0)" ::: "memory");
        if (lane == 0) __hip_atomic_fetch_add(cnt + 64 * u.pm, 1u, __ATOMIC_RELAXED, __HIP_MEMORY_SCOPE_AGENT);
        if (wid == 0) {
            bool dead = false; const unsigned long long t0 = __builtin_amdgcn_s_memrealtime(); const unsigned want = 8u * (unsigned)ntn;
            for (;;) {
#if defined(BROKEN_EXCHANGE_NO_WAIT)
                break;
#endif
                if ((unsigned)__builtin_amdgcn_readfirstlane(__hip_atomic_load(cnt + 64 * u.pm, __ATOMIC_RELAXED, __HIP_MEMORY_SCOPE_AGENT)) >= want) break;
                if (__builtin_amdgcn_s_memrealtime() - t0 > 2000000ull) {
                    if (lane == 0) { unsigned expect = 0u; __hip_atomic_compare_exchange_strong(tmo + 1, &expect, code | (unsigned)(u.pm & 0xff), __ATOMIC_RELAXED, __ATOMIC_RELAXED, __HIP_MEMORY_SCOPE_AGENT);
                                     __hip_atomic_store(tmo, 1u, __ATOMIC_RELAXED, __HIP_MEMORY_SCOPE_AGENT); }
                    dead = true; break; }
                __builtin_amdgcn_s_sleep(2);
            }
            __builtin_amdgcn_fence(__ATOMIC_ACQUIRE, "agent");
            if (lane == 0) flag[0] = dead ? 1u : 0u;
        }
        asm volatile("s_waitcnt vmcnt(0) lgkmcnt(0)" ::: "memory"); __builtin_amdgcn_s_barrier(); asm volatile("" ::: "memory");
        const bool bad = flag[0] != 0u;
        if (lane < 32) {
            const unsigned long long* slot = (const unsigned long long*)xbuf + (size_t)(u.pm * BM + row) * 4; float mt[4], m2[4]; float ms = 0.f;
#pragma unroll
            for (int t = 0; t < 4; ++t) { if (t < ntn) { const unsigned long long w = __hip_atomic_load(slot + t, __ATOMIC_RELAXED, __HIP_MEMORY_SCOPE_AGENT); mt[t] = __uint_as_float((unsigned)w); m2[t] = __uint_as_float((unsigned)(w >> 32)); } else { mt[t] = 0.f; m2[t] = 0.f; } ms += mt[t]; }
            const float mean = ms / (float)ntn; float q = 0.f;
#pragma unroll
            for (int t = 0; t < 4; ++t) if (t < ntn) { const float dm = mt[t] - mean; q += m2[t] + 256.0f * dm * dm; }
            S[row] = (f32x2v){mean, 1.0f / sqrtf(q / (256.0f * (float)ntn) + eps)};
        }
        asm volatile("s_waitcnt lgkmcnt(0)" ::: "memory"); __builtin_amdgcn_s_barrier(); asm volatile("" ::: "memory");
        return bad;
    }
};
struct EpiLnRes {
    static constexpr bool PERM = false, AFTER_DRAIN = true;
    const float* base; float* out; int ldc; const float* bias; PanelStats st; unsigned poison;
    __device__ __forceinline__ void fused(f32x4 (&acc)[2][2][4][2], const Unit& u, int wr, int wc, int fr, int fq, PG8_LAS unsigned char* lds, int wid, int lane) const {
        typedef float f32x2v __attribute__((ext_vector_type(2)));
        const PG8_LAS f32x2v* S = (const PG8_LAS f32x2v*)(lds + 8192);
        const int col0 = u.pn * BM + wc * 32 + 4 * fq;
#pragma unroll
        for (int bj = 0; bj < 2; ++bj)
#pragma unroll
            for (int n = 0; n < 2; ++n) { const f32x4 bv = bias ? *(const f32x4*)(bias + col0 + bj * HALF + n * 16) : (f32x4){0.f, 0.f, 0.f, 0.f};
#pragma unroll
                for (int ai = 0; ai < 2; ++ai)
#pragma unroll
                    for (int m = 0; m < 4; ++m) acc[ai][bj][m][n] += bv; }
        f32x4 pre[4][2][2];
#pragma unroll
        for (int m = 0; m < 4; ++m) { const size_t off = (size_t)(u.pm * BM + wr * 64 + m * 16 + fr) * ldc + col0;
#pragma unroll
            for (int bj = 0; bj < 2; ++bj)
#pragma unroll
                for (int n = 0; n < 2; ++n) pre[m][bj][n] = *(const f32x4*)(base + off + bj * HALF + n * 16); }
        const bool bad = st.run(acc, u, wr, wc, fr, fq, lds, wid, lane) || poison != 0u;
        const float qnan = __builtin_nanf("");
#pragma unroll
        for (int ai = 0; ai < 2; ++ai)
#pragma unroll
            for (int m = 0; m < 4; ++m) { const int r = ai * HALF + wr * 64 + m * 16 + fr; const f32x2v sr = S[r]; const size_t off = (size_t)(u.pm * BM + r) * ldc + col0;
#pragma unroll
                for (int bj = 0; bj < 2; ++bj)
#pragma unroll
                    for (int n = 0; n < 2; ++n) { const f32x4 bs = ai == 0 ? pre[m][bj][n] : *(const f32x4*)(base + off + bj * HALF + n * 16); f32x4 o = bs + (acc[ai][bj][m][n] - sr.x) * sr.y;
                        if (bad) o = (f32x4){qnan, qnan, qnan, qnan}; *(f32x4*)(out + off + bj * HALF + n * 16) = o; }
                if (m & 1) asm volatile("" ::: "memory"); }
    }
};
struct EpiLnResLn {
    static constexpr bool PERM = false, AFTER_DRAIN = true;
    const float* base; float* out; bf16_t* xn; int ldc; const float* bias; PanelStats st1, st2; unsigned poison;
    __device__ __forceinline__ void fused(f32x4 (&acc)[2][2][4][2], const Unit& u, int wr, int wc, int fr, int fq, PG8_LAS unsigned char* lds, int wid, int lane) const {
        typedef float f32x2v __attribute__((ext_vector_type(2))); typedef unsigned u32x2v __attribute__((ext_vector_type(2)));
        const PG8_LAS f32x2v* S = (const PG8_LAS f32x2v*)(lds + 8192);
        const int col0 = u.pn * BM + wc * 32 + 4 * fq;
#pragma unroll
        for (int bj = 0; bj < 2; ++bj)
#pragma unroll
            for (int n = 0; n < 2; ++n) { const f32x4 bv = bias ? *(const f32x4*)(bias + col0 + bj * HALF + n * 16) : (f32x4){0.f, 0.f, 0.f, 0.f};
#pragma unroll
                for (int ai = 0; ai < 2; ++ai)
#pragma unroll
                    for (int m = 0; m < 4; ++m) acc[ai][bj][m][n] += bv; }
        bool bad = st1.run(acc, u, wr, wc, fr, fq, lds, wid, lane) || poison != 0u;
        const float qnan = __builtin_nanf("");
#pragma unroll
        for (int ai = 0; ai < 2; ++ai)
#pragma unroll
            for (int m = 0; m < 4; ++m) { const int r = ai * HALF + wr * 64 + m * 16 + fr; const f32x2v sr = S[r]; const size_t off = (size_t)(u.pm * BM + r) * ldc + col0;
#pragma unroll
                for (int bj = 0; bj < 2; ++bj)
#pragma unroll
                    for (int n = 0; n < 2; ++n) { const f32x4 bs = *(const f32x4*)(base + off + bj * HALF + n * 16); acc[ai][bj][m][n] = bs + (acc[ai][bj][m][n] - sr.x) * sr.y; }
                asm volatile("" : "+v"(acc[ai][0][m][0]), "+v"(acc[ai][0][m][1]), "+v"(acc[ai][1][m][0]), "+v"(acc[ai][1][m][1]));
                if (m & 1) asm volatile("" ::: "memory"); }
        const bool bad1 = bad;
        bad = st2.run(acc, u, wr, wc, fr, fq, lds, wid, lane) || bad;
#pragma unroll
        for (int ai = 0; ai < 2; ++ai)
#pragma unroll
            for (int m = 0; m < 4; ++m) { const int r = ai * HALF + wr * 64 + m * 16 + fr; const f32x2v sr = S[r]; const size_t off = (size_t)(u.pm * BM + r) * ldc + col0;
#pragma unroll
                for (int bj = 0; bj < 2; ++bj)
#pragma unroll
                    for (int n = 0; n < 2; ++n) { const f32x4 x1 = acc[ai][bj][m][n]; *(f32x4*)(out + off + bj * HALF + n * 16) = bad1 ? (f32x4){qnan, qnan, qnan, qnan} : x1;
                        const f32x4 o = (x1 - sr.x) * sr.y; u32x2v w; w.x = cvt_pk_bf16(o[0], o[1]); w.y = cvt_pk_bf16(o[2], o[3]);
                        if (bad) { w.x = 0x7fc07fc0u; w.y = 0x7fc07fc0u; } *(u32x2v*)(xn + off + bj * HALF + n * 16) = w; }
                asm volatile("" ::: "memory"); }
    }
};

template <class Epi, class Sched, bool ALIGN_EPI = false, bool SP2 = false>
__device__ __forceinline__ void gemm_phase(PG8_LAS unsigned char* lds, const Gemm g, const Sched& S, const Epi& E, const int wid_in) {
    const int lane = (int)__builtin_amdgcn_mbcnt_hi(~0u, __builtin_amdgcn_mbcnt_lo(~0u, 0u)), wid = wid_in, tid = wid * 64 + lane, wr = wid >> 2, wc = wid & 3, fr = lane & 15, fq = lane >> 4;
    const int K = g.K, nt = K / BK;
    unsigned voffA[2], voffB[2];
#pragma unroll
    for (int i = 0; i < 2; ++i) { int R, C; stage_rc(tid * 16 + i * 8192, R, C); const int Rb = Epi::PERM ? ((R & ~31) + perm32(R & 31)) : R;
        voffA[i] = (unsigned)(R * K + C) * 2u; voffB[i] = (unsigned)(Rb * K + C) * 2u; }
    const size_t kstep = (size_t)(BK * 2);
    const size_t hstep = (size_t)HALF * K * 2;
    const size_t tstep = 2 * hstep;
    const unsigned ldsw = (unsigned)wid * 1024u;
    const int aoff = lds_byte(wr * 64 + fr, fq * 8), boff = lds_byte(wc * 32 + fr, fq * 8);
#define PG8_SA(b, h) (((b) * 2 + (h)) * HTB)
#define PG8_SB(b, h) ((4 + (b) * 2 + (h)) * HTB)
#define PG8_STAGE(bufoff, gbase, voff) do { _Pragma("unroll") for (int _i = 0; _i < 2; ++_i) \
        __builtin_amdgcn_global_load_lds((const unsigned*)((const char*)(gbase) + (voff)[_i]), (PG8_LAS unsigned*)(lds + (bufoff) + ldsw + _i * 8192), 16, 0, 0); } while (0)
#define PG8_LDA(dst, b, h) do { _Pragma("unroll") for (int m = 0; m < 4; ++m) _Pragma("unroll") for (int k = 0; k < 2; ++k) dst[m][k] = *(const PG8_LAS bf16x8*)(lds + PG8_SA(b, h) + aoff + m * 2048 + k * 1024); } while (0)
#define PG8_LDB(dst, b, h) do { _Pragma("unroll") for (int n = 0; n < 2; ++n) _Pragma("unroll") for (int k = 0; k < 2; ++k) dst[n][k] = *(const PG8_LAS bf16x8*)(lds + PG8_SB(b, h) + boff + n * 2048 + k * 1024); } while (0)
#define PG8_MMA(ai, bj, At, Bt) do { __builtin_amdgcn_s_setprio(1); _Pragma("unroll") for (int m = 0; m < 4; ++m) _Pragma("unroll") for (int n = 0; n < 2; ++n) _Pragma("unroll") for (int k = 0; k < 2; ++k) \
        acc[ai][bj][m][n] = __builtin_amdgcn_mfma_f32_16x16x32_bf16(Bt[n][k], At[m][k], acc[ai][bj][m][n], 0, 0, 0); __builtin_amdgcn_s_setprio(0); } while (0)
#define PG8_WAIT_V(n) asm volatile("s_waitcnt vmcnt(" #n ")" ::: "memory")
#define PG8_WAIT_L(n) asm volatile("s_waitcnt lgkmcnt(" #n ")" ::: "memory")
#define PG8_BAR __builtin_amdgcn_s_barrier()
#define PG8_SCHED __builtin_amdgcn_sched_barrier(0)
    Unit cur, nxt; int ui = 0;
    if (!S.next(0, cur)) return;
    f32x4 acc[2][2][4][2];
#pragma unroll
    for (int a = 0; a < 2; ++a)
#pragma unroll
        for (int b = 0; b < 2; ++b)
#pragma unroll
            for (int m = 0; m < 4; ++m)
#pragma unroll
                for (int n = 0; n < 2; ++n) acc[a][b][m][n] = (f32x4){0.f, 0.f, 0.f, 0.f};
    bf16x8 At[4][2], B0[2][2], B1[2][2];
    const char* cA = (const char*)g.A + (size_t)cur.pm * tstep; const char* cB = (const char*)g.Bt + (size_t)cur.pn * tstep;
    S.a_ready(cur);
    if constexpr (SP2) {
        PG8_STAGE(PG8_SB(0, 0), cB, voffB); PG8_STAGE(PG8_SB(0, 1), cB + hstep, voffB); PG8_STAGE(PG8_SA(0, 0), cA, voffA); PG8_STAGE(PG8_SA(0, 1), cA + hstep, voffA);
        if (wr == 1) PG8_BAR;
        PG8_WAIT_V(2); PG8_BAR;
        PG8_STAGE(PG8_SB(1, 0), cB + kstep, voffB); PG8_STAGE(PG8_SA(1, 0), cA + kstep, voffA); PG8_STAGE(PG8_SB(1, 1), cB + hstep + kstep, voffB);
        PG8_WAIT_V(6); PG8_BAR;
    } else {
        PG8_STAGE(PG8_SB(0, 0), cB, voffB); PG8_STAGE(PG8_SA(0, 0), cA, voffA); PG8_STAGE(PG8_SB(0, 1), cB + hstep, voffB); PG8_STAGE(PG8_SA(0, 1), cA + hstep, voffA);
        if (wr == 1) PG8_BAR;
        PG8_WAIT_V(4); PG8_BAR;
        PG8_STAGE(PG8_SB(1, 0), cB + kstep, voffB); PG8_STAGE(PG8_SA(1, 0), cA + kstep, voffA); PG8_STAGE(PG8_SB(1, 1), cB + hstep + kstep, voffB);
        PG8_WAIT_V(6); PG8_BAR;
    }
    for (;;) {
        const bool has_next = S.next(ui + 1, nxt);
        const char* nA = has_next ? (const char*)g.A + (size_t)nxt.pm * tstep : cA; const char* nB = has_next ? (const char*)g.Bt + (size_t)nxt.pn * tstep : cB;
        for (int t = 0; t < nt; t += 2) {
            const bool last = (t == nt - 2);
            const char* a1 = cA + (size_t)(t + 1) * kstep;
            const char* a2 = last ? nA : cA + (size_t)(t + 2) * kstep; const char* b2 = last ? nB : cB + (size_t)(t + 2) * kstep;
            const char* a3 = a2 + kstep; const char* b3 = b2 + kstep;
            if (last && has_next) S.a_ready(nxt);
            if constexpr (SP2) {
            PG8_LDB(B0, 0, 0); PG8_LDB(B1, 0, 1); PG8_SCHED; PG8_LDA(At, 0, 0); PG8_STAGE(PG8_SA(1, 1), a1 + hstep, voffA);
            PG8_WAIT_V(8); PG8_WAIT_L(0); PG8_BAR; PG8_MMA(0, 0, At, B0); PG8_MMA(0, 1, At, B1); PG8_BAR; PG8_SCHED;
            PG8_LDA(At, 0, 1); PG8_STAGE(PG8_SB(0, 0), b2, voffB); PG8_STAGE(PG8_SB(0, 1), b2 + hstep, voffB); PG8_STAGE(PG8_SA(0, 0), a2, voffA);
            PG8_WAIT_V(8); PG8_WAIT_L(0); PG8_BAR; PG8_MMA(1, 0, At, B0); PG8_MMA(1, 1, At, B1); PG8_BAR; PG8_SCHED;
            PG8_LDB(B0, 1, 0); PG8_LDB(B1, 1, 1); PG8_SCHED; PG8_LDA(At, 1, 0); PG8_STAGE(PG8_SA(0, 1), a2 + hstep, voffA);
            PG8_WAIT_V(8); PG8_WAIT_L(0); PG8_BAR; PG8_MMA(0, 0, At, B0); PG8_MMA(0, 1, At, B1); PG8_BAR; PG8_SCHED;
            PG8_LDA(At, 1, 1); PG8_STAGE(PG8_SB(1, 0), b3, voffB); PG8_STAGE(PG8_SB(1, 1), b3 + hstep, voffB); PG8_STAGE(PG8_SA(1, 0), a3, voffA);
            PG8_WAIT_V(8); PG8_WAIT_L(0); PG8_BAR; PG8_MMA(1, 0, At, B0); PG8_MMA(1, 1, At, B1); PG8_BAR; PG8_SCHED;
            } else {
            PG8_LDB(B0, 0, 0); PG8_SCHED; PG8_LDA(At, 0, 0); PG8_STAGE(PG8_SA(1, 1), a1 + hstep, voffA);
            PG8_WAIT_L(8); PG8_BAR; PG8_WAIT_L(0); PG8_MMA(0, 0, At, B0); PG8_BAR; PG8_SCHED;
            PG8_LDB(B1, 0, 1); PG8_STAGE(PG8_SB(0, 0), b2, voffB);
            PG8_BAR; PG8_WAIT_L(0); PG8_MMA(0, 1, At, B1); PG8_BAR;
            PG8_LDA(At, 0, 1); PG8_STAGE(PG8_SA(0, 0), a2, voffA);
            PG8_BAR; PG8_WAIT_L(0); PG8_MMA(1, 0, At, B0); PG8_BAR; PG8_SCHED;
            PG8_STAGE(PG8_SB(0, 1), b2 + hstep, voffB);
            PG8_WAIT_V(6); PG8_BAR; PG8_MMA(1, 1, At, B1); PG8_BAR;
            PG8_LDB(B0, 1, 0); PG8_SCHED; PG8_LDA(At, 1, 0); PG8_STAGE(PG8_SA(0, 1), a2 + hstep, voffA);
            PG8_WAIT_L(8); PG8_BAR; PG8_WAIT_L(0); PG8_MMA(0, 0, At, B0); PG8_BAR; PG8_SCHED;
            PG8_LDB(B1, 1, 1); PG8_STAGE(PG8_SB(1, 0), b3, voffB);
            PG8_BAR; PG8_WAIT_L(0); PG8_MMA(0, 1, At, B1); PG8_BAR;
            PG8_LDA(At, 1, 1); PG8_STAGE(PG8_SA(1, 0), a3, voffA);
            PG8_BAR; PG8_WAIT_L(0); PG8_MMA(1, 0, At, B0); PG8_BAR; PG8_SCHED;
            PG8_STAGE(PG8_SB(1, 1), b3 + hstep, voffB);
            PG8_WAIT_V(6); PG8_BAR; PG8_MMA(1, 1, At, B1); PG8_BAR;
            }
        }
        if constexpr (ALIGN_EPI) { if (wr == 0) PG8_BAR; }
        if constexpr (!Epi::AFTER_DRAIN) { E(acc, cur, wr, wc, fr, fq); S.done(cur); }
        if (!has_next) break;
#pragma unroll
        for (int a = 0; a < 2; ++a)
#pragma unroll
            for (int b = 0; b < 2; ++b)
#pragma unroll
                for (int m = 0; m < 4; ++m)
#pragma unroll
                    for (int n = 0; n < 2; ++n) acc[a][b][m][n] = (f32x4){0.f, 0.f, 0.f, 0.f};
        cur = nxt; cA = nA; cB = nB; ++ui;
        if constexpr (ALIGN_EPI) { if (wr == 1) PG8_BAR; }
    }
    PG8_WAIT_V(0);
    if constexpr (!ALIGN_EPI) { if (wr == 0) PG8_BAR; }
    PG8_BAR;
    if constexpr (Epi::AFTER_DRAIN) { E.fused(acc, cur, wr, wc, fr, fq, lds, wid, lane); S.done(cur); }
#undef PG8_SA
#undef PG8_SB
#undef PG8_STAGE
#undef PG8_LDA
#undef PG8_LDB
#undef PG8_MMA
#undef PG8_WAIT_V
#undef PG8_WAIT_L
#undef PG8_BAR
#undef PG8_SCHED
}
}
#define LAS __attribute__((address_space(3)))
typedef float f32x4 __attribute__((ext_vector_type(4)));
struct Ctx { int tid, lane, wave, bid, nb, gw, ngw; unsigned char* lds; };

namespace nv {
__device__ __forceinline__ void d_cvt_bf16(const Ctx& c, const float* __restrict__ in, bf16* __restrict__ out, size_t n4) {
    for (size_t i = (size_t)c.bid * 512 + c.tid; i < n4; i += (size_t)c.nb * 512) { f32x4 v = ((const f32x4*)in)[i]; uint2 o; o.x = pk2bf(v.x, v.y); o.y = pk2bf(v.z, v.w); ((uint2*)out)[i] = o; }
}
__device__ __forceinline__ void d_transpose_w(const Ctx& c, const float* __restrict__ W, int K, int N, int Npad, bf16* __restrict__ WT) {
    float* t = (float*)(c.lds) + c.wave * (32 * 33);
    const int tx = c.lane & 31, ty = c.lane >> 5, nbn = Npad / 32, ntile = nbn * (K / 32);
    for (int it = c.gw; it < ntile; it += c.ngw) {
        const int n0 = (it % nbn) * 32, k0 = (it / nbn) * 32;
        for (int i = ty; i < 32; i += 2) { const int n = n0 + tx; t[i * 33 + tx] = (n < N) ? W[(size_t)(k0 + i) * N + n] : 0.f; }
        __builtin_amdgcn_fence(__ATOMIC_RELEASE, "workgroup"); __builtin_amdgcn_wave_barrier();
        for (int i = ty; i < 32; i += 2) WT[(size_t)(n0 + i) * K + k0 + tx] = f2bf(t[tx * 33 + i]);
        __builtin_amdgcn_fence(__ATOMIC_RELEASE, "workgroup"); __builtin_amdgcn_wave_barrier();
    }
}
__device__ __forceinline__ void d_rope_table(const Ctx& c, float2* __restrict__ tab) {
    for (int id = c.bid * 512 + c.tid; id < SEQ * 32; id += c.nb * 512) {
        const int pos = id >> 5, i = id & 31;
        const float inv = (float)pow(10000.0, -(double)i / 32.0);
        const float ang = (float)pos * inv;
        tab[id] = make_float2((float)cos((double)ang), (float)sin((double)ang));
    }
}
__device__ __forceinline__ void d_rotary(const Ctx& c, const bf16* __restrict__ proj, const float2* __restrict__ tab, bf16* __restrict__ qr, bf16* __restrict__ kr) {
    for (size_t id = (size_t)c.bid * 512 + c.tid; id < (size_t)NTOK * 320; id += (size_t)c.nb * 512) {
        const int d = id & 31, hh = (id >> 5) % 10; const size_t t = id / 320; const int pos = (int)(t % SEQ);
        const float2 cs = tab[pos * 32 + d];
        const bf16* src = proj + t * IN_PAD + hh * 64;
        const float t1 = bf2f(src[d]), t2 = bf2f(src[d + 32]);
        const float o1 = t1 * cs.x - t2 * cs.y, o2 = t2 * cs.x + t1 * cs.y;
        bf16* dst = (hh < 8) ? (qr + t * 512 + hh * 64) : (kr + t * 128 + (hh - 8) * 64);
        dst[d] = f2bf(o1); dst[d + 32] = f2bf(o2);
    }
}
__device__ __forceinline__ void d_attn(const Ctx& c, const bf16* __restrict__ qr, const bf16* __restrict__ kr, const bf16* __restrict__ proj, const float* __restrict__ sink, bf16* __restrict__ mix) {
    for (int id = c.bid * 512 + c.tid; id < NTOK * 8; id += c.nb * 512) {
        const int hq = id & 7, t = id >> 3, b = t / SEQ, i = t % SEQ, kvh = hq >> 2;
        float q[64], acc[64];
#pragma unroll
        for (int d = 0; d < 64; ++d) { q[d] = bf2f(qr[(size_t)t * 512 + hq * 64 + d]) * 0.125f; acc[d] = 0.f; }
        float m = sink[hq], l = 1.f;
        const int j0 = max(0, i - 128), j1 = min(SEQ - 1, i + 128);
        for (int j = j0; j <= j1; ++j) {
            const size_t tj = (size_t)b * SEQ + j;
            const uint4* kp = (const uint4*)(kr + tj * 128 + kvh * 64);
            float s = 0.f;
#pragma unroll
            for (int cc = 0; cc < 8; ++cc) { const uint4 w = kp[cc]; const unsigned ww[4] = {w.x, w.y, w.z, w.w};
#pragma unroll
                for (int e = 0; e < 4; ++e) { s += q[cc * 8 + 2 * e] * __uint_as_float(ww[e] << 16) + q[cc * 8 + 2 * e + 1] * __uint_as_float(ww[e] & 0xffff0000u); } }
            if (s > m) { const float f = __expf(m - s); l *= f;
#pragma unroll
                for (int d = 0; d < 64; ++d) acc[d] *= f;
                m = s; }
            const float p = __expf(s - m); l += p;
            const uint4* vp = (const uint4*)(proj + tj * IN_PAD + C_V + kvh * 64);
#pragma unroll
            for (int cc = 0; cc < 8; ++cc) { const uint4 w = vp[cc]; const unsigned ww[4] = {w.x, w.y, w.z, w.w};
#pragma unroll
                for (int e = 0; e < 4; ++e) { acc[cc * 8 + 2 * e] += p * __uint_as_float(ww[e] << 16); acc[cc * 8 + 2 * e + 1] += p * __uint_as_float(ww[e] & 0xffff0000u); } }
        }
        const float il = 1.f / l;
#pragma unroll
        for (int d = 0; d < 64; d += 2) *(unsigned*)(mix + (size_t)t * DM + hq * 64 + d) = pk2bf(acc[d] * il, acc[d + 1] * il);
    }
}
__device__ __forceinline__ void d_scan(const Ctx& c, const bf16* __restrict__ proj, const float* __restrict__ mu_prev, const float* __restrict__ mu_next,
                                       const float* __restrict__ w0, const float* __restrict__ w2, const float* __restrict__ a0, const float* __restrict__ a2,
                                       const float* __restrict__ k_k, const float* __restrict__ k_a, float* __restrict__ ydir) {
    if (c.wave != 0) return;
    for (int unit = c.bid; unit < 128; unit += c.nb) {
    const int b = unit >> 4, h = (unit >> 1) & 7, d = unit & 1, lane = c.lane, ch = h * 64 + lane;
    float (*sh)[64] = (float (*)[64])c.lds;
    const int colx = lane < 32 ? (P_WD + d * 32 + lane) : (P_AD + d * 32 + lane - 32);
    const int cols[4] = {P_R + ch, P_KK + ch, P_VV + ch, colx};
    float mp[4], mn[4];
#pragma unroll
    for (int q = 0; q < 4; ++q) { mp[q] = mu_prev[cols[q]]; mn[q] = mu_next[cols[q]]; }
    float* w2c = (float*)c.lds + 6 * 64 + lane; float* a2c = w2c + 32 * 64;
    for (int j = 0; j < 32; ++j) { w2c[j * 64] = w2[(size_t)(d * 32 + j) * 512 + ch]; a2c[j * 64] = a2[(size_t)(d * 32 + j) * 512 + ch]; }
    const float w0c = w0[d * 512 + ch], a0c = a0[d * 512 + ch], kkc = k_k[ch], kac = k_a[ch];
    float S[64];
#pragma unroll
    for (int k = 0; k < 64; ++k) S[k] = 0.f;
    const int sgn = d ? -1 : 1; int t = d ? SEQ - 1 : 0;
    const bf16* pb = proj + (size_t)b * SEQ * IN_PAD + C_P;
    float behind[4], cur[4], ahead[4];
#pragma unroll
    for (int q = 0; q < 4; ++q) { behind[q] = 0.f; cur[q] = bf2f(pb[(size_t)t * IN_PAD + cols[q]]); ahead[q] = bf2f(pb[(size_t)(t + sgn) * IN_PAD + cols[q]]); }
    for (int step = 0; step < SEQ; ++step, t += sgn) {
        float ahead2[4]; const int t2 = t + 2 * sgn; const bool ok2 = (t2 >= 0 && t2 < SEQ);
#pragma unroll
        for (int q = 0; q < 4; ++q) ahead2[q] = ok2 ? bf2f(pb[(size_t)t2 * IN_PAD + cols[q]]) : 0.f;
        float sv[4];
#pragma unroll
        for (int q = 0; q < 4; ++q) { const float prv = d ? ahead[q] : behind[q], nxt = d ? behind[q] : ahead[q]; sv[q] = cur[q] + mp[q] * (prv - cur[q]) + mn[q] * (nxt - cur[q]); }
        const float r = sv[0], k = sv[1], v = sv[2];
        sh[5][lane] = lane < 32 ? tanhf(sv[3]) : sv[3];
        __builtin_amdgcn_fence(__ATOMIC_RELEASE, "workgroup"); __builtin_amdgcn_wave_barrier();
        float ws = w0c, as = a0c;
#pragma unroll
        for (int j = 0; j < 32; ++j) { ws += sh[5][j] * w2c[j * 64]; as += sh[5][32 + j] * a2c[j * 64]; }
        const float nsp = -ws; const float sp = (nsp > 20.f) ? nsp : log1pf(__expf(nsp));
        const float wlog = -sp - 0.5f; const float decay = __expf(-__expf(wlog));
        const float a = sigmoidf_(as);
        float kk = k * kkc; const float ss = wave_sum(kk * kk); kk = kk * rsqrtf(fmaxf(ss, 1e-24f));
        const float kd = k * (1.f + (a - 1.f) * kac);
        sh[0][lane] = decay; sh[1][lane] = kk * a; sh[2][lane] = kd; sh[3][lane] = r; sh[4][lane] = kk;
        __builtin_amdgcn_fence(__ATOMIC_RELEASE, "workgroup"); __builtin_amdgcn_wave_barrier();
        float sa = 0.f;
#pragma unroll
        for (int q = 0; q < 64; ++q) sa -= S[q] * sh[4][q];
        float y = 0.f;
#pragma unroll
        for (int q = 0; q < 64; ++q) { S[q] = S[q] * sh[0][q] + sa * sh[1][q] + v * sh[2][q]; y += S[q] * sh[3][q]; }
        ydir[((size_t)d * NTOK + (size_t)b * SEQ + t) * 512 + ch] = y;
        __builtin_amdgcn_fence(__ATOMIC_RELEASE, "workgroup"); __builtin_amdgcn_wave_barrier();
#pragma unroll
        for (int q = 0; q < 4; ++q) { behind[q] = cur[q]; cur[q] = ahead[q]; ahead[q] = ahead2[q]; }
    }
    }
}
template <bool YSINGLE> __device__ __forceinline__ void d_rwkv_out(const Ctx& c, const bf16* __restrict__ proj, const float* __restrict__ ydir, const float* __restrict__ mu_prev, const float* __restrict__ mu_next,
                                           const float* __restrict__ a0, const float* __restrict__ a2, const float* __restrict__ g2, const float* __restrict__ k_a, const float* __restrict__ r_k,
                                           const float* __restrict__ lnx_g, const float* __restrict__ lnx_b, bf16* __restrict__ mix) {
    float* sad = (float*)c.lds; float* sgd = sad + 64; const int ch = c.tid;
    const float mpr = mu_prev[P_R + ch], mnr = mu_next[P_R + ch], mpk = mu_prev[P_KK + ch], mnk = mu_next[P_KK + ch], mpv = mu_prev[P_VV + ch], mnv = mu_next[P_VV + ch];
    const int cx = (ch < 64) ? (P_AD + ch) : (ch < 160 ? P_GD + ch - 64 : 0); const float mpx = mu_prev[cx], mnx = mu_next[cx];
    for (int t = c.bid; t < NTOK; t += c.nb) {
        const int i = t % SEQ; const bf16* p0 = proj + (size_t)t * IN_PAD + C_P;
        const bool hp = i > 0, hn = i < SEQ - 1;
#define SHF(col, mp_, mn_) ({ const float c_ = bf2f(p0[col]); const float pv_ = hp ? bf2f(p0[(col) - IN_PAD]) : 0.f, nx_ = hn ? bf2f(p0[(col) + IN_PAD]) : 0.f; c_ + (mp_) * (pv_ - c_) + (mn_) * (nx_ - c_); })
        if (ch < 64) sad[ch] = SHF(cx, mpx, mnx);
        else if (ch < 160) sgd[ch - 64] = sigmoidf_(SHF(cx, mpx, mnx));
        const float r = SHF(P_R + ch, mpr, mnr), k = SHF(P_KK + ch, mpk, mnk), v = SHF(P_VV + ch, mpv, mnv);
#undef SHF
        __syncthreads();
        asm volatile("" ::: "memory");
        float as0 = a0[ch], as1 = a0[512 + ch];
#pragma unroll 4
        for (int j = 0; j < 32; ++j) { as0 += sad[j] * a2[(size_t)j * 512 + ch]; as1 += sad[32 + j] * a2[(size_t)(32 + j) * 512 + ch]; }
        const float am = 0.5f * (sigmoidf_(as0) + sigmoidf_(as1));
        float g = 0.f;
#pragma unroll 4
        for (int j = 0; j < 96; ++j) g += sgd[j] * g2[(size_t)j * 512 + ch];
        const float y = YSINGLE ? ydir[(size_t)t * 512 + ch] : (ydir[(size_t)t * 512 + ch] + ydir[((size_t)NTOK + t) * 512 + ch]);
        const float mu = wave_sum(y) * (1.f / 64.f); const float dy = y - mu; const float var = wave_sum(dy * dy) * (1.f / 64.f);
        const float yn = dy * rsqrtf(var + GN_EPS) * lnx_g[ch] + lnx_b[ch];
        const float kmean = k * (1.f + (am - 1.f) * k_a[ch]);
        const float bonus = wave_sum(r * kmean * r_k[ch]) * v;
        mix[(size_t)t * DM + 512 + ch] = f2bf((yn + bonus) * g);
        __syncthreads();
    }
}
__device__ __forceinline__ void d_ln1(const Ctx& c, const float* y1, const float* __restrict__ g, const float* __restrict__ bta, float* h1f, bf16* __restrict__ h1b) {
    for (int row = c.gw; row < NTOK; row += c.ngw) {
        const int lane = c.lane;
        const f32x4* xr = (const f32x4*)(y1 + (size_t)row * DM) + lane;
        f32x4 v[4]; float s = 0.f;
#pragma unroll
        for (int j = 0; j < 4; ++j) { v[j] = xr[64 * j]; s += (v[j].x + v[j].y) + (v[j].z + v[j].w); }
        const float mean = wave_sum(s) * (1.f / DM); float s2 = 0.f;
#pragma unroll
        for (int j = 0; j < 4; ++j) { v[j] = v[j] - mean; s2 += (v[j].x * v[j].x + v[j].y * v[j].y) + (v[j].z * v[j].z + v[j].w * v[j].w); }
        const float rstd = rsqrtf(wave_sum(s2) * (1.f / DM) + LN_EPS);
#pragma unroll
        for (int j = 0; j < 4; ++j) { const f32x4 gg = ((const f32x4*)g)[64 * j + lane], bb = ((const f32x4*)bta)[64 * j + lane];
            const f32x4 o = v[j] * rstd * gg + bb;
            ((f32x4*)(h1f + (size_t)row * DM))[64 * j + lane] = o;
            uint2 w; w.x = pk2bf(o.x, o.y); w.y = pk2bf(o.z, o.w); ((uint2*)(h1b + (size_t)row * DM))[64 * j + lane] = w; }
    }
}
__device__ __forceinline__ void d_peer_topk(const Ctx& c, const bf16* __restrict__ qb, const float* __restrict__ keys, int* __restrict__ idx, float* __restrict__ gate) {
    float* keysT = (float*)c.lds; float* sq = keysT + 2 * 128 * 128; float* sc = sq + 256; float* s12 = sc + 256; int* i12 = (int*)(s12 + 32);
    const int tid = c.tid, lane = c.lane, wave = c.wave;
    for (int item = c.bid; item < 8 * 64; item += c.nb) {
        const int h = item & 7, grp = item >> 3;
        __syncthreads();
        for (int e = tid; e < 2 * 128 * 128; e += 512) { const int p = e >> 14, n = (e >> 7) & 127, cc = e & 127; keysT[(p * 128 + cc) * 128 + n] = keys[(size_t)h * 32768 + e]; }
        __syncthreads();
        for (int tt = 0; tt < 512; ++tt) {
            const size_t t = (size_t)grp * 512 + tt;
            if (tid < 256) sq[tid] = bf2f(qb[t * PEER_Q + h * 256 + tid]);
            __syncthreads();
            if (tid < 256) { const int p = tid >> 7, n = tid & 127; float s = 0.f; const float* kt = keysT + p * 16384 + n; const float* qq = sq + p * 128;
                for (int cc = 0; cc < 128; ++cc) s += qq[cc] * kt[cc * 128];
                sc[tid] = s; }
            __syncthreads();
            if (wave < 2) {
                float v0 = sc[wave * 128 + lane], v1 = sc[wave * 128 + 64 + lane];
                for (int r = 0; r < 16; ++r) {
                    float bv; int bi; if (v1 > v0) { bv = v1; bi = lane + 64; } else { bv = v0; bi = lane; }
#pragma unroll
                    for (int o = 1; o < 64; o <<= 1) { const float ov = __shfl_xor(bv, o); const int oi = __shfl_xor(bi, o); if (ov > bv || (ov == bv && oi < bi)) { bv = ov; bi = oi; } }
                    if (lane == 0) { s12[wave * 16 + r] = bv; i12[wave * 16 + r] = bi; }
                    if (bi == lane) v0 = -INFINITY; if (bi == lane + 64) v1 = -INFINITY;
                }
            }
            __syncthreads();
            if (wave == 0) {
                float cv[4];
#pragma unroll
                for (int j = 0; j < 4; ++j) { const int f = lane + 64 * j; cv[j] = s12[f >> 4] + s12[16 + (f & 15)]; }
                float mycs = 0.f; int myid = 0;
                for (int r = 0; r < 16; ++r) {
                    float bv = cv[0]; int bi = lane;
#pragma unroll
                    for (int j = 1; j < 4; ++j) if (cv[j] > bv) { bv = cv[j]; bi = lane + 64 * j; }
#pragma unroll
                    for (int o = 1; o < 64; o <<= 1) { const float ov = __shfl_xor(bv, o); const int oi = __shfl_xor(bi, o); if (ov > bv || (ov == bv && oi < bi)) { bv = ov; bi = oi; } }
                    if (lane == r) { mycs = bv; myid = i12[bi >> 4] * 128 + i12[16 + (bi & 15)]; }
#pragma unroll
                    for (int j = 0; j < 4; ++j) if (bi == lane + 64 * j) cv[j] = -INFINITY;
                }
                float mx = (lane < 16) ? mycs : -INFINITY;
#pragma unroll
                for (int o = 1; o < 64; o <<= 1) mx = fmaxf(mx, __shfl_xor(mx, o));
                const float e = (lane < 16) ? __expf(mycs - mx) : 0.f; const float den = wave_sum(e);
                if (lane < 16) { idx[t * 128 + h * 16 + lane] = myid; gate[t * 128 + h * 16 + lane] = e / den; }
            }
            __syncthreads();
        }
    }
}
__device__ __forceinline__ void d_peer_gather(const Ctx& c, const float* __restrict__ h1f, const int* __restrict__ idx, const float* __restrict__ gate, const float* __restrict__ u, const float* __restrict__ v,
                                              const float* __restrict__ g, const float* __restrict__ bta, float* __restrict__ out) {
    const int lane = c.lane;
    for (int t = c.gw; t < NTOK; t += c.ngw) {
        f32x4 hv[4], f[4];
#pragma unroll
        for (int j = 0; j < 4; ++j) { hv[j] = ((const f32x4*)(h1f + (size_t)t * DM))[64 * j + lane]; f[j] = (f32x4){0.f, 0.f, 0.f, 0.f}; }
        for (int e = 0; e < 128; ++e) {
            const int id = idx[(size_t)t * 128 + e]; const float gt = gate[(size_t)t * 128 + e];
            const f32x4* ur = (const f32x4*)(u + (size_t)id * DM); const f32x4* vr = (const f32x4*)(v + (size_t)id * DM);
            float z = 0.f;
#pragma unroll
            for (int j = 0; j < 4; ++j) { const f32x4 w = ur[64 * j + lane]; z += (w.x * hv[j].x + w.y * hv[j].y) + (w.z * hv[j].z + w.w * hv[j].w); }
            z = wave_sum(z);
            const float act = gt * 0.5f * z * (1.f + erff(z * 0.70710678118654752f));
#pragma unroll
            for (int j = 0; j < 4; ++j) { const f32x4 w = vr[64 * j + lane]; f[j] += act * w; }
        }
        float s = 0.f;
#pragma unroll
        for (int j = 0; j < 4; ++j) { f[j] = DN_ALPHA * hv[j] + f[j]; s += (f[j].x + f[j].y) + (f[j].z + f[j].w); }
        const float mean = wave_sum(s) * (1.f / DM); float s2 = 0.f;
#pragma unroll
        for (int j = 0; j < 4; ++j) { f[j] = f[j] - mean; s2 += (f[j].x * f[j].x + f[j].y * f[j].y) + (f[j].z * f[j].z + f[j].w * f[j].w); }
        const float rstd = rsqrtf(wave_sum(s2) * (1.f / DM) + LN_EPS);
#pragma unroll
        for (int j = 0; j < 4; ++j) { const f32x4 gg = ((const f32x4*)g)[64 * j + lane], bb = ((const f32x4*)bta)[64 * j + lane];
            ((f32x4*)(out + (size_t)t * DM))[64 * j + lane] = f[j] * rstd * gg + bb; }
    }
}
}
namespace pe {
typedef __bf16 bf16x2_t __attribute__((ext_vector_type(2)));
__device__ __forceinline__ float dot2(unsigned a, unsigned b, float c) { return __builtin_amdgcn_fdot2_f32_bf16(__builtin_bit_cast(bf16x2_t, a), __builtin_bit_cast(bf16x2_t, b), c, false); }
__device__ __forceinline__ float gelu_erf(float z) { return 0.5f * z * (1.f + erff(z * 0.70710678118654752f)); }
constexpr int GE = 4;
struct Rows { uint4 a[GE], b[GE]; };
__device__ __forceinline__ void load_rows(Rows& r, const bf16* __restrict__ tab, int i0, int i1, int lane, int g) {
#pragma unroll
    for (int j = 0; j < GE; ++j) { const int e = g * GE + j; const int id = __builtin_amdgcn_readlane((e & 64) ? i1 : i0, e & 63);
        const uint4* p = (const uint4*)(tab + (size_t)id * DM) + lane; r.a[j] = p[0]; r.b[j] = p[64]; }
}
__device__ __forceinline__ void d_peer_gather(const Ctx& c, const bf16* __restrict__ h1b, const int* __restrict__ idx, const float* __restrict__ gate, const bf16* __restrict__ ub, const bf16* __restrict__ vb,
                                              const float* __restrict__ g, const float* __restrict__ bta, float* __restrict__ out) {
    const int lane = c.lane;
    for (int t = c.gw; t < NTOK; t += c.ngw) {
        const uint4* hp = (const uint4*)(h1b + (size_t)t * DM) + lane; const uint4 h0 = hp[0], h1 = hp[64];
        const unsigned hw[8] = {h0.x, h0.y, h0.z, h0.w, h1.x, h1.y, h1.z, h1.w};
        const int i0 = idx[(size_t)t * 128 + lane], i1 = idx[(size_t)t * 128 + 64 + lane];
        const float g0 = gate[(size_t)t * 128 + lane], g1 = gate[(size_t)t * 128 + 64 + lane];
        float f[16];
#pragma unroll
        for (int i = 0; i < 16; ++i) f[i] = 0.f;
        Rows U, V, Un;
        load_rows(U, ub, i0, i1, lane, 0);
        for (int grp = 0; grp < 128 / GE; ++grp) {
            load_rows(V, vb, i0, i1, lane, grp);
            if (grp + 1 < 128 / GE) load_rows(Un, ub, i0, i1, lane, grp + 1);
            float z[GE];
#pragma unroll
            for (int j = 0; j < GE; ++j) { const unsigned uw[8] = {U.a[j].x, U.a[j].y, U.a[j].z, U.a[j].w, U.b[j].x, U.b[j].y, U.b[j].z, U.b[j].w}; float s = 0.f;
#pragma unroll
                for (int i = 0; i < 8; ++i) s = dot2(uw[i], hw[i], s);
                z[j] = s; }
            { const bool b0 = lane & 1; float k0 = b0 ? z[1] : z[0], s0 = b0 ? z[0] : z[1], k1 = b0 ? z[3] : z[2], s1 = b0 ? z[2] : z[3];
              k0 += __shfl_xor(s0, 1); k1 += __shfl_xor(s1, 1);
              const bool b1 = lane & 2; float kk = b1 ? k1 : k0, ss = b1 ? k0 : k1; kk += __shfl_xor(ss, 2);
              kk += __shfl_xor(kk, 4); kk += __shfl_xor(kk, 8); kk += __shfl_xor(kk, 16); kk += __shfl_xor(kk, 32);
              z[0] = kk; }
            const int e_me = grp * GE + (lane & 3);
            const float gt = __shfl((e_me & 64) ? g1 : g0, e_me & 63);
            const float act = gt * gelu_erf(z[0]);
            const unsigned actb = (unsigned)f2bf(act);
#pragma unroll
            for (int j = 0; j < GE; ++j) { const unsigned alo = __builtin_amdgcn_readlane(actb, j), ahi = alo << 16;
                const unsigned vw[8] = {V.a[j].x, V.a[j].y, V.a[j].z, V.a[j].w, V.b[j].x, V.b[j].y, V.b[j].z, V.b[j].w};
#pragma unroll
                for (int i = 0; i < 8; ++i) { f[2 * i] = dot2(vw[i], alo, f[2 * i]); f[2 * i + 1] = dot2(vw[i], ahi, f[2 * i + 1]); } }
            U = Un;
        }
        float s = 0.f;
#pragma unroll
        for (int i = 0; i < 8; ++i) { f[2 * i] += DN_ALPHA * __uint_as_float(hw[i] << 16); f[2 * i + 1] += DN_ALPHA * __uint_as_float(hw[i] & 0xffff0000u); s += f[2 * i] + f[2 * i + 1]; }
        const float mean = wave_sum(s) * (1.f / DM); float s2 = 0.f;
#pragma unroll
        for (int i = 0; i < 16; ++i) { f[i] -= mean; s2 += f[i] * f[i]; }
        const float rstd = rsqrtf(wave_sum(s2) * (1.f / DM) + LN_EPS);
#pragma unroll
        for (int hh = 0; hh < 2; ++hh) {
            const int e0 = hh * 512 + 8 * lane;
            const f32x4 ga = *(const f32x4*)(g + e0), gb = *(const f32x4*)(g + e0 + 4), ba = *(const f32x4*)(bta + e0), bb = *(const f32x4*)(bta + e0 + 4);
            f32x4 oa, ob;
            oa.x = f[hh * 8 + 0] * rstd * ga.x + ba.x; oa.y = f[hh * 8 + 1] * rstd * ga.y + ba.y; oa.z = f[hh * 8 + 2] * rstd * ga.z + ba.z; oa.w = f[hh * 8 + 3] * rstd * ga.w + ba.w;
            ob.x = f[hh * 8 + 4] * rstd * gb.x + bb.x; ob.y = f[hh * 8 + 5] * rstd * gb.y + bb.y; ob.z = f[hh * 8 + 6] * rstd * gb.z + bb.z; ob.w = f[hh * 8 + 7] * rstd * gb.w + bb.w;
            *(f32x4*)(out + (size_t)t * DM + e0) = oa; *(f32x4*)(out + (size_t)t * DM + e0 + 4) = ob;
        }
    }
}
}
namespace rw {
typedef short bf16x8 __attribute__((ext_vector_type(8)));
typedef short s16x4 __attribute__((ext_vector_type(4)));
typedef float f32x16 __attribute__((ext_vector_type(16)));
typedef float f32x2_t __attribute__((ext_vector_type(2)));
typedef __bf16 bf16x2_t __attribute__((ext_vector_type(2)));
typedef unsigned u32x4 __attribute__((ext_vector_type(4)));
typedef unsigned u32x2 __attribute__((ext_vector_type(2)));
typedef LAS unsigned char* lptr;
#define MFMA32(a, b, c) __builtin_amdgcn_mfma_f32_32x32x16_bf16((a), (b), (c), 0, 0, 0)
#define DI __device__ __forceinline__
constexpr int UNIT_BYTES = 10 * 2048;
constexpr int STG_STRIDE = 392;
constexpr int CST_OFF = 131072, GC_OFF = 131072 + 4096;

DI int crow(int i, int h) { return (i & 3) + 8 * (i >> 2) + 4 * h; }
DI unsigned cvtpk(float lo, float hi) { f32x2_t v = {lo, hi}; bf16x2_t b = __builtin_convertvector(v, bf16x2_t); return __builtin_bit_cast(unsigned, b); }
DI bf16x8 pack(const f32x16& x, int s) { u32x4 p; p[0] = cvtpk(x[8 * s], x[8 * s + 1]); p[1] = cvtpk(x[8 * s + 2], x[8 * s + 3]); p[2] = cvtpk(x[8 * s + 4], x[8 * s + 5]); p[3] = cvtpk(x[8 * s + 6], x[8 * s + 7]); return __builtin_bit_cast(bf16x8, p); }
DI bf16x8 frag4(unsigned a, unsigned b, unsigned c, unsigned d) { u32x4 p = {a, b, c, d}; return __builtin_bit_cast(bf16x8, p); }
DI float lo_f(unsigned w) { return __uint_as_float(w << 16); }
DI float hi_f(unsigned w) { return __uint_as_float(w & 0xffff0000u); }
DI int img_off(int row, int slot) { return row * 128 + ((slot ^ ((((row >> 1) & 1) << 3) | ((row >> 2) & 3))) << 3); }
DI s16x4 tr_read(lptr p) { return __builtin_bit_cast(s16x4, __builtin_amdgcn_ds_read_tr16_b64_v4i16((LAS s16x4*)p)); }
DI bf16x8 trfrag(lptr img, int tau, int s, int lane) {
    const int h = lane >> 5, gg = (lane >> 4) & 1, l16 = lane & 15, q = l16 >> 2, p = l16 & 3, slot = 8 * tau + 4 * gg + p, r0 = 16 * s + 4 * h + q;
    const s16x4 lo = tr_read(img + img_off(r0, slot)), hi = tr_read(img + img_off(r0 + 8, slot));
    return __builtin_shufflevector(lo, hi, 0, 1, 2, 3, 4, 5, 6, 7);
}
template <int CTRL, int RMASK> DI float dpp0(float x) { return __uint_as_float(__builtin_amdgcn_update_dpp(0u, __float_as_uint(x), CTRL, RMASK, 0xf, false)); }
DI float prefix32(float x) {
    x += dpp0<0x111, 0xf>(x); x += dpp0<0x112, 0xf>(x); x += dpp0<0x114, 0xf>(x); x += dpp0<0x118, 0xf>(x);
    x += dpp0<0x142, 0xa>(x);
    return x;
}
DI float fsig(float x) { return __builtin_amdgcn_rcpf(1.f + __expf(-x)); }
DI void store_tile(unsigned char* dst, const f32x16& x, int lane) {
    u32x4 a, b; a[0] = cvtpk(x[0], x[1]); a[1] = cvtpk(x[2], x[3]); a[2] = cvtpk(x[4], x[5]); a[3] = cvtpk(x[6], x[7]);
    b[0] = cvtpk(x[8], x[9]); b[1] = cvtpk(x[10], x[11]); b[2] = cvtpk(x[12], x[13]); b[3] = cvtpk(x[14], x[15]);
    u32x4* d = (u32x4*)(dst + lane * 32); d[0] = a; d[1] = b;
}

DI void d_lowrank_t(const Ctx& c, const float* __restrict__ w2, const float* __restrict__ a2, bf16* __restrict__ w2t, bf16* __restrict__ a2t) {
    for (int id = c.bid * 512 + c.tid; id < 2 * 512 * 32; id += c.nb * 512) { const int j = id & 31, ch = (id >> 5) & 511, d = id >> 14;
        w2t[id] = f2bf(w2[(size_t)(d * 32 + j) * 512 + ch]); a2t[id] = f2bf(a2[(size_t)(d * 32 + j) * 512 + ch]); }
}

DI void d_prep(const Ctx& c, int d, const bf16* __restrict__ proj, const float* __restrict__ mu_prev, const float* __restrict__ mu_next,
               const float* __restrict__ w0, const float* __restrict__ a0, const float* __restrict__ k_k, const float* __restrict__ k_a,
               const bf16* __restrict__ w2t, const bf16* __restrict__ a2t, unsigned char* __restrict__ UO, float* __restrict__ ybuf) {
    const int lane = c.lane, n = lane & 31, h = lane >> 5, hd = c.bid & 7;
    lptr L = (lptr)c.lds + c.wave * 16384;
    LAS float* cst = (LAS float*)((lptr)c.lds + CST_OFF);
    LAS float* gC = (LAS float*)((lptr)c.lds + GC_OFF) + c.wave * 64;
    __syncthreads();
    for (int i = c.tid; i < 768; i += 512) { float v;
        if (i < 640) { const int vec = i >> 6, ch = i & 63, gch = 64 * hd + ch;
            v = vec == 0 ? mu_prev[P_R + gch] : vec == 1 ? mu_next[P_R + gch] : vec == 2 ? mu_prev[P_KK + gch] : vec == 3 ? mu_next[P_KK + gch] : vec == 4 ? mu_prev[P_VV + gch] : vec == 5 ? mu_next[P_VV + gch]
              : vec == 6 ? w0[d * 512 + gch] : vec == 7 ? a0[d * 512 + gch] : vec == 8 ? k_k[gch] : k_a[gch]; }
        else { const int vec = (i - 640) >> 5, j = i & 31; const int col = (vec < 2 ? P_WD : P_AD) + 32 * d + j; v = (vec & 1) ? mu_next[col] : mu_prev[col]; }
        cst[i] = v; }
    __syncthreads();
    const int nper = (c.nb >> 3) * 8;
    for (int u = (c.bid >> 3) * 8 + c.wave; u < 1024; u += nper) {
        const int b = u >> 7, c32 = u & 127;
        const int tok0 = d ? SEQ - 32 * (c32 + 1) : 32 * c32;
        const bf16* prow = proj + (size_t)b * SEQ * IN_PAD + C_P;
#pragma unroll 1
        for (int it = 0; it < 13; ++it) { const int pid = it * 64 + lane; if (pid < 816) { const int rho = pid / 24, w = pid % 24, mat = w >> 3, pc = w & 7, tok = tok0 - 1 + rho;
                uint4 val = make_uint4(0, 0, 0, 0);
                if (tok >= 0 && tok < SEQ) val = *(const uint4*)(prow + (size_t)tok * IN_PAD + mat * 512 + 64 * hd + pc * 8);
                LAS u32x2* dp = (LAS u32x2*)(L + rho * STG_STRIDE + mat * 128 + pc * 16); dp[0] = (u32x2){val.x, val.y}; dp[1] = (u32x2){val.z, val.w}; } }
        const int rho = d ? 32 - n : n + 1, tok = tok0 - 1 + rho;
        bf16x8 wdf[2], adf[2];
        {
            const bool hp = tok > 0, hn = tok < SEQ - 1;
#pragma unroll
            for (int s = 0; s < 2; ++s) {
                const bf16* pc_ = prow + (size_t)tok * IN_PAD + 32 * d + 16 * s + 8 * h;
                const uint4 z4 = make_uint4(0, 0, 0, 0);
                const uint4 wc = *(const uint4*)(pc_ + P_WD), ac = *(const uint4*)(pc_ + P_AD);
                const uint4 wp = hp ? *(const uint4*)(pc_ + P_WD - IN_PAD) : z4, ap = hp ? *(const uint4*)(pc_ + P_AD - IN_PAD) : z4;
                const uint4 wn = hn ? *(const uint4*)(pc_ + P_WD + IN_PAD) : z4, an = hn ? *(const uint4*)(pc_ + P_AD + IN_PAD) : z4;
                const unsigned wcw[4] = {wc.x, wc.y, wc.z, wc.w}, wpw[4] = {wp.x, wp.y, wp.z, wp.w}, wnw[4] = {wn.x, wn.y, wn.z, wn.w};
                const unsigned acw[4] = {ac.x, ac.y, ac.z, ac.w}, apw[4] = {ap.x, ap.y, ap.z, ap.w}, anw[4] = {an.x, an.y, an.z, an.w};
                unsigned wo[4], ao[4];
#pragma unroll
                for (int e = 0; e < 4; ++e) { const int j = 16 * s + 8 * h + 2 * e;
                    const float mpw0 = cst[640 + j], mpw1 = cst[640 + j + 1], mnw0 = cst[672 + j], mnw1 = cst[672 + j + 1], mpa0 = cst[704 + j], mpa1 = cst[704 + j + 1], mna0 = cst[736 + j], mna1 = cst[736 + j + 1];
                    float c0 = lo_f(wcw[e]), c1 = hi_f(wcw[e]);
                    float x0 = c0 + mpw0 * (lo_f(wpw[e]) - c0) + mnw0 * (lo_f(wnw[e]) - c0), x1 = c1 + mpw1 * (hi_f(wpw[e]) - c1) + mnw1 * (hi_f(wnw[e]) - c1);
                    x0 = 1.f - 2.f * __builtin_amdgcn_rcpf(__expf(2.f * x0) + 1.f); x1 = 1.f - 2.f * __builtin_amdgcn_rcpf(__expf(2.f * x1) + 1.f);
                    wo[e] = cvtpk(x0, x1);
                    c0 = lo_f(acw[e]); c1 = hi_f(acw[e]);
                    x0 = c0 + mpa0 * (lo_f(apw[e]) - c0) + mna0 * (lo_f(anw[e]) - c0); x1 = c1 + mpa1 * (hi_f(apw[e]) - c1) + mna1 * (hi_f(anw[e]) - c1);
                    ao[e] = cvtpk(x0, x1); }
                wdf[s] = frag4(wo[0], wo[1], wo[2], wo[3]); adf[s] = frag4(ao[0], ao[1], ao[2], ao[3]);
                __builtin_amdgcn_sched_barrier(0);
            }
        }
        float lw[32], av[32];
        {
            const f32x16 zz = {0.f};
            int opq = 0; asm volatile("" : "+v"(opq));
#pragma unroll
            for (int tau = 0; tau < 2; ++tau) {
                const bf16* wrow = w2t + ((d * 512 + 64 * hd + 32 * tau + n + opq) * 32 + 8 * (h + opq));
                const bf16* arow = a2t + ((d * 512 + 64 * hd + 32 * tau + n + opq) * 32 + 8 * (h + opq));
                const bf16x8 wa0 = *(const bf16x8*)wrow, wa1 = *(const bf16x8*)(wrow + 16), aa0 = *(const bf16x8*)arow, aa1 = *(const bf16x8*)(arow + 16);
                f32x16 cw = MFMA32(wa0, wdf[0], zz); cw = MFMA32(wa1, wdf[1], cw);
                f32x16 ca = MFMA32(aa0, adf[0], zz); ca = MFMA32(aa1, adf[1], ca);
#pragma unroll
                for (int i = 0; i < 16; ++i) { const int ch = 32 * tau + 8 * (i >> 2) + 4 * h + (i & 3);
                    lw[16 * tau + i] = -0.60653066f * fsig(cw[i] + cst[6 * 64 + ch]); av[16 * tau + i] = fsig(ca[i] + cst[7 * 64 + ch]); }
                __builtin_amdgcn_sched_barrier(0);
            }
        }
        unsigned ge[32], avp[16];
#pragma unroll
        for (int m = 0; m < 32; ++m) { const float clm = prefix32(lw[m]); const float eg = __expf(clm); ge[m] = cvtpk(eg, eg * __expf(-lw[m])); if (n == 31) gC[8 * (m >> 2) + 4 * h + (m & 3)] = eg; }
#pragma unroll
        for (int m = 0; m < 16; ++m) avp[m] = cvtpk(av[2 * m], av[2 * m + 1]);
        __builtin_amdgcn_sched_barrier(0);
        unsigned pA[16], pB[16], pK[16], pR[16], pV[16];
        {
            unsigned kfp[16]; float ss = 0.f;
            lptr sb = L + rho * STG_STRIDE + 8 * h;
#pragma unroll
            for (int q = 0; q < 8; ++q) {
                const u32x2 cu = *(LAS u32x2*)(sb + 128 + 16 * q), pu_ = *(LAS u32x2*)(sb + 128 + 16 * q - STG_STRIDE), nu = *(LAS u32x2*)(sb + 128 + 16 * q + STG_STRIDE);
                const float cc[4] = {lo_f(cu.x), hi_f(cu.x), lo_f(cu.y), hi_f(cu.y)}, pp[4] = {lo_f(pu_.x), hi_f(pu_.x), lo_f(pu_.y), hi_f(pu_.y)}, nn[4] = {lo_f(nu.x), hi_f(nu.x), lo_f(nu.y), hi_f(nu.y)};
                float xk[4];
#pragma unroll
                for (int e = 0; e < 4; ++e) { const int ch = 8 * q + 4 * h + e; const float x = cc[e] + cst[2 * 64 + ch] * (pp[e] - cc[e]) + cst[3 * 64 + ch] * (nn[e] - cc[e]);
                    xk[e] = x; const float kr_ = x * cst[8 * 64 + ch]; ss += kr_ * kr_; }
                kfp[2 * q] = cvtpk(xk[0], xk[1]); kfp[2 * q + 1] = cvtpk(xk[2], xk[3]);
                __builtin_amdgcn_sched_barrier(0);
            }
            ss += __shfl_xor(ss, 32);
            const float inv = rsqrtf(fmaxf(ss, 1e-24f));
#pragma unroll
            for (int q = 0; q < 8; ++q) {
                const u32x2 cu = *(LAS u32x2*)(sb + 16 * q), pu_ = *(LAS u32x2*)(sb + 16 * q - STG_STRIDE), nu = *(LAS u32x2*)(sb + 16 * q + STG_STRIDE);
                const u32x2 cv = *(LAS u32x2*)(sb + 256 + 16 * q), pv_ = *(LAS u32x2*)(sb + 256 + 16 * q - STG_STRIDE), nv_ = *(LAS u32x2*)(sb + 256 + 16 * q + STG_STRIDE);
                const float rc[4] = {lo_f(cu.x), hi_f(cu.x), lo_f(cu.y), hi_f(cu.y)}, rp[4] = {lo_f(pu_.x), hi_f(pu_.x), lo_f(pu_.y), hi_f(pu_.y)}, rn[4] = {lo_f(nu.x), hi_f(nu.x), lo_f(nu.y), hi_f(nu.y)};
                const float vc[4] = {lo_f(cv.x), hi_f(cv.x), lo_f(cv.y), hi_f(cv.y)}, vp[4] = {lo_f(pv_.x), hi_f(pv_.x), lo_f(pv_.y), hi_f(pv_.y)}, vn[4] = {lo_f(nv_.x), hi_f(nv_.x), lo_f(nv_.y), hi_f(nv_.y)};
                float oa[4], ob[4], ok[4], orr[4], ov[4];
#pragma unroll
                for (int e = 0; e < 4; ++e) { const int ch = 8 * q + 4 * h + e, m = 4 * q + e;
                    const float rf = rc[e] + cst[0 * 64 + ch] * (rp[e] - rc[e]) + cst[1 * 64 + ch] * (rn[e] - rc[e]);
                    const float vf = vc[e] + cst[4 * 64 + ch] * (vp[e] - vc[e]) + cst[5 * 64 + ch] * (vn[e] - vc[e]);
                    const float eg = lo_f(ge[m]), ieg = __builtin_amdgcn_rcpf(eg), egm1 = hi_f(ge[m]);
                    const float kfm = (m & 1) ? hi_f(kfp[m >> 1]) : lo_f(kfp[m >> 1]), avm = (m & 1) ? hi_f(avp[m >> 1]) : lo_f(avp[m >> 1]);
                    const float kkn = kfm * cst[8 * 64 + ch] * inv;
                    oa[e] = -kkn * egm1; ob[e] = kkn * avm * ieg; ok[e] = kfm * (1.f + (avm - 1.f) * cst[9 * 64 + ch]) * ieg; orr[e] = rf * eg; ov[e] = vf; }
                pA[2 * q] = cvtpk(oa[0], oa[1]); pA[2 * q + 1] = cvtpk(oa[2], oa[3]); pB[2 * q] = cvtpk(ob[0], ob[1]); pB[2 * q + 1] = cvtpk(ob[2], ob[3]);
                pK[2 * q] = cvtpk(ok[0], ok[1]); pK[2 * q + 1] = cvtpk(ok[2], ok[3]); pR[2 * q] = cvtpk(orr[0], orr[1]); pR[2 * q + 1] = cvtpk(orr[2], orr[3]);
                pV[2 * q] = cvtpk(ov[0], ov[1]); pV[2 * q + 1] = cvtpk(ov[2], ov[3]);
                __builtin_amdgcn_sched_barrier(0);
            }
        }
        __builtin_amdgcn_fence(__ATOMIC_RELEASE, "workgroup"); __builtin_amdgcn_wave_barrier();
#pragma unroll
        for (int q = 0; q < 8; ++q) { const int off = img_off(n, 2 * q + h);
            *(LAS u32x2*)(L + off) = (u32x2){pA[2 * q], pA[2 * q + 1]}; *(LAS u32x2*)(L + 4096 + off) = (u32x2){pB[2 * q], pB[2 * q + 1]};
            *(LAS u32x2*)(L + 8192 + off) = (u32x2){pK[2 * q], pK[2 * q + 1]}; *(LAS u32x2*)(L + 12288 + off) = (u32x2){pV[2 * q], pV[2 * q + 1]}; }
        __builtin_amdgcn_fence(__ATOMIC_RELEASE, "workgroup"); __builtin_amdgcn_wave_barrier();
        const f32x16 Z16 = {0.f};
        f32x16 Lab = Z16, LabT = Z16, LakT = Z16, MrbT = Z16, MrkT = Z16;
#pragma unroll
        for (int ks = 0; ks < 4; ++ks) {
            const bf16x8 fA = frag4(pA[4 * ks], pA[4 * ks + 1], pA[4 * ks + 2], pA[4 * ks + 3]), fB = frag4(pB[4 * ks], pB[4 * ks + 1], pB[4 * ks + 2], pB[4 * ks + 3]);
            const bf16x8 fK = frag4(pK[4 * ks], pK[4 * ks + 1], pK[4 * ks + 2], pK[4 * ks + 3]), fR = frag4(pR[4 * ks], pR[4 * ks + 1], pR[4 * ks + 2], pR[4 * ks + 3]);
            Lab = MFMA32(fA, fB, Lab); LabT = MFMA32(fB, fA, LabT); LakT = MFMA32(fK, fA, LakT); MrbT = MFMA32(fB, fR, MrbT); MrkT = MFMA32(fK, fR, MrkT);
        }
#pragma unroll
        for (int i = 0; i < 16; ++i) { const int rr = crow(i, h);
            Lab[i] = (n < rr) ? Lab[i] : 0.f; LabT[i] = (rr < n) ? LabT[i] : 0.f; LakT[i] = (rr < n) ? LakT[i] : 0.f;
            MrbT[i] = (rr <= n) ? MrbT[i] : 0.f; MrkT[i] = (rr <= n) ? MrkT[i] : 0.f; }
        const bf16x8 pLk0 = pack(LakT, 0), pLk1 = pack(LakT, 1), pMb0 = pack(MrbT, 0), pMb1 = pack(MrbT, 1), pMk0 = pack(MrkT, 0), pMk1 = pack(MrkT, 1);
        __builtin_amdgcn_sched_barrier(0);
        f32x16 Pc = Lab, Ptc = LabT, Rtc = LabT;
#pragma unroll
        for (int i = 0; i < 16; ++i) Rtc[i] += (crow(i, h) == n) ? 1.f : 0.f;
#pragma unroll
        for (int lvl = 0; lvl < 4; ++lvl) {
            const bf16x8 pP0 = pack(Pc, 0), pP1 = pack(Pc, 1), pT0 = pack(Ptc, 0), pT1 = pack(Ptc, 1);
            f32x16 nPc = MFMA32(pT0, pP0, Z16); nPc = MFMA32(pT1, pP1, nPc);
            if (lvl < 3) { f32x16 nPt = MFMA32(pP0, pT0, Z16); nPt = MFMA32(pP1, pT1, nPt); Ptc = nPt; }
            const bf16x8 pN0 = pack(nPc, 0), pN1 = pack(nPc, 1), pR0 = pack(Rtc, 0), pR1 = pack(Rtc, 1);
            Rtc = MFMA32(pN0, pR0, Rtc); Rtc = MFMA32(pN1, pR1, Rtc);
            Pc = nPc;
        }
        const bf16x8 pT0 = pack(Rtc, 0), pT1 = pack(Rtc, 1);
        bf16x8 vt[2][2];
#pragma unroll
        for (int tau = 0; tau < 2; ++tau) { vt[tau][0] = trfrag(L + 12288, tau, 0, lane); vt[tau][1] = trfrag(L + 12288, tau, 1, lane); }
        bf16x8 pW1[2][2], pW2[2][2];
#pragma unroll
        for (int tau = 0; tau < 2; ++tau) {
            f32x16 lv = MFMA32(pLk0, vt[tau][0], Z16); lv = MFMA32(pLk1, vt[tau][1], lv);
            const bf16x8 a0f = trfrag(L, tau, 0, lane), a1f = trfrag(L, tau, 1, lane);
            f32x16 w1 = MFMA32(pT0, a0f, Z16); w1 = MFMA32(pT1, a1f, w1);
            const bf16x8 l0 = pack(lv, 0), l1 = pack(lv, 1);
            f32x16 w2_ = MFMA32(pT0, l0, Z16); w2_ = MFMA32(pT1, l1, w2_);
            pW1[tau][0] = pack(w1, 0); pW1[tau][1] = pack(w1, 1); pW2[tau][0] = pack(w2_, 0); pW2[tau][1] = pack(w2_, 1);
        }
        int opq2 = 0; asm volatile("" : "+v"(opq2));
        const int lane_o = lane + opq2, n_o = n + opq2;
        unsigned char* uo = UO + ((size_t)(b * 8 + hd) * 128 + c32) * UNIT_BYTES;
#pragma unroll
        for (int kap = 0; kap < 2; ++kap) { f32x16 q1;
#pragma unroll
            for (int i = 0; i < 16; ++i) q1[i] = (i & 1) ? hi_f(pR[8 * kap + (i >> 1)]) : lo_f(pR[8 * kap + (i >> 1)]);
            q1 = MFMA32(pW1[kap][0], pMb0, q1); q1 = MFMA32(pW1[kap][1], pMb1, q1);
            store_tile(uo + kap * 2048, q1, lane_o); }
#pragma unroll
        for (int tau = 0; tau < 2; ++tau) { f32x16 q2 = MFMA32(pMb0, pW2[tau][0], Z16); q2 = MFMA32(pMb1, pW2[tau][1], q2); q2 = MFMA32(pMk0, vt[tau][0], q2); q2 = MFMA32(pMk1, vt[tau][1], q2);
#pragma unroll
            for (int i = 0; i < 16; ++i) { const int s = crow(i, h), tk = d ? tok0 + 31 - s : tok0 + s; float* yp = ybuf + ((size_t)b * SEQ + tk) * 512 + 64 * hd + 32 * tau + n_o;
                if (d) *yp += q2[i]; else *yp = q2[i]; } }
        __builtin_amdgcn_fence(__ATOMIC_RELEASE, "workgroup"); __builtin_amdgcn_wave_barrier();
#pragma unroll
        for (int tp = 0; tp < 2; ++tp) {
            const bf16x8 b0f = trfrag(L + 4096, tp, 0, lane), b1f = trfrag(L + 4096, tp, 1, lane), k0f = trfrag(L + 8192, tp, 0, lane), k1f = trfrag(L + 8192, tp, 1, lane);
            const float gcl = gC[32 * tp + n];
#pragma unroll
            for (int kap = 0; kap < 2; ++kap) { f32x16 g = MFMA32(pW1[kap][0], b0f, Z16); g = MFMA32(pW1[kap][1], b1f, g);
#pragma unroll
                for (int i = 0; i < 16; ++i) g[i] = (g[i] + ((kap == tp && crow(i, h) == n) ? 1.f : 0.f)) * gcl;
                store_tile(uo + (2 + 2 * kap + tp) * 2048, g, lane_o); }
#pragma unroll
            for (int tau = 0; tau < 2; ++tau) { f32x16 ht = MFMA32(b0f, pW2[tau][0], Z16); ht = MFMA32(b1f, pW2[tau][1], ht); ht = MFMA32(k0f, vt[tau][0], ht); ht = MFMA32(k1f, vt[tau][1], ht);
#pragma unroll
                for (int i = 0; i < 16; ++i) ht[i] *= gC[32 * tp + crow(i, h)];
                store_tile(uo + (6 + 2 * tp + tau) * 2048, ht, lane_o); }
        }
        __builtin_amdgcn_fence(__ATOMIC_RELEASE, "workgroup"); __builtin_amdgcn_wave_barrier();
    }
}

DI void d_seq(const Ctx& c, int d, const unsigned char* __restrict__ UO, float* __restrict__ ybuf) {
    if (c.wave >= 2) return;
    const int lane = c.lane, n = lane & 31, h = lane >> 5, tau = c.wave;
    for (int chain = c.bid; chain < 64; chain += c.nb) {
        const int b = chain >> 3, hd = chain & 7;
        const unsigned char* ub = UO + (size_t)chain * 128 * UNIT_BYTES + lane * 32;
        const f32x16 Z16 = {0.f};
        f32x16 X0 = Z16, X1 = Z16;
        u32x4 T[8][2];
        auto loadu = [&](int c32) {
            const unsigned char* p = ub + (size_t)c32 * UNIT_BYTES;
#pragma unroll
            for (int k = 0; k < 6; ++k) { T[k][0] = *(const u32x4*)(p + k * 2048); T[k][1] = *(const u32x4*)(p + k * 2048 + 16); }
#pragma unroll
            for (int tp = 0; tp < 2; ++tp) { T[6 + tp][0] = *(const u32x4*)(p + (6 + 2 * tp + tau) * 2048); T[6 + tp][1] = *(const u32x4*)(p + (6 + 2 * tp + tau) * 2048 + 16); }
        };
        loadu(0);
#pragma unroll 1
        for (int c32 = 0; c32 < 128; ++c32) {
            const int tok0 = d ? SEQ - 32 * (c32 + 1) : 32 * c32;
            float* yb = ybuf + ((size_t)b * SEQ) * 512 + 64 * hd + 32 * tau + n;
            f32x16 y;
#pragma unroll
            for (int i = 0; i < 16; ++i) { const int s = crow(i, h), tk = d ? tok0 + 31 - s : tok0 + s; y[i] = yb[(size_t)tk * 512]; }
            const bf16x8 x00 = pack(X0, 0), x01 = pack(X0, 1), x10 = pack(X1, 0), x11 = pack(X1, 1);
            f32x16 n0, n1;
#pragma unroll
            for (int i = 0; i < 8; ++i) { n0[2 * i] = lo_f(T[6][i >> 2][i & 3]); n0[2 * i + 1] = hi_f(T[6][i >> 2][i & 3]); n1[2 * i] = lo_f(T[7][i >> 2][i & 3]); n1[2 * i + 1] = hi_f(T[7][i >> 2][i & 3]); }
#define FR(t, s) __builtin_bit_cast(bf16x8, T[t][s])
            n0 = MFMA32(FR(2, 0), x00, n0); n1 = MFMA32(FR(3, 0), x00, n1);
            n0 = MFMA32(FR(2, 1), x01, n0); n1 = MFMA32(FR(3, 1), x01, n1);
            n0 = MFMA32(FR(4, 0), x10, n0); n1 = MFMA32(FR(5, 0), x10, n1);
            n0 = MFMA32(FR(4, 1), x11, n0); n1 = MFMA32(FR(5, 1), x11, n1);
            y = MFMA32(FR(0, 0), x00, y); y = MFMA32(FR(0, 1), x01, y); y = MFMA32(FR(1, 0), x10, y); y = MFMA32(FR(1, 1), x11, y);
#undef FR
            if (c32 + 1 < 128) loadu(c32 + 1);
#pragma unroll
            for (int i = 0; i < 16; ++i) { const int s = crow(i, h), tk = d ? tok0 + 31 - s : tok0 + s; yb[(size_t)tk * 512] = y[i]; }
            X0 = n0; X1 = n1;
        }
    }
}
#undef DI
}
namespace pg8 {
struct EpiResF32 {
    static constexpr bool PERM = false, AFTER_DRAIN = false;
    const float* base; float* out; int ldc; float alpha;
    __device__ __forceinline__ void operator()(const f32x4 (&acc)[2][2][4][2], const Unit& u, int wr, int wc, int fr, int fq) const {
        const int col0 = u.pn * BM + wc * 32 + 4 * fq;
#pragma unroll
        for (int ai = 0; ai < 2; ++ai)
#pragma unroll
            for (int m = 0; m < 4; ++m) { const int r = ai * HALF + wr * 64 + m * 16 + fr; const size_t off = (size_t)(u.pm * BM + r) * ldc + col0;
#pragma unroll
                for (int bj = 0; bj < 2; ++bj)
#pragma unroll
                    for (int n = 0; n < 2; ++n) { const f32x4 bs = *(const f32x4*)(base + off + bj * HALF + n * 16); *(f32x4*)(out + off + bj * HALF + n * 16) = bs * alpha + acc[ai][bj][m][n]; } }
    }
};
}
constexpr size_t MiB = 1u << 20;
constexpr int LDS_BYTES = 147456;
constexpr int NPHASE = 14;
struct Params { const float* in[24]; float* out; unsigned char* ws; int ph_lo, ph_hi; };

__global__ void __launch_bounds__(512, 2) mega(Params p) {
    extern __shared__ __attribute__((aligned(16))) unsigned char lds[];
    cg::grid_group grid = cg::this_grid();
    Ctx c; c.wave = __builtin_amdgcn_readfirstlane(threadIdx.x >> 6); c.lane = (int)__builtin_amdgcn_mbcnt_hi(~0u, __builtin_amdgcn_mbcnt_lo(~0u, 0u)); c.tid = c.wave * 64 + c.lane; c.bid = blockIdx.x; c.nb = gridDim.x; c.gw = c.bid * 8 + c.wave; c.ngw = c.nb * 8; c.lds = lds;
#define LND(ptr) ({ auto q_ = (ptr); asm volatile("" : "+s"(q_)); q_; })
#define WSP(T, mb) ((T*)(LND(p.ws) + (size_t)(mb) * MiB))
#define x LND(p.in[0])
#define w_in LND(p.in[1])
#define mu_prev LND(p.in[2])
#define mu_next LND(p.in[3])
#define w0 LND(p.in[4])
#define w2 LND(p.in[5])
#define a0 LND(p.in[6])
#define a2 LND(p.in[7])
#define g2 LND(p.in[8])
#define k_k LND(p.in[9])
#define k_a LND(p.in[10])
#define r_k LND(p.in[11])
#define lnx_g LND(p.in[12])
#define lnx_b LND(p.in[13])
#define sink LND(p.in[14])
#define w_out LND(p.in[15])
#define ln1_g LND(p.in[16])
#define ln1_b LND(p.in[17])
#define wq LND(p.in[18])
#define keys LND(p.in[19])
#define pu LND(p.in[20])
#define pv LND(p.in[21])
#define ln2_g LND(p.in[22])
#define ln2_b LND(p.in[23])
#define out LND(p.out)
#define rope WSP(float2, 1)
#define w2t WSP(bf16, 2)
#define a2t ((bf16*)(LND(p.ws) + 2 * MiB + 65536))
#define w_in_t WSP(bf16, 4)
#define w_out_t WSP(bf16, 10)
#define wq_t WSP(bf16, 12)
#define xb WSP(bf16, 16)
#define qr WSP(bf16, 16)
#define kr WSP(bf16, 48)
#define ybuf WSP(float, 16)
#define ub WSP(bf16, 16)
#define vb WSP(bf16, 48)
#define proj WSP(bf16, 80)
#define y1 WSP(float, 80)
#define idx WSP(int, 208)
#define gate WSP(float, 224)
#define mix WSP(bf16, 240)
#define UO WSP(unsigned char, 304)
#define qb WSP(bf16, 304)
#define h1b WSP(bf16, 432)
    const int lo = p.ph_lo, hi = p.ph_hi;
#ifndef PH_MASK
#define PH_MASK 0xFFFF
#endif
#define IN(k) (((PH_MASK >> (k)) & 1) && lo <= (k) && (k) < hi)
#define SEAM(k) do { if (IN(k) && IN((k) + 1)) grid.sync(); c.lane = (int)__builtin_amdgcn_mbcnt_hi(~0u, __builtin_amdgcn_mbcnt_lo(~0u, 0u)); c.tid = c.wave * 64 + c.lane; } while (0)
    if (IN(0)) {
        nv::d_cvt_bf16(c, x, xb, (size_t)NTOK * DM / 4);
        nv::d_transpose_w(c, w_in, DM, IN_COLS, IN_PAD, w_in_t);
        nv::d_transpose_w(c, w_out, DM, DM, DM, w_out_t);
        nv::d_transpose_w(c, wq, DM, PEER_Q, PEER_Q, wq_t);
        nv::d_rope_table(c, rope);
        rw::d_lowrank_t(c, w2, a2, w2t, a2t);
    }
    SEAM(0);
    if (IN(1)) { pg8::Gemm g{xb, w_in_t, NTOK, IN_PAD, DM}; pg8::StaticOrder S; S.init(NTOK, IN_PAD, c.nb, c.bid); pg8::EpiBf16<0> E{proj, IN_PAD, nullptr, 0, 0, 1.f};
        pg8::gemm_phase<pg8::EpiBf16<0>, pg8::StaticOrder, true, true>((PG8_LAS unsigned char*)lds, g, S, E, c.wave); }
    SEAM(1);
    if (IN(2)) nv::d_rotary(c, proj, rope, qr, kr);
    SEAM(2);
    if (IN(3)) nv::d_attn(c, qr, kr, proj, sink, mix);
    SEAM(3);
    if (IN(4)) rw::d_prep(c, 0, proj, mu_prev, mu_next, w0, a0, k_k, k_a, w2t, a2t, UO, ybuf);
    SEAM(4);
    if (IN(5)) rw::d_seq(c, 0, UO, ybuf);
    SEAM(5);
    if (IN(6)) rw::d_prep(c, 1, proj, mu_prev, mu_next, w0, a0, k_k, k_a, w2t, a2t, UO, ybuf);
    SEAM(6);
    if (IN(7)) rw::d_seq(c, 1, UO, ybuf);
    SEAM(7);
    if (IN(8)) nv::d_rwkv_out<true>(c, proj, ybuf, mu_prev, mu_next, a0, a2, g2, k_a, r_k, lnx_g, lnx_b, mix);
    SEAM(8);
    if (IN(9)) { pg8::Gemm g{mix, w_out_t, NTOK, DM, DM}; pg8::StaticOrder S; S.init(NTOK, DM, c.nb, c.bid); pg8::EpiResF32 E{x, y1, DM, DN_ALPHA};
        pg8::gemm_phase<pg8::EpiResF32, pg8::StaticOrder, true, true>((PG8_LAS unsigned char*)lds, g, S, E, c.wave); }
    SEAM(9);
    if (IN(10)) { { float* y1p = y1; nv::d_ln1(c, y1p, ln1_g, ln1_b, y1p, h1b); } nv::d_cvt_bf16(c, pu, ub, (size_t)NEXP * DM / 4); nv::d_cvt_bf16(c, pv, vb, (size_t)NEXP * DM / 4); }
    SEAM(10);
    if (IN(11)) { pg8::Gemm g{h1b, wq_t, NTOK, PEER_Q, DM}; pg8::StaticOrder S; S.init(NTOK, PEER_Q, c.nb, c.bid); pg8::EpiBf16<0> E{qb, PEER_Q, nullptr, 0, 0, 1.f};
        pg8::gemm_phase<pg8::EpiBf16<0>, pg8::StaticOrder, true, true>((PG8_LAS unsigned char*)lds, g, S, E, c.wave); }
    SEAM(11);
    if (IN(12)) nv::d_peer_topk(c, qb, keys, idx, gate);
    SEAM(12);
    if (IN(13)) pe::d_peer_gather(c, h1b, idx, gate, ub, vb, ln2_g, ln2_b, out);
#undef IN
#undef SEAM
}
#undef x
#undef out
#undef proj
#undef mix
#undef idx
#undef gate
#undef keys
#undef rope
#undef w0
#undef w2
#undef a0
#undef a2
#undef g2
#undef sink
#undef qr
#undef kr
#undef ub
#undef vb
#undef qb
#undef xb
#undef y1
#undef UO
#undef ybuf
#undef pu
#undef pv

#ifndef N_LAUNCHES
#define N_LAUNCHES 1
#endif
extern "C" void kernel_launch(void* const* d_in, const int* in_sizes, int n_in, void* d_out, int out_size, void* d_ws, size_t ws_size, hipStream_t stream) {
    static int grid = 0;
    if (grid == 0) {
        if (n_in != 24 || in_sizes[0] != NTOK * DM || out_size != NTOK * DM || ws_size < 496 * MiB) { fprintf(stderr, "kernel_launch: unexpected shapes/ws (n_in %d, ws %zu)\n", n_in, ws_size); grid = -1; return; }
        int dev = 0, cus = 0, per_cu = 0;
        if (hipGetDevice(&dev) != hipSuccess || hipDeviceGetAttribute(&cus, hipDeviceAttributeMultiprocessorCount, dev) != hipSuccess) { grid = -1; return; }
        if (hipFuncSetAttribute((const void*)mega, hipFuncAttributeMaxDynamicSharedMemorySize, LDS_BYTES) != hipSuccess) { fprintf(stderr, "kernel_launch: hipFuncSetAttribute failed\n"); grid = -1; return; }
        if (hipOccupancyMaxActiveBlocksPerMultiprocessor(&per_cu, (const void*)mega, 512, LDS_BYTES) != hipSuccess || per_cu < 1) { fprintf(stderr, "kernel_launch: occupancy query failed (%d)\n", per_cu); (void)hipGetLastError(); grid = -1; return; }
        grid = cus * per_cu;
        fprintf(stderr, "kernel_launch: cus %d per_cu %d grid %d\n", cus, per_cu, grid);
    }
    if (grid < 0) return;
    Params p{};
    for (int i = 0; i < 24; ++i) p.in[i] = (const float*)d_in[i];
    p.out = (float*)d_out; p.ws = (unsigned char*)d_ws;
#if N_LAUNCHES == 1
    p.ph_lo = 0; p.ph_hi = NPHASE;
    void* args[] = {&p};
    hipError_t e = hipLaunchCooperativeKernel((const void*)mega, dim3(grid), dim3(512), args, LDS_BYTES, stream);
    if (e != hipSuccess) fprintf(stderr, "cooperative launch failed: %s (grid %d)\n", hipGetErrorString(e), grid);
#else
    for (int k = 0; k < NPHASE; ++k) { p.ph_lo = k; p.ph_hi = k + 1; hipLaunchKernelGGL(mega, dim3(grid), dim3(512), LDS_BYTES, stream, p); }
#endif
}
```

```cpp
#include <hip/hip_runtime.h>
#include <hip/hip_cooperative_groups.h>
#include <cstdio>
#include <cstdint>
#include <cmath>
namespace cg = cooperative_groups;

constexpr int BATCH = 8, SEQ = 4096, DM = 1024, NTOK = BATCH * SEQ;
constexpr int IN_COLS = 2528, IN_PAD = 2560;
constexpr int C_Q = 0, C_K = 512, C_V = 640, C_P = 768;
constexpr int P_R = 0, P_KK = 512, P_VV = 1024, P_WD = 1536, P_AD = 1600, P_GD = 1664, RW_COLS = 1760;
constexpr int NEXP = 16384, PEER_Q = 2048;
constexpr float LN_EPS = 1e-5f, GN_EPS = 64e-5f;
constexpr float DN_ALPHA = 1.189207115002721f;

typedef unsigned short bf16;
__device__ __forceinline__ float bf2f(bf16 v) { return __uint_as_float(((unsigned)v) << 16); }
__device__ __forceinline__ bf16 f2bf(float f) { unsigned u = __float_as_uint(f); return (bf16)((u + 0x7fffu + ((u >> 16) & 1u)) >> 16); }
__device__ __forceinline__ unsigned pk2bf(float lo, float hi) { return (unsigned)f2bf(lo) | ((unsigned)f2bf(hi) << 16); }
__device__ __forceinline__ float wave_sum(float v) {
#pragma unroll
    for (int o = 1; o < 64; o <<= 1) v += __shfl_xor(v, o);
    return v;
}
__device__ __forceinline__ float sigmoidf_(float x) { return 1.f / (1.f + __expf(-x)); }
namespace pg8 {
#define PG8_LAS __attribute__((address_space(3)))
typedef unsigned short bf16_t;
typedef short bf16x8 __attribute__((ext_vector_type(8)));
typedef float f32x4 __attribute__((ext_vector_type(4)));
typedef unsigned u32x4 __attribute__((ext_vector_type(4)));
constexpr int BM = 256, BK = 64, HALF = 128, HTB = HALF * BK * 2  , STAGE_BYTES = 8 * HTB, NXCD = 8, WGM = 8;

__host__ __device__ __forceinline__ int lds_byte(int r, int c) { const int st = (r >> 4) * 2 + (c >> 5), rr = r & 15, cc = c & 31, ob = rr * 64 + cc * 2; return st * 1024 + (ob ^ (((ob >> 9) & 1) << 5)); }
__host__ __device__ __forceinline__ void stage_rc(int b, int& R, int& C) { const int st = b / 1024, sb = b % 1024, swz = sb ^ (((sb >> 9) & 1) << 5); R = (st >> 1) * 16 + swz / 64; C = (st & 1) * 32 + (swz % 64) / 2; }
__host__ __device__ __forceinline__ int perm32(int rho) { const int n = rho >> 4, i = rho & 15; return 8 * (i >> 2) + 4 * n + (i & 3); }

struct Unit { int pm, pn; };
struct Gemm { const bf16_t* A; const bf16_t* Bt; int M, N, K; };

struct StaticOrder {
    int nM, nN, nwg, G, c;
    __host__ __device__ void init(int M, int N, int G_, int c_) { nM = M / BM; nN = N / BM; nwg = nM * nN; G = G_; c = c_; }
    __host__ __device__ bool next(int i, Unit& u) const {
        const long L = (long)i * G + c; if (L >= nwg) return false;
        int wgid = (int)L; { const int q = nwg / NXCD, r = nwg % NXCD, xcd = wgid % NXCD, off = wgid / NXCD; wgid = (xcd < r ? xcd * (q + 1) : r * (q + 1) + (xcd - r) * q) + off; }
        const int nig = WGM * nN, gid = wgid / nig, fm = gid * WGM, gsz = (nM - fm) < WGM ? (nM - fm) : WGM;
        u.pm = fm + ((wgid % nig) % gsz); u.pn = (wgid % nig) / gsz; return true;
    }
    __device__ __forceinline__ void a_ready(const Unit&) const {}
    __device__ __forceinline__ void done(const Unit&) const {}
};

__device__ __forceinline__ unsigned cvt_pk_bf16(float lo, float hi) { unsigned r; asm volatile("v_cvt_pk_bf16_f32 %0, %1, %2" : "=v"(r) : "v"(lo), "v"(hi)); return r; }
typedef float f32x2 __attribute__((ext_vector_type(2)));
__device__ __forceinline__ f32x2 gelu_pk(f32x2 v) {
    const f32x2 av = __builtin_elementwise_abs(v), d = av * 0.2316418882f + 1.0f;
    f32x2 t; t.x = __builtin_amdgcn_rcpf(d.x); t.y = __builtin_amdgcn_rcpf(d.y);
    f32x2 q = t * 0.5307027145f + (-0.7265760135f); q = q * t + 0.7107068705f; q = q * t + (-0.142248368f); q = q * t + 0.127414796f; q = q * t;
    const f32x2 s = (v * v) * (-0.72134752044f);
    f32x2 e; e.x = __builtin_amdgcn_exp2f(s.x); e.y = __builtin_amdgcn_exp2f(s.y);
    const f32x2 m = v * (q * e), r = v - m;
    f32x2 o; o.x = v.x < 0.f ? m.x : r.x; o.y = v.y < 0.f ? m.y : r.y; return o;
}

template <int ACT  > struct EpiBf16 {
    static constexpr bool PERM = true, AFTER_DRAIN = false; static_assert(ACT == 0 || ACT == 1, "EpiBf16: ACT is 0 (none) or 1 (gelu_pk)");
    bf16_t* O; int ldc; const float* bias; int split_cols; size_t split_stride; float scale0;
    __device__ __forceinline__ void operator()(const f32x4 (&acc)[2][2][4][2], const Unit& u, int wr, int wc, int fr, int fq) const {
        const int row0 = u.pm * BM + wr * 64 + fr; int colt = u.pn * BM; bf16_t* base = O;
        float sc = 1.f; if (split_cols) { const int t = colt / split_cols; base += (size_t)t * split_stride; colt -= t * split_cols; if (t == 0) sc = scale0; }
        const int col0 = colt + wc * 32 + 8 * fq, bcol0 = u.pn * BM + wc * 32 + 8 * fq;
        f32x4 bv[2][2];
#pragma unroll
        for (int bj = 0; bj < 2; ++bj)
#pragma unroll
            for (int n = 0; n < 2; ++n) bv[bj][n] = bias ? *(const f32x4*)(bias + bcol0 + bj * HALF + 4 * n) : (f32x4){0.f, 0.f, 0.f, 0.f};
#pragma unroll
        for (int ai = 0; ai < 2; ++ai)
#pragma unroll
            for (int m = 0; m < 4; ++m) { bf16_t* rowp = base + (size_t)(row0 + ai * HALF + m * 16) * ldc + col0;
#pragma unroll
                for (int bj = 0; bj < 2; ++bj) { f32x4 v0 = acc[ai][bj][m][0] + bv[bj][0], v1 = acc[ai][bj][m][1] + bv[bj][1];
                    if (ACT == 1) { f32x2 a = gelu_pk((f32x2){v0[0], v0[1]}), b = gelu_pk((f32x2){v0[2], v0[3]}), c = gelu_pk((f32x2){v1[0], v1[1]}), d = gelu_pk((f32x2){v1[2], v1[3]});
                        v0 = (f32x4){a.x, a.y, b.x, b.y}; v1 = (f32x4){c.x, c.y, d.x, d.y}; }
                    v0 = v0 * sc; v1 = v1 * sc; u32x4 w; w.x = cvt_pk_bf16(v0[0], v0[1]); w.y = cvt_pk_bf16(v0[2], v0[3]); w.z = cvt_pk_bf16(v1[0], v1[1]); w.w = cvt_pk_bf16(v1[2], v1[3]);
                    *(u32x4*)(rowp + bj * HALF) = w; } }
    }
};

struct PanelStats {
    unsigned* xbuf;
    unsigned* cnt;
    unsigned* tmo;
    int ntn; float eps;
    unsigned code;
    __device__ __forceinline__ bool run(const f32x4 (&v)[2][2][4][2], const Unit& u, int wr, int wc, int fr, int fq, PG8_LAS unsigned char* lds, int wid, int lane) const {
        typedef float f32x2v __attribute__((ext_vector_type(2)));
        PG8_LAS f32x2v* P = (PG8_LAS f32x2v*)lds;
        PG8_LAS f32x2v* S = (PG8_LAS f32x2v*)(lds + 8192);
        PG8_LAS unsigned* flag = (PG8_LAS unsigned*)(lds + 8192 + 2048);
#pragma unroll
        for (int ai = 0; ai < 2; ++ai)
#pragma unroll
            for (int m = 0; m < 4; ++m) {
                float s = 0.f;
#pragma unroll
                for (int bj = 0; bj < 2; ++bj)
#pragma unroll
                    for (int n = 0; n < 2; ++n) { const f32x4 x = v[ai][bj][m][n]; s += (x[0] + x[1]) + (x[2] + x[3]); }
                s += __shfl_xor(s, 16); s += __shfl_xor(s, 32);
                const float mw = s * (1.0f / 64.0f); float q = 0.f;
#pragma unroll
                for (int bj = 0; bj < 2; ++bj)
#pragma unroll
                    for (int n = 0; n < 2; ++n) { const f32x4 d = v[ai][bj][m][n] - mw; q += (d[0] * d[0] + d[1] * d[1]) + (d[2] * d[2] + d[3] * d[3]); }
                q += __shfl_xor(q, 16); q += __shfl_xor(q, 32);
                if (fq == 0) P[(ai * HALF + wr * 64 + m * 16 + fr) * 4 + wc] = (f32x2v){mw, q};
            }
        asm volatile("s_waitcnt lgkmcnt(0)" ::: "memory"); __builtin_amdgcn_s_barrier(); asm volatile("" ::: "memory");
#if defined(BROKEN_EXCHANGE_NO_WAIT)
#warning BROKEN CONTROL BUILD: the row-statistics exchange does not wait; results are wrong by design
        if (blockIdx.x >= 64) { const long long t0_ = clock64(); while (clock64() - t0_ < 60000) __builtin_amdgcn_s_sleep(8); }
#endif
        const int row = wid * 32 + (lane & 31);
        if (lane < 32) {
            const f32x2v a = P[row * 4 + 0], b = P[row * 4 + 1], c = P[row * 4 + 2], d = P[row * 4 + 3];
            const float mt = (a.x + b.x + c.x + d.x) * 0.25f;
            const float da = a.x - mt, db = b.x - mt, dc = c.x - mt, dd = d.x - mt;
            const float m2 = (a.y + b.y) + (c.y + d.y) + 64.0f * ((da * da + db * db) + (dc * dc + dd * dd));
            unsigned long long* slot = (unsigned long long*)xbuf + ((size_t)(u.pm * BM + row) * 4 + u.pn);
            __hip_atomic_store(slot, ((unsigned long long)__float_as_uint(m2) << 32) | __float_as_uint(mt), __ATOMIC_RELAXED, __HIP_MEMORY_SCOPE_AGENT);
        }
        asm volatile("s_waitcnt vmcnt(0)" ::: "memory");
        if (lane == 0) __hip_atomic_fetch_add(cnt + 64 * u.pm, 1u, __ATOMIC_RELAXED, __HIP_MEMORY_SCOPE_AGENT);
        if (wid == 0) {
            bool dead = false; const unsigned long long t0 = __builtin_amdgcn_s_memrealtime(); const unsigned want = 8u * (unsigned)ntn;
            for (;;) {
#if defined(BROKEN_EXCHANGE_NO_WAIT)
                break;
#endif
                if ((unsigned)__builtin_amdgcn_readfirstlane(__hip_atomic_load(cnt + 64 * u.pm, __ATOMIC_RELAXED, __HIP_MEMORY_SCOPE_AGENT)) >= want) break;
                if (__builtin_amdgcn_s_memrealtime() - t0 > 2000000ull) {
                    if (lane == 0) { unsigned expect = 0u; __hip_atomic_compare_exchange_strong(tmo + 1, &expect, code | (unsigned)(u.pm & 0xff), __ATOMIC_RELAXED, __ATOMIC_RELAXED, __HIP_MEMORY_SCOPE_AGENT);
                                     __hip_atomic_store(tmo, 1u, __ATOMIC_RELAXED, __HIP_MEMORY_SCOPE_AGENT); }
                    dead = true; break; }
                __builtin_amdgcn_s_sleep(2);
            }
            __builtin_amdgcn_fence(__ATOMIC_ACQUIRE, "agent");
            if (lane == 0) flag[0] = dead ? 1u : 0u;
        }
        asm volatile("s_waitcnt vmcnt(0) lgkmcnt(0)" ::: "memory"); __builtin_amdgcn_s_barrier(); asm volatile("" ::: "memory");
        const bool bad = flag[0] != 0u;
        if (lane < 32) {
            const unsigned long long* slot = (const unsigned long long*)xbuf + (size_t)(u.pm * BM + row) * 4; float mt[4], m2[4]; float ms = 0.f;
#pragma unroll
            for (int t = 0; t < 4; ++t) { if (t < ntn) { const unsigned long long w = __hip_atomic_load(slot + t, __ATOMIC_RELAXED, __HIP_MEMORY_SCOPE_AGENT); mt[t] = __uint_as_float((unsigned)w); m2[t] = __uint_as_float((unsigned)(w >> 32)); } else { mt[t] = 0.f; m2[t] = 0.f; } ms += mt[t]; }
            const float mean = ms / (float)ntn; float q = 0.f;
#pragma unroll
            for (int t = 0; t < 4; ++t) if (t < ntn) { const float dm = mt[t] - mean; q += m2[t] + 256.0f * dm * dm; }
            S[row] = (f32x2v){mean, 1.0f / sqrtf(q / (256.0f * (float)ntn) + eps)};
        }
        asm volatile("s_waitcnt lgkmcnt(0)" ::: "memory"); __builtin_amdgcn_s_barrier(); asm volatile("" ::: "memory");
        return bad;
    }
};
struct EpiLnRes {
    static constexpr bool PERM = false, AFTER_DRAIN = true;
    const float* base; float* out; int ldc; const float* bias; PanelStats st; unsigned poison;
    __device__ __forceinline__ void fused(f32x4 (&acc)[2][2][4][2], const Unit& u, int wr, int wc, int fr, int fq, PG8_LAS unsigned char* lds, int wid, int lane) const {
        typedef float f32x2v __attribute__((ext_vector_type(2)));
        const PG8_LAS f32x2v* S = (const PG8_LAS f32x2v*)(lds + 8192);
        const int col0 = u.pn * BM + wc * 32 + 4 * fq;
#pragma unroll
        for (int bj = 0; bj < 2; ++bj)
#pragma unroll
            for (int n = 0; n < 2; ++n) { const f32x4 bv = bias ? *(const f32x4*)(bias + col0 + bj * HALF + n * 16) : (f32x4){0.f, 0.f, 0.f, 0.f};
#pragma unroll
                for (int ai = 0; ai < 2; ++ai)
#pragma unroll
                    for (int m = 0; m < 4; ++m) acc[ai][bj][m][n] += bv; }
        f32x4 pre[4][2][2];
#pragma unroll
        for (int m = 0; m < 4; ++m) { const size_t off = (size_t)(u.pm * BM + wr * 64 + m * 16 + fr) * ldc + col0;
#pragma unroll
            for (int bj = 0; bj < 2; ++bj)
#pragma unroll
                for (int n = 0; n < 2; ++n) pre[m][bj][n] = *(const f32x4*)(base + off + bj * HALF + n * 16); }
        const bool bad = st.run(acc, u, wr, wc, fr, fq, lds, wid, lane) || poison != 0u;
        const float qnan = __builtin_nanf("");
#pragma unroll
        for (int ai = 0; ai < 2; ++ai)
#pragma unroll
            for (int m = 0; m < 4; ++m) { const int r = ai * HALF + wr * 64 + m * 16 + fr; const f32x2v sr = S[r]; const size_t off = (size_t)(u.pm * BM + r) * ldc + col0;
#pragma unroll
                for (int bj = 0; bj < 2; ++bj)
#pragma unroll
                    for (int n = 0; n < 2; ++n) { const f32x4 bs = ai == 0 ? pre[m][bj][n] : *(const f32x4*)(base + off + bj * HALF + n * 16); f32x4 o = bs + (acc[ai][bj][m][n] - sr.x) * sr.y;
                        if (bad) o = (f32x4){qnan, qnan, qnan, qnan}; *(f32x4*)(out + off + bj * HALF + n * 16) = o; }
                if (m & 1) asm volatile("" ::: "memory"); }
    }
};
struct EpiLnResLn {
    static constexpr bool PERM = false, AFTER_DRAIN = true;
    const float* base; float* out; bf16_t* xn; int ldc; const float* bias; PanelStats st1, st2; unsigned poison;
    __device__ __forceinline__ void fused(f32x4 (&acc)[2][2][4][2], const Unit& u, int wr, int wc, int fr, int fq, PG8_LAS unsigned char* lds, int wid, int lane) const {
        typedef float f32x2v __attribute__((ext_vector_type(2))); typedef unsigned u32x2v __attribute__((ext_vector_type(2)));
        const PG8_LAS f32x2v* S = (const PG8_LAS f32x2v*)(lds + 8192);
        const int col0 = u.pn * BM + wc * 32 + 4 * fq;
#pragma unroll
        for (int bj = 0; bj < 2; ++bj)
#pragma unroll
            for (int n = 0; n < 2; ++n) { const f32x4 bv = bias ? *(const f32x4*)(bias + col0 + bj * HALF + n * 16) : (f32x4){0.f, 0.f, 0.f, 0.f};
#pragma unroll
                for (int ai = 0; ai < 2; ++ai)
#pragma unroll
                    for (int m = 0; m < 4; ++m) acc[ai][bj][m][n] += bv; }
        bool bad = st1.run(acc, u, wr, wc, fr, fq, lds, wid, lane) || poison != 0u;
        const float qnan = __builtin_nanf("");
#pragma unroll
        for (int ai = 0; ai < 2; ++ai)
#pragma unroll
            for (int m = 0; m < 4; ++m) { const int r = ai * HALF + wr * 64 + m * 16 + fr; const f32x2v sr = S[r]; const size_t off = (size_t)(u.pm * BM + r) * ldc + col0;
#pragma unroll
                for (int bj = 0; bj < 2; ++bj)
#pragma unroll
                    for (int n = 0; n < 2; ++n) { const f32x4 bs = *(const f32x4*)(base + off + bj * HALF + n * 16); acc[ai][bj][m][n] = bs + (acc[ai][bj][m][n] - sr.x) * sr.y; }
                asm volatile("" : "+v"(acc[ai][0][m][0]), "+v"(acc[ai][0][m][1]), "+v"(acc[ai][1][m][0]), "+v"(acc[ai][1][m][1]));
                if (m & 1) asm volatile("" ::: "memory"); }
        const bool bad1 = bad;
        bad = st2.run(acc, u, wr, wc, fr, fq, lds, wid, lane) || bad;
#pragma unroll
        for (int ai = 0; ai < 2; ++ai)
#pragma unroll
            for (int m = 0; m < 4; ++m) { const int r = ai * HALF + wr * 64 + m * 16 + fr; const f32x2v sr = S[r]; const size_t off = (size_t)(u.pm * BM + r) * ldc + col0;
#pragma unroll
                for (int bj = 0; bj < 2; ++bj)
#pragma unroll
                    for (int n = 0; n < 2; ++n) { const f32x4 x1 = acc[ai][bj][m][n]; *(f32x4*)(out + off + bj * HALF + n * 16) = bad1 ? (f32x4){qnan, qnan, qnan, qnan} : x1;
                        const f32x4 o = (x1 - sr.x) * sr.y; u32x2v w; w.x = cvt_pk_bf16(o[0], o[1]); w.y = cvt_pk_bf16(o[2], o[3]);
                        if (bad) { w.x = 0x7fc07fc0u; w.y = 0x7fc07fc0u; } *(u32x2v*)(xn + off + bj * HALF + n * 16) = w; }
                asm volatile("" ::: "memory"); }
    }
};

template <class Epi, class Sched, bool ALIGN_EPI = false, bool SP2 = false>
__device__ __forceinline__ void gemm_phase(PG8_LAS unsigned char* lds, const Gemm g, const Sched& S, const Epi& E, const int wid_in) {
    const int lane = (int)__builtin_amdgcn_mbcnt_hi(~0u, __builtin_amdgcn_mbcnt_lo(~0u, 0u)), wid = wid_in, tid = wid * 64 + lane, wr = wid >> 2, wc = wid & 3, fr = lane & 15, fq = lane >> 4;
    const int K = g.K, nt = K / BK;
    unsigned voffA[2], voffB[2];
#pragma unroll
    for (int i = 0; i < 2; ++i) { int R, C; stage_rc(tid * 16 + i * 8192, R, C); const int Rb = Epi::PERM ? ((R & ~31) + perm32(R & 31)) : R;
        voffA[i] = (unsigned)(R * K + C) * 2u; voffB[i] = (unsigned)(Rb * K + C) * 2u; }
    const size_t kstep = (size_t)(BK * 2);
    const size_t hstep = (size_t)HALF * K * 2;
    const size_t tstep = 2 * hstep;
    const unsigned ldsw = (unsigned)wid * 1024u;
    const int aoff = lds_byte(wr * 64 + fr, fq * 8), boff = lds_byte(wc * 32 + fr, fq * 8);
#define PG8_SA(b, h) (((b) * 2 + (h)) * HTB)
#define PG8_SB(b, h) ((4 + (b) * 2 + (h)) * HTB)
#define PG8_STAGE(bufoff, gbase, voff) do { _Pragma("unroll") for (int _i = 0; _i < 2; ++_i) \
        __builtin_amdgcn_global_load_lds((const unsigned*)((const char*)(gbase) + (voff)[_i]), (PG8_LAS unsigned*)(lds + (bufoff) + ldsw + _i * 8192), 16, 0, 0); } while (0)
#define PG8_LDA(dst, b, h) do { _Pragma("unroll") for (int m = 0; m < 4; ++m) _Pragma("unroll") for (int k = 0; k < 2; ++k) dst[m][k] = *(const PG8_LAS bf16x8*)(lds + PG8_SA(b, h) + aoff + m * 2048 + k * 1024); } while (0)
#define PG8_LDB(dst, b, h) do { _Pragma("unroll") for (int n = 0; n < 2; ++n) _Pragma("unroll") for (int k = 0; k < 2; ++k) dst[n][k] = *(const PG8_LAS bf16x8*)(lds + PG8_SB(b, h) + boff + n * 2048 + k * 1024); } while (0)
#define PG8_MMA(ai, bj, At, Bt) do { __builtin_amdgcn_s_setprio(1); _Pragma("unroll") for (int m = 0; m < 4; ++m) _Pragma("unroll") for (int n = 0; n < 2; ++n) _Pragma("unroll") for (int k = 0; k < 2; ++k) \
        acc[ai][bj][m][n] = __builtin_amdgcn_mfma_f32_16x16x32_bf16(Bt[n][k], At[m][k], acc[ai][bj][m][n], 0, 0, 0); __builtin_amdgcn_s_setprio(0); } while (0)
#define PG8_WAIT_V(n) asm volatile("s_waitcnt vmcnt(" #n ")" ::: "memory")
#define PG8_WAIT_L(n) asm volatile("s_waitcnt lgkmcnt(" #n ")" ::: "memory")
#define PG8_BAR __builtin_amdgcn_s_barrier()
#define PG8_SCHED __builtin_amdgcn_sched_barrier(0)
    Unit cur, nxt; int ui = 0;
    if (!S.next(0, cur)) return;
    f32x4 acc[2][2][4][2];
#pragma unroll
    for (int a = 0; a < 2; ++a)
#pragma unroll
        for (int b = 0; b < 2; ++b)
#pragma unroll
            for (int m = 0; m < 4; ++m)
#pragma unroll
                for (int n = 0; n < 2; ++n) acc[a][b][m][n] = (f32x4){0.f, 0.f, 0.f, 0.f};
    bf16x8 At[4][2], B0[2][2], B1[2][2];
    const char* cA = (const char*)g.A + (size_t)cur.pm * tstep; const char* cB = (const char*)g.Bt + (size_t)cur.pn * tstep;
    S.a_ready(cur);
    if constexpr (SP2) {
        PG8_STAGE(PG8_SB(0, 0), cB, voffB); PG8_STAGE(PG8_SB(0, 1), cB + hstep, voffB); PG8_STAGE(PG8_SA(0, 0), cA, voffA); PG8_STAGE(PG8_SA(0, 1), cA + hstep, voffA);
        if (wr == 1) PG8_BAR;
        PG8_WAIT_V(2); PG8_BAR;
        PG8_STAGE(PG8_SB(1, 0), cB + kstep, voffB); PG8_STAGE(PG8_SA(1, 0), cA + kstep, voffA); PG8_STAGE(PG8_SB(1, 1), cB + hstep + kstep, voffB);
        PG8_WAIT_V(6); PG8_BAR;
    } else {
        PG8_STAGE(PG8_SB(0, 0), cB, voffB); PG8_STAGE(PG8_SA(0, 0), cA, voffA); PG8_STAGE(PG8_SB(0, 1), cB + hstep, voffB); PG8_STAGE(PG8_SA(0, 1), cA + hstep, voffA);
        if (wr == 1) PG8_BAR;
        PG8_WAIT_V(4); PG8_BAR;
        PG8_STAGE(PG8_SB(1, 0), cB + kstep, voffB); PG8_STAGE(PG8_SA(1, 0), cA + kstep, voffA); PG8_STAGE(PG8_SB(1, 1), cB + hstep + kstep, voffB);
        PG8_WAIT_V(6); PG8_BAR;
    }
    for (;;) {
        const bool has_next = S.next(ui + 1, nxt);
        const char* nA = has_next ? (const char*)g.A + (size_t)nxt.pm * tstep : cA; const char* nB = has_next ? (const char*)g.Bt + (size_t)nxt.pn * tstep : cB;
        for (int t = 0; t < nt; t += 2) {
            const bool last = (t == nt - 2);
            const char* a1 = cA + (size_t)(t + 1) * kstep;
            const char* a2 = last ? nA : cA + (size_t)(t + 2) * kstep; const char* b2 = last ? nB : cB + (size_t)(t + 2) * kstep;
            const char* a3 = a2 + kstep; const char* b3 = b2 + kstep;
            if (last && has_next) S.a_ready(nxt);
            if constexpr (SP2) {
            PG8_LDB(B0, 0, 0); PG8_LDB(B1, 0, 1); PG8_SCHED; PG8_LDA(At, 0, 0); PG8_STAGE(PG8_SA(1, 1), a1 + hstep, voffA);
            PG8_WAIT_V(8); PG8_WAIT_L(0); PG8_BAR; PG8_MMA(0, 0, At, B0); PG8_MMA(0, 1, At, B1); PG8_BAR; PG8_SCHED;
            PG8_LDA(At, 0, 1); PG8_STAGE(PG8_SB(0, 0), b2, voffB); PG8_STAGE(PG8_SB(0, 1), b2 + hstep, voffB); PG8_STAGE(PG8_SA(0, 0), a2, voffA);
            PG8_WAIT_V(8); PG8_WAIT_L(0); PG8_BAR; PG8_MMA(1, 0, At, B0); PG8_MMA(1, 1, At, B1); PG8_BAR; PG8_SCHED;
            PG8_LDB(B0, 1, 0); PG8_LDB(B1, 1, 1); PG8_SCHED; PG8_LDA(At, 1, 0); PG8_STAGE(PG8_SA(0, 1), a2 + hstep, voffA);
            PG8_WAIT_V(8); PG8_WAIT_L(0); PG8_BAR; PG8_MMA(0, 0, At, B0); PG8_MMA(0, 1, At, B1); PG8_BAR; PG8_SCHED;
            PG8_LDA(At, 1, 1); PG8_STAGE(PG8_SB(1, 0), b3, voffB); PG8_STAGE(PG8_SB(1, 1), b3 + hstep, voffB); PG8_STAGE(PG8_SA(1, 0), a3, voffA);
            PG8_WAIT_V(8); PG8_WAIT_L(0); PG8_BAR; PG8_MMA(1, 0, At, B0); PG8_MMA(1, 1, At, B1); PG8_BAR; PG8_SCHED;
            } else {
            PG8_LDB(B0, 0, 0); PG8_SCHED; PG8_LDA(At, 0, 0); PG8_STAGE(PG8_SA(1, 1), a1 + hstep, voffA);
            PG8_WAIT_L(8); PG8_BAR; PG8_WAIT_L(0); PG8_MMA(0, 0, At, B0); PG8_BAR; PG8_SCHED;
            PG8_LDB(B1, 0, 1); PG8_STAGE(PG8_SB(0, 0), b2, voffB);
            PG8_BAR; PG8_WAIT_L(0); PG8_MMA(0, 1, At, B1); PG8_BAR;
            PG8_LDA(At, 0, 1); PG8_STAGE(PG8_SA(0, 0), a2, voffA);
            PG8_BAR; PG8_WAIT_L(0); PG8_MMA(1, 0, At, B0); PG8_BAR; PG8_SCHED;
            PG8_STAGE(PG8_SB(0, 1), b2 + hstep, voffB);
            PG8_WAIT_V(6); PG8_BAR; PG8_MMA(1, 1, At, B1); PG8_BAR;
            PG8_LDB(B0, 1, 0); PG8_SCHED; PG8_LDA(At, 1, 0); PG8_STAGE(PG8_SA(0, 1), a2 + hstep, voffA);
            PG8_WAIT_L(8); PG8_BAR; PG8_WAIT_L(0); PG8_MMA(0, 0, At, B0); PG8_BAR; PG8_SCHED;
            PG8_LDB(B1, 1, 1); PG8_STAGE(PG8_SB(1, 0), b3, voffB);
            PG8_BAR; PG8_WAIT_L(0); PG8_MMA(0, 1, At, B1); PG8_BAR;
            PG8_LDA(At, 1, 1); PG8_STAGE(PG8_SA(1, 0), a3, voffA);
            PG8_BAR; PG8_WAIT_L(0); PG8_MMA(1, 0, At, B0); PG8_BAR; PG8_SCHED;
            PG8_STAGE(PG8_SB(1, 1), b3 + hstep, voffB);
            PG8_WAIT_V(6); PG8_BAR; PG8_MMA(1, 1, At, B1); PG8_BAR;
            }
        }
        if constexpr (ALIGN_EPI) { if (wr == 0) PG8_BAR; }
        if constexpr (!Epi::AFTER_DRAIN) { E(acc, cur, wr, wc, fr, fq); S.done(cur); }
        if (!has_next) break;
#pragma unroll
        for (int a = 0; a < 2; ++a)
#pragma unroll
            for (int b = 0; b < 2; ++b)
#pragma unroll
                for (int m = 0; m < 4; ++m)
#pragma unroll
                    for (int n = 0; n < 2; ++n) acc[a][b][m][n] = (f32x4){0.f, 0.f, 0.f, 0.f};
        cur = nxt; cA = nA; cB = nB; ++ui;
        if constexpr (ALIGN_EPI) { if (wr == 1) PG8_BAR; }
    }
    PG8_WAIT_V(0);
    if constexpr (!ALIGN_EPI) { if (wr == 0) PG8_BAR; }
    PG8_BAR;
    if constexpr (Epi::AFTER_DRAIN) { E.fused(acc, cur, wr, wc, fr, fq, lds, wid, lane); S.done(cur); }
#undef PG8_SA
#undef PG8_SB
#undef PG8_STAGE
#undef PG8_LDA
#undef PG8_LDB
#undef PG8_MMA
#undef PG8_WAIT_V
#undef PG8_WAIT_L
#undef PG8_BAR
#undef PG8_SCHED
}
}
#define LAS __attribute__((address_space(3)))
typedef float f32x4 __attribute__((ext_vector_type(4)));
struct Ctx { int tid, lane, wave, bid, nb, gw, ngw; unsigned char* lds; };

namespace nv {
__device__ __forceinline__ void d_cvt_bf16(const Ctx& c, const float* __restrict__ in, bf16* __restrict__ out, size_t n4) {
    for (size_t i = (size_t)c.bid * 512 + c.tid; i < n4; i += (size_t)c.nb * 512) { f32x4 v = ((const f32x4*)in)[i]; uint2 o; o.x = pk2bf(v.x, v.y); o.y = pk2bf(v.z, v.w); ((uint2*)out)[i] = o; }
}
__device__ __forceinline__ void d_transpose_w(const Ctx& c, const float* __restrict__ W, int K, int N, int Npad, bf16* __restrict__ WT) {
    float* t = (float*)(c.lds) + c.wave * (32 * 33);
    const int tx = c.lane & 31, ty = c.lane >> 5, nbn = Npad / 32, ntile = nbn * (K / 32);
    for (int it = c.gw; it < ntile; it += c.ngw) {
        const int n0 = (it % nbn) * 32, k0 = (it / nbn) * 32;
        for (int i = ty; i < 32; i += 2) { const int n = n0 + tx; t[i * 33 + tx] = (n < N) ? W[(size_t)(k0 + i) * N + n] : 0.f; }
        __builtin_amdgcn_fence(__ATOMIC_RELEASE, "workgroup"); __builtin_amdgcn_wave_barrier();
        for (int i = ty; i < 32; i += 2) WT[(size_t)(n0 + i) * K + k0 + tx] = f2bf(t[tx * 33 + i]);
        __builtin_amdgcn_fence(__ATOMIC_RELEASE, "workgroup"); __builtin_amdgcn_wave_barrier();
    }
}
__device__ __forceinline__ void d_rope_table(const Ctx& c, float2* __restrict__ tab) {
    for (int id = c.bid * 512 + c.tid; id < SEQ * 32; id += c.nb * 512) {
        const int pos = id >> 5, i = id & 31;
        const float inv = (float)pow(10000.0, -(double)i / 32.0);
        const float ang = (float)pos * inv;
        tab[id] = make_float2((float)cos((double)ang), (float)sin((double)ang));
    }
}
__device__ __forceinline__ void d_rotary(const Ctx& c, const bf16* __restrict__ proj, const float2* __restrict__ tab, bf16* __restrict__ qr, bf16* __restrict__ kr) {
    for (size_t id = (size_t)c.bid * 512 + c.tid; id < (size_t)NTOK * 320; id += (size_t)c.nb * 512) {
        const int d = id & 31, hh = (id >> 5) % 10; const size_t t = id / 320; const int pos = (int)(t % SEQ);
        const float2 cs = tab[pos * 32 + d];
        const bf16* src = proj + t * IN_PAD + hh * 64;
        const float t1 = bf2f(src[d]), t2 = bf2f(src[d + 32]);
        const float o1 = t1 * cs.x - t2 * cs.y, o2 = t2 * cs.x + t1 * cs.y;
        bf16* dst = (hh < 8) ? (qr + t * 512 + hh * 64) : (kr + t * 128 + (hh - 8) * 64);
        dst[d] = f2bf(o1); dst[d + 32] = f2bf(o2);
    }
}
__device__ __forceinline__ void d_attn(const Ctx& c, const bf16* __restrict__ qr, const bf16* __restrict__ kr, const bf16* __restrict__ proj, const float* __restrict__ sink, bf16* __restrict__ mix) {
    for (int id = c.bid * 512 + c.tid; id < NTOK * 8; id += c.nb * 512) {
        const int hq = id & 7, t = id >> 3, b = t / SEQ, i = t % SEQ, kvh = hq >> 2;
        float q[64], acc[64];
#pragma unroll
        for (int d = 0; d < 64; ++d) { q[d] = bf2f(qr[(size_t)t * 512 + hq * 64 + d]) * 0.125f; acc[d] = 0.f; }
        float m = sink[hq], l = 1.f;
        const int j0 = max(0, i - 128), j1 = min(SEQ - 1, i + 128);
        for (int j = j0; j <= j1; ++j) {
            const size_t tj = (size_t)b * SEQ + j;
            const uint4* kp = (const uint4*)(kr + tj * 128 + kvh * 64);
            float s = 0.f;
#pragma unroll
            for (int cc = 0; cc < 8; ++cc) { const uint4 w = kp[cc]; const unsigned ww[4] = {w.x, w.y, w.z, w.w};
#pragma unroll
                for (int e = 0; e < 4; ++e) { s += q[cc * 8 + 2 * e] * __uint_as_float(ww[e] << 16) + q[cc * 8 + 2 * e + 1] * __uint_as_float(ww[e] & 0xffff0000u); } }
            if (s > m) { const float f = __expf(m - s); l *= f;
#pragma unroll
                for (int d = 0; d < 64; ++d) acc[d] *= f;
                m = s; }
            const float p = __expf(s - m); l += p;
            const uint4* vp = (const uint4*)(proj + tj * IN_PAD + C_V + kvh * 64);
#pragma unroll
            for (int cc = 0; cc < 8; ++cc) { const uint4 w = vp[cc]; const unsigned ww[4] = {w.x, w.y, w.z, w.w};
#pragma unroll
                for (int e = 0; e < 4; ++e) { acc[cc * 8 + 2 * e] += p * __uint_as_float(ww[e] << 16); acc[cc * 8 + 2 * e + 1] += p * __uint_as_float(ww[e] & 0xffff0000u); } }
        }
        const float il = 1.f / l;
#pragma unroll
        for (int d = 0; d < 64; d += 2) *(unsigned*)(mix + (size_t)t * DM + hq * 64 + d) = pk2bf(acc[d] * il, acc[d + 1] * il);
    }
}
__device__ __forceinline__ void d_scan(const Ctx& c, const bf16* __restrict__ proj, const float* __restrict__ mu_prev, const float* __restrict__ mu_next,
                                       const float* __restrict__ w0, const float* __restrict__ w2, const float* __restrict__ a0, const float* __restrict__ a2,
                                       const float* __restrict__ k_k, const float* __restrict__ k_a, float* __restrict__ ydir) {
    if (c.wave != 0) return;
    for (int unit = c.bid; unit < 128; unit += c.nb) {
    const int b = unit >> 4, h = (unit >> 1) & 7, d = unit & 1, lane = c.lane, ch = h * 64 + lane;
    float (*sh)[64] = (float (*)[64])c.lds;
    const int colx = lane < 32 ? (P_WD + d * 32 + lane) : (P_AD + d * 32 + lane - 32);
    const int cols[4] = {P_R + ch, P_KK + ch, P_VV + ch, colx};
    float mp[4], mn[4];
#pragma unroll
    for (int q = 0; q < 4; ++q) { mp[q] = mu_prev[cols[q]]; mn[q] = mu_next[cols[q]]; }
    float* w2c = (float*)c.lds + 6 * 64 + lane; float* a2c = w2c + 32 * 64;
    for (int j = 0; j < 32; ++j) { w2c[j * 64] = w2[(size_t)(d * 32 + j) * 512 + ch]; a2c[j * 64] = a2[(size_t)(d * 32 + j) * 512 + ch]; }
    const float w0c = w0[d * 512 + ch], a0c = a0[d * 512 + ch], kkc = k_k[ch], kac = k_a[ch];
    float S[64];
#pragma unroll
    for (int k = 0; k < 64; ++k) S[k] = 0.f;
    const int sgn = d ? -1 : 1; int t = d ? SEQ - 1 : 0;
    const bf16* pb = proj + (size_t)b * SEQ * IN_PAD + C_P;
    float behind[4], cur[4], ahead[4];
#pragma unroll
    for (int q = 0; q < 4; ++q) { behind[q] = 0.f; cur[q] = bf2f(pb[(size_t)t * IN_PAD + cols[q]]); ahead[q] = bf2f(pb[(size_t)(t + sgn) * IN_PAD + cols[q]]); }
    for (int step = 0; step < SEQ; ++step, t += sgn) {
        float ahead2[4]; const int t2 = t + 2 * sgn; const bool ok2 = (t2 >= 0 && t2 < SEQ);
#pragma unroll
        for (int q = 0; q < 4; ++q) ahead2[q] = ok2 ? bf2f(pb[(size_t)t2 * IN_PAD + cols[q]]) : 0.f;
        float sv[4];
#pragma unroll
        for (int q = 0; q < 4; ++q) { const float prv = d ? ahead[q] : behind[q], nxt = d ? behind[q] : ahead[q]; sv[q] = cur[q] + mp[q] * (prv - cur[q]) + mn[q] * (nxt - cur[q]); }
        const float r = sv[0], k = sv[1], v = sv[2];
        sh[5][lane] = lane < 32 ? tanhf(sv[3]) : sv[3];
        __builtin_amdgcn_fence(__ATOMIC_RELEASE, "workgroup"); __builtin_amdgcn_wave_barrier();
        float ws = w0c, as = a0c;
#pragma unroll
        for (int j = 0; j < 32; ++j) { ws += sh[5][j] * w2c[j * 64]; as += sh[5][32 + j] * a2c[j * 64]; }
        const float nsp = -ws; const float sp = (nsp > 20.f) ? nsp : log1pf(__expf(nsp));
        const float wlog = -sp - 0.5f; const float decay = __expf(-__expf(wlog));
        const float a = sigmoidf_(as);
        float kk = k * kkc; const float ss = wave_sum(kk * kk); kk = kk * rsqrtf(fmaxf(ss, 1e-24f));
        const float kd = k * (1.f + (a - 1.f) * kac);
        sh[0][lane] = decay; sh[1][lane] = kk * a; sh[2][lane] = kd; sh[3][lane] = r; sh[4][lane] = kk;
        __builtin_amdgcn_fence(__ATOMIC_RELEASE, "workgroup"); __builtin_amdgcn_wave_barrier();
        float sa = 0.f;
#pragma unroll
        for (int q = 0; q < 64; ++q) sa -= S[q] * sh[4][q];
        float y = 0.f;
#pragma unroll
        for (int q = 0; q < 64; ++q) { S[q] = S[q] * sh[0][q] + sa * sh[1][q] + v * sh[2][q]; y += S[q] * sh[3][q]; }
        ydir[((size_t)d * NTOK + (size_t)b * SEQ + t) * 512 + ch] = y;
        __builtin_amdgcn_fence(__ATOMIC_RELEASE, "workgroup"); __builtin_amdgcn_wave_barrier();
#pragma unroll
        for (int q = 0; q < 4; ++q) { behind[q] = cur[q]; cur[q] = ahead[q]; ahead[q] = ahead2[q]; }
    }
    }
}
template <bool YSINGLE> __device__ __forceinline__ void d_rwkv_out(const Ctx& c, const bf16* __restrict__ proj, const float* __restrict__ ydir, const float* __restrict__ mu_prev, const float* __restrict__ mu_next,
                                           const float* __restrict__ a0, const float* __restrict__ a2, const float* __restrict__ g2, const float* __restrict__ k_a, const float* __restrict__ r_k,
                                           const float* __restrict__ lnx_g, const float* __restrict__ lnx_b, bf16* __restrict__ mix) {
    float* sad = (float*)c.lds; float* sgd = sad + 64; const int ch = c.tid;
    const float mpr = mu_prev[P_R + ch], mnr = mu_next[P_R + ch], mpk = mu_prev[P_KK + ch], mnk = mu_next[P_KK + ch], mpv = mu_prev[P_VV + ch], mnv = mu_next[P_VV + ch];
    const int cx = (ch < 64) ? (P_AD + ch) : (ch < 160 ? P_GD + ch - 64 : 0); const float mpx = mu_prev[cx], mnx = mu_next[cx];
    for (int t = c.bid; t < NTOK; t += c.nb) {
        const int i = t % SEQ; const bf16* p0 = proj + (size_t)t * IN_PAD + C_P;
        const bool hp = i > 0, hn = i < SEQ - 1;
#define SHF(col, mp_, mn_) ({ const float c_ = bf2f(p0[col]); const float pv_ = hp ? bf2f(p0[(col) - IN_PAD]) : 0.f, nx_ = hn ? bf2f(p0[(col) + IN_PAD]) : 0.f; c_ + (mp_) * (pv_ - c_) + (mn_) * (nx_ - c_); })
        if (ch < 64) sad[ch] = SHF(cx, mpx, mnx);
        else if (ch < 160) sgd[ch - 64] = sigmoidf_(SHF(cx, mpx, mnx));
        const float r = SHF(P_R + ch, mpr, mnr), k = SHF(P_KK + ch, mpk, mnk), v = SHF(P_VV + ch, mpv, mnv);
#undef SHF
        __syncthreads();
        asm volatile("" ::: "memory");
        float as0 = a0[ch], as1 = a0[512 + ch];
#pragma unroll 4
        for (int j = 0; j < 32; ++j) { as0 += sad[j] * a2[(size_t)j * 512 + ch]; as1 += sad[32 + j] * a2[(size_t)(32 + j) * 512 + ch]; }
        const float am = 0.5f * (sigmoidf_(as0) + sigmoidf_(as1));
        float g = 0.f;
#pragma unroll 4
        for (int j = 0; j < 96; ++j) g += sgd[j] * g2[(size_t)j * 512 + ch];
        const float y = YSINGLE ? ydir[(size_t)t * 512 + ch] : (ydir[(size_t)t * 512 + ch] + ydir[((size_t)NTOK + t) * 512 + ch]);
        const float mu = wave_sum(y) * (1.f / 64.f); const float dy = y - mu; const float var = wave_sum(dy * dy) * (1.f / 64.f);
        const float yn = dy * rsqrtf(var + GN_EPS) * lnx_g[ch] + lnx_b[ch];
        const float kmean = k * (1.f + (am - 1.f) * k_a[ch]);
        const float bonus = wave_sum(r * kmean * r_k[ch]) * v;
        mix[(size_t)t * DM + 512 + ch] = f2bf((yn + bonus) * g);
        __syncthreads();
    }
}
__device__ __forceinline__ void d_ln1(const Ctx& c, const float* y1, const float* __restrict__ g, const float* __restrict__ bta, float* h1f, bf16* __restrict__ h1b) {
    for (int row = c.gw; row < NTOK; row += c.ngw) {
        const int lane = c.lane;
        const f32x4* xr = (const f32x4*)(y1 + (size_t)row * DM) + lane;
        f32x4 v[4]; float s = 0.f;
#pragma unroll
        for (int j = 0; j < 4; ++j) { v[j] = xr[64 * j]; s += (v[j].x + v[j].y) + (v[j].z + v[j].w); }
        const float mean = wave_sum(s) * (1.f / DM); float s2 = 0.f;
#pragma unroll
        for (int j = 0; j < 4; ++j) { v[j] = v[j] - mean; s2 += (v[j].x * v[j].x + v[j].y * v[j].y) + (v[j].z * v[j].z + v[j].w * v[j].w); }
        const float rstd = rsqrtf(wave_sum(s2) * (1.f / DM) + LN_EPS);
#pragma unroll
        for (int j = 0; j < 4; ++j) { const f32x4 gg = ((const f32x4*)g)[64 * j + lane], bb = ((const f32x4*)bta)[64 * j + lane];
            const f32x4 o = v[j] * rstd * gg + bb;
            ((f32x4*)(h1f + (size_t)row * DM))[64 * j + lane] = o;
            uint2 w; w.x = pk2bf(o.x, o.y); w.y = pk2bf(o.z, o.w); ((uint2*)(h1b + (size_t)row * DM))[64 * j + lane] = w; }
    }
}
__device__ __forceinline__ void d_peer_topk(const Ctx& c, const bf16* __restrict__ qb, const float* __restrict__ keys, int* __restrict__ idx, float* __restrict__ gate) {
    float* keysT = (float*)c.lds; float* sq = keysT + 2 * 128 * 128; float* sc = sq + 256; float* s12 = sc + 256; int* i12 = (int*)(s12 + 32);
    const int tid = c.tid, lane = c.lane, wave = c.wave;
    for (int item = c.bid; item < 8 * 64; item += c.nb) {
        const int h = item & 7, grp = item >> 3;
        __syncthreads();
        for (int e = tid; e < 2 * 128 * 128; e += 512) { const int p = e >> 14, n = (e >> 7) & 127, cc = e & 127; keysT[(p * 128 + cc) * 128 + n] = keys[(size_t)h * 32768 + e]; }
        __syncthreads();
        for (int tt = 0; tt < 512; ++tt) {
            const size_t t = (size_t)grp * 512 + tt;
            if (tid < 256) sq[tid] = bf2f(qb[t * PEER_Q + h * 256 + tid]);
            __syncthreads();
            if (tid < 256) { const int p = tid >> 7, n = tid & 127; float s = 0.f; const float* kt = keysT + p * 16384 + n; const float* qq = sq + p * 128;
                for (int cc = 0; cc < 128; ++cc) s += qq[cc] * kt[cc * 128];
                sc[tid] = s; }
            __syncthreads();
            if (wave < 2) {
                float v0 = sc[wave * 128 + lane], v1 = sc[wave * 128 + 64 + lane];
                for (int r = 0; r < 16; ++r) {
                    float bv; int bi; if (v1 > v0) { bv = v1; bi = lane + 64; } else { bv = v0; bi = lane; }
#pragma unroll
                    for (int o = 1; o < 64; o <<= 1) { const float ov = __shfl_xor(bv, o); const int oi = __shfl_xor(bi, o); if (ov > bv || (ov == bv && oi < bi)) { bv = ov; bi = oi; } }
                    if (lane == 0) { s12[wave * 16 + r] = bv; i12[wave * 16 + r] = bi; }
                    if (bi == lane) v0 = -INFINITY; if (bi == lane + 64) v1 = -INFINITY;
                }
            }
            __syncthreads();
            if (wave == 0) {
                float cv[4];
#pragma unroll
                for (int j = 0; j < 4; ++j) { const int f = lane + 64 * j; cv[j] = s12[f >> 4] + s12[16 + (f & 15)]; }
                float mycs = 0.f; int myid = 0;
                for (int r = 0; r < 16; ++r) {
                    float bv = cv[0]; int bi = lane;
#pragma unroll
                    for (int j = 1; j < 4; ++j) if (cv[j] > bv) { bv = cv[j]; bi = lane + 64 * j; }
#pragma unroll
                    for (int o = 1; o < 64; o <<= 1) { const float ov = __shfl_xor(bv, o); const int oi = __shfl_xor(bi, o); if (ov > bv || (ov == bv && oi < bi)) { bv = ov; bi = oi; } }
                    if (lane == r) { mycs = bv; myid = i12[bi >> 4] * 128 + i12[16 + (bi & 15)]; }
#pragma unroll
                    for (int j = 0; j < 4; ++j) if (bi == lane + 64 * j) cv[j] = -INFINITY;
                }
                float mx = (lane < 16) ? mycs : -INFINITY;
#pragma unroll
                for (int o = 1; o < 64; o <<= 1) mx = fmaxf(mx, __shfl_xor(mx, o));
                const float e = (lane < 16) ? __expf(mycs - mx) : 0.f; const float den = wave_sum(e);
                if (lane < 16) { idx[t * 128 + h * 16 + lane] = myid; gate[t * 128 + h * 16 + lane] = e / den; }
            }
            __syncthreads();
        }
    }
}
__device__ __forceinline__ void d_peer_gather(const Ctx& c, const float* __restrict__ h1f, const int* __restrict__ idx, const float* __restrict__ gate, const float* __restrict__ u, const float* __restrict__ v,
                                              const float* __restrict__ g, const float* __restrict__ bta, float* __restrict__ out) {
    const int lane = c.lane;
    for (int t = c.gw; t < NTOK; t += c.ngw) {
        f32x4 hv[4], f[4];
#pragma unroll
        for (int j = 0; j < 4; ++j) { hv[j] = ((const f32x4*)(h1f + (size_t)t * DM))[64 * j + lane]; f[j] = (f32x4){0.f, 0.f, 0.f, 0.f}; }
        for (int e = 0; e < 128; ++e) {
            const int id = idx[(size_t)t * 128 + e]; const float gt = gate[(size_t)t * 128 + e];
            const f32x4* ur = (const f32x4*)(u + (size_t)id * DM); const f32x4* vr = (const f32x4*)(v + (size_t)id * DM);
            float z = 0.f;
#pragma unroll
            for (int j = 0; j < 4; ++j) { const f32x4 w = ur[64 * j + lane]; z += (w.x * hv[j].x + w.y * hv[j].y) + (w.z * hv[j].z + w.w * hv[j].w); }
            z = wave_sum(z);
            const float act = gt * 0.5f * z * (1.f + erff(z * 0.70710678118654752f));
#pragma unroll
            for (int j = 0; j < 4; ++j) { const f32x4 w = vr[64 * j + lane]; f[j] += act * w; }
        }
        float s = 0.f;
#pragma unroll
        for (int j = 0; j < 4; ++j) { f[j] = DN_ALPHA * hv[j] + f[j]; s += (f[j].x + f[j].y) + (f[j].z + f[j].w); }
        const float mean = wave_sum(s) * (1.f / DM); float s2 = 0.f;
#pragma unroll
        for (int j = 0; j < 4; ++j) { f[j] = f[j] - mean; s2 += (f[j].x * f[j].x + f[j].y * f[j].y) + (f[j].z * f[j].z + f[j].w * f[j].w); }
        const float rstd = rsqrtf(wave_sum(s2) * (1.f / DM) + LN_EPS);
#pragma unroll
        for (int j = 0; j < 4; ++j) { const f32x4 gg = ((const f32x4*)g)[64 * j + lane], bb = ((const f32x4*)bta)[64 * j + lane];
            ((f32x4*)(out + (size_t)t * DM))[64 * j + lane] = f[j] * rstd * gg + bb; }
    }
}
}
namespace pe {
typedef __bf16 bf16x2_t __attribute__((ext_vector_type(2)));
__device__ __forceinline__ float dot2(unsigned a, unsigned b, float c) { return __builtin_amdgcn_fdot2_f32_bf16(__builtin_bit_cast(bf16x2_t, a), __builtin_bit_cast(bf16x2_t, b), c, false); }
__device__ __forceinline__ float gelu_erf(float z) { return 0.5f * z * (1.f + erff(z * 0.70710678118654752f)); }
constexpr int GE = 4;
struct Rows { uint4 a[GE], b[GE]; };
__device__ __forceinline__ void load_rows(Rows& r, const bf16* __restrict__ tab, int i0, int i1, int lane, int g) {
#pragma unroll
    for (int j = 0; j < GE; ++j) { const int e = g * GE + j; const int id = __builtin_amdgcn_readlane((e & 64) ? i1 : i0, e & 63);
        const uint4* p = (const uint4*)(tab + (size_t)id * DM) + lane; r.a[j] = p[0]; r.b[j] = p[64]; }
}
__device__ __forceinline__ void d_peer_gather(const Ctx& c, const bf16* __restrict__ h1b, const int* __restrict__ idx, const float* __restrict__ gate, const bf16* __restrict__ ub, const bf16* __restrict__ vb,
                                              const float* __restrict__ g, const float* __restrict__ bta, float* __restrict__ out) {
    const int lane = c.lane;
    for (int t = c.gw; t < NTOK; t += c.ngw) {
        const uint4* hp = (const uint4*)(h1b + (size_t)t * DM) + lane; const uint4 h0 = hp[0], h1 = hp[64];
        const unsigned hw[8] = {h0.x, h0.y, h0.z, h0.w, h1.x, h1.y, h1.z, h1.w};
        const int i0 = idx[(size_t)t * 128 + lane], i1 = idx[(size_t)t * 128 + 64 + lane];
        const float g0 = gate[(size_t)t * 128 + lane], g1 = gate[(size_t)t * 128 + 64 + lane];
        float f[16];
#pragma unroll
        for (int i = 0; i < 16; ++i) f[i] = 0.f;
        Rows U, V, Un;
        load_rows(U, ub, i0, i1, lane, 0);
        for (int grp = 0; grp < 128 / GE; ++grp) {
            load_rows(V, vb, i0, i1, lane, grp);
            if (grp + 1 < 128 / GE) load_rows(Un, ub, i0, i1, lane, grp + 1);
            float z[GE];
#pragma unroll
            for (int j = 0; j < GE; ++j) { const unsigned uw[8] = {U.a[j].x, U.a[j].y, U.a[j].z, U.a[j].w, U.b[j].x, U.b[j].y, U.b[j].z, U.b[j].w}; float s = 0.f;
#pragma unroll
                for (int i = 0; i < 8; ++i) s = dot2(uw[i], hw[i], s);
                z[j] = s; }
            { const bool b0 = lane & 1; float k0 = b0 ? z[1] : z[0], s0 = b0 ? z[0] : z[1], k1 = b0 ? z[3] : z[2], s1 = b0 ? z[2] : z[3];
              k0 += __shfl_xor(s0, 1); k1 += __shfl_xor(s1, 1);
              const bool b1 = lane & 2; float kk = b1 ? k1 : k0, ss = b1 ? k0 : k1; kk += __shfl_xor(ss, 2);
              kk += __shfl_xor(kk, 4); kk += __shfl_xor(kk, 8); kk += __shfl_xor(kk, 16); kk += __shfl_xor(kk, 32);
              z[0] = kk; }
            const int e_me = grp * GE + (lane & 3);
            const float gt = __shfl((e_me & 64) ? g1 : g0, e_me & 63);
            const float act = gt * gelu_erf(z[0]);
            const unsigned actb = (unsigned)f2bf(act);
#pragma unroll
            for (int j = 0; j < GE; ++j) { const unsigned alo = __builtin_amdgcn_readlane(actb, j), ahi = alo << 16;
                const unsigned vw[8] = {V.a[j].x, V.a[j].y, V.a[j].z, V.a[j].w, V.b[j].x, V.b[j].y, V.b[j].z, V.b[j].w};
#pragma unroll
                for (int i = 0; i < 8; ++i) { f[2 * i] = dot2(vw[i], alo, f[2 * i]); f[2 * i + 1] = dot2(vw[i], ahi, f[2 * i + 1]); } }
            U = Un;
        }
        float s = 0.f;
#pragma unroll
        for (int i = 0; i < 8; ++i) { f[2 * i] += DN_ALPHA * __uint_as_float(hw[i] << 16); f[2 * i + 1] += DN_ALPHA * __uint_as_float(hw[i] & 0xffff0000u); s += f[2 * i] + f[2 * i + 1]; }
        const float mean = wave_sum(s) * (1.f / DM); float s2 = 0.f;
#pragma unroll
        for (int i = 0; i < 16; ++i) { f[i] -= mean; s2 += f[i] * f[i]; }
        const float rstd = rsqrtf(wave_sum(s2) * (1.f / DM) + LN_EPS);
#pragma unroll
        for (int hh = 0; hh < 2; ++hh) {
            const int e0 = hh * 512 + 8 * lane;
            const f32x4 ga = *(const f32x4*)(g + e0), gb = *(const f32x4*)(g + e0 + 4), ba = *(const f32x4*)(bta + e0), bb = *(const f32x4*)(bta + e0 + 4);
            f32x4 oa, ob;
            oa.x = f[hh * 8 + 0] * rstd * ga.x + ba.x; oa.y = f[hh * 8 + 1] * rstd * ga.y + ba.y; oa.z = f[hh * 8 + 2] * rstd * ga.z + ba.z; oa.w = f[hh * 8 + 3] * rstd * ga.w + ba.w;
            ob.x = f[hh * 8 + 4] * rstd * gb.x + bb.x; ob.y = f[hh * 8 + 5] * rstd * gb.y + bb.y; ob.z = f[hh * 8 + 6] * rstd * gb.z + bb.z; ob.w = f[hh * 8 + 7] * rstd * gb.w + bb.w;
            *(f32x4*)(out + (size_t)t * DM + e0) = oa; *(f32x4*)(out + (size_t)t * DM + e0 + 4) = ob;
        }
    }
}
}
namespace rw {
typedef short bf16x8 __attribute__((ext_vector_type(8)));
typedef short s16x4 __attribute__((ext_vector_type(4)));
typedef float f32x16 __attribute__((ext_vector_type(16)));
typedef float f32x2_t __attribute__((ext_vector_type(2)));
typedef __bf16 bf16x2_t __attribute__((ext_vector_type(2)));
typedef unsigned u32x4 __attribute__((ext_vector_type(4)));
typedef unsigned u32x2 __attribute__((ext_vector_type(2)));
typedef LAS unsigned char* lptr;
#define MFMA32(a, b, c) __builtin_amdgcn_mfma_f32_32x32x16_bf16((a), (b), (c), 0, 0, 0)
#define DI __device__ __forceinline__
constexpr int UNIT_BYTES = 10 * 2048;
constexpr int STG_STRIDE = 392;
constexpr int CST_OFF = 131072, GC_OFF = 131072 + 4096;

DI int crow(int i, int h) { return (i & 3) + 8 * (i >> 2) + 4 * h; }
DI unsigned cvtpk(float lo, float hi) { f32x2_t v = {lo, hi}; bf16x2_t b = __builtin_convertvector(v, bf16x2_t); return __builtin_bit_cast(unsigned, b); }
DI bf16x8 pack(const f32x16& x, int s) { u32x4 p; p[0] = cvtpk(x[8 * s], x[8 * s + 1]); p[1] = cvtpk(x[8 * s + 2], x[8 * s + 3]); p[2] = cvtpk(x[8 * s + 4], x[8 * s + 5]); p[3] = cvtpk(x[8 * s + 6], x[8 * s + 7]); return __builtin_bit_cast(bf16x8, p); }
DI bf16x8 frag4(unsigned a, unsigned b, unsigned c, unsigned d) { u32x4 p = {a, b, c, d}; return __builtin_bit_cast(bf16x8, p); }
DI float lo_f(unsigned w) { return __uint_as_float(w << 16); }
DI float hi_f(unsigned w) { return __uint_as_float(w & 0xffff0000u); }
DI int img_off(int row, int slot) { return row * 128 + ((slot ^ ((((row >> 1) & 1) << 3) | ((row >> 2) & 3))) << 3); }
DI s16x4 tr_read(lptr p) { return __builtin_bit_cast(s16x4, __builtin_amdgcn_ds_read_tr16_b64_v4i16((LAS s16x4*)p)); }
DI bf16x8 trfrag(lptr img, int tau, int s, int lane) {
    const int h = lane >> 5, gg = (lane >> 4) & 1, l16 = lane & 15, q = l16 >> 2, p = l16 & 3, slot = 8 * tau + 4 * gg + p, r0 = 16 * s + 4 * h + q;
    const s16x4 lo = tr_read(img + img_off(r0, slot)), hi = tr_read(img + img_off(r0 + 8, slot));
    return __builtin_shufflevector(lo, hi, 0, 1, 2, 3, 4, 5, 6, 7);
}
template <int CTRL, int RMASK> DI float dpp0(float x) { return __uint_as_float(__builtin_amdgcn_update_dpp(0u, __float_as_uint(x), CTRL, RMASK, 0xf, false)); }
DI float prefix32(float x) {
    x += dpp0<0x111, 0xf>(x); x += dpp0<0x112, 0xf>(x); x += dpp0<0x114, 0xf>(x); x += dpp0<0x118, 0xf>(x);
    x += dpp0<0x142, 0xa>(x);
    return x;
}
DI float fsig(float x) { return __builtin_amdgcn_rcpf(1.f + __expf(-x)); }
DI void store_tile(unsigned char* dst, const f32x16& x, int lane) {
    u32x4 a, b; a[0] = cvtpk(x[0], x[1]); a[1] = cvtpk(x[2], x[3]); a[2] = cvtpk(x[4], x[5]); a[3] = cvtpk(x[6], x[7]);
    b[0] = cvtpk(x[8], x[9]); b[1] = cvtpk(x[10], x[11]); b[2] = cvtpk(x[12], x[13]); b[3] = cvtpk(x[14], x[15]);
    u32x4* d = (u32x4*)(dst + lane * 32); d[0] = a; d[1] = b;
}

DI void d_lowrank_t(const Ctx& c, const float* __restrict__ w2, const float* __restrict__ a2, bf16* __restrict__ w2t, bf16* __restrict__ a2t) {
    for (int id = c.bid * 512 + c.tid; id < 2 * 512 * 32; id += c.nb * 512) { const int j = id & 31, ch = (id >> 5) & 511, d = id >> 14;
        w2t[id] = f2bf(w2[(size_t)(d * 32 + j) * 512 + ch]); a2t[id] = f2bf(a2[(size_t)(d * 32 + j) * 512 + ch]); }
}

DI void d_prep(const Ctx& c, int d, const bf16* __restrict__ proj, const float* __restrict__ mu_prev, const float* __restrict__ mu_next,
               const float* __restrict__ w0, const float* __restrict__ a0, const float* __restrict__ k_k, const float* __restrict__ k_a,
               const bf16* __restrict__ w2t, const bf16* __restrict__ a2t, unsigned char* __restrict__ UO, float* __restrict__ ybuf) {
    const int lane = c.lane, n = lane & 31, h = lane >> 5, hd = c.bid & 7;
    lptr L = (lptr)c.lds + c.wave * 16384;
    LAS float* cst = (LAS float*)((lptr)c.lds + CST_OFF);
    LAS float* gC = (LAS float*)((lptr)c.lds + GC_OFF) + c.wave * 64;
    __syncthreads();
    for (int i = c.tid; i < 768; i += 512) { float v;
        if (i < 640) { const int vec = i >> 6, ch = i & 63, gch = 64 * hd + ch;
            v = vec == 0 ? mu_prev[P_R + gch] : vec == 1 ? mu_next[P_R + gch] : vec == 2 ? mu_prev[P_KK + gch] : vec == 3 ? mu_next[P_KK + gch] : vec == 4 ? mu_prev[P_VV + gch] : vec == 5 ? mu_next[P_VV + gch]
              : vec == 6 ? w0[d * 512 + gch] : vec == 7 ? a0[d * 512 + gch] : vec == 8 ? k_k[gch] : k_a[gch]; }
        else { const int vec = (i - 640) >> 5, j = i & 31; const int col = (vec < 2 ? P_WD : P_AD) + 32 * d + j; v = (vec & 1) ? mu_next[col] : mu_prev[col]; }
        cst[i] = v; }
    __syncthreads();
    const int nper = (c.nb >> 3) * 8;
    for (int u = (c.bid >> 3) * 8 + c.wave; u < 1024; u += nper) {
        const int b = u >> 7, c32 = u & 127;
        const int tok0 = d ? SEQ - 32 * (c32 + 1) : 32 * c32;
        const bf16* prow = proj + (size_t)b * SEQ * IN_PAD + C_P;
#pragma unroll 1
        for (int it = 0; it < 13; ++it) { const int pid = it * 64 + lane; if (pid < 816) { const int rho = pid / 24, w = pid % 24, mat = w >> 3, pc = w & 7, tok = tok0 - 1 + rho;
                uint4 val = make_uint4(0, 0, 0, 0);
                if (tok >= 0 && tok < SEQ) val = *(const uint4*)(prow + (size_t)tok * IN_PAD + mat * 512 + 64 * hd + pc * 8);
                LAS u32x2* dp = (LAS u32x2*)(L + rho * STG_STRIDE + mat * 128 + pc * 16); dp[0] = (u32x2){val.x, val.y}; dp[1] = (u32x2){val.z, val.w}; } }
        const int rho = d ? 32 - n : n + 1, tok = tok0 - 1 + rho;
        bf16x8 wdf[2], adf[2];
        {
            const bool hp = tok > 0, hn = tok < SEQ - 1;
#pragma unroll
            for (int s = 0; s < 2; ++s) {
                const bf16* pc_ = prow + (size_t)tok * IN_PAD + 32 * d + 16 * s + 8 * h;
                const uint4 z4 = make_uint4(0, 0, 0, 0);
                const uint4 wc = *(const uint4*)(pc_ + P_WD), ac = *(const uint4*)(pc_ + P_AD);
                const uint4 wp = hp ? *(const uint4*)(pc_ + P_WD - IN_PAD) : z4, ap = hp ? *(const uint4*)(pc_ + P_AD - IN_PAD) : z4;
                const uint4 wn = hn ? *(const uint4*)(pc_ + P_WD + IN_PAD) : z4, an = hn ? *(const uint4*)(pc_ + P_AD + IN_PAD) : z4;
                const unsigned wcw[4] = {wc.x, wc.y, wc.z, wc.w}, wpw[4] = {wp.x, wp.y, wp.z, wp.w}, wnw[4] = {wn.x, wn.y, wn.z, wn.w};
                const unsigned acw[4] = {ac.x, ac.y, ac.z, ac.w}, apw[4] = {ap.x, ap.y, ap.z, ap.w}, anw[4] = {an.x, an.y, an.z, an.w};
                unsigned wo[4], ao[4];
#pragma unroll
                for (int e = 0; e < 4; ++e) { const int j = 16 * s + 8 * h + 2 * e;
                    const float mpw0 = cst[640 + j], mpw1 = cst[640 + j + 1], mnw0 = cst[672 + j], mnw1 = cst[672 + j + 1], mpa0 = cst[704 + j], mpa1 = cst[704 + j + 1], mna0 = cst[736 + j], mna1 = cst[736 + j + 1];
                    float c0 = lo_f(wcw[e]), c1 = hi_f(wcw[e]);
                    float x0 = c0 + mpw0 * (lo_f(wpw[e]) - c0) + mnw0 * (lo_f(wnw[e]) - c0), x1 = c1 + mpw1 * (hi_f(wpw[e]) - c1) + mnw1 * (hi_f(wnw[e]) - c1);
                    x0 = 1.f - 2.f * __builtin_amdgcn_rcpf(__expf(2.f * x0) + 1.f); x1 = 1.f - 2.f * __builtin_amdgcn_rcpf(__expf(2.f * x1) + 1.f);
                    wo[e] = cvtpk(x0, x1);
                    c0 = lo_f(acw[e]); c1 = hi_f(acw[e]);
                    x0 = c0 + mpa0 * (lo_f(apw[e]) - c0) + mna0 * (lo_f(anw[e]) - c0); x1 = c1 + mpa1 * (hi_f(apw[e]) - c1) + mna1 * (hi_f(anw[e]) - c1);
                    ao[e] = cvtpk(x0, x1); }
                wdf[s] = frag4(wo[0], wo[1], wo[2], wo[3]); adf[s] = frag4(ao[0], ao[1], ao[2], ao[3]);
                __builtin_amdgcn_sched_barrier(0);
            }
        }
        float lw[32], av[32];
        {
            const f32x16 zz = {0.f};
            int opq = 0; asm volatile("" : "+v"(opq));
#pragma unroll
            for (int tau = 0; tau < 2; ++tau) {
                const bf16* wrow = w2t + ((d * 512 + 64 * hd + 32 * tau + n + opq) * 32 + 8 * (h + opq));
                const bf16* arow = a2t + ((d * 512 + 64 * hd + 32 * tau + n + opq) * 32 + 8 * (h + opq));
                const bf16x8 wa0 = *(const bf16x8*)wrow, wa1 = *(const bf16x8*)(wrow + 16), aa0 = *(const bf16x8*)arow, aa1 = *(const bf16x8*)(arow + 16);
                f32x16 cw = MFMA32(wa0, wdf[0], zz); cw = MFMA32(wa1, wdf[1], cw);
                f32x16 ca = MFMA32(aa0, adf[0], zz); ca = MFMA32(aa1, adf[1], ca);
#pragma unroll
                for (int i = 0; i < 16; ++i) { const int ch = 32 * tau + 8 * (i >> 2) + 4 * h + (i & 3);
                    lw[16 * tau + i] = -0.60653066f * fsig(cw[i] + cst[6 * 64 + ch]); av[16 * tau + i] = fsig(ca[i] + cst[7 * 64 + ch]); }
                __builtin_amdgcn_sched_barrier(0);
            }
        }
        unsigned ge[32], avp[16];
#pragma unroll
        for (int m = 0; m < 32; ++m) { const float clm = prefix32(lw[m]); const float eg = __expf(clm); ge[m] = cvtpk(eg, eg * __expf(-lw[m])); if (n == 31) gC[8 * (m >> 2) + 4 * h + (m & 3)] = eg; }
#pragma unroll
        for (int m = 0; m < 16; ++m) avp[m] = cvtpk(av[2 * m], av[2 * m + 1]);
        __builtin_amdgcn_sched_barrier(0);
        unsigned pA[16], pB[16], pK[16], pR[16], pV[16];
        {
            unsigned kfp[16]; float ss = 0.f;
            lptr sb = L + rho * STG_STRIDE + 8 * h;
#pragma unroll
            for (int q = 0; q < 8; ++q) {
                const u32x2 cu = *(LAS u32x2*)(sb + 128 + 16 * q), pu_ = *(LAS u32x2*)(sb + 128 + 16 * q - STG_STRIDE), nu = *(LAS u32x2*)(sb + 128 + 16 * q + STG_STRIDE);
                const float cc[4] = {lo_f(cu.x), hi_f(cu.x), lo_f(cu.y), hi_f(cu.y)}, pp[4] = {lo_f(pu_.x), hi_f(pu_.x), lo_f(pu_.y), hi_f(pu_.y)}, nn[4] = {lo_f(nu.x), hi_f(nu.x), lo_f(nu.y), hi_f(nu.y)};
                float xk[4];
#pragma unroll
                for (int e = 0; e < 4; ++e) { const int ch = 8 * q + 4 * h + e; const float x = cc[e] + cst[2 * 64 + ch] * (pp[e] - cc[e]) + cst[3 * 64 + ch] * (nn[e] - cc[e]);
                    xk[e] = x; const float kr_ = x * cst[8 * 64 + ch]; ss += kr_ * kr_; }
                kfp[2 * q] = cvtpk(xk[0], xk[1]); kfp[2 * q + 1] = cvtpk(xk[2], xk[3]);
                __builtin_amdgcn_sched_barrier(0);
            }
            ss += __shfl_xor(ss, 32);
            const float inv = rsqrtf(fmaxf(ss, 1e-24f));
#pragma unroll
            for (int q = 0; q < 8; ++q) {
                const u32x2 cu = *(LAS u32x2*)(sb + 16 * q), pu_ = *(LAS u32x2*)(sb + 16 * q - STG_STRIDE), nu = *(LAS u32x2*)(sb + 16 * q + STG_STRIDE);
                const u32x2 cv = *(LAS u32x2*)(sb + 256 + 16 * q), pv_ = *(LAS u32x2*)(sb + 256 + 16 * q - STG_STRIDE), nv_ = *(LAS u32x2*)(sb + 256 + 16 * q + STG_STRIDE);
                const float rc[4] = {lo_f(cu.x), hi_f(cu.x), lo_f(cu.y), hi_f(cu.y)}, rp[4] = {lo_f(pu_.x), hi_f(pu_.x), lo_f(pu_.y), hi_f(pu_.y)}, rn[4] = {lo_f(nu.x), hi_f(nu.x), lo_f(nu.y), hi_f(nu.y)};
                const float vc[4] = {lo_f(cv.x), hi_f(cv.x), lo_f(cv.y), hi_f(cv.y)}, vp[4] = {lo_f(pv_.x), hi_f(pv_.x), lo_f(pv_.y), hi_f(pv_.y)}, vn[4] = {lo_f(nv_.x), hi_f(nv_.x), lo_f(nv_.y), hi_f(nv_.y)};
                float oa[4], ob[4], ok[4], orr[4], ov[4];
#pragma unroll
                for (int e = 0; e < 4; ++e) { const int ch = 8 * q + 4 * h + e, m = 4 * q + e;
                    const float rf = rc[e] + cst[0 * 64 + ch] * (rp[e] - rc[e]) + cst[1 * 64 + ch] * (rn[e] - rc[e]);
                    const float vf = vc[e] + cst[4 * 64 + ch] * (vp[e] - vc[e]) + cst[5 * 64 + ch] * (vn[e] - vc[e]);
                    const float eg = lo_f(ge[m]), ieg = __builtin_amdgcn_rcpf(eg), egm1 = hi_f(ge[m]);
                    const float kfm = (m & 1) ? hi_f(kfp[m >> 1]) : lo_f(kfp[m >> 1]), avm = (m & 1) ? hi_f(avp[m >> 1]) : lo_f(avp[m >> 1]);
                    const float kkn = kfm * cst[8 * 64 + ch] * inv;
                    oa[e] = -kkn * egm1; ob[e] = kkn * avm * ieg; ok[e] = kfm * (1.f + (avm - 1.f) * cst[9 * 64 + ch]) * ieg; orr[e] = rf * eg; ov[e] = vf; }
                pA[2 * q] = cvtpk(oa[0], oa[1]); pA[2 * q + 1] = cvtpk(oa[2], oa[3]); pB[2 * q] = cvtpk(ob[0], ob[1]); pB[2 * q + 1] = cvtpk(ob[2], ob[3]);
                pK[2 * q] = cvtpk(ok[0], ok[1]); pK[2 * q + 1] = cvtpk(ok[2], ok[3]); pR[2 * q] = cvtpk(orr[0], orr[1]); pR[2 * q + 1] = cvtpk(orr[2], orr[3]);
                pV[2 * q] = cvtpk(ov[0], ov[1]); pV[2 * q + 1] = cvtpk(ov[2], ov[3]);
                __builtin_amdgcn_sched_barrier(0);
            }
        }
        __builtin_amdgcn_fence(__ATOMIC_RELEASE, "workgroup"); __builtin_amdgcn_wave_barrier();
#pragma unroll
        for (int q = 0; q < 8; ++q) { const int off = img_off(n, 2 * q + h);
            *(LAS u32x2*)(L + off) = (u32x2){pA[2 * q], pA[2 * q + 1]}; *(LAS u32x2*)(L + 4096 + off) = (u32x2){pB[2 * q], pB[2 * q + 1]};
            *(LAS u32x2*)(L + 8192 + off) = (u32x2){pK[2 * q], pK[2 * q + 1]}; *(LAS u32x2*)(L + 12288 + off) = (u32x2){pV[2 * q], pV[2 * q + 1]}; }
        __builtin_amdgcn_fence(__ATOMIC_RELEASE, "workgroup"); __builtin_amdgcn_wave_barrier();
        const f32x16 Z16 = {0.f};
        f32x16 Lab = Z16, LabT = Z16, LakT = Z16, MrbT = Z16, MrkT = Z16;
#pragma unroll
        for (int ks = 0; ks < 4; ++ks) {
            const bf16x8 fA = frag4(pA[4 * ks], pA[4 * ks + 1], pA[4 * ks + 2], pA[4 * ks + 3]), fB = frag4(pB[4 * ks], pB[4 * ks + 1], pB[4 * ks + 2], pB[4 * ks + 3]);
            const bf16x8 fK = frag4(pK[4 * ks], pK[4 * ks + 1], pK[4 * ks + 2], pK[4 * ks + 3]), fR = frag4(pR[4 * ks], pR[4 * ks + 1], pR[4 * ks + 2], pR[4 * ks + 3]);
            Lab = MFMA32(fA, fB, Lab); LabT = MFMA32(fB, fA, LabT); LakT = MFMA32(fK, fA, LakT); MrbT = MFMA32(fB, fR, MrbT); MrkT = MFMA32(fK, fR, MrkT);
        }
#pragma unroll
        for (int i = 0; i < 16; ++i) { const int rr = crow(i, h);
            Lab[i] = (n < rr) ? Lab[i] : 0.f; LabT[i] = (rr < n) ? LabT[i] : 0.f; LakT[i] = (rr < n) ? LakT[i] : 0.f;
            MrbT[i] = (rr <= n) ? MrbT[i] : 0.f; MrkT[i] = (rr <= n) ? MrkT[i] : 0.f; }
        const bf16x8 pLk0 = pack(LakT, 0), pLk1 = pack(LakT, 1), pMb0 = pack(MrbT, 0), pMb1 = pack(MrbT, 1), pMk0 = pack(MrkT, 0), pMk1 = pack(MrkT, 1);
        __builtin_amdgcn_sched_barrier(0);
        f32x16 Pc = Lab, Ptc = LabT, Rtc = LabT;
#pragma unroll
        for (int i = 0; i < 16; ++i) Rtc[i] += (crow(i, h) == n) ? 1.f : 0.f;
#pragma unroll
        for (int lvl = 0; lvl < 4; ++lvl) {
            const bf16x8 pP0 = pack(Pc, 0), pP1 = pack(Pc, 1), pT0 = pack(Ptc, 0), pT1 = pack(Ptc, 1);
            f32x16 nPc = MFMA32(pT0, pP0, Z16); nPc = MFMA32(pT1, pP1, nPc);
            if (lvl < 3) { f32x16 nPt = MFMA32(pP0, pT0, Z16); nPt = MFMA32(pP1, pT1, nPt); Ptc = nPt; }
            const bf16x8 pN0 = pack(nPc, 0), pN1 = pack(nPc, 1), pR0 = pack(Rtc, 0), pR1 = pack(Rtc, 1);
            Rtc = MFMA32(pN0, pR0, Rtc); Rtc = MFMA32(pN1, pR1, Rtc);
            Pc = nPc;
        }
        const bf16x8 pT0 = pack(Rtc, 0), pT1 = pack(Rtc, 1);
        bf16x8 vt[2][2];
#pragma unroll
        for (int tau = 0; tau < 2; ++tau) { vt[tau][0] = trfrag(L + 12288, tau, 0, lane); vt[tau][1] = trfrag(L + 12288, tau, 1, lane); }
        bf16x8 pW1[2][2], pW2[2][2];
#pragma unroll
        for (int tau = 0; tau < 2; ++tau) {
            f32x16 lv = MFMA32(pLk0, vt[tau][0], Z16); lv = MFMA32(pLk1, vt[tau][1], lv);
            const bf16x8 a0f = trfrag(L, tau, 0, lane), a1f = trfrag(L, tau, 1, lane);
            f32x16 w1 = MFMA32(pT0, a0f, Z16); w1 = MFMA32(pT1, a1f, w1);
            const bf16x8 l0 = pack(lv, 0), l1 = pack(lv, 1);
            f32x16 w2_ = MFMA32(pT0, l0, Z16); w2_ = MFMA32(pT1, l1, w2_);
            pW1[tau][0] = pack(w1, 0); pW1[tau][1] = pack(w1, 1); pW2[tau][0] = pack(w2_, 0); pW2[tau][1] = pack(w2_, 1);
        }
        int opq2 = 0; asm volatile("" : "+v"(opq2));
        const int lane_o = lane + opq2, n_o = n + opq2;
        unsigned char* uo = UO + ((size_t)(b * 8 + hd) * 128 + c32) * UNIT_BYTES;
#pragma unroll
        for (int kap = 0; kap < 2; ++kap) { f32x16 q1;
#pragma unroll
            for (int i = 0; i < 16; ++i) q1[i] = (i & 1) ? hi_f(pR[8 * kap + (i >> 1)]) : lo_f(pR[8 * kap + (i >> 1)]);
            q1 = MFMA32(pW1[kap][0], pMb0, q1); q1 = MFMA32(pW1[kap][1], pMb1, q1);
            store_tile(uo + kap * 2048, q1, lane_o); }
#pragma unroll
        for (int tau = 0; tau < 2; ++tau) { f32x16 q2 = MFMA32(pMb0, pW2[tau][0], Z16); q2 = MFMA32(pMb1, pW2[tau][1], q2); q2 = MFMA32(pMk0, vt[tau][0], q2); q2 = MFMA32(pMk1, vt[tau][1], q2);
#pragma unroll
            for (int i = 0; i < 16; ++i) { const int s = crow(i, h), tk = d ? tok0 + 31 - s : tok0 + s; float* yp = ybuf + ((size_t)b * SEQ + tk) * 512 + 64 * hd + 32 * tau + n_o;
                if (d) *yp += q2[i]; else *yp = q2[i]; } }
        __builtin_amdgcn_fence(__ATOMIC_RELEASE, "workgroup"); __builtin_amdgcn_wave_barrier();
#pragma unroll
        for (int tp = 0; tp < 2; ++tp) {
            const bf16x8 b0f = trfrag(L + 4096, tp, 0, lane), b1f = trfrag(L + 4096, tp, 1, lane), k0f = trfrag(L + 8192, tp, 0, lane), k1f = trfrag(L + 8192, tp, 1, lane);
            const float gcl = gC[32 * tp + n];
#pragma unroll
            for (int kap = 0; kap < 2; ++kap) { f32x16 g = MFMA32(pW1[kap][0], b0f, Z16); g = MFMA32(pW1[kap][1], b1f, g);
#pragma unroll
                for (int i = 0; i < 16; ++i) g[i] = (g[i] + ((kap == tp && crow(i, h) == n) ? 1.f : 0.f)) * gcl;
                store_tile(uo + (2 + 2 * kap + tp) * 2048, g, lane_o); }
#pragma unroll
            for (int tau = 0; tau < 2; ++tau) { f32x16 ht = MFMA32(b0f, pW2[tau][0], Z16); ht = MFMA32(b1f, pW2[tau][1], ht); ht = MFMA32(k0f, vt[tau][0], ht); ht = MFMA32(k1f, vt[tau][1], ht);
#pragma unroll
                for (int i = 0; i < 16; ++i) ht[i] *= gC[32 * tp + crow(i, h)];
                store_tile(uo + (6 + 2 * tp + tau) * 2048, ht, lane_o); }
        }
        __builtin_amdgcn_fence(__ATOMIC_RELEASE, "workgroup"); __builtin_amdgcn_wave_barrier();
    }
}

DI void d_seq(const Ctx& c, int d, const unsigned char* __restrict__ UO, float* __restrict__ ybuf) {
    if (c.wave >= 2) return;
    const int lane = c.lane, n = lane & 31, h = lane >> 5, tau = c.wave;
    for (int chain = c.bid; chain < 64; chain += c.nb) {
        const int b = chain >> 3, hd = chain & 7;
        const unsigned char* ub = UO + (size_t)chain * 128 * UNIT_BYTES + lane * 32;
        const f32x16 Z16 = {0.f};
        f32x16 X0 = Z16, X1 = Z16;
        u32x4 T[8][2];
        auto loadu = [&](int c32) {
            const unsigned char* p = ub + (size_t)c32 * UNIT_BYTES;
#pragma unroll
            for (int k = 0; k < 6; ++k) { T[k][0] = *(const u32x4*)(p + k * 2048); T[k][1] = *(const u32x4*)(p + k * 2048 + 16); }
#pragma unroll
            for (int tp = 0; tp < 2; ++tp) { T[6 + tp][0] = *(const u32x4*)(p + (6 + 2 * tp + tau) * 2048); T[6 + tp][1] = *(const u32x4*)(p + (6 + 2 * tp + tau) * 2048 + 16); }
        };
        loadu(0);
#pragma unroll 1
        for (int c32 = 0; c32 < 128; ++c32) {
            const int tok0 = d ? SEQ - 32 * (c32 + 1) : 32 * c32;
            float* yb = ybuf + ((size_t)b * SEQ) * 512 + 64 * hd + 32 * tau + n;
            f32x16 y;
#pragma unroll
            for (int i = 0; i < 16; ++i) { const int s = crow(i, h), tk = d ? tok0 + 31 - s : tok0 + s; y[i] = yb[(size_t)tk * 512]; }
            const bf16x8 x00 = pack(X0, 0), x01 = pack(X0, 1), x10 = pack(X1, 0), x11 = pack(X1, 1);
            f32x16 n0, n1;
#pragma unroll
            for (int i = 0; i < 8; ++i) { n0[2 * i] = lo_f(T[6][i >> 2][i & 3]); n0[2 * i + 1] = hi_f(T[6][i >> 2][i & 3]); n1[2 * i] = lo_f(T[7][i >> 2][i & 3]); n1[2 * i + 1] = hi_f(T[7][i >> 2][i & 3]); }
#define FR(t, s) __builtin_bit_cast(bf16x8, T[t][s])
            n0 = MFMA32(FR(2, 0), x00, n0); n1 = MFMA32(FR(3, 0), x00, n1);
            n0 = MFMA32(FR(2, 1), x01, n0); n1 = MFMA32(FR(3, 1), x01, n1);
            n0 = MFMA32(FR(4, 0), x10, n0); n1 = MFMA32(FR(5, 0), x10, n1);
            n0 = MFMA32(FR(4, 1), x11, n0); n1 = MFMA32(FR(5, 1), x11, n1);
            y = MFMA32(FR(0, 0), x00, y); y = MFMA32(FR(0, 1), x01, y); y = MFMA32(FR(1, 0), x10, y); y = MFMA32(FR(1, 1), x11, y);
#undef FR
            if (c32 + 1 < 128) loadu(c32 + 1);
#pragma unroll
            for (int i = 0; i < 16; ++i) { const int s = crow(i, h), tk = d ? tok0 + 31 - s : tok0 + s; yb[(size_t)tk * 512] = y[i]; }
            X0 = n0; X1 = n1;
        }
    }
}
#undef DI
}
namespace pk {
typedef short bf16x8 __attribute__((ext_vector_type(8)));
typedef float f32x16 __attribute__((ext_vector_type(16)));
typedef unsigned u32x4 __attribute__((ext_vector_type(4)));
typedef LAS unsigned char* lptr;
#define DI __device__ __forceinline__
DI float fmx(float a, float b) { float r; asm("v_max_f32 %0, %1, %2" : "=v"(r) : "v"(a), "v"(b)); return r; }
DI float fmn(float a, float b) { float r; asm("v_min_f32 %0, %1, %2" : "=v"(r) : "v"(a), "v"(b)); return r; }
DI void ce(float& hi, float& lo) { const float a = fmx(hi, lo), b = fmn(hi, lo); hi = a; lo = b; }
template <int N> DI void sort_desc(float (&v)[N]) {
#pragma unroll
    for (int k = 2; k <= N; k <<= 1)
#pragma unroll
        for (int j = k >> 1; j > 0; j >>= 1)
#pragma unroll
            for (int i = 0; i < N; ++i) { const int l = i ^ j; if (l > i) { if ((i & k) == 0) ce(v[i], v[l]); else ce(v[l], v[i]); } }
}
DI void merge16(float (&v)[16]) {
#pragma unroll
    for (int j = 8; j > 0; j >>= 1)
#pragma unroll
        for (int i = 0; i < 16; ++i) { const int l = i ^ j; if (l > i) ce(v[i], v[l]); }
}
DI void top_merge(float (&a)[16], const float (&b)[16]) {
#pragma unroll
    for (int i = 0; i < 16; ++i) a[i] = fmx(a[i], b[15 - i]);
    merge16(a);
}
DI float setcode(float v, unsigned code, unsigned mask) { return __uint_as_float((__float_as_uint(v) & ~mask) | code); }

DI void d_peer_topk(const Ctx& c, const bf16* __restrict__ qb, const float* __restrict__ keys, int* __restrict__ idx, float* __restrict__ gate) {
    const int lane = c.lane, n = lane & 31, hh = lane >> 5, hd = c.bid & 7;
    lptr KL = (lptr)c.lds;
    lptr TB = (lptr)c.lds + 65536 + c.wave * 2048;
    __syncthreads();
    for (int e = c.tid; e < 2 * 128 * 16; e += 512) {
        const int row = e >> 4, ch = e & 15; const float* src = keys + (size_t)hd * 32768 + row * 128 + ch * 8;
        const f32x4 a = *(const f32x4*)src, b = *(const f32x4*)(src + 4);
        u32x4 w; w[0] = pk2bf(a.x, a.y); w[1] = pk2bf(a.z, a.w); w[2] = pk2bf(b.x, b.y); w[3] = pk2bf(b.z, b.w);
        *(LAS u32x4*)(KL + row * 256 + ((ch ^ (row & 15)) << 4)) = w; }
    __syncthreads();
    const int nper = (c.nb >> 3) * 8;
    for (int tile = (c.bid >> 3) * 8 + c.wave; tile < NTOK / 32; tile += nper) {
        const int t0 = tile * 32;
        float sp[2][16];
#pragma unroll
        for (int p = 0; p < 2; ++p) {
            bf16x8 qf[8];
            { const bf16* qrow = qb + (size_t)(t0 + n) * PEER_Q + hd * 256 + p * 128 + 8 * hh;
#pragma unroll
              for (int ks = 0; ks < 8; ++ks) qf[ks] = *(const bf16x8*)(qrow + 16 * ks); }
            float top[16];
#pragma unroll
            for (int j = 0; j < 4; ++j) {
                f32x16 acc = {0.f};
                const int row = p * 128 + 32 * j + n;
#pragma unroll
                for (int ks = 0; ks < 8; ++ks) { const bf16x8 kfr = *(LAS bf16x8*)(KL + row * 256 + (((2 * ks + hh) ^ (row & 15)) << 4));
                    acc = __builtin_amdgcn_mfma_f32_32x32x16_bf16(kfr, qf[ks], acc, 0, 0, 0); }
                float g[16];
#pragma unroll
                for (int i = 0; i < 16; ++i) { const int key = 32 * j + (i & 3) + 8 * (i >> 2) + 4 * hh; g[i] = setcode(acc[i], 127u - (unsigned)key, 127u); }
                sort_desc<16>(g);
                if (j == 0) {
#pragma unroll
                    for (int i = 0; i < 16; ++i) top[i] = g[i];
                } else top_merge(top, g);
            }
            float oth[16];
#pragma unroll
            for (int i = 0; i < 16; ++i) oth[i] = __shfl_xor(top[i], 32);
            top_merge(top, oth);
#pragma unroll
            for (int i = 0; i < 16; ++i) sp[p][i] = top[i];
        }
        {
            unsigned w[8];
#pragma unroll
            for (int q = 0; q < 8; ++q) { const int p = q >> 2, a0 = (q & 3) * 4; w[q] = 0;
#pragma unroll
                for (int e = 0; e < 4; ++e) w[q] |= (127u - (__float_as_uint(sp[p][a0 + e]) & 127u)) << (8 * e); }
            *(LAS u32x4*)(TB + lane * 32) = (u32x4){w[0], w[1], w[2], w[3]}; *(LAS u32x4*)(TB + lane * 32 + 16) = (u32x4){w[4], w[5], w[6], w[7]};
        }
        float cd[64];
        {
            int cnt = 0;
#pragma unroll
            for (int a = 0; a < 16; ++a)
#pragma unroll
                for (int b = 0; b < 16; ++b) if ((a + 1) * (b + 1) <= 16) { cd[cnt] = setcode(sp[0][a] + sp[1][b], 255u - (unsigned)(a * 16 + b), 255u); ++cnt; }
#pragma unroll
            for (int i = 50; i < 64; ++i) cd[i] = -INFINITY;
        }
        sort_desc<64>(cd);
        const float mx = cd[0]; float ex[16]; float den = 0.f;
#pragma unroll
        for (int k = 0; k < 16; ++k) { ex[k] = __expf(cd[k] - mx); den += ex[k]; }
        const float rden = 1.f / den;
        const size_t ob = (size_t)(t0 + n) * 128 + hd * 16;
        if (hh == 0) {
            int id[16];
#pragma unroll
            for (int k = 0; k < 16; ++k) { const unsigned flat = 255u - (__float_as_uint(cd[k]) & 255u); const unsigned i1 = *(LAS unsigned char*)(TB + lane * 32 + (flat >> 4)), i2 = *(LAS unsigned char*)(TB + lane * 32 + 16 + (flat & 15)); id[k] = (int)(i1 * 128 + i2); }
#pragma unroll
            for (int k = 0; k < 4; ++k) *(int4*)(idx + ob + 4 * k) = make_int4(id[4 * k], id[4 * k + 1], id[4 * k + 2], id[4 * k + 3]);
        } else {
#pragma unroll
            for (int k = 0; k < 4; ++k) *(f32x4*)(gate + ob + 4 * k) = (f32x4){ex[4 * k] * rden, ex[4 * k + 1] * rden, ex[4 * k + 2] * rden, ex[4 * k + 3] * rden};
        }
    }
}
#undef DI
}
namespace pg8 {
struct EpiResF32 {
    static constexpr bool PERM = false, AFTER_DRAIN = false;
    const float* base; float* out; int ldc; float alpha;
    __device__ __forceinline__ void operator()(const f32x4 (&acc)[2][2][4][2], const Unit& u, int wr, int wc, int fr, int fq) const {
        const int col0 = u.pn * BM + wc * 32 + 4 * fq;
#pragma unroll
        for (int ai = 0; ai < 2; ++ai)
#pragma unroll
            for (int m = 0; m < 4; ++m) { const int r = ai * HALF + wr * 64 + m * 16 + fr; const size_t off = (size_t)(u.pm * BM + r) * ldc + col0;
#pragma unroll
                for (int bj = 0; bj < 2; ++bj)
#pragma unroll
                    for (int n = 0; n < 2; ++n) { const f32x4 bs = *(const f32x4*)(base + off + bj * HALF + n * 16); *(f32x4*)(out + off + bj * HALF + n * 16) = bs * alpha + acc[ai][bj][m][n]; } }
    }
};
}
constexpr size_t MiB = 1u << 20;
constexpr int LDS_BYTES = 147456;
constexpr int NPHASE = 14;
struct Params { const float* in[24]; float* out; unsigned char* ws; int ph_lo, ph_hi; };

__global__ void __launch_bounds__(512, 2) mega(Params p) {
    extern __shared__ __attribute__((aligned(16))) unsigned char lds[];
    cg::grid_group grid = cg::this_grid();
    Ctx c; c.wave = __builtin_amdgcn_readfirstlane(threadIdx.x >> 6); c.lane = (int)__builtin_amdgcn_mbcnt_hi(~0u, __builtin_amdgcn_mbcnt_lo(~0u, 0u)); c.tid = c.wave * 64 + c.lane; c.bid = blockIdx.x; c.nb = gridDim.x; c.gw = c.bid * 8 + c.wave; c.ngw = c.nb * 8; c.lds = lds;
#define LND(ptr) ({ auto q_ = (ptr); asm volatile("" : "+s"(q_)); q_; })
#define WSP(T, mb) ((T*)(LND(p.ws) + (size_t)(mb) * MiB))
#define x LND(p.in[0])
#define w_in LND(p.in[1])
#define mu_prev LND(p.in[2])
#define mu_next LND(p.in[3])
#define w0 LND(p.in[4])
#define w2 LND(p.in[5])
#define a0 LND(p.in[6])
#define a2 LND(p.in[7])
#define g2 LND(p.in[8])
#define k_k LND(p.in[9])
#define k_a LND(p.in[10])
#define r_k LND(p.in[11])
#define lnx_g LND(p.in[12])
#define lnx_b LND(p.in[13])
#define sink LND(p.in[14])
#define w_out LND(p.in[15])
#define ln1_g LND(p.in[16])
#define ln1_b LND(p.in[17])
#define wq LND(p.in[18])
#define keys LND(p.in[19])
#define pu LND(p.in[20])
#define pv LND(p.in[21])
#define ln2_g LND(p.in[22])
#define ln2_b LND(p.in[23])
#define out LND(p.out)
#define rope WSP(float2, 1)
#define w2t WSP(bf16, 2)
#define a2t ((bf16*)(LND(p.ws) + 2 * MiB + 65536))
#define w_in_t WSP(bf16, 4)
#define w_out_t WSP(bf16, 10)
#define wq_t WSP(bf16, 12)
#define xb WSP(bf16, 16)
#define qr WSP(bf16, 16)
#define kr WSP(bf16, 48)
#define ybuf WSP(float, 16)
#define ub WSP(bf16, 16)
#define vb WSP(bf16, 48)
#define proj WSP(bf16, 80)
#define y1 WSP(float, 80)
#define idx WSP(int, 208)
#define gate WSP(float, 224)
#define mix WSP(bf16, 240)
#define UO WSP(unsigned char, 304)
#define qb WSP(bf16, 304)
#define h1b WSP(bf16, 432)
    const int lo = p.ph_lo, hi = p.ph_hi;
#ifndef PH_MASK
#define PH_MASK 0xFFFF
#endif
#define IN(k) (((PH_MASK >> (k)) & 1) && lo <= (k) && (k) < hi)
#define SEAM(k) do { if (IN(k) && IN((k) + 1)) grid.sync(); c.lane = (int)__builtin_amdgcn_mbcnt_hi(~0u, __builtin_amdgcn_mbcnt_lo(~0u, 0u)); c.tid = c.wave * 64 + c.lane; } while (0)
#ifndef REPEAT_MASK
#define REPEAT_MASK 0
#endif
#define PHASE(k, ...) do { if (IN(k)) { __VA_ARGS__; if ((REPEAT_MASK >> (k)) & 1) { grid.sync(); __VA_ARGS__; } } SEAM(k); } while (0)
#define GEMM_PHASE(EPI, A_, Bt_, N_, ...) do { pg8::Gemm g{A_, Bt_, NTOK, N_, DM}; pg8::StaticOrder S; S.init(NTOK, N_, c.nb, c.bid); EPI E{__VA_ARGS__}; \
        pg8::gemm_phase<EPI, pg8::StaticOrder, true, true>((PG8_LAS unsigned char*)lds, g, S, E, c.wave); } while (0)
    PHASE(0, nv::d_cvt_bf16(c, x, xb, (size_t)NTOK * DM / 4); nv::d_transpose_w(c, w_in, DM, IN_COLS, IN_PAD, w_in_t); nv::d_transpose_w(c, w_out, DM, DM, DM, w_out_t);
             nv::d_transpose_w(c, wq, DM, PEER_Q, PEER_Q, wq_t); nv::d_rope_table(c, rope); rw::d_lowrank_t(c, w2, a2, w2t, a2t));
    PHASE(1, GEMM_PHASE(pg8::EpiBf16<0>, xb, w_in_t, IN_PAD, proj, IN_PAD, nullptr, 0, 0, 1.f));
    PHASE(2, nv::d_rotary(c, proj, rope, qr, kr));
    PHASE(3, nv::d_attn(c, qr, kr, proj, sink, mix));
    PHASE(4, rw::d_prep(c, 0, proj, mu_prev, mu_next, w0, a0, k_k, k_a, w2t, a2t, UO, ybuf));
    PHASE(5, rw::d_seq(c, 0, UO, ybuf));
    PHASE(6, rw::d_prep(c, 1, proj, mu_prev, mu_next, w0, a0, k_k, k_a, w2t, a2t, UO, ybuf));
    PHASE(7, rw::d_seq(c, 1, UO, ybuf));
    PHASE(8, nv::d_rwkv_out<true>(c, proj, ybuf, mu_prev, mu_next, a0, a2, g2, k_a, r_k, lnx_g, lnx_b, mix));
    PHASE(9, GEMM_PHASE(pg8::EpiResF32, mix, w_out_t, DM, x, y1, DM, DN_ALPHA));
    PHASE(10, { float* y1p = y1; nv::d_ln1(c, y1p, ln1_g, ln1_b, y1p, h1b); } nv::d_cvt_bf16(c, pu, ub, (size_t)NEXP * DM / 4); nv::d_cvt_bf16(c, pv, vb, (size_t)NEXP * DM / 4));
    PHASE(11, GEMM_PHASE(pg8::EpiBf16<0>, h1b, wq_t, PEER_Q, qb, PEER_Q, nullptr, 0, 0, 1.f));
    PHASE(12, pk::d_peer_topk(c, qb, keys, idx, gate));
    PHASE(13, pe::d_peer_gather(c, h1b, idx, gate, ub, vb, ln2_g, ln2_b, out));
#undef IN
#undef SEAM
}
#undef x
#undef out
#undef proj
#undef mix
#undef idx
#undef gate
#undef keys
#undef rope
#undef w0
#undef w2
#undef a0
#undef a2
#undef g2
#undef sink
#undef qr
#undef kr
#undef ub
#undef vb
#undef qb
#undef xb
#undef y1
#undef UO
#undef ybuf
#undef pu
#undef pv

#ifndef N_LAUNCHES
#define N_LAUNCHES 1
#endif
extern "C" void kernel_launch(void* const* d_in, const int* in_sizes, int n_in, void* d_out, int out_size, void* d_ws, size_t ws_size, hipStream_t stream) {
    static int grid = 0;
    if (grid == 0) {
        if (n_in != 24 || in_sizes[0] != NTOK * DM || out_size != NTOK * DM || ws_size < 496 * MiB) { fprintf(stderr, "kernel_launch: unexpected shapes/ws (n_in %d, ws %zu)\n", n_in, ws_size); grid = -1; return; }
        int dev = 0, cus = 0, per_cu = 0;
        if (hipGetDevice(&dev) != hipSuccess || hipDeviceGetAttribute(&cus, hipDeviceAttributeMultiprocessorCount, dev) != hipSuccess) { grid = -1; return; }
        if (hipFuncSetAttribute((const void*)mega, hipFuncAttributeMaxDynamicSharedMemorySize, LDS_BYTES) != hipSuccess) { fprintf(stderr, "kernel_launch: hipFuncSetAttribute failed\n"); grid = -1; return; }
        if (hipOccupancyMaxActiveBlocksPerMultiprocessor(&per_cu, (const void*)mega, 512, LDS_BYTES) != hipSuccess || per_cu < 1) { fprintf(stderr, "kernel_launch: occupancy query failed (%d)\n", per_cu); (void)hipGetLastError(); grid = -1; return; }
        grid = cus * per_cu;
        fprintf(stderr, "kernel_launch: cus %d per_cu %d grid %d\n", cus, per_cu, grid);
    }
    if (grid < 0) return;
    Params p{};
    for (int i = 0; i < 24; ++i) p.in[i] = (const float*)d_in[i];
    p.out = (float*)d_out; p.ws = (unsigned char*)d_ws;
#if N_LAUNCHES == 1
    p.ph_lo = 0; p.ph_hi = NPHASE;
    void* args[] = {&p};
    hipError_t e = hipLaunchCooperativeKernel((const void*)mega, dim3(grid), dim3(512), args, LDS_BYTES, stream);
    if (e != hipSuccess) fprintf(stderr, "cooperative launch failed: %s (grid %d)\n", hipGetErrorString(e), grid);
#else
    for (int k = 0; k < NPHASE; ++k) { p.ph_lo = k; p.ph_hi = k + 1; hipLaunchKernelGGL(mega, dim3(grid), dim3(512), LDS_BYTES, stream, p); }
#endif
}
```

```cpp
#include <hip/hip_runtime.h>
#include <hip/hip_cooperative_groups.h>
#include <cstdio>
#include <cstdint>
#include <cmath>
namespace cg = cooperative_groups;

constexpr int BATCH = 8, SEQ = 4096, DM = 1024, NTOK = BATCH * SEQ;
constexpr int IN_COLS = 2528, IN_PAD = 2560;
constexpr int C_Q = 0, C_K = 512, C_V = 640, C_P = 768;
constexpr int P_R = 0, P_KK = 512, P_VV = 1024, P_WD = 1536, P_AD = 1600, P_GD = 1664, RW_COLS = 1760;
constexpr int NEXP = 16384, PEER_Q = 2048;
constexpr float LN_EPS = 1e-5f, GN_EPS = 64e-5f;
constexpr float DN_ALPHA = 1.189207115002721f;

typedef unsigned short bf16;
__device__ __forceinline__ float bf2f(bf16 v) { return __uint_as_float(((unsigned)v) << 16); }
__device__ __forceinline__ bf16 f2bf(float f) { unsigned u = __float_as_uint(f); return (bf16)((u + 0x7fffu + ((u >> 16) & 1u)) >> 16); }
__device__ __forceinline__ unsigned pk2bf(float lo, float hi) { return (unsigned)f2bf(lo) | ((unsigned)f2bf(hi) << 16); }
__device__ __forceinline__ float wave_sum(float v) {
#pragma unroll
    for (int o = 1; o < 64; o <<= 1) v += __shfl_xor(v, o);
    return v;
}
__device__ __forceinline__ float sigmoidf_(float x) { return 1.f / (1.f + __expf(-x)); }
namespace pg8 {
#define PG8_LAS __attribute__((address_space(3)))
typedef unsigned short bf16_t;
typedef short bf16x8 __attribute__((ext_vector_type(8)));
typedef float f32x4 __attribute__((ext_vector_type(4)));
typedef unsigned u32x4 __attribute__((ext_vector_type(4)));
constexpr int BM = 256, BK = 64, HALF = 128, HTB = HALF * BK * 2  , STAGE_BYTES = 8 * HTB, NXCD = 8, WGM = 8;

__host__ __device__ __forceinline__ int lds_byte(int r, int c) { const int st = (r >> 4) * 2 + (c >> 5), rr = r & 15, cc = c & 31, ob = rr * 64 + cc * 2; return st * 1024 + (ob ^ (((ob >> 9) & 1) << 5)); }
__host__ __device__ __forceinline__ void stage_rc(int b, int& R, int& C) { const int st = b / 1024, sb = b % 1024, swz = sb ^ (((sb >> 9) & 1) << 5); R = (st >> 1) * 16 + swz / 64; C = (st & 1) * 32 + (swz % 64) / 2; }
__host__ __device__ __forceinline__ int perm32(int rho) { const int n = rho >> 4, i = rho & 15; return 8 * (i >> 2) + 4 * n + (i & 3); }

struct Unit { int pm, pn; };
struct Gemm { const bf16_t* A; const bf16_t* Bt; int M, N, K; };

struct StaticOrder {
    int nM, nN, nwg, G, c;
    __host__ __device__ void init(int M, int N, int G_, int c_) { nM = M / BM; nN = N / BM; nwg = nM * nN; G = G_; c = c_; }
    __host__ __device__ bool next(int i, Unit& u) const {
        const long L = (long)i * G + c; if (L >= nwg) return false;
        int wgid = (int)L; { const int q = nwg / NXCD, r = nwg % NXCD, xcd = wgid % NXCD, off = wgid / NXCD; wgid = (xcd < r ? xcd * (q + 1) : r * (q + 1) + (xcd - r) * q) + off; }
        const int nig = WGM * nN, gid = wgid / nig, fm = gid * WGM, gsz = (nM - fm) < WGM ? (nM - fm) : WGM;
        u.pm = fm + ((wgid % nig) % gsz); u.pn = (wgid % nig) / gsz; return true;
    }
    __device__ __forceinline__ void a_ready(const Unit&) const {}
    __device__ __forceinline__ void done(const Unit&) const {}
};

__device__ __forceinline__ unsigned cvt_pk_bf16(float lo, float hi) { unsigned r; asm volatile("v_cvt_pk_bf16_f32 %0, %1, %2" : "=v"(r) : "v"(lo), "v"(hi)); return r; }
typedef float f32x2 __attribute__((ext_vector_type(2)));
__device__ __forceinline__ f32x2 gelu_pk(f32x2 v) {
    const f32x2 av = __builtin_elementwise_abs(v), d = av * 0.2316418882f + 1.0f;
    f32x2 t; t.x = __builtin_amdgcn_rcpf(d.x); t.y = __builtin_amdgcn_rcpf(d.y);
    f32x2 q = t * 0.5307027145f + (-0.7265760135f); q = q * t + 0.7107068705f; q = q * t + (-0.142248368f); q = q * t + 0.127414796f; q = q * t;
    const f32x2 s = (v * v) * (-0.72134752044f);
    f32x2 e; e.x = __builtin_amdgcn_exp2f(s.x); e.y = __builtin_amdgcn_exp2f(s.y);
    const f32x2 m = v * (q * e), r = v - m;
    f32x2 o; o.x = v.x < 0.f ? m.x : r.x; o.y = v.y < 0.f ? m.y : r.y; return o;
}

template <int ACT  > struct EpiBf16 {
    static constexpr bool PERM = true, AFTER_DRAIN = false; static_assert(ACT == 0 || ACT == 1, "EpiBf16: ACT is 0 (none) or 1 (gelu_pk)");
    bf16_t* O; int ldc; const float* bias; int split_cols; size_t split_stride; float scale0;
    __device__ __forceinline__ void operator()(const f32x4 (&acc)[2][2][4][2], const Unit& u, int wr, int wc, int fr, int fq) const {
        const int row0 = u.pm * BM + wr * 64 + fr; int colt = u.pn * BM; bf16_t* base = O;
        float sc = 1.f; if (split_cols) { const int t = colt / split_cols; base += (size_t)t * split_stride; colt -= t * split_cols; if (t == 0) sc = scale0; }
        const int col0 = colt + wc * 32 + 8 * fq, bcol0 = u.pn * BM + wc * 32 + 8 * fq;
        f32x4 bv[2][2];
#pragma unroll
        for (int bj = 0; bj < 2; ++bj)
#pragma unroll
            for (int n = 0; n < 2; ++n) bv[bj][n] = bias ? *(const f32x4*)(bias + bcol0 + bj * HALF + 4 * n) : (f32x4){0.f, 0.f, 0.f, 0.f};
#pragma unroll
        for (int ai = 0; ai < 2; ++ai)
#pragma unroll
            for (int m = 0; m < 4; ++m) { bf16_t* rowp = base + (size_t)(row0 + ai * HALF + m * 16) * ldc + col0;
#pragma unroll
                for (int bj = 0; bj < 2; ++bj) { f32x4 v0 = acc[ai][bj][m][0] + bv[bj][0], v1 = acc[ai][bj][m][1] + bv[bj][1];
                    if (ACT == 1) { f32x2 a = gelu_pk((f32x2){v0[0], v0[1]}), b = gelu_pk((f32x2){v0[2], v0[3]}), c = gelu_pk((f32x2){v1[0], v1[1]}), d = gelu_pk((f32x2){v1[2], v1[3]});
                        v0 = (f32x4){a.x, a.y, b.x, b.y}; v1 = (f32x4){c.x, c.y, d.x, d.y}; }
                    v0 = v0 * sc; v1 = v1 * sc; u32x4 w; w.x = cvt_pk_bf16(v0[0], v0[1]); w.y = cvt_pk_bf16(v0[2], v0[3]); w.z = cvt_pk_bf16(v1[0], v1[1]); w.w = cvt_pk_bf16(v1[2], v1[3]);
                    *(u32x4*)(rowp + bj * HALF) = w; } }
    }
};

struct PanelStats {
    unsigned* xbuf;
    unsigned* cnt;
    unsigned* tmo;
    int ntn; float eps;
    unsigned code;
    __device__ __forceinline__ bool run(const f32x4 (&v)[2][2][4][2], const Unit& u, int wr, int wc, int fr, int fq, PG8_LAS unsigned char* lds, int wid, int lane) const {
        typedef float f32x2v __attribute__((ext_vector_type(2)));
        PG8_LAS f32x2v* P = (PG8_LAS f32x2v*)lds;
        PG8_LAS f32x2v* S = (PG8_LAS f32x2v*)(lds + 8192);
        PG8_LAS unsigned* flag = (PG8_LAS unsigned*)(lds + 8192 + 2048);
#pragma unroll
        for (int ai = 0; ai < 2; ++ai)
#pragma unroll
            for (int m = 0; m < 4; ++m) {
                float s = 0.f;
#pragma unroll
                for (int bj = 0; bj < 2; ++bj)
#pragma unroll
                    for (int n = 0; n < 2; ++n) { const f32x4 x = v[ai][bj][m][n]; s += (x[0] + x[1]) + (x[2] + x[3]); }
                s += __shfl_xor(s, 16); s += __shfl_xor(s, 32);
                const float mw = s * (1.0f / 64.0f); float q = 0.f;
#pragma unroll
                for (int bj = 0; bj < 2; ++bj)
#pragma unroll
                    for (int n = 0; n < 2; ++n) { const f32x4 d = v[ai][bj][m][n] - mw; q += (d[0] * d[0] + d[1] * d[1]) + (d[2] * d[2] + d[3] * d[3]); }
                q += __shfl_xor(q, 16); q += __shfl_xor(q, 32);
                if (fq == 0) P[(ai * HALF + wr * 64 + m * 16 + fr) * 4 + wc] = (f32x2v){mw, q};
            }
        asm volatile("s_waitcnt lgkmcnt(0)" ::: "memory"); __builtin_amdgcn_s_barrier(); asm volatile("" ::: "memory");
#if defined(BROKEN_EXCHANGE_NO_WAIT)
#warning BROKEN CONTROL BUILD: the row-statistics exchange does not wait; results are wrong by design
        if (blockIdx.x >= 64) { const long long t0_ = clock64(); while (clock64() - t0_ < 60000) __builtin_amdgcn_s_sleep(8); }
#endif
        const int row = wid * 32 + (lane & 31);
        if (lane < 32) {
            const f32x2v a = P[row * 4 + 0], b = P[row * 4 + 1], c = P[row * 4 + 2], d = P[row * 4 + 3];
            const float mt = (a.x + b.x + c.x + d.x) * 0.25f;
            const float da = a.x - mt, db = b.x - mt, dc = c.x - mt, dd = d.x - mt;
            const float m2 = (a.y + b.y) + (c.y + d.y) + 64.0f * ((da * da + db * db) + (dc * dc + dd * dd));
            unsigned long long* slot = (unsigned long long*)xbuf + ((size_t)(u.pm * BM + row) * 4 + u.pn);
            __hip_atomic_store(slot, ((unsigned long long)__float_as_uint(m2) << 32) | __float_as_uint(mt), __ATOMIC_RELAXED, __HIP_MEMORY_SCOPE_AGENT);
        }
        asm volatile("s_waitcnt vmcnt(0)" ::: "memory");
        if (lane == 0) __hip_atomic_fetch_add(cnt + 64 * u.pm, 1u, __ATOMIC_RELAXED, __HIP_MEMORY_SCOPE_AGENT);
        if (wid == 0) {
            bool dead = false; const unsigned long long t0 = __builtin_amdgcn_s_memrealtime(); const unsigned want = 8u * (unsigned)ntn;
            for (;;) {
#if defined(BROKEN_EXCHANGE_NO_WAIT)
                break;
#endif
                if ((unsigned)__builtin_amdgcn_readfirstlane(__hip_atomic_load(cnt + 64 * u.pm, __ATOMIC_RELAXED, __HIP_MEMORY_SCOPE_AGENT)) >= want) break;
                if (__builtin_amdgcn_s_memrealtime() - t0 > 2000000ull) {
                    if (lane == 0) { unsigned expect = 0u; __hip_atomic_compare_exchange_strong(tmo + 1, &expect, code | (unsigned)(u.pm & 0xff), __ATOMIC_RELAXED, __ATOMIC_RELAXED, __HIP_MEMORY_SCOPE_AGENT);
                                     __hip_atomic_store(tmo, 1u, __ATOMIC_RELAXED, __HIP_MEMORY_SCOPE_AGENT); }
                    dead = true; break; }
                __builtin_amdgcn_s_sleep(2);
            }
            __builtin_amdgcn_fence(__ATOMIC_ACQUIRE, "agent");
            if (lane == 0) flag[0] = dead ? 1u : 0u;
        }
        asm volatile("s_waitcnt vmcnt(0) lgkmcnt(0)" ::: "memory"); __builtin_amdgcn_s_barrier(); asm volatile("" ::: "memory");
        const bool bad = flag[0] != 0u;
        if (lane < 32) {
            const unsigned long long* slot = (const unsigned long long*)xbuf + (size_t)(u.pm * BM + row) * 4; float mt[4], m2[4]; float ms = 0.f;
#pragma unroll
            for (int t = 0; t < 4; ++t) { if (t < ntn) { const unsigned long long w = __hip_atomic_load(slot + t, __ATOMIC_RELAXED, __HIP_MEMORY_SCOPE_AGENT); mt[t] = __uint_as_float((unsigned)w); m2[t] = __uint_as_float((unsigned)(w >> 32)); } else { mt[t] = 0.f; m2[t] = 0.f; } ms += mt[t]; }
            const float mean = ms / (float)ntn; float q = 0.f;
#pragma unroll
            for (int t = 0; t < 4; ++t) if (t < ntn) { const float dm = mt[t] - mean; q += m2[t] + 256.0f * dm * dm; }
            S[row] = (f32x2v){mean, 1.0f / sqrtf(q / (256.0f * (float)ntn) + eps)};
        }
        asm volatile("s_waitcnt lgkmcnt(0)" ::: "memory"); __builtin_amdgcn_s_barrier(); asm volatile("" ::: "memory");
        return bad;
    }
};
struct EpiLnRes {
    static constexpr bool PERM = false, AFTER_DRAIN = true;
    const float* base; float* out; int ldc; const float* bias; PanelStats st; unsigned poison;
    __device__ __forceinline__ void fused(f32x4 (&acc)[2][2][4][2], const Unit& u, int wr, int wc, int fr, int fq, PG8_LAS unsigned char* lds, int wid, int lane) const {
        typedef float f32x2v __attribute__((ext_vector_type(2)));
        const PG8_LAS f32x2v* S = (const PG8_LAS f32x2v*)(lds + 8192);
        const int col0 = u.pn * BM + wc * 32 + 4 * fq;
#pragma unroll
        for (int bj = 0; bj < 2; ++bj)
#pragma unroll
            for (int n = 0; n < 2; ++n) { const f32x4 bv = bias ? *(const f32x4*)(bias + col0 + bj * HALF + n * 16) : (f32x4){0.f, 0.f, 0.f, 0.f};
#pragma unroll
                for (int ai = 0; ai < 2; ++ai)
#pragma unroll
                    for (int m = 0; m < 4; ++m) acc[ai][bj][m][n] += bv; }
        f32x4 pre[4][2][2];
#pragma unroll
        for (int m = 0; m < 4; ++m) { const size_t off = (size_t)(u.pm * BM + wr * 64 + m * 16 + fr) * ldc + col0;
#pragma unroll
            for (int bj = 0; bj < 2; ++bj)
#pragma unroll
                for (int n = 0; n < 2; ++n) pre[m][bj][n] = *(const f32x4*)(base + off + bj * HALF + n * 16); }
        const bool bad = st.run(acc, u, wr, wc, fr, fq, lds, wid, lane) || poison != 0u;
        const float qnan = __builtin_nanf("");
#pragma unroll
        for (int ai = 0; ai < 2; ++ai)
#pragma unroll
            for (int m = 0; m < 4; ++m) { const int r = ai * HALF + wr * 64 + m * 16 + fr; const f32x2v sr = S[r]; const size_t off = (size_t)(u.pm * BM + r) * ldc + col0;
#pragma unroll
                for (int bj = 0; bj < 2; ++bj)
#pragma unroll
                    for (int n = 0; n < 2; ++n) { const f32x4 bs = ai == 0 ? pre[m][bj][n] : *(const f32x4*)(base + off + bj * HALF + n * 16); f32x4 o = bs + (acc[ai][bj][m][n] - sr.x) * sr.y;
                        if (bad) o = (f32x4){qnan, qnan, qnan, qnan}; *(f32x4*)(out + off + bj * HALF + n * 16) = o; }
                if (m & 1) asm volatile("" ::: "memory"); }
    }
};
struct EpiLnResLn {
    static constexpr bool PERM = false, AFTER_DRAIN = true;
    const float* base; float* out; bf16_t* xn; int ldc; const float* bias; PanelStats st1, st2; unsigned poison;
    __device__ __forceinline__ void fused(f32x4 (&acc)[2][2][4][2], const Unit& u, int wr, int wc, int fr, int fq, PG8_LAS unsigned char* lds, int wid, int lane) const {
        typedef float f32x2v __attribute__((ext_vector_type(2))); typedef unsigned u32x2v __attribute__((ext_vector_type(2)));
        const PG8_LAS f32x2v* S = (const PG8_LAS f32x2v*)(lds + 8192);
        const int col0 = u.pn * BM + wc * 32 + 4 * fq;
#pragma unroll
        for (int bj = 0; bj < 2; ++bj)
#pragma unroll
            for (int n = 0; n < 2; ++n) { const f32x4 bv = bias ? *(const f32x4*)(bias + col0 + bj * HALF + n * 16) : (f32x4){0.f, 0.f, 0.f, 0.f};
#pragma unroll
                for (int ai = 0; ai < 2; ++ai)
#pragma unroll
                    for (int m = 0; m < 4; ++m) acc[ai][bj][m][n] += bv; }
        bool bad = st1.run(acc, u, wr, wc, fr, fq, lds, wid, lane) || poison != 0u;
        const float qnan = __builtin_nanf("");
#pragma unroll
        for (int ai = 0; ai < 2; ++ai)
#pragma unroll
            for (int m = 0; m < 4; ++m) { const int r = ai * HALF + wr * 64 + m * 16 + fr; const f32x2v sr = S[r]; const size_t off = (size_t)(u.pm * BM + r) * ldc + col0;
#pragma unroll
                for (int bj = 0; bj < 2; ++bj)
#pragma unroll
                    for (int n = 0; n < 2; ++n) { const f32x4 bs = *(const f32x4*)(base + off + bj * HALF + n * 16); acc[ai][bj][m][n] = bs + (acc[ai][bj][m][n] - sr.x) * sr.y; }
                asm volatile("" : "+v"(acc[ai][0][m][0]), "+v"(acc[ai][0][m][1]), "+v"(acc[ai][1][m][0]), "+v"(acc[ai][1][m][1]));
                if (m & 1) asm volatile("" ::: "memory"); }
        const bool bad1 = bad;
        bad = st2.run(acc, u, wr, wc, fr, fq, lds, wid, lane) || bad;
#pragma unroll
        for (int ai = 0; ai < 2; ++ai)
#pragma unroll
            for (int m = 0; m < 4; ++m) { const int r = ai * HALF + wr * 64 + m * 16 + fr; const f32x2v sr = S[r]; const size_t off = (size_t)(u.pm * BM + r) * ldc + col0;
#pragma unroll
                for (int bj = 0; bj < 2; ++bj)
#pragma unroll
                    for (int n = 0; n < 2; ++n) { const f32x4 x1 = acc[ai][bj][m][n]; *(f32x4*)(out + off + bj * HALF + n * 16) = bad1 ? (f32x4){qnan, qnan, qnan, qnan} : x1;
                        const f32x4 o = (x1 - sr.x) * sr.y; u32x2v w; w.x = cvt_pk_bf16(o[0], o[1]); w.y = cvt_pk_bf16(o[2], o[3]);
                        if (bad) { w.x = 0x7fc07fc0u; w.y = 0x7fc07fc0u; } *(u32x2v*)(xn + off + bj * HALF + n * 16) = w; }
                asm volatile("" ::: "memory"); }
    }
};

template <class Epi, class Sched, bool ALIGN_EPI = false, bool SP2 = false>
__device__ __forceinline__ void gemm_phase(PG8_LAS unsigned char* lds, const Gemm g, const Sched& S, const Epi& E, const int wid_in) {
    const int lane = (int)__builtin_amdgcn_mbcnt_hi(~0u, __builtin_amdgcn_mbcnt_lo(~0u, 0u)), wid = wid_in, tid = wid * 64 + lane, wr = wid >> 2, wc = wid & 3, fr = lane & 15, fq = lane >> 4;
    const int K = g.K, nt = K / BK;
    unsigned voffA[2], voffB[2];
#pragma unroll
    for (int i = 0; i < 2; ++i) { int R, C; stage_rc(tid * 16 + i * 8192, R, C); const int Rb = Epi::PERM ? ((R & ~31) + perm32(R & 31)) : R;
        voffA[i] = (unsigned)(R * K + C) * 2u; voffB[i] = (unsigned)(Rb * K + C) * 2u; }
    const size_t kstep = (size_t)(BK * 2);
    const size_t hstep = (size_t)HALF * K * 2;
    const size_t tstep = 2 * hstep;
    const unsigned ldsw = (unsigned)wid * 1024u;
    const int aoff = lds_byte(wr * 64 + fr, fq * 8), boff = lds_byte(wc * 32 + fr, fq * 8);
#define PG8_SA(b, h) (((b) * 2 + (h)) * HTB)
#define PG8_SB(b, h) ((4 + (b) * 2 + (h)) * HTB)
#define PG8_STAGE(bufoff, gbase, voff) do { _Pragma("unroll") for (int _i = 0; _i < 2; ++_i) \
        __builtin_amdgcn_global_load_lds((const unsigned*)((const char*)(gbase) + (voff)[_i]), (PG8_LAS unsigned*)(lds + (bufoff) + ldsw + _i * 8192), 16, 0, 0); } while (0)
#define PG8_LDA(dst, b, h) do { _Pragma("unroll") for (int m = 0; m < 4; ++m) _Pragma("unroll") for (int k = 0; k < 2; ++k) dst[m][k] = *(const PG8_LAS bf16x8*)(lds + PG8_SA(b, h) + aoff + m * 2048 + k * 1024); } while (0)
#define PG8_LDB(dst, b, h) do { _Pragma("unroll") for (int n = 0; n < 2; ++n) _Pragma("unroll") for (int k = 0; k < 2; ++k) dst[n][k] = *(const PG8_LAS bf16x8*)(lds + PG8_SB(b, h) + boff + n * 2048 + k * 1024); } while (0)
#define PG8_MMA(ai, bj, At, Bt) do { __builtin_amdgcn_s_setprio(1); _Pragma("unroll") for (int m = 0; m < 4; ++m) _Pragma("unroll") for (int n = 0; n < 2; ++n) _Pragma("unroll") for (int k = 0; k < 2; ++k) \
        acc[ai][bj][m][n] = __builtin_amdgcn_mfma_f32_16x16x32_bf16(Bt[n][k], At[m][k], acc[ai][bj][m][n], 0, 0, 0); __builtin_amdgcn_s_setprio(0); } while (0)
#define PG8_WAIT_V(n) asm volatile("s_waitcnt vmcnt(" #n ")" ::: "memory")
#define PG8_WAIT_L(n) asm volatile("s_waitcnt lgkmcnt(" #n ")" ::: "memory")
#define PG8_BAR __builtin_amdgcn_s_barrier()
#define PG8_SCHED __builtin_amdgcn_sched_barrier(0)
    Unit cur, nxt; int ui = 0;
    if (!S.next(0, cur)) return;
    f32x4 acc[2][2][4][2];
#pragma unroll
    for (int a = 0; a < 2; ++a)
#pragma unroll
        for (int b = 0; b < 2; ++b)
#pragma unroll
            for (int m = 0; m < 4; ++m)
#pragma unroll
                for (int n = 0; n < 2; ++n) acc[a][b][m][n] = (f32x4){0.f, 0.f, 0.f, 0.f};
    bf16x8 At[4][2], B0[2][2], B1[2][2];
    const char* cA = (const char*)g.A + (size_t)cur.pm * tstep; const char* cB = (const char*)g.Bt + (size_t)cur.pn * tstep;
    S.a_ready(cur);
    if constexpr (SP2) {
        PG8_STAGE(PG8_SB(0, 0), cB, voffB); PG8_STAGE(PG8_SB(0, 1), cB + hstep, voffB); PG8_STAGE(PG8_SA(0, 0), cA, voffA); PG8_STAGE(PG8_SA(0, 1), cA + hstep, voffA);
        if (wr == 1) PG8_BAR;
        PG8_WAIT_V(2); PG8_BAR;
        PG8_STAGE(PG8_SB(1, 0), cB + kstep, voffB); PG8_STAGE(PG8_SA(1, 0), cA + kstep, voffA); PG8_STAGE(PG8_SB(1, 1), cB + hstep + kstep, voffB);
        PG8_WAIT_V(6); PG8_BAR;
    } else {
        PG8_STAGE(PG8_SB(0, 0), cB, voffB); PG8_STAGE(PG8_SA(0, 0), cA, voffA); PG8_STAGE(PG8_SB(0, 1), cB + hstep, voffB); PG8_STAGE(PG8_SA(0, 1), cA + hstep, voffA);
        if (wr == 1) PG8_BAR;
        PG8_WAIT_V(4); PG8_BAR;
        PG8_STAGE(PG8_SB(1, 0), cB + kstep, voffB); PG8_STAGE(PG8_SA(1, 0), cA + kstep, voffA); PG8_STAGE(PG8_SB(1, 1), cB + hstep + kstep, voffB);
        PG8_WAIT_V(6); PG8_BAR;
    }
    for (;;) {
        const bool has_next = S.next(ui + 1, nxt);
        const char* nA = has_next ? (const char*)g.A + (size_t)nxt.pm * tstep : cA; const char* nB = has_next ? (const char*)g.Bt + (size_t)nxt.pn * tstep : cB;
        for (int t = 0; t < nt; t += 2) {
            const bool last = (t == nt - 2);
            const char* a1 = cA + (size_t)(t + 1) * kstep;
            const char* a2 = last ? nA : cA + (size_t)(t + 2) * kstep; const char* b2 = last ? nB : cB + (size_t)(t + 2) * kstep;
            const char* a3 = a2 + kstep; const char* b3 = b2 + kstep;
            if (last && has_next) S.a_ready(nxt);
            if constexpr (SP2) {
            PG8_LDB(B0, 0, 0); PG8_LDB(B1, 0, 1); PG8_SCHED; PG8_LDA(At, 0, 0); PG8_STAGE(PG8_SA(1, 1), a1 + hstep, voffA);
            PG8_WAIT_V(8); PG8_WAIT_L(0); PG8_BAR; PG8_MMA(0, 0, At, B0); PG8_MMA(0, 1, At, B1); PG8_BAR; PG8_SCHED;
            PG8_LDA(At, 0, 1); PG8_STAGE(PG8_SB(0, 0), b2, voffB); PG8_STAGE(PG8_SB(0, 1), b2 + hstep, voffB); PG8_STAGE(PG8_SA(0, 0), a2, voffA);
            PG8_WAIT_V(8); PG8_WAIT_L(0); PG8_BAR; PG8_MMA(1, 0, At, B0); PG8_MMA(1, 1, At, B1); PG8_BAR; PG8_SCHED;
            PG8_LDB(B0, 1, 0); PG8_LDB(B1, 1, 1); PG8_SCHED; PG8_LDA(At, 1, 0); PG8_STAGE(PG8_SA(0, 1), a2 + hstep, voffA);
            PG8_WAIT_V(8); PG8_WAIT_L(0); PG8_BAR; PG8_MMA(0, 0, At, B0); PG8_MMA(0, 1, At, B1); PG8_BAR; PG8_SCHED;
            PG8_LDA(At, 1, 1); PG8_STAGE(PG8_SB(1, 0), b3, voffB); PG8_STAGE(PG8_SB(1, 1), b3 + hstep, voffB); PG8_STAGE(PG8_SA(1, 0), a3, voffA);
            PG8_WAIT_V(8); PG8_WAIT_L(0); PG8_BAR; PG8_MMA(1, 0, At, B0); PG8_MMA(1, 1, At, B1); PG8_BAR; PG8_SCHED;
            } else {
            PG8_LDB(B0, 0, 0); PG8_SCHED; PG8_LDA(At, 0, 0); PG8_STAGE(PG8_SA(1, 1), a1 + hstep, voffA);
            PG8_WAIT_L(8); PG8_BAR; PG8_WAIT_L(0); PG8_MMA(0, 0, At, B0); PG8_BAR; PG8_SCHED;
            PG8_LDB(B1, 0, 1); PG8_STAGE(PG8_SB(0, 0), b2, voffB);
            PG8_BAR; PG8_WAIT_L(0); PG8_MMA(0, 1, At, B1); PG8_BAR;
            PG8_LDA(At, 0, 1); PG8_STAGE(PG8_SA(0, 0), a2, voffA);
            PG8_BAR; PG8_WAIT_L(0); PG8_MMA(1, 0, At, B0); PG8_BAR; PG8_SCHED;
            PG8_STAGE(PG8_SB(0, 1), b2 + hstep, voffB);
            PG8_WAIT_V(6); PG8_BAR; PG8_MMA(1, 1, At, B1); PG8_BAR;
            PG8_LDB(B0, 1, 0); PG8_SCHED; PG8_LDA(At, 1, 0); PG8_STAGE(PG8_SA(0, 1), a2 + hstep, voffA);
            PG8_WAIT_L(8); PG8_BAR; PG8_WAIT_L(0); PG8_MMA(0, 0, At, B0); PG8_BAR; PG8_SCHED;
            PG8_LDB(B1, 1, 1); PG8_STAGE(PG8_SB(1, 0), b3, voffB);
            PG8_BAR; PG8_WAIT_L(0); PG8_MMA(0, 1, At, B1); PG8_BAR;
            PG8_LDA(At, 1, 1); PG8_STAGE(PG8_SA(1, 0), a3, voffA);
            PG8_BAR; PG8_WAIT_L(0); PG8_MMA(1, 0, At, B0); PG8_BAR; PG8_SCHED;
            PG8_STAGE(PG8_SB(1, 1), b3 + hstep, voffB);
            PG8_WAIT_V(6); PG8_BAR; PG8_MMA(1, 1, At, B1); PG8_BAR;
            }
        }
        if constexpr (ALIGN_EPI) { if (wr == 0) PG8_BAR; }
        if constexpr (!Epi::AFTER_DRAIN) { E(acc, cur, wr, wc, fr, fq); S.done(cur); }
        if (!has_next) break;
#pragma unroll
        for (int a = 0; a < 2; ++a)
#pragma unroll
            for (int b = 0; b < 2; ++b)
#pragma unroll
                for (int m = 0; m < 4; ++m)
#pragma unroll
                    for (int n = 0; n < 2; ++n) acc[a][b][m][n] = (f32x4){0.f, 0.f, 0.f, 0.f};
        cur = nxt; cA = nA; cB = nB; ++ui;
        if constexpr (ALIGN_EPI) { if (wr == 1) PG8_BAR; }
    }
    PG8_WAIT_V(0);
    if constexpr (!ALIGN_EPI) { if (wr == 0) PG8_BAR; }
    PG8_BAR;
    if constexpr (Epi::AFTER_DRAIN) { E.fused(acc, cur, wr, wc, fr, fq, lds, wid, lane); S.done(cur); }
#undef PG8_SA
#undef PG8_SB
#undef PG8_STAGE
#undef PG8_LDA
#undef PG8_LDB
#undef PG8_MMA
#undef PG8_WAIT_V
#undef PG8_WAIT_L
#undef PG8_BAR
#undef PG8_SCHED
}
}
#define LAS __attribute__((address_space(3)))
typedef float f32x4 __attribute__((ext_vector_type(4)));
struct Ctx { int tid, lane, wave, bid, nb, gw, ngw; unsigned char* lds; };

namespace nv {
__device__ __forceinline__ void d_cvt_bf16(const Ctx& c, const float* __restrict__ in, bf16* __restrict__ out, size_t n4) {
    for (size_t i = (size_t)c.bid * 512 + c.tid; i < n4; i += (size_t)c.nb * 512) { f32x4 v = ((const f32x4*)in)[i]; uint2 o; o.x = pk2bf(v.x, v.y); o.y = pk2bf(v.z, v.w); ((uint2*)out)[i] = o; }
}
__device__ __forceinline__ void d_transpose_w(const Ctx& c, const float* __restrict__ W, int K, int N, int Npad, bf16* __restrict__ WT) {
    float* t = (float*)(c.lds) + c.wave * (32 * 33);
    const int tx = c.lane & 31, ty = c.lane >> 5, nbn = Npad / 32, ntile = nbn * (K / 32);
    for (int it = c.gw; it < ntile; it += c.ngw) {
        const int n0 = (it % nbn) * 32, k0 = (it / nbn) * 32;
        for (int i = ty; i < 32; i += 2) { const int n = n0 + tx; t[i * 33 + tx] = (n < N) ? W[(size_t)(k0 + i) * N + n] : 0.f; }
        __builtin_amdgcn_fence(__ATOMIC_RELEASE, "workgroup"); __builtin_amdgcn_wave_barrier();
        for (int i = ty; i < 32; i += 2) WT[(size_t)(n0 + i) * K + k0 + tx] = f2bf(t[tx * 33 + i]);
        __builtin_amdgcn_fence(__ATOMIC_RELEASE, "workgroup"); __builtin_amdgcn_wave_barrier();
    }
}
__device__ __forceinline__ void d_rope_table(const Ctx& c, float2* __restrict__ tab) {
    for (int id = c.bid * 512 + c.tid; id < SEQ * 32; id += c.nb * 512) {
        const int pos = id >> 5, i = id & 31;
        const float inv = (float)pow(10000.0, -(double)i / 32.0);
        const float ang = (float)pos * inv;
        tab[id] = make_float2((float)cos((double)ang), (float)sin((double)ang));
    }
}
__device__ __forceinline__ void d_rotary(const Ctx& c, const bf16* __restrict__ proj, const float2* __restrict__ tab, bf16* __restrict__ qr, bf16* __restrict__ kr) {
    for (size_t id = (size_t)c.bid * 512 + c.tid; id < (size_t)NTOK * 320; id += (size_t)c.nb * 512) {
        const int d = id & 31, hh = (id >> 5) % 10; const size_t t = id / 320; const int pos = (int)(t % SEQ);
        const float2 cs = tab[pos * 32 + d];
        const bf16* src = proj + t * IN_PAD + hh * 64;
        const float t1 = bf2f(src[d]), t2 = bf2f(src[d + 32]);
        const float o1 = t1 * cs.x - t2 * cs.y, o2 = t2 * cs.x + t1 * cs.y;
        bf16* dst = (hh < 8) ? (qr + t * 512 + hh * 64) : (kr + t * 128 + (hh - 8) * 64);
        dst[d] = f2bf(o1); dst[d + 32] = f2bf(o2);
    }
}
__device__ __forceinline__ void d_attn(const Ctx& c, const bf16* __restrict__ qr, const bf16* __restrict__ kr, const bf16* __restrict__ proj, const float* __restrict__ sink, bf16* __restrict__ mix) {
    for (int id = c.bid * 512 + c.tid; id < NTOK * 8; id += c.nb * 512) {
        const int hq = id & 7, t = id >> 3, b = t / SEQ, i = t % SEQ, kvh = hq >> 2;
        float q[64], acc[64];
#pragma unroll
        for (int d = 0; d < 64; ++d) { q[d] = bf2f(qr[(size_t)t * 512 + hq * 64 + d]) * 0.125f; acc[d] = 0.f; }
        float m = sink[hq], l = 1.f;
        const int j0 = max(0, i - 128), j1 = min(SEQ - 1, i + 128);
        for (int j = j0; j <= j1; ++j) {
            const size_t tj = (size_t)b * SEQ + j;
            const uint4* kp = (const uint4*)(kr + tj * 128 + kvh * 64);
            float s = 0.f;
#pragma unroll
            for (int cc = 0; cc < 8; ++cc) { const uint4 w = kp[cc]; const unsigned ww[4] = {w.x, w.y, w.z, w.w};
#pragma unroll
                for (int e = 0; e < 4; ++e) { s += q[cc * 8 + 2 * e] * __uint_as_float(ww[e] << 16) + q[cc * 8 + 2 * e + 1] * __uint_as_float(ww[e] & 0xffff0000u); } }
            if (s > m) { const float f = __expf(m - s); l *= f;
#pragma unroll
                for (int d = 0; d < 64; ++d) acc[d] *= f;
                m = s; }
            const float p = __expf(s - m); l += p;
            const uint4* vp = (const uint4*)(proj + tj * IN_PAD + C_V + kvh * 64);
#pragma unroll
            for (int cc = 0; cc < 8; ++cc) { const uint4 w = vp[cc]; const unsigned ww[4] = {w.x, w.y, w.z, w.w};
#pragma unroll
                for (int e = 0; e < 4; ++e) { acc[cc * 8 + 2 * e] += p * __uint_as_float(ww[e] << 16); acc[cc * 8 + 2 * e + 1] += p * __uint_as_float(ww[e] & 0xffff0000u); } }
        }
        const float il = 1.f / l;
#pragma unroll
        for (int d = 0; d < 64; d += 2) *(unsigned*)(mix + (size_t)t * DM + hq * 64 + d) = pk2bf(acc[d] * il, acc[d + 1] * il);
    }
}
__device__ __forceinline__ void d_scan(const Ctx& c, const bf16* __restrict__ proj, const float* __restrict__ mu_prev, const float* __restrict__ mu_next,
                                       const float* __restrict__ w0, const float* __restrict__ w2, const float* __restrict__ a0, const float* __restrict__ a2,
                                       const float* __restrict__ k_k, const float* __restrict__ k_a, float* __restrict__ ydir) {
    if (c.wave != 0) return;
    for (int unit = c.bid; unit < 128; unit += c.nb) {
    const int b = unit >> 4, h = (unit >> 1) & 7, d = unit & 1, lane = c.lane, ch = h * 64 + lane;
    float (*sh)[64] = (float (*)[64])c.lds;
    const int colx = lane < 32 ? (P_WD + d * 32 + lane) : (P_AD + d * 32 + lane - 32);
    const int cols[4] = {P_R + ch, P_KK + ch, P_VV + ch, colx};
    float mp[4], mn[4];
#pragma unroll
    for (int q = 0; q < 4; ++q) { mp[q] = mu_prev[cols[q]]; mn[q] = mu_next[cols[q]]; }
    float* w2c = (float*)c.lds + 6 * 64 + lane; float* a2c = w2c + 32 * 64;
    for (int j = 0; j < 32; ++j) { w2c[j * 64] = w2[(size_t)(d * 32 + j) * 512 + ch]; a2c[j * 64] = a2[(size_t)(d * 32 + j) * 512 + ch]; }
    const float w0c = w0[d * 512 + ch], a0c = a0[d * 512 + ch], kkc = k_k[ch], kac = k_a[ch];
    float S[64];
#pragma unroll
    for (int k = 0; k < 64; ++k) S[k] = 0.f;
    const int sgn = d ? -1 : 1; int t = d ? SEQ - 1 : 0;
    const bf16* pb = proj + (size_t)b * SEQ * IN_PAD + C_P;
    float behind[4], cur[4], ahead[4];
#pragma unroll
    for (int q = 0; q < 4; ++q) { behind[q] = 0.f; cur[q] = bf2f(pb[(size_t)t * IN_PAD + cols[q]]); ahead[q] = bf2f(pb[(size_t)(t + sgn) * IN_PAD + cols[q]]); }
    for (int step = 0; step < SEQ; ++step, t += sgn) {
        float ahead2[4]; const int t2 = t + 2 * sgn; const bool ok2 = (t2 >= 0 && t2 < SEQ);
#pragma unroll
        for (int q = 0; q < 4; ++q) ahead2[q] = ok2 ? bf2f(pb[(size_t)t2 * IN_PAD + cols[q]]) : 0.f;
        float sv[4];
#pragma unroll
        for (int q = 0; q < 4; ++q) { const float prv = d ? ahead[q] : behind[q], nxt = d ? behind[q] : ahead[q]; sv[q] = cur[q] + mp[q] * (prv - cur[q]) + mn[q] * (nxt - cur[q]); }
        const float r = sv[0], k = sv[1], v = sv[2];
        sh[5][lane] = lane < 32 ? tanhf(sv[3]) : sv[3];
        __builtin_amdgcn_fence(__ATOMIC_RELEASE, "workgroup"); __builtin_amdgcn_wave_barrier();
        float ws = w0c, as = a0c;
#pragma unroll
        for (int j = 0; j < 32; ++j) { ws += sh[5][j] * w2c[j * 64]; as += sh[5][32 + j] * a2c[j * 64]; }
        const float nsp = -ws; const float sp = (nsp > 20.f) ? nsp : log1pf(__expf(nsp));
        const float wlog = -sp - 0.5f; const float decay = __expf(-__expf(wlog));
        const float a = sigmoidf_(as);
        float kk = k * kkc; const float ss = wave_sum(kk * kk); kk = kk * rsqrtf(fmaxf(ss, 1e-24f));
        const float kd = k * (1.f + (a - 1.f) * kac);
        sh[0][lane] = decay; sh[1][lane] = kk * a; sh[2][lane] = kd; sh[3][lane] = r; sh[4][lane] = kk;
        __builtin_amdgcn_fence(__ATOMIC_RELEASE, "workgroup"); __builtin_amdgcn_wave_barrier();
        float sa = 0.f;
#pragma unroll
        for (int q = 0; q < 64; ++q) sa -= S[q] * sh[4][q];
        float y = 0.f;
#pragma unroll
        for (int q = 0; q < 64; ++q) { S[q] = S[q] * sh[0][q] + sa * sh[1][q] + v * sh[2][q]; y += S[q] * sh[3][q]; }
        ydir[((size_t)d * NTOK + (size_t)b * SEQ + t) * 512 + ch] = y;
        __builtin_amdgcn_fence(__ATOMIC_RELEASE, "workgroup"); __builtin_amdgcn_wave_barrier();
#pragma unroll
        for (int q = 0; q < 4; ++q) { behind[q] = cur[q]; cur[q] = ahead[q]; ahead[q] = ahead2[q]; }
    }
    }
}
template <bool YSINGLE> __device__ __forceinline__ void d_rwkv_out(const Ctx& c, const bf16* __restrict__ proj, const float* __restrict__ ydir, const float* __restrict__ mu_prev, const float* __restrict__ mu_next,
                                           const float* __restrict__ a0, const float* __restrict__ a2, const float* __restrict__ g2, const float* __restrict__ k_a, const float* __restrict__ r_k,
                                           const float* __restrict__ lnx_g, const float* __restrict__ lnx_b, bf16* __restrict__ mix) {
    float* sad = (float*)c.lds; float* sgd = sad + 64; const int ch = c.tid;
    const float mpr = mu_prev[P_R + ch], mnr = mu_next[P_R + ch], mpk = mu_prev[P_KK + ch], mnk = mu_next[P_KK + ch], mpv = mu_prev[P_VV + ch], mnv = mu_next[P_VV + ch];
    const int cx = (ch < 64) ? (P_AD + ch) : (ch < 160 ? P_GD + ch - 64 : 0); const float mpx = mu_prev[cx], mnx = mu_next[cx];
    for (int t = c.bid; t < NTOK; t += c.nb) {
        const int i = t % SEQ; const bf16* p0 = proj + (size_t)t * IN_PAD + C_P;
        const bool hp = i > 0, hn = i < SEQ - 1;
#define SHF(col, mp_, mn_) ({ const float c_ = bf2f(p0[col]); const float pv_ = hp ? bf2f(p0[(col) - IN_PAD]) : 0.f, nx_ = hn ? bf2f(p0[(col) + IN_PAD]) : 0.f; c_ + (mp_) * (pv_ - c_) + (mn_) * (nx_ - c_); })
        if (ch < 64) sad[ch] = SHF(cx, mpx, mnx);
        else if (ch < 160) sgd[ch - 64] = sigmoidf_(SHF(cx, mpx, mnx));
        const float r = SHF(P_R + ch, mpr, mnr), k = SHF(P_KK + ch, mpk, mnk), v = SHF(P_VV + ch, mpv, mnv);
#undef SHF
        __syncthreads();
        asm volatile("" ::: "memory");
        float as0 = a0[ch], as1 = a0[512 + ch];
#pragma unroll 4
        for (int j = 0; j < 32; ++j) { as0 += sad[j] * a2[(size_t)j * 512 + ch]; as1 += sad[32 + j] * a2[(size_t)(32 + j) * 512 + ch]; }
        const float am = 0.5f * (sigmoidf_(as0) + sigmoidf_(as1));
        float g = 0.f;
#pragma unroll 4
        for (int j = 0; j < 96; ++j) g += sgd[j] * g2[(size_t)j * 512 + ch];
        const float y = YSINGLE ? ydir[(size_t)t * 512 + ch] : (ydir[(size_t)t * 512 + ch] + ydir[((size_t)NTOK + t) * 512 + ch]);
        const float mu = wave_sum(y) * (1.f / 64.f); const float dy = y - mu; const float var = wave_sum(dy * dy) * (1.f / 64.f);
        const float yn = dy * rsqrtf(var + GN_EPS) * lnx_g[ch] + lnx_b[ch];
        const float kmean = k * (1.f + (am - 1.f) * k_a[ch]);
        const float bonus = wave_sum(r * kmean * r_k[ch]) * v;
        mix[(size_t)t * DM + 512 + ch] = f2bf((yn + bonus) * g);
        __syncthreads();
    }
}
__device__ __forceinline__ void d_ln1(const Ctx& c, const float* y1, const float* __restrict__ g, const float* __restrict__ bta, float* h1f, bf16* __restrict__ h1b) {
    for (int row = c.gw; row < NTOK; row += c.ngw) {
        const int lane = c.lane;
        const f32x4* xr = (const f32x4*)(y1 + (size_t)row * DM) + lane;
        f32x4 v[4]; float s = 0.f;
#pragma unroll
        for (int j = 0; j < 4; ++j) { v[j] = xr[64 * j]; s += (v[j].x + v[j].y) + (v[j].z + v[j].w); }
        const float mean = wave_sum(s) * (1.f / DM); float s2 = 0.f;
#pragma unroll
        for (int j = 0; j < 4; ++j) { v[j] = v[j] - mean; s2 += (v[j].x * v[j].x + v[j].y * v[j].y) + (v[j].z * v[j].z + v[j].w * v[j].w); }
        const float rstd = rsqrtf(wave_sum(s2) * (1.f / DM) + LN_EPS);
#pragma unroll
        for (int j = 0; j < 4; ++j) { const f32x4 gg = ((const f32x4*)g)[64 * j + lane], bb = ((const f32x4*)bta)[64 * j + lane];
            const f32x4 o = v[j] * rstd * gg + bb;
            ((f32x4*)(h1f + (size_t)row * DM))[64 * j + lane] = o;
            uint2 w; w.x = pk2bf(o.x, o.y); w.y = pk2bf(o.z, o.w); ((uint2*)(h1b + (size_t)row * DM))[64 * j + lane] = w; }
    }
}
__device__ __forceinline__ void d_peer_topk(const Ctx& c, const bf16* __restrict__ qb, const float* __restrict__ keys, int* __restrict__ idx, float* __restrict__ gate) {
    float* keysT = (float*)c.lds; float* sq = keysT + 2 * 128 * 128; float* sc = sq + 256; float* s12 = sc + 256; int* i12 = (int*)(s12 + 32);
    const int tid = c.tid, lane = c.lane, wave = c.wave;
    for (int item = c.bid; item < 8 * 64; item += c.nb) {
        const int h = item & 7, grp = item >> 3;
        __syncthreads();
        for (int e = tid; e < 2 * 128 * 128; e += 512) { const int p = e >> 14, n = (e >> 7) & 127, cc = e & 127; keysT[(p * 128 + cc) * 128 + n] = keys[(size_t)h * 32768 + e]; }
        __syncthreads();
        for (int tt = 0; tt < 512; ++tt) {
            const size_t t = (size_t)grp * 512 + tt;
            if (tid < 256) sq[tid] = bf2f(qb[t * PEER_Q + h * 256 + tid]);
            __syncthreads();
            if (tid < 256) { const int p = tid >> 7, n = tid & 127; float s = 0.f; const float* kt = keysT + p * 16384 + n; const float* qq = sq + p * 128;
                for (int cc = 0; cc < 128; ++cc) s += qq[cc] * kt[cc * 128];
                sc[tid] = s; }
            __syncthreads();
            if (wave < 2) {
                float v0 = sc[wave * 128 + lane], v1 = sc[wave * 128 + 64 + lane];
                for (int r = 0; r < 16; ++r) {
                    float bv; int bi; if (v1 > v0) { bv = v1; bi = lane + 64; } else { bv = v0; bi = lane; }
#pragma unroll
                    for (int o = 1; o < 64; o <<= 1) { const float ov = __shfl_xor(bv, o); const int oi = __shfl_xor(bi, o); if (ov > bv || (ov == bv && oi < bi)) { bv = ov; bi = oi; } }
                    if (lane == 0) { s12[wave * 16 + r] = bv; i12[wave * 16 + r] = bi; }
                    if (bi == lane) v0 = -INFINITY; if (bi == lane + 64) v1 = -INFINITY;
                }
            }
            __syncthreads();
            if (wave == 0) {
                float cv[4];
#pragma unroll
                for (int j = 0; j < 4; ++j) { const int f = lane + 64 * j; cv[j] = s12[f >> 4] + s12[16 + (f & 15)]; }
                float mycs = 0.f; int myid = 0;
                for (int r = 0; r < 16; ++r) {
                    float bv = cv[0]; int bi = lane;
#pragma unroll
                    for (int j = 1; j < 4; ++j) if (cv[j] > bv) { bv = cv[j]; bi = lane + 64 * j; }
#pragma unroll
                    for (int o = 1; o < 64; o <<= 1) { const float ov = __shfl_xor(bv, o); const int oi = __shfl_xor(bi, o); if (ov > bv || (ov == bv && oi < bi)) { bv = ov; bi = oi; } }
                    if (lane == r) { mycs = bv; myid = i12[bi >> 4] * 128 + i12[16 + (bi & 15)]; }
#pragma unroll
                    for (int j = 0; j < 4; ++j) if (bi == lane + 64 * j) cv[j] = -INFINITY;
                }
                float mx = (lane < 16) ? mycs : -INFINITY;
#pragma unroll
                for (int o = 1; o < 64; o <<= 1) mx = fmaxf(mx, __shfl_xor(mx, o));
                const float e = (lane < 16) ? __expf(mycs - mx) : 0.f; const float den = wave_sum(e);
                if (lane < 16) { idx[t * 128 + h * 16 + lane] = myid; gate[t * 128 + h * 16 + lane] = e / den; }
            }
            __syncthreads();
        }
    }
}
__device__ __forceinline__ void d_peer_gather(const Ctx& c, const float* __restrict__ h1f, const int* __restrict__ idx, const float* __restrict__ gate, const float* __restrict__ u, const float* __restrict__ v,
                                              const float* __restrict__ g, const float* __restrict__ bta, float* __restrict__ out) {
    const int lane = c.lane;
    for (int t = c.gw; t < NTOK; t += c.ngw) {
        f32x4 hv[4], f[4];
#pragma unroll
        for (int j = 0; j < 4; ++j) { hv[j] = ((const f32x4*)(h1f + (size_t)t * DM))[64 * j + lane]; f[j] = (f32x4){0.f, 0.f, 0.f, 0.f}; }
        for (int e = 0; e < 128; ++e) {
            const int id = idx[(size_t)t * 128 + e]; const float gt = gate[(size_t)t * 128 + e];
            const f32x4* ur = (const f32x4*)(u + (size_t)id * DM); const f32x4* vr = (const f32x4*)(v + (size_t)id * DM);
            float z = 0.f;
#pragma unroll
            for (int j = 0; j < 4; ++j) { const f32x4 w = ur[64 * j + lane]; z += (w.x * hv[j].x + w.y * hv[j].y) + (w.z * hv[j].z + w.w * hv[j].w); }
            z = wave_sum(z);
            const float act = gt * 0.5f * z * (1.f + erff(z * 0.70710678118654752f));
#pragma unroll
            for (int j = 0; j < 4; ++j) { const f32x4 w = vr[64 * j + lane]; f[j] += act * w; }
        }
        float s = 0.f;
#pragma unroll
        for (int j = 0; j < 4; ++j) { f[j] = DN_ALPHA * hv[j] + f[j]; s += (f[j].x + f[j].y) + (f[j].z + f[j].w); }
        const float mean = wave_sum(s) * (1.f / DM); float s2 = 0.f;
#pragma unroll
        for (int j = 0; j < 4; ++j) { f[j] = f[j] - mean; s2 += (f[j].x * f[j].x + f[j].y * f[j].y) + (f[j].z * f[j].z + f[j].w * f[j].w); }
        const float rstd = rsqrtf(wave_sum(s2) * (1.f / DM) + LN_EPS);
#pragma unroll
        for (int j = 0; j < 4; ++j) { const f32x4 gg = ((const f32x4*)g)[64 * j + lane], bb = ((const f32x4*)bta)[64 * j + lane];
            ((f32x4*)(out + (size_t)t * DM))[64 * j + lane] = f[j] * rstd * gg + bb; }
    }
}
}
namespace pe {
typedef __bf16 bf16x2_t __attribute__((ext_vector_type(2)));
__device__ __forceinline__ float dot2(unsigned a, unsigned b, float c) { return __builtin_amdgcn_fdot2_f32_bf16(__builtin_bit_cast(bf16x2_t, a), __builtin_bit_cast(bf16x2_t, b), c, false); }
__device__ __forceinline__ float gelu_erf(float z) { return 0.5f * z * (1.f + erff(z * 0.70710678118654752f)); }
constexpr int GE = 4;
struct Rows { uint4 a[GE], b[GE]; };
__device__ __forceinline__ void load_rows(Rows& r, const bf16* __restrict__ tab, int i0, int i1, int lane, int g) {
#pragma unroll
    for (int j = 0; j < GE; ++j) { const int e = g * GE + j; const int id = __builtin_amdgcn_readlane((e & 64) ? i1 : i0, e & 63);
        const uint4* p = (const uint4*)(tab + (size_t)id * DM) + lane; r.a[j] = p[0]; r.b[j] = p[64]; }
}
__device__ __forceinline__ void d_peer_gather(const Ctx& c, const bf16* __restrict__ h1b, const int* __restrict__ idx, const float* __restrict__ gate, const bf16* __restrict__ ub, const bf16* __restrict__ vb,
                                              const float* __restrict__ g, const float* __restrict__ bta, float* __restrict__ out) {
    const int lane = c.lane;
    for (int t = c.gw; t < NTOK; t += c.ngw) {
        const uint4* hp = (const uint4*)(h1b + (size_t)t * DM) + lane; const uint4 h0 = hp[0], h1 = hp[64];
        const unsigned hw[8] = {h0.x, h0.y, h0.z, h0.w, h1.x, h1.y, h1.z, h1.w};
        const int i0 = idx[(size_t)t * 128 + lane], i1 = idx[(size_t)t * 128 + 64 + lane];
        const float g0 = gate[(size_t)t * 128 + lane], g1 = gate[(size_t)t * 128 + 64 + lane];
        float f[16];
#pragma unroll
        for (int i = 0; i < 16; ++i) f[i] = 0.f;
        Rows U, V, Un;
        load_rows(U, ub, i0, i1, lane, 0);
        for (int grp = 0; grp < 128 / GE; ++grp) {
            load_rows(V, vb, i0, i1, lane, grp);
            if (grp + 1 < 128 / GE) load_rows(Un, ub, i0, i1, lane, grp + 1);
            float z[GE];
#pragma unroll
            for (int j = 0; j < GE; ++j) { const unsigned uw[8] = {U.a[j].x, U.a[j].y, U.a[j].z, U.a[j].w, U.b[j].x, U.b[j].y, U.b[j].z, U.b[j].w}; float s = 0.f;
#pragma unroll
                for (int i = 0; i < 8; ++i) s = dot2(uw[i], hw[i], s);
                z[j] = s; }
            { const bool b0 = lane & 1; float k0 = b0 ? z[1] : z[0], s0 = b0 ? z[0] : z[1], k1 = b0 ? z[3] : z[2], s1 = b0 ? z[2] : z[3];
              k0 += __shfl_xor(s0, 1); k1 += __shfl_xor(s1, 1);
              const bool b1 = lane & 2; float kk = b1 ? k1 : k0, ss = b1 ? k0 : k1; kk += __shfl_xor(ss, 2);
              kk += __shfl_xor(kk, 4); kk += __shfl_xor(kk, 8); kk += __shfl_xor(kk, 16); kk += __shfl_xor(kk, 32);
              z[0] = kk; }
            const int e_me = grp * GE + (lane & 3);
            const float gt = __shfl((e_me & 64) ? g1 : g0, e_me & 63);
            const float act = gt * gelu_erf(z[0]);
            const unsigned actb = (unsigned)f2bf(act);
#pragma unroll
            for (int j = 0; j < GE; ++j) { const unsigned alo = __builtin_amdgcn_readlane(actb, j), ahi = alo << 16;
                const unsigned vw[8] = {V.a[j].x, V.a[j].y, V.a[j].z, V.a[j].w, V.b[j].x, V.b[j].y, V.b[j].z, V.b[j].w};
#pragma unroll
                for (int i = 0; i < 8; ++i) { f[2 * i] = dot2(vw[i], alo, f[2 * i]); f[2 * i + 1] = dot2(vw[i], ahi, f[2 * i + 1]); } }
            U = Un;
        }
        float s = 0.f;
#pragma unroll
        for (int i = 0; i < 8; ++i) { f[2 * i] += DN_ALPHA * __uint_as_float(hw[i] << 16); f[2 * i + 1] += DN_ALPHA * __uint_as_float(hw[i] & 0xffff0000u); s += f[2 * i] + f[2 * i + 1]; }
        const float mean = wave_sum(s) * (1.f / DM); float s2 = 0.f;
#pragma unroll
        for (int i = 0; i < 16; ++i) { f[i] -= mean; s2 += f[i] * f[i]; }
        const float rstd = rsqrtf(wave_sum(s2) * (1.f / DM) + LN_EPS);
#pragma unroll
        for (int hh = 0; hh < 2; ++hh) {
            const int e0 = hh * 512 + 8 * lane;
            const f32x4 ga = *(const f32x4*)(g + e0), gb = *(const f32x4*)(g + e0 + 4), ba = *(const f32x4*)(bta + e0), bb = *(const f32x4*)(bta + e0 + 4);
            f32x4 oa, ob;
            oa.x = f[hh * 8 + 0] * rstd * ga.x + ba.x; oa.y = f[hh * 8 + 1] * rstd * ga.y + ba.y; oa.z = f[hh * 8 + 2] * rstd * ga.z + ba.z; oa.w = f[hh * 8 + 3] * rstd * ga.w + ba.w;
            ob.x = f[hh * 8 + 4] * rstd * gb.x + bb.x; ob.y = f[hh * 8 + 5] * rstd * gb.y + bb.y; ob.z = f[hh * 8 + 6] * rstd * gb.z + bb.z; ob.w = f[hh * 8 + 7] * rstd * gb.w + bb.w;
            *(f32x4*)(out + (size_t)t * DM + e0) = oa; *(f32x4*)(out + (size_t)t * DM + e0 + 4) = ob;
        }
    }
}
}
namespace pe8 {
typedef float f32x2 __attribute__((ext_vector_type(2)));
__device__ __forceinline__ void d_quant_tables(const Ctx& c, const float* __restrict__ u, const float* __restrict__ v, unsigned* __restrict__ u8, unsigned* __restrict__ v8, float* __restrict__ su, float* __restrict__ sv) {
    const int lane = c.lane;
    for (int r = c.gw; r < 2 * NEXP; r += c.ngw) {
        const bool isv = r >= NEXP; const int row = isv ? r - NEXP : r;
        const f32x4* src = (const f32x4*)((isv ? v : u) + (size_t)row * DM) + lane;
        f32x4 x[4]; float am = 0.f;
#pragma unroll
        for (int j = 0; j < 4; ++j) { x[j] = src[64 * j]; am = fmaxf(am, fmaxf(fmaxf(fabsf(x[j].x), fabsf(x[j].y)), fmaxf(fabsf(x[j].z), fabsf(x[j].w)))); }
#pragma unroll
        for (int o = 1; o < 64; o <<= 1) am = fmaxf(am, __shfl_xor(am, o));
        am = fmaxf(am, 1e-30f);
        if (!isv) { const float sc = am * (1.f / 127.f), is = 127.f / am;
#pragma unroll
            for (int j = 0; j < 4; ++j) { const int a = (int)rintf(x[j].x * is), b = (int)rintf(x[j].y * is), cc = (int)rintf(x[j].z * is), d = (int)rintf(x[j].w * is);
                u8[(size_t)row * 256 + 64 * j + lane] = (unsigned)(a & 255) | ((unsigned)(b & 255) << 8) | ((unsigned)(cc & 255) << 16) | ((unsigned)(d & 255) << 24); }
            if (lane == 0) su[row] = sc; }
        else { const float sc = am * (1.f / 440.f), is = 440.f / am;
#pragma unroll
            for (int j = 0; j < 4; ++j) { int w = 0; w = __builtin_amdgcn_cvt_pk_fp8_f32(x[j].x * is, x[j].y * is, w, false); w = __builtin_amdgcn_cvt_pk_fp8_f32(x[j].z * is, x[j].w * is, w, true);
                v8[(size_t)row * 256 + 64 * j + lane] = (unsigned)w; }
            if (lane == 0) sv[row] = sc; }
    }
}
constexpr int GE = 8;
struct Rows { uint4 a[GE]; };
__device__ __forceinline__ void load_rows(Rows& r, const unsigned* __restrict__ tab, int i0, int i1, int lane, int g) {
#pragma unroll
    for (int j = 0; j < GE; ++j) { const int e = g * GE + j; const int id = __builtin_amdgcn_readlane((e & 64) ? i1 : i0, e & 63); r.a[j] = *((const uint4*)(tab + (size_t)id * 256) + lane); }
}
__device__ __forceinline__ void d_peer_gather(const Ctx& c, const bf16* __restrict__ h1b, const int* __restrict__ idx, const float* __restrict__ gate, const unsigned* __restrict__ u8, const unsigned* __restrict__ v8,
                                              const float* __restrict__ su, const float* __restrict__ sv, const float* __restrict__ g, const float* __restrict__ bta, float* __restrict__ out) {
    const int lane = c.lane;
    for (int t = c.gw; t < NTOK; t += c.ngw) {
        const uint4* hp = (const uint4*)(h1b + (size_t)t * DM) + 2 * lane; const uint4 ha = hp[0], hb = hp[1];
        const unsigned hw[8] = {ha.x, ha.y, ha.z, ha.w, hb.x, hb.y, hb.z, hb.w};
        float hf[16]; float am = 0.f;
#pragma unroll
        for (int i = 0; i < 8; ++i) { hf[2 * i] = __uint_as_float(hw[i] << 16); hf[2 * i + 1] = __uint_as_float(hw[i] & 0xffff0000u); am = fmaxf(am, fmaxf(fabsf(hf[2 * i]), fabsf(hf[2 * i + 1]))); }
#pragma unroll
        for (int o = 1; o < 64; o <<= 1) am = fmaxf(am, __shfl_xor(am, o));
        am = fmaxf(am, 1e-30f);
        const float sh = am * (1.f / 127.f), ish = 127.f / am;
        int hq[4];
#pragma unroll
        for (int w = 0; w < 4; ++w) { const int a = (int)rintf(hf[4 * w] * ish), b = (int)rintf(hf[4 * w + 1] * ish), cc = (int)rintf(hf[4 * w + 2] * ish), d = (int)rintf(hf[4 * w + 3] * ish);
            hq[w] = (int)((unsigned)(a & 255) | ((unsigned)(b & 255) << 8) | ((unsigned)(cc & 255) << 16) | ((unsigned)(d & 255) << 24)); }
        const int i0 = idx[(size_t)t * 128 + lane], i1 = idx[(size_t)t * 128 + 64 + lane];
        const float g0 = gate[(size_t)t * 128 + lane], g1 = gate[(size_t)t * 128 + 64 + lane];
        float f[16];
#pragma unroll
        for (int i = 0; i < 16; ++i) f[i] = 0.f;
        Rows U, V, Un;
        load_rows(U, u8, i0, i1, lane, 0);
        float sun, svn;
        { const int e_me = lane & 7; const int id = __shfl((e_me & 64) ? i1 : i0, e_me & 63); sun = su[id]; svn = sv[id]; }
#pragma unroll 1
        for (int grp = 0; grp < 128 / GE; ++grp) {
            load_rows(V, v8, i0, i1, lane, grp);
            const float suc = sun, svc = svn;
            if (grp + 1 < 128 / GE) { load_rows(Un, u8, i0, i1, lane, grp + 1); const int e_n = (grp + 1) * GE + (lane & 7); const int id = __shfl((e_n & 64) ? i1 : i0, e_n & 63); sun = su[id]; svn = sv[id]; }
            int z[GE];
#pragma unroll
            for (int j = 0; j < GE; ++j) { int s = __builtin_amdgcn_sdot4((int)U.a[j].x, hq[0], 0, false); s = __builtin_amdgcn_sdot4((int)U.a[j].y, hq[1], s, false);
                s = __builtin_amdgcn_sdot4((int)U.a[j].z, hq[2], s, false); s = __builtin_amdgcn_sdot4((int)U.a[j].w, hq[3], s, false); z[j] = s; }
            int zz;
            { const bool b0 = lane & 1, b1 = lane & 2, b2 = lane & 4;
              int k0 = b0 ? z[1] : z[0], s0 = b0 ? z[0] : z[1], k1 = b0 ? z[3] : z[2], s1 = b0 ? z[2] : z[3], k2 = b0 ? z[5] : z[4], s2 = b0 ? z[4] : z[5], k3 = b0 ? z[7] : z[6], s3 = b0 ? z[6] : z[7];
              k0 += __shfl_xor(s0, 1); k1 += __shfl_xor(s1, 1); k2 += __shfl_xor(s2, 1); k3 += __shfl_xor(s3, 1);
              int m0 = b1 ? k1 : k0, t0_ = b1 ? k0 : k1, m1 = b1 ? k3 : k2, t1_ = b1 ? k2 : k3;
              m0 += __shfl_xor(t0_, 2); m1 += __shfl_xor(t1_, 2);
              int q0 = b2 ? m1 : m0, r0 = b2 ? m0 : m1; q0 += __shfl_xor(r0, 4);
              q0 += __shfl_xor(q0, 8); q0 += __shfl_xor(q0, 16); q0 += __shfl_xor(q0, 32); zz = q0; }
            const int e_me = grp * GE + (lane & 7);
            const float gt = __shfl((e_me & 64) ? g1 : g0, e_me & 63);
            const float zf = (float)zz * sh * suc;
            const float act = gt * pe::gelu_erf(zf) * svc;
#pragma unroll
            for (int j = 0; j < GE; ++j) { const float aj = __uint_as_float(__builtin_amdgcn_readlane(__float_as_uint(act), j));
                const unsigned vw[4] = {V.a[j].x, V.a[j].y, V.a[j].z, V.a[j].w};
#pragma unroll
                for (int w = 0; w < 4; ++w) { const f32x2 lo = __builtin_amdgcn_cvt_pk_f32_fp8((int)vw[w], false), hi = __builtin_amdgcn_cvt_pk_f32_fp8((int)vw[w], true);
                    f[4 * w] += aj * lo.x; f[4 * w + 1] += aj * lo.y; f[4 * w + 2] += aj * hi.x; f[4 * w + 3] += aj * hi.y; }
                __builtin_amdgcn_sched_barrier(0); }
            U = Un;
        }
        float s = 0.f;
#pragma unroll
        for (int i = 0; i < 16; ++i) { f[i] += DN_ALPHA * hf[i]; s += f[i]; }
        const float mean = wave_sum(s) * (1.f / DM); float s2 = 0.f;
#pragma unroll
        for (int i = 0; i < 16; ++i) { f[i] -= mean; s2 += f[i] * f[i]; }
        const float rstd = rsqrtf(wave_sum(s2) * (1.f / DM) + LN_EPS);
        const int e0 = 16 * lane;
#pragma unroll
        for (int q = 0; q < 4; ++q) { const f32x4 ga = *(const f32x4*)(g + e0 + 4 * q), ba = *(const f32x4*)(bta + e0 + 4 * q); f32x4 o;
            o.x = f[4 * q] * rstd * ga.x + ba.x; o.y = f[4 * q + 1] * rstd * ga.y + ba.y; o.z = f[4 * q + 2] * rstd * ga.z + ba.z; o.w = f[4 * q + 3] * rstd * ga.w + ba.w;
            *(f32x4*)(out + (size_t)t * DM + e0 + 4 * q) = o; }
    }
}
}
namespace rw {
typedef short bf16x8 __attribute__((ext_vector_type(8)));
typedef short s16x4 __attribute__((ext_vector_type(4)));
typedef float f32x16 __attribute__((ext_vector_type(16)));
typedef float f32x2_t __attribute__((ext_vector_type(2)));
typedef __bf16 bf16x2_t __attribute__((ext_vector_type(2)));
typedef unsigned u32x4 __attribute__((ext_vector_type(4)));
typedef unsigned u32x2 __attribute__((ext_vector_type(2)));
typedef LAS unsigned char* lptr;
#define MFMA32(a, b, c) __builtin_amdgcn_mfma_f32_32x32x16_bf16((a), (b), (c), 0, 0, 0)
#define DI __device__ __forceinline__
constexpr int UNIT_BYTES = 10 * 2048;
constexpr int STG_STRIDE = 392;
constexpr int CST_OFF = 131072, GC_OFF = 131072 + 4096;

DI int crow(int i, int h) { return (i & 3) + 8 * (i >> 2) + 4 * h; }
DI unsigned cvtpk(float lo, float hi) { f32x2_t v = {lo, hi}; bf16x2_t b = __builtin_convertvector(v, bf16x2_t); return __builtin_bit_cast(unsigned, b); }
DI bf16x8 pack(const f32x16& x, int s) { u32x4 p; p[0] = cvtpk(x[8 * s], x[8 * s + 1]); p[1] = cvtpk(x[8 * s + 2], x[8 * s + 3]); p[2] = cvtpk(x[8 * s + 4], x[8 * s + 5]); p[3] = cvtpk(x[8 * s + 6], x[8 * s + 7]); return __builtin_bit_cast(bf16x8, p); }
DI bf16x8 frag4(unsigned a, unsigned b, unsigned c, unsigned d) { u32x4 p = {a, b, c, d}; return __builtin_bit_cast(bf16x8, p); }
DI float lo_f(unsigned w) { return __uint_as_float(w << 16); }
DI float hi_f(unsigned w) { return __uint_as_float(w & 0xffff0000u); }
DI int img_off(int row, int slot) { return row * 128 + ((slot ^ ((((row >> 1) & 1) << 3) | ((row >> 2) & 3))) << 3); }
DI s16x4 tr_read(lptr p) { return __builtin_bit_cast(s16x4, __builtin_amdgcn_ds_read_tr16_b64_v4i16((LAS s16x4*)p)); }
DI bf16x8 trfrag(lptr img, int tau, int s, int lane) {
    const int h = lane >> 5, gg = (lane >> 4) & 1, l16 = lane & 15, q = l16 >> 2, p = l16 & 3, slot = 8 * tau + 4 * gg + p, r0 = 16 * s + 4 * h + q;
    const s16x4 lo = tr_read(img + img_off(r0, slot)), hi = tr_read(img + img_off(r0 + 8, slot));
    return __builtin_shufflevector(lo, hi, 0, 1, 2, 3, 4, 5, 6, 7);
}
template <int CTRL, int RMASK> DI float dpp0(float x) { return __uint_as_float(__builtin_amdgcn_update_dpp(0u, __float_as_uint(x), CTRL, RMASK, 0xf, false)); }
DI float prefix32(float x) {
    x += dpp0<0x111, 0xf>(x); x += dpp0<0x112, 0xf>(x); x += dpp0<0x114, 0xf>(x); x += dpp0<0x118, 0xf>(x);
    x += dpp0<0x142, 0xa>(x);
    return x;
}
DI float fsig(float x) { return __builtin_amdgcn_rcpf(1.f + __expf(-x)); }
DI void store_tile(unsigned char* dst, const f32x16& x, int lane) {
    u32x4 a, b; a[0] = cvtpk(x[0], x[1]); a[1] = cvtpk(x[2], x[3]); a[2] = cvtpk(x[4], x[5]); a[3] = cvtpk(x[6], x[7]);
    b[0] = cvtpk(x[8], x[9]); b[1] = cvtpk(x[10], x[11]); b[2] = cvtpk(x[12], x[13]); b[3] = cvtpk(x[14], x[15]);
    u32x4* d = (u32x4*)(dst + lane * 32); d[0] = a; d[1] = b;
}

DI void d_lowrank_t(const Ctx& c, const float* __restrict__ w2, const float* __restrict__ a2, bf16* __restrict__ w2t, bf16* __restrict__ a2t) {
    for (int id = c.bid * 512 + c.tid; id < 2 * 512 * 32; id += c.nb * 512) { const int j = id & 31, ch = (id >> 5) & 511, d = id >> 14;
        w2t[id] = f2bf(w2[(size_t)(d * 32 + j) * 512 + ch]); a2t[id] = f2bf(a2[(size_t)(d * 32 + j) * 512 + ch]); }
}

DI void d_prep(const Ctx& c, int d, const bf16* __restrict__ proj, const float* __restrict__ mu_prev, const float* __restrict__ mu_next,
               const float* __restrict__ w0, const float* __restrict__ a0, const float* __restrict__ k_k, const float* __restrict__ k_a,
               const bf16* __restrict__ w2t, const bf16* __restrict__ a2t, unsigned char* __restrict__ UO, float* __restrict__ ybuf) {
    const int lane = c.lane, n = lane & 31, h = lane >> 5, hd = c.bid & 7;
    lptr L = (lptr)c.lds + c.wave * 16384;
    LAS float* cst = (LAS float*)((lptr)c.lds + CST_OFF);
    LAS float* gC = (LAS float*)((lptr)c.lds + GC_OFF) + c.wave * 64;
    __syncthreads();
    for (int i = c.tid; i < 768; i += 512) { float v;
        if (i < 640) { const int vec = i >> 6, ch = i & 63, gch = 64 * hd + ch;
            v = vec == 0 ? mu_prev[P_R + gch] : vec == 1 ? mu_next[P_R + gch] : vec == 2 ? mu_prev[P_KK + gch] : vec == 3 ? mu_next[P_KK + gch] : vec == 4 ? mu_prev[P_VV + gch] : vec == 5 ? mu_next[P_VV + gch]
              : vec == 6 ? w0[d * 512 + gch] : vec == 7 ? a0[d * 512 + gch] : vec == 8 ? k_k[gch] : k_a[gch]; }
        else { const int vec = (i - 640) >> 5, j = i & 31; const int col = (vec < 2 ? P_WD : P_AD) + 32 * d + j; v = (vec & 1) ? mu_next[col] : mu_prev[col]; }
        cst[i] = v; }
    __syncthreads();
    const int nper = (c.nb >> 3) * 8;
    for (int u = (c.bid >> 3) * 8 + c.wave; u < 1024; u += nper) {
        const int b = u >> 7, c32 = u & 127;
        const int tok0 = d ? SEQ - 32 * (c32 + 1) : 32 * c32;
        const bf16* prow = proj + (size_t)b * SEQ * IN_PAD + C_P;
#pragma unroll 1
        for (int it = 0; it < 13; ++it) { const int pid = it * 64 + lane; if (pid < 816) { const int rho = pid / 24, w = pid % 24, mat = w >> 3, pc = w & 7, tok = tok0 - 1 + rho;
                uint4 val = make_uint4(0, 0, 0, 0);
                if (tok >= 0 && tok < SEQ) val = *(const uint4*)(prow + (size_t)tok * IN_PAD + mat * 512 + 64 * hd + pc * 8);
                LAS u32x2* dp = (LAS u32x2*)(L + rho * STG_STRIDE + mat * 128 + pc * 16); dp[0] = (u32x2){val.x, val.y}; dp[1] = (u32x2){val.z, val.w}; } }
        const int rho = d ? 32 - n : n + 1, tok = tok0 - 1 + rho;
        bf16x8 wdf[2], adf[2];
        {
            const bool hp = tok > 0, hn = tok < SEQ - 1;
#pragma unroll
            for (int s = 0; s < 2; ++s) {
                const bf16* pc_ = prow + (size_t)tok * IN_PAD + 32 * d + 16 * s + 8 * h;
                const uint4 z4 = make_uint4(0, 0, 0, 0);
                const uint4 wc = *(const uint4*)(pc_ + P_WD), ac = *(const uint4*)(pc_ + P_AD);
                const uint4 wp = hp ? *(const uint4*)(pc_ + P_WD - IN_PAD) : z4, ap = hp ? *(const uint4*)(pc_ + P_AD - IN_PAD) : z4;
                const uint4 wn = hn ? *(const uint4*)(pc_ + P_WD + IN_PAD) : z4, an = hn ? *(const uint4*)(pc_ + P_AD + IN_PAD) : z4;
                const unsigned wcw[4] = {wc.x, wc.y, wc.z, wc.w}, wpw[4] = {wp.x, wp.y, wp.z, wp.w}, wnw[4] = {wn.x, wn.y, wn.z, wn.w};
                const unsigned acw[4] = {ac.x, ac.y, ac.z, ac.w}, apw[4] = {ap.x, ap.y, ap.z, ap.w}, anw[4] = {an.x, an.y, an.z, an.w};
                unsigned wo[4], ao[4];
#pragma unroll
                for (int e = 0; e < 4; ++e) { const int j = 16 * s + 8 * h + 2 * e;
                    const float mpw0 = cst[640 + j], mpw1 = cst[640 + j + 1], mnw0 = cst[672 + j], mnw1 = cst[672 + j + 1], mpa0 = cst[704 + j], mpa1 = cst[704 + j + 1], mna0 = cst[736 + j], mna1 = cst[736 + j + 1];
                    float c0 = lo_f(wcw[e]), c1 = hi_f(wcw[e]);
                    float x0 = c0 + mpw0 * (lo_f(wpw[e]) - c0) + mnw0 * (lo_f(wnw[e]) - c0), x1 = c1 + mpw1 * (hi_f(wpw[e]) - c1) + mnw1 * (hi_f(wnw[e]) - c1);
                    x0 = 1.f - 2.f * __builtin_amdgcn_rcpf(__expf(2.f * x0) + 1.f); x1 = 1.f - 2.f * __builtin_amdgcn_rcpf(__expf(2.f * x1) + 1.f);
                    wo[e] = cvtpk(x0, x1);
                    c0 = lo_f(acw[e]); c1 = hi_f(acw[e]);
                    x0 = c0 + mpa0 * (lo_f(apw[e]) - c0) + mna0 * (lo_f(anw[e]) - c0); x1 = c1 + mpa1 * (hi_f(apw[e]) - c1) + mna1 * (hi_f(anw[e]) - c1);
                    ao[e] = cvtpk(x0, x1); }
                wdf[s] = frag4(wo[0], wo[1], wo[2], wo[3]); adf[s] = frag4(ao[0], ao[1], ao[2], ao[3]);
                __builtin_amdgcn_sched_barrier(0);
            }
        }
        float lw[32], av[32];
        {
            const f32x16 zz = {0.f};
            int opq = 0; asm volatile("" : "+v"(opq));
#pragma unroll
            for (int tau = 0; tau < 2; ++tau) {
                const bf16* wrow = w2t + ((d * 512 + 64 * hd + 32 * tau + n + opq) * 32 + 8 * (h + opq));
                const bf16* arow = a2t + ((d * 512 + 64 * hd + 32 * tau + n + opq) * 32 + 8 * (h + opq));
                const bf16x8 wa0 = *(const bf16x8*)wrow, wa1 = *(const bf16x8*)(wrow + 16), aa0 = *(const bf16x8*)arow, aa1 = *(const bf16x8*)(arow + 16);
                f32x16 cw = MFMA32(wa0, wdf[0], zz); cw = MFMA32(wa1, wdf[1], cw);
                f32x16 ca = MFMA32(aa0, adf[0], zz); ca = MFMA32(aa1, adf[1], ca);
#pragma unroll
                for (int i = 0; i < 16; ++i) { const int ch = 32 * tau + 8 * (i >> 2) + 4 * h + (i & 3);
                    lw[16 * tau + i] = -0.60653066f * fsig(cw[i] + cst[6 * 64 + ch]); av[16 * tau + i] = fsig(ca[i] + cst[7 * 64 + ch]); }
                __builtin_amdgcn_sched_barrier(0);
            }
        }
        unsigned ge[32], avp[16];
#pragma unroll
        for (int m = 0; m < 32; ++m) { const float clm = prefix32(lw[m]); const float eg = __expf(clm); ge[m] = cvtpk(eg, eg * __expf(-lw[m])); if (n == 31) gC[8 * (m >> 2) + 4 * h + (m & 3)] = eg; }
#pragma unroll
        for (int m = 0; m < 16; ++m) avp[m] = cvtpk(av[2 * m], av[2 * m + 1]);
        __builtin_amdgcn_sched_barrier(0);
        unsigned pA[16], pB[16], pK[16], pR[16], pV[16];
        {
            unsigned kfp[16]; float ss = 0.f;
            lptr sb = L + rho * STG_STRIDE + 8 * h;
#pragma unroll
            for (int q = 0; q < 8; ++q) {
                const u32x2 cu = *(LAS u32x2*)(sb + 128 + 16 * q), pu_ = *(LAS u32x2*)(sb + 128 + 16 * q - STG_STRIDE), nu = *(LAS u32x2*)(sb + 128 + 16 * q + STG_STRIDE);
                const float cc[4] = {lo_f(cu.x), hi_f(cu.x), lo_f(cu.y), hi_f(cu.y)}, pp[4] = {lo_f(pu_.x), hi_f(pu_.x), lo_f(pu_.y), hi_f(pu_.y)}, nn[4] = {lo_f(nu.x), hi_f(nu.x), lo_f(nu.y), hi_f(nu.y)};
                float xk[4];
#pragma unroll
                for (int e = 0; e < 4; ++e) { const int ch = 8 * q + 4 * h + e; const float x = cc[e] + cst[2 * 64 + ch] * (pp[e] - cc[e]) + cst[3 * 64 + ch] * (nn[e] - cc[e]);
                    xk[e] = x; const float kr_ = x * cst[8 * 64 + ch]; ss += kr_ * kr_; }
                kfp[2 * q] = cvtpk(xk[0], xk[1]); kfp[2 * q + 1] = cvtpk(xk[2], xk[3]);
                __builtin_amdgcn_sched_barrier(0);
            }
            ss += __shfl_xor(ss, 32);
            const float inv = rsqrtf(fmaxf(ss, 1e-24f));
#pragma unroll
            for (int q = 0; q < 8; ++q) {
                const u32x2 cu = *(LAS u32x2*)(sb + 16 * q), pu_ = *(LAS u32x2*)(sb + 16 * q - STG_STRIDE), nu = *(LAS u32x2*)(sb + 16 * q + STG_STRIDE);
                const u32x2 cv = *(LAS u32x2*)(sb + 256 + 16 * q), pv_ = *(LAS u32x2*)(sb + 256 + 16 * q - STG_STRIDE), nv_ = *(LAS u32x2*)(sb + 256 + 16 * q + STG_STRIDE);
                const float rc[4] = {lo_f(cu.x), hi_f(cu.x), lo_f(cu.y), hi_f(cu.y)}, rp[4] = {lo_f(pu_.x), hi_f(pu_.x), lo_f(pu_.y), hi_f(pu_.y)}, rn[4] = {lo_f(nu.x), hi_f(nu.x), lo_f(nu.y), hi_f(nu.y)};
                const float vc[4] = {lo_f(cv.x), hi_f(cv.x), lo_f(cv.y), hi_f(cv.y)}, vp[4] = {lo_f(pv_.x), hi_f(pv_.x), lo_f(pv_.y), hi_f(pv_.y)}, vn[4] = {lo_f(nv_.x), hi_f(nv_.x), lo_f(nv_.y), hi_f(nv_.y)};
                float oa[4], ob[4], ok[4], orr[4], ov[4];
#pragma unroll
                for (int e = 0; e < 4; ++e) { const int ch = 8 * q + 4 * h + e, m = 4 * q + e;
                    const float rf = rc[e] + cst[0 * 64 + ch] * (rp[e] - rc[e]) + cst[1 * 64 + ch] * (rn[e] - rc[e]);
                    const float vf = vc[e] + cst[4 * 64 + ch] * (vp[e] - vc[e]) + cst[5 * 64 + ch] * (vn[e] - vc[e]);
                    const float eg = lo_f(ge[m]), ieg = __builtin_amdgcn_rcpf(eg), egm1 = hi_f(ge[m]);
                    const float kfm = (m & 1) ? hi_f(kfp[m >> 1]) : lo_f(kfp[m >> 1]), avm = (m & 1) ? hi_f(avp[m >> 1]) : lo_f(avp[m >> 1]);
                    const float kkn = kfm * cst[8 * 64 + ch] * inv;
                    oa[e] = -kkn * egm1; ob[e] = kkn * avm * ieg; ok[e] = kfm * (1.f + (avm - 1.f) * cst[9 * 64 + ch]) * ieg; orr[e] = rf * eg; ov[e] = vf; }
                pA[2 * q] = cvtpk(oa[0], oa[1]); pA[2 * q + 1] = cvtpk(oa[2], oa[3]); pB[2 * q] = cvtpk(ob[0], ob[1]); pB[2 * q + 1] = cvtpk(ob[2], ob[3]);
                pK[2 * q] = cvtpk(ok[0], ok[1]); pK[2 * q + 1] = cvtpk(ok[2], ok[3]); pR[2 * q] = cvtpk(orr[0], orr[1]); pR[2 * q + 1] = cvtpk(orr[2], orr[3]);
                pV[2 * q] = cvtpk(ov[0], ov[1]); pV[2 * q + 1] = cvtpk(ov[2], ov[3]);
                __builtin_amdgcn_sched_barrier(0);
            }
        }
        __builtin_amdgcn_fence(__ATOMIC_RELEASE, "workgroup"); __builtin_amdgcn_wave_barrier();
#pragma unroll
        for (int q = 0; q < 8; ++q) { const int off = img_off(n, 2 * q + h);
            *(LAS u32x2*)(L + off) = (u32x2){pA[2 * q], pA[2 * q + 1]}; *(LAS u32x2*)(L + 4096 + off) = (u32x2){pB[2 * q], pB[2 * q + 1]};
            *(LAS u32x2*)(L + 8192 + off) = (u32x2){pK[2 * q], pK[2 * q + 1]}; *(LAS u32x2*)(L + 12288 + off) = (u32x2){pV[2 * q], pV[2 * q + 1]}; }
        __builtin_amdgcn_fence(__ATOMIC_RELEASE, "workgroup"); __builtin_amdgcn_wave_barrier();
        const f32x16 Z16 = {0.f};
        f32x16 Lab = Z16, LabT = Z16, LakT = Z16, MrbT = Z16, MrkT = Z16;
#pragma unroll
        for (int ks = 0; ks < 4; ++ks) {
            const bf16x8 fA = frag4(pA[4 * ks], pA[4 * ks + 1], pA[4 * ks + 2], pA[4 * ks + 3]), fB = frag4(pB[4 * ks], pB[4 * ks + 1], pB[4 * ks + 2], pB[4 * ks + 3]);
            const bf16x8 fK = frag4(pK[4 * ks], pK[4 * ks + 1], pK[4 * ks + 2], pK[4 * ks + 3]), fR = frag4(pR[4 * ks], pR[4 * ks + 1], pR[4 * ks + 2], pR[4 * ks + 3]);
            Lab = MFMA32(fA, fB, Lab); LabT = MFMA32(fB, fA, LabT); LakT = MFMA32(fK, fA, LakT); MrbT = MFMA32(fB, fR, MrbT); MrkT = MFMA32(fK, fR, MrkT);
        }
#pragma unroll
        for (int i = 0; i < 16; ++i) { const int rr = crow(i, h);
            Lab[i] = (n < rr) ? Lab[i] : 0.f; LabT[i] = (rr < n) ? LabT[i] : 0.f; LakT[i] = (rr < n) ? LakT[i] : 0.f;
            MrbT[i] = (rr <= n) ? MrbT[i] : 0.f; MrkT[i] = (rr <= n) ? MrkT[i] : 0.f; }
        const bf16x8 pLk0 = pack(LakT, 0), pLk1 = pack(LakT, 1), pMb0 = pack(MrbT, 0), pMb1 = pack(MrbT, 1), pMk0 = pack(MrkT, 0), pMk1 = pack(MrkT, 1);
        __builtin_amdgcn_sched_barrier(0);
        f32x16 Pc = Lab, Ptc = LabT, Rtc = LabT;
#pragma unroll
        for (int i = 0; i < 16; ++i) Rtc[i] += (crow(i, h) == n) ? 1.f : 0.f;
#pragma unroll
        for (int lvl = 0; lvl < 4; ++lvl) {
            const bf16x8 pP0 = pack(Pc, 0), pP1 = pack(Pc, 1), pT0 = pack(Ptc, 0), pT1 = pack(Ptc, 1);
            f32x16 nPc = MFMA32(pT0, pP0, Z16); nPc = MFMA32(pT1, pP1, nPc);
            if (lvl < 3) { f32x16 nPt = MFMA32(pP0, pT0, Z16); nPt = MFMA32(pP1, pT1, nPt); Ptc = nPt; }
            const bf16x8 pN0 = pack(nPc, 0), pN1 = pack(nPc, 1), pR0 = pack(Rtc, 0), pR1 = pack(Rtc, 1);
            Rtc = MFMA32(pN0, pR0, Rtc); Rtc = MFMA32(pN1, pR1, Rtc);
            Pc = nPc;
        }
        const bf16x8 pT0 = pack(Rtc, 0), pT1 = pack(Rtc, 1);
        bf16x8 vt[2][2];
#pragma unroll
        for (int tau = 0; tau < 2; ++tau) { vt[tau][0] = trfrag(L + 12288, tau, 0, lane); vt[tau][1] = trfrag(L + 12288, tau, 1, lane); }
        bf16x8 pW1[2][2], pW2[2][2];
#pragma unroll
        for (int tau = 0; tau < 2; ++tau) {
            f32x16 lv = MFMA32(pLk0, vt[tau][0], Z16); lv = MFMA32(pLk1, vt[tau][1], lv);
            const bf16x8 a0f = trfrag(L, tau, 0, lane), a1f = trfrag(L, tau, 1, lane);
            f32x16 w1 = MFMA32(pT0, a0f, Z16); w1 = MFMA32(pT1, a1f, w1);
            const bf16x8 l0 = pack(lv, 0), l1 = pack(lv, 1);
            f32x16 w2_ = MFMA32(pT0, l0, Z16); w2_ = MFMA32(pT1, l1, w2_);
            pW1[tau][0] = pack(w1, 0); pW1[tau][1] = pack(w1, 1); pW2[tau][0] = pack(w2_, 0); pW2[tau][1] = pack(w2_, 1);
        }
        int opq2 = 0; asm volatile("" : "+v"(opq2));
        const int lane_o = lane + opq2, n_o = n + opq2;
        unsigned char* uo = UO + ((size_t)(b * 8 + hd) * 128 + c32) * UNIT_BYTES;
#pragma unroll
        for (int kap = 0; kap < 2; ++kap) { f32x16 q1;
#pragma unroll
            for (int i = 0; i < 16; ++i) q1[i] = (i & 1) ? hi_f(pR[8 * kap + (i >> 1)]) : lo_f(pR[8 * kap + (i >> 1)]);
            q1 = MFMA32(pW1[kap][0], pMb0, q1); q1 = MFMA32(pW1[kap][1], pMb1, q1);
            store_tile(uo + kap * 2048, q1, lane_o); }
#pragma unroll
        for (int tau = 0; tau < 2; ++tau) { f32x16 q2 = MFMA32(pMb0, pW2[tau][0], Z16); q2 = MFMA32(pMb1, pW2[tau][1], q2); q2 = MFMA32(pMk0, vt[tau][0], q2); q2 = MFMA32(pMk1, vt[tau][1], q2);
#pragma unroll
            for (int i = 0; i < 16; ++i) { const int s = crow(i, h), tk = d ? tok0 + 31 - s : tok0 + s; float* yp = ybuf + ((size_t)b * SEQ + tk) * 512 + 64 * hd + 32 * tau + n_o;
                if (d) *yp += q2[i]; else *yp = q2[i]; } }
        __builtin_amdgcn_fence(__ATOMIC_RELEASE, "workgroup"); __builtin_amdgcn_wave_barrier();
#pragma unroll
        for (int tp = 0; tp < 2; ++tp) {
            const bf16x8 b0f = trfrag(L + 4096, tp, 0, lane), b1f = trfrag(L + 4096, tp, 1, lane), k0f = trfrag(L + 8192, tp, 0, lane), k1f = trfrag(L + 8192, tp, 1, lane);
            const float gcl = gC[32 * tp + n];
#pragma unroll
            for (int kap = 0; kap < 2; ++kap) { f32x16 g = MFMA32(pW1[kap][0], b0f, Z16); g = MFMA32(pW1[kap][1], b1f, g);
#pragma unroll
                for (int i = 0; i < 16; ++i) g[i] = (g[i] + ((kap == tp && crow(i, h) == n) ? 1.f : 0.f)) * gcl;
                store_tile(uo + (2 + 2 * kap + tp) * 2048, g, lane_o); }
#pragma unroll
            for (int tau = 0; tau < 2; ++tau) { f32x16 ht = MFMA32(b0f, pW2[tau][0], Z16); ht = MFMA32(b1f, pW2[tau][1], ht); ht = MFMA32(k0f, vt[tau][0], ht); ht = MFMA32(k1f, vt[tau][1], ht);
#pragma unroll
                for (int i = 0; i < 16; ++i) ht[i] *= gC[32 * tp + crow(i, h)];
                store_tile(uo + (6 + 2 * tp + tau) * 2048, ht, lane_o); }
        }
        __builtin_amdgcn_fence(__ATOMIC_RELEASE, "workgroup"); __builtin_amdgcn_wave_barrier();
    }
}

DI void d_seq(const Ctx& c, int d, const unsigned char* __restrict__ UO, float* __restrict__ ybuf) {
    if (c.wave >= 2) return;
    const int lane = c.lane, n = lane & 31, h = lane >> 5, tau = c.wave;
    for (int chain = c.bid; chain < 64; chain += c.nb) {
        const int b = chain >> 3, hd = chain & 7;
        const unsigned char* ub = UO + (size_t)chain * 128 * UNIT_BYTES + lane * 32;
        const f32x16 Z16 = {0.f};
        f32x16 X0 = Z16, X1 = Z16;
        u32x4 T[8][2];
        auto loadu = [&](int c32) {
            const unsigned char* p = ub + (size_t)c32 * UNIT_BYTES;
#pragma unroll
            for (int k = 0; k < 6; ++k) { T[k][0] = *(const u32x4*)(p + k * 2048); T[k][1] = *(const u32x4*)(p + k * 2048 + 16); }
#pragma unroll
            for (int tp = 0; tp < 2; ++tp) { T[6 + tp][0] = *(const u32x4*)(p + (6 + 2 * tp + tau) * 2048); T[6 + tp][1] = *(const u32x4*)(p + (6 + 2 * tp + tau) * 2048 + 16); }
        };
        loadu(0);
#pragma unroll 1
        for (int c32 = 0; c32 < 128; ++c32) {
            const int tok0 = d ? SEQ - 32 * (c32 + 1) : 32 * c32;
            float* yb = ybuf + ((size_t)b * SEQ) * 512 + 64 * hd + 32 * tau + n;
            f32x16 y;
#pragma unroll
            for (int i = 0; i < 16; ++i) { const int s = crow(i, h), tk = d ? tok0 + 31 - s : tok0 + s; y[i] = yb[(size_t)tk * 512]; }
            const bf16x8 x00 = pack(X0, 0), x01 = pack(X0, 1), x10 = pack(X1, 0), x11 = pack(X1, 1);
            f32x16 n0, n1;
#pragma unroll
            for (int i = 0; i < 8; ++i) { n0[2 * i] = lo_f(T[6][i >> 2][i & 3]); n0[2 * i + 1] = hi_f(T[6][i >> 2][i & 3]); n1[2 * i] = lo_f(T[7][i >> 2][i & 3]); n1[2 * i + 1] = hi_f(T[7][i >> 2][i & 3]); }
#define FR(t, s) __builtin_bit_cast(bf16x8, T[t][s])
            n0 = MFMA32(FR(2, 0), x00, n0); n1 = MFMA32(FR(3, 0), x00, n1);
            n0 = MFMA32(FR(2, 1), x01, n0); n1 = MFMA32(FR(3, 1), x01, n1);
            n0 = MFMA32(FR(4, 0), x10, n0); n1 = MFMA32(FR(5, 0), x10, n1);
            n0 = MFMA32(FR(4, 1), x11, n0); n1 = MFMA32(FR(5, 1), x11, n1);
            y = MFMA32(FR(0, 0), x00, y); y = MFMA32(FR(0, 1), x01, y); y = MFMA32(FR(1, 0), x10, y); y = MFMA32(FR(1, 1), x11, y);
#undef FR
            if (c32 + 1 < 128) loadu(c32 + 1);
#pragma unroll
            for (int i = 0; i < 16; ++i) { const int s = crow(i, h), tk = d ? tok0 + 31 - s : tok0 + s; yb[(size_t)tk * 512] = y[i]; }
            X0 = n0; X1 = n1;
        }
    }
}
#undef DI
}
namespace pk {
typedef short bf16x8 __attribute__((ext_vector_type(8)));
typedef float f32x16 __attribute__((ext_vector_type(16)));
typedef unsigned u32x4 __attribute__((ext_vector_type(4)));
typedef LAS unsigned char* lptr;
#define DI __device__ __forceinline__
DI float fmx(float a, float b) { float r; asm("v_max_f32 %0, %1, %2" : "=v"(r) : "v"(a), "v"(b)); return r; }
DI float fmn(float a, float b) { float r; asm("v_min_f32 %0, %1, %2" : "=v"(r) : "v"(a), "v"(b)); return r; }
DI void ce(float& hi, float& lo) { const float a = fmx(hi, lo), b = fmn(hi, lo); hi = a; lo = b; }
template <int N> DI void sort_desc(float (&v)[N]) {
#pragma unroll
    for (int k = 2; k <= N; k <<= 1)
#pragma unroll
        for (int j = k >> 1; j > 0; j >>= 1)
#pragma unroll
            for (int i = 0; i < N; ++i) { const int l = i ^ j; if (l > i) { if ((i & k) == 0) ce(v[i], v[l]); else ce(v[l], v[i]); } }
}
DI void merge16(float (&v)[16]) {
#pragma unroll
    for (int j = 8; j > 0; j >>= 1)
#pragma unroll
        for (int i = 0; i < 16; ++i) { const int l = i ^ j; if (l > i) ce(v[i], v[l]); }
}
DI void top_merge(float (&a)[16], const float (&b)[16]) {
#pragma unroll
    for (int i = 0; i < 16; ++i) a[i] = fmx(a[i], b[15 - i]);
    merge16(a);
}
DI float setcode(float v, unsigned code, unsigned mask) { return __uint_as_float((__float_as_uint(v) & ~mask) | code); }

DI void d_peer_topk(const Ctx& c, const bf16* __restrict__ qb, const float* __restrict__ keys, int* __restrict__ idx, float* __restrict__ gate) {
    const int lane = c.lane, n = lane & 31, hh = lane >> 5, hd = c.bid & 7;
    lptr KL = (lptr)c.lds;
    lptr TB = (lptr)c.lds + 65536 + c.wave * 2048;
    __syncthreads();
    for (int e = c.tid; e < 2 * 128 * 16; e += 512) {
        const int row = e >> 4, ch = e & 15; const float* src = keys + (size_t)hd * 32768 + row * 128 + ch * 8;
        const f32x4 a = *(const f32x4*)src, b = *(const f32x4*)(src + 4);
        u32x4 w; w[0] = pk2bf(a.x, a.y); w[1] = pk2bf(a.z, a.w); w[2] = pk2bf(b.x, b.y); w[3] = pk2bf(b.z, b.w);
        *(LAS u32x4*)(KL + row * 256 + ((ch ^ (row & 15)) << 4)) = w; }
    __syncthreads();
    const int nper = (c.nb >> 3) * 8;
    for (int tile = (c.bid >> 3) * 8 + c.wave; tile < NTOK / 32; tile += nper) {
        const int t0 = tile * 32;
        float sp[2][16];
#pragma unroll
        for (int p = 0; p < 2; ++p) {
            bf16x8 qf[8];
            { const bf16* qrow = qb + (size_t)(t0 + n) * PEER_Q + hd * 256 + p * 128 + 8 * hh;
#pragma unroll
              for (int ks = 0; ks < 8; ++ks) qf[ks] = *(const bf16x8*)(qrow + 16 * ks); }
            float top[16];
#pragma unroll
            for (int j = 0; j < 4; ++j) {
                f32x16 acc = {0.f};
                const int row = p * 128 + 32 * j + n;
#pragma unroll
                for (int ks = 0; ks < 8; ++ks) { const bf16x8 kfr = *(LAS bf16x8*)(KL + row * 256 + (((2 * ks + hh) ^ (row & 15)) << 4));
                    acc = __builtin_amdgcn_mfma_f32_32x32x16_bf16(kfr, qf[ks], acc, 0, 0, 0); }
                float g[16];
#pragma unroll
                for (int i = 0; i < 16; ++i) { const int key = 32 * j + (i & 3) + 8 * (i >> 2) + 4 * hh; g[i] = setcode(acc[i], 127u - (unsigned)key, 127u); }
                sort_desc<16>(g);
                if (j == 0) {
#pragma unroll
                    for (int i = 0; i < 16; ++i) top[i] = g[i];
                } else top_merge(top, g);
            }
            float oth[16];
#pragma unroll
            for (int i = 0; i < 16; ++i) oth[i] = __shfl_xor(top[i], 32);
            top_merge(top, oth);
#pragma unroll
            for (int i = 0; i < 16; ++i) sp[p][i] = top[i];
        }
        {
            unsigned w[8];
#pragma unroll
            for (int q = 0; q < 8; ++q) { const int p = q >> 2, a0 = (q & 3) * 4; w[q] = 0;
#pragma unroll
                for (int e = 0; e < 4; ++e) w[q] |= (127u - (__float_as_uint(sp[p][a0 + e]) & 127u)) << (8 * e); }
            *(LAS u32x4*)(TB + lane * 32) = (u32x4){w[0], w[1], w[2], w[3]}; *(LAS u32x4*)(TB + lane * 32 + 16) = (u32x4){w[4], w[5], w[6], w[7]};
        }
        float cd[64];
        {
            int cnt = 0;
#pragma unroll
            for (int a = 0; a < 16; ++a)
#pragma unroll
                for (int b = 0; b < 16; ++b) if ((a + 1) * (b + 1) <= 16) { cd[cnt] = setcode(sp[0][a] + sp[1][b], 255u - (unsigned)(a * 16 + b), 255u); ++cnt; }
#pragma unroll
            for (int i = 50; i < 64; ++i) cd[i] = -INFINITY;
        }
        sort_desc<64>(cd);
        const float mx = cd[0]; float ex[16]; float den = 0.f;
#pragma unroll
        for (int k = 0; k < 16; ++k) { ex[k] = __expf(cd[k] - mx); den += ex[k]; }
        const float rden = 1.f / den;
        const size_t ob = (size_t)(t0 + n) * 128 + hd * 16;
        if (hh == 0) {
            int id[16];
#pragma unroll
            for (int k = 0; k < 16; ++k) { const unsigned flat = 255u - (__float_as_uint(cd[k]) & 255u); const unsigned i1 = *(LAS unsigned char*)(TB + lane * 32 + (flat >> 4)), i2 = *(LAS unsigned char*)(TB + lane * 32 + 16 + (flat & 15)); id[k] = (int)(i1 * 128 + i2); }
#pragma unroll
            for (int k = 0; k < 4; ++k) *(int4*)(idx + ob + 4 * k) = make_int4(id[4 * k], id[4 * k + 1], id[4 * k + 2], id[4 * k + 3]);
        } else {
#pragma unroll
            for (int k = 0; k < 4; ++k) *(f32x4*)(gate + ob + 4 * k) = (f32x4){ex[4 * k] * rden, ex[4 * k + 1] * rden, ex[4 * k + 2] * rden, ex[4 * k + 3] * rden};
        }
    }
}
#undef DI
}
namespace pg8 {
struct EpiResF32 {
    static constexpr bool PERM = false, AFTER_DRAIN = false;
    const float* base; float* out; int ldc; float alpha;
    __device__ __forceinline__ void operator()(const f32x4 (&acc)[2][2][4][2], const Unit& u, int wr, int wc, int fr, int fq) const {
        const int col0 = u.pn * BM + wc * 32 + 4 * fq;
#pragma unroll
        for (int ai = 0; ai < 2; ++ai)
#pragma unroll
            for (int m = 0; m < 4; ++m) { const int r = ai * HALF + wr * 64 + m * 16 + fr; const size_t off = (size_t)(u.pm * BM + r) * ldc + col0;
#pragma unroll
                for (int bj = 0; bj < 2; ++bj)
#pragma unroll
                    for (int n = 0; n < 2; ++n) { const f32x4 bs = *(const f32x4*)(base + off + bj * HALF + n * 16); *(f32x4*)(out + off + bj * HALF + n * 16) = bs * alpha + acc[ai][bj][m][n]; } }
    }
};
}
constexpr size_t MiB = 1u << 20;
constexpr int LDS_BYTES = 147456;
constexpr int NPHASE = 14;
struct Params { const float* in[24]; float* out; unsigned char* ws; int ph_lo, ph_hi; };

__global__ void __launch_bounds__(512, 2) mega(Params p) {
    extern __shared__ __attribute__((aligned(16))) unsigned char lds[];
    cg::grid_group grid = cg::this_grid();
    Ctx c; c.wave = __builtin_amdgcn_readfirstlane(threadIdx.x >> 6); c.lane = (int)__builtin_amdgcn_mbcnt_hi(~0u, __builtin_amdgcn_mbcnt_lo(~0u, 0u)); c.tid = c.wave * 64 + c.lane; c.bid = blockIdx.x; c.nb = gridDim.x; c.gw = c.bid * 8 + c.wave; c.ngw = c.nb * 8; c.lds = lds;
#define LND(ptr) ({ auto q_ = (ptr); asm volatile("" : "+s"(q_)); q_; })
#define WSP(T, mb) ((T*)(LND(p.ws) + (size_t)(mb) * MiB))
#define x LND(p.in[0])
#define w_in LND(p.in[1])
#define mu_prev LND(p.in[2])
#define mu_next LND(p.in[3])
#define w0 LND(p.in[4])
#define w2 LND(p.in[5])
#define a0 LND(p.in[6])
#define a2 LND(p.in[7])
#define g2 LND(p.in[8])
#define k_k LND(p.in[9])
#define k_a LND(p.in[10])
#define r_k LND(p.in[11])
#define lnx_g LND(p.in[12])
#define lnx_b LND(p.in[13])
#define sink LND(p.in[14])
#define w_out LND(p.in[15])
#define ln1_g LND(p.in[16])
#define ln1_b LND(p.in[17])
#define wq LND(p.in[18])
#define keys LND(p.in[19])
#define pu LND(p.in[20])
#define pv LND(p.in[21])
#define ln2_g LND(p.in[22])
#define ln2_b LND(p.in[23])
#define out LND(p.out)
#define rope WSP(float2, 1)
#define w2t WSP(bf16, 2)
#define a2t ((bf16*)(LND(p.ws) + 2 * MiB + 65536))
#define w_in_t WSP(bf16, 4)
#define w_out_t WSP(bf16, 10)
#define wq_t WSP(bf16, 12)
#define xb WSP(bf16, 16)
#define qr WSP(bf16, 16)
#define kr WSP(bf16, 48)
#define ybuf WSP(float, 16)
#define ub WSP(bf16, 16)
#define u8t WSP(unsigned, 16)
#define v8t WSP(unsigned, 32)
#define su8 WSP(float, 48)
#define sv8 WSP(float, 49)
#define vb WSP(bf16, 48)
#define proj WSP(bf16, 80)
#define y1 WSP(float, 80)
#define idx WSP(int, 208)
#define gate WSP(float, 224)
#define mix WSP(bf16, 240)
#define UO WSP(unsigned char, 304)
#define qb WSP(bf16, 304)
#define h1b WSP(bf16, 432)
    const int lo = p.ph_lo, hi = p.ph_hi;
#ifndef PH_MASK
#define PH_MASK 0xFFFF
#endif
#define IN(k) (((PH_MASK >> (k)) & 1) && lo <= (k) && (k) < hi)
#define SEAM(k) do { if (IN(k) && IN((k) + 1)) grid.sync(); c.lane = (int)__builtin_amdgcn_mbcnt_hi(~0u, __builtin_amdgcn_mbcnt_lo(~0u, 0u)); c.tid = c.wave * 64 + c.lane; } while (0)
#ifndef REPEAT_MASK
#define REPEAT_MASK 0
#endif
#define PHASE(k, ...) do { if (IN(k)) { __VA_ARGS__; if ((REPEAT_MASK >> (k)) & 1) { grid.sync(); __VA_ARGS__; } } SEAM(k); } while (0)
#define GEMM_PHASE(EPI, A_, Bt_, N_, ...) do { pg8::Gemm g{A_, Bt_, NTOK, N_, DM}; pg8::StaticOrder S; S.init(NTOK, N_, c.nb, c.bid); EPI E{__VA_ARGS__}; \
        pg8::gemm_phase<EPI, pg8::StaticOrder, true, true>((PG8_LAS unsigned char*)lds, g, S, E, c.wave); } while (0)
    PHASE(0, nv::d_cvt_bf16(c, x, xb, (size_t)NTOK * DM / 4); nv::d_transpose_w(c, w_in, DM, IN_COLS, IN_PAD, w_in_t); nv::d_transpose_w(c, w_out, DM, DM, DM, w_out_t);
             nv::d_transpose_w(c, wq, DM, PEER_Q, PEER_Q, wq_t); nv::d_rope_table(c, rope); rw::d_lowrank_t(c, w2, a2, w2t, a2t));
    PHASE(1, GEMM_PHASE(pg8::EpiBf16<0>, xb, w_in_t, IN_PAD, proj, IN_PAD, nullptr, 0, 0, 1.f));
    PHASE(2, nv::d_rotary(c, proj, rope, qr, kr));
    PHASE(3, nv::d_attn(c, qr, kr, proj, sink, mix));
    PHASE(4, rw::d_prep(c, 0, proj, mu_prev, mu_next, w0, a0, k_k, k_a, w2t, a2t, UO, ybuf));
    PHASE(5, rw::d_seq(c, 0, UO, ybuf));
    PHASE(6, rw::d_prep(c, 1, proj, mu_prev, mu_next, w0, a0, k_k, k_a, w2t, a2t, UO, ybuf));
    PHASE(7, rw::d_seq(c, 1, UO, ybuf));
    PHASE(8, nv::d_rwkv_out<true>(c, proj, ybuf, mu_prev, mu_next, a0, a2, g2, k_a, r_k, lnx_g, lnx_b, mix));
    PHASE(9, GEMM_PHASE(pg8::EpiResF32, mix, w_out_t, DM, x, y1, DM, DN_ALPHA));
    PHASE(10, { float* y1p = y1; nv::d_ln1(c, y1p, ln1_g, ln1_b, y1p, h1b); } pe8::d_quant_tables(c, pu, pv, u8t, v8t, su8, sv8));
    PHASE(11, GEMM_PHASE(pg8::EpiBf16<0>, h1b, wq_t, PEER_Q, qb, PEER_Q, nullptr, 0, 0, 1.f));
    PHASE(12, pk::d_peer_topk(c, qb, keys, idx, gate));
    PHASE(13, pe8::d_peer_gather(c, h1b, idx, gate, u8t, v8t, su8, sv8, ln2_g, ln2_b, out));
#undef IN
#undef SEAM
}
#undef x
#undef out
#undef proj
#undef mix
#undef idx
#undef gate
#undef keys
#undef rope
#undef w0
#undef w2
#undef a0
#undef a2
#undef g2
#undef sink
#undef qr
#undef kr
#undef ub
#undef vb
#undef qb
#undef xb
#undef y1
#undef UO
#undef ybuf
#undef pu
#undef pv

#ifndef N_LAUNCHES
#define N_LAUNCHES 1
#endif
extern "C" void kernel_launch(void* const* d_in, const int* in_sizes, int n_in, void* d_out, int out_size, void* d_ws, size_t ws_size, hipStream_t stream) {
    static int grid = 0;
    if (grid == 0) {
        if (n_in != 24 || in_sizes[0] != NTOK * DM || out_size != NTOK * DM || ws_size < 496 * MiB) { fprintf(stderr, "kernel_launch: unexpected shapes/ws (n_in %d, ws %zu)\n", n_in, ws_size); grid = -1; return; }
        int dev = 0, cus = 0, per_cu = 0;
        if (hipGetDevice(&dev) != hipSuccess || hipDeviceGetAttribute(&cus, hipDeviceAttributeMultiprocessorCount, dev) != hipSuccess) { grid = -1; return; }
        if (hipFuncSetAttribute((const void*)mega, hipFuncAttributeMaxDynamicSharedMemorySize, LDS_BYTES) != hipSuccess) { fprintf(stderr, "kernel_launch: hipFuncSetAttribute failed\n"); grid = -1; return; }
        if (hipOccupancyMaxActiveBlocksPerMultiprocessor(&per_cu, (const void*)mega, 512, LDS_BYTES) != hipSuccess || per_cu < 1) { fprintf(stderr, "kernel_launch: occupancy query failed (%d)\n", per_cu); (void)hipGetLastError(); grid = -1; return; }
        grid = cus * per_cu;
        fprintf(stderr, "kernel_launch: cus %d per_cu %d grid %d\n", cus, per_cu, grid);
    }
    if (grid < 0) return;
    Params p{};
    for (int i = 0; i < 24; ++i) p.in[i] = (const float*)d_in[i];
    p.out = (float*)d_out; p.ws = (unsigned char*)d_ws;
#if N_LAUNCHES == 1
    p.ph_lo = 0; p.ph_hi = NPHASE;
    void* args[] = {&p};
    hipError_t e = hipLaunchCooperativeKernel((const void*)mega, dim3(grid), dim3(512), args, LDS_BYTES, stream);
    if (e != hipSuccess) fprintf(stderr, "cooperative launch failed: %s (grid %d)\n", hipGetErrorString(e), grid);
#else
    for (int k = 0; k < NPHASE; ++k) { p.ph_lo = k; p.ph_hi = k + 1; hipLaunchKernelGGL(mega, dim3(grid), dim3(512), LDS_BYTES, stream, p); }
#endif
}
```

```cpp
#include <hip/hip_runtime.h>
#include <hip/hip_cooperative_groups.h>
#include <cstdio>
#include <cstdint>
#include <cmath>
namespace cg = cooperative_groups;

constexpr int BATCH = 8, SEQ = 4096, DM = 1024, NTOK = BATCH * SEQ;
constexpr int IN_COLS = 2528, IN_PAD = 2560;
constexpr int C_Q = 0, C_K = 512, C_V = 640, C_P = 768;
constexpr int P_R = 0, P_KK = 512, P_VV = 1024, P_WD = 1536, P_AD = 1600, P_GD = 1664, RW_COLS = 1760;
constexpr int NEXP = 16384, PEER_Q = 2048;
constexpr float LN_EPS = 1e-5f, GN_EPS = 64e-5f;
constexpr float DN_ALPHA = 1.189207115002721f;

typedef unsigned short bf16;
__device__ __forceinline__ float bf2f(bf16 v) { return __uint_as_float(((unsigned)v) << 16); }
__device__ __forceinline__ bf16 f2bf(float f) { unsigned u = __float_as_uint(f); return (bf16)((u + 0x7fffu + ((u >> 16) & 1u)) >> 16); }
__device__ __forceinline__ unsigned pk2bf(float lo, float hi) { return (unsigned)f2bf(lo) | ((unsigned)f2bf(hi) << 16); }
__device__ __forceinline__ float wave_sum(float v) {
#pragma unroll
    for (int o = 1; o < 64; o <<= 1) v += __shfl_xor(v, o);
    return v;
}
__device__ __forceinline__ float sigmoidf_(float x) { return 1.f / (1.f + __expf(-x)); }
namespace pg8 {
#define PG8_LAS __attribute__((address_space(3)))
typedef unsigned short bf16_t;
typedef short bf16x8 __attribute__((ext_vector_type(8)));
typedef float f32x4 __attribute__((ext_vector_type(4)));
typedef unsigned u32x4 __attribute__((ext_vector_type(4)));
constexpr int BM = 256, BK = 64, HALF = 128, HTB = HALF * BK * 2  , STAGE_BYTES = 8 * HTB, NXCD = 8, WGM = 8;

__host__ __device__ __forceinline__ int lds_byte(int r, int c) { const int st = (r >> 4) * 2 + (c >> 5), rr = r & 15, cc = c & 31, ob = rr * 64 + cc * 2; return st * 1024 + (ob ^ (((ob >> 9) & 1) << 5)); }
__host__ __device__ __forceinline__ void stage_rc(int b, int& R, int& C) { const int st = b / 1024, sb = b % 1024, swz = sb ^ (((sb >> 9) & 1) << 5); R = (st >> 1) * 16 + swz / 64; C = (st & 1) * 32 + (swz % 64) / 2; }
__host__ __device__ __forceinline__ int perm32(int rho) { const int n = rho >> 4, i = rho & 15; return 8 * (i >> 2) + 4 * n + (i & 3); }

struct Unit { int pm, pn; };
struct Gemm { const bf16_t* A; const bf16_t* Bt; int M, N, K; };

struct StaticOrder {
    int nM, nN, nwg, G, c;
    __host__ __device__ void init(int M, int N, int G_, int c_) { nM = M / BM; nN = N / BM; nwg = nM * nN; G = G_; c = c_; }
    __host__ __device__ bool next(int i, Unit& u) const {
        const long L = (long)i * G + c; if (L >= nwg) return false;
        int wgid = (int)L; { const int q = nwg / NXCD, r = nwg % NXCD, xcd = wgid % NXCD, off = wgid / NXCD; wgid = (xcd < r ? xcd * (q + 1) : r * (q + 1) + (xcd - r) * q) + off; }
        const int nig = WGM * nN, gid = wgid / nig, fm = gid * WGM, gsz = (nM - fm) < WGM ? (nM - fm) : WGM;
        u.pm = fm + ((wgid % nig) % gsz); u.pn = (wgid % nig) / gsz; return true;
    }
    __device__ __forceinline__ void a_ready(const Unit&) const {}
    __device__ __forceinline__ void done(const Unit&) const {}
};

__device__ __forceinline__ unsigned cvt_pk_bf16(float lo, float hi) { unsigned r; asm volatile("v_cvt_pk_bf16_f32 %0, %1, %2" : "=v"(r) : "v"(lo), "v"(hi)); return r; }
typedef float f32x2 __attribute__((ext_vector_type(2)));
__device__ __forceinline__ f32x2 gelu_pk(f32x2 v) {
    const f32x2 av = __builtin_elementwise_abs(v), d = av * 0.2316418882f + 1.0f;
    f32x2 t; t.x = __builtin_amdgcn_rcpf(d.x); t.y = __builtin_amdgcn_rcpf(d.y);
    f32x2 q = t * 0.5307027145f + (-0.7265760135f); q = q * t + 0.7107068705f; q = q * t + (-0.142248368f); q = q * t + 0.127414796f; q = q * t;
    const f32x2 s = (v * v) * (-0.72134752044f);
    f32x2 e; e.x = __builtin_amdgcn_exp2f(s.x); e.y = __builtin_amdgcn_exp2f(s.y);
    const f32x2 m = v * (q * e), r = v - m;
    f32x2 o; o.x = v.x < 0.f ? m.x : r.x; o.y = v.y < 0.f ? m.y : r.y; return o;
}

template <int ACT  > struct EpiBf16 {
    static constexpr bool PERM = true, AFTER_DRAIN = false; static_assert(ACT == 0 || ACT == 1, "EpiBf16: ACT is 0 (none) or 1 (gelu_pk)");
    bf16_t* O; int ldc; const float* bias; int split_cols; size_t split_stride; float scale0;
    __device__ __forceinline__ void operator()(const f32x4 (&acc)[2][2][4][2], const Unit& u, int wr, int wc, int fr, int fq) const {
        const int row0 = u.pm * BM + wr * 64 + fr; int colt = u.pn * BM; bf16_t* base = O;
        float sc = 1.f; if (split_cols) { const int t = colt / split_cols; base += (size_t)t * split_stride; colt -= t * split_cols; if (t == 0) sc = scale0; }
        const int col0 = colt + wc * 32 + 8 * fq, bcol0 = u.pn * BM + wc * 32 + 8 * fq;
        f32x4 bv[2][2];
#pragma unroll
        for (int bj = 0; bj < 2; ++bj)
#pragma unroll
            for (int n = 0; n < 2; ++n) bv[bj][n] = bias ? *(const f32x4*)(bias + bcol0 + bj * HALF + 4 * n) : (f32x4){0.f, 0.f, 0.f, 0.f};
#pragma unroll
        for (int ai = 0; ai < 2; ++ai)
#pragma unroll
            for (int m = 0; m < 4; ++m) { bf16_t* rowp = base + (size_t)(row0 + ai * HALF + m * 16) * ldc + col0;
#pragma unroll
                for (int bj = 0; bj < 2; ++bj) { f32x4 v0 = acc[ai][bj][m][0] + bv[bj][0], v1 = acc[ai][bj][m][1] + bv[bj][1];
                    if (ACT == 1) { f32x2 a = gelu_pk((f32x2){v0[0], v0[1]}), b = gelu_pk((f32x2){v0[2], v0[3]}), c = gelu_pk((f32x2){v1[0], v1[1]}), d = gelu_pk((f32x2){v1[2], v1[3]});
                        v0 = (f32x4){a.x, a.y, b.x, b.y}; v1 = (f32x4){c.x, c.y, d.x, d.y}; }
                    v0 = v0 * sc; v1 = v1 * sc; u32x4 w; w.x = cvt_pk_bf16(v0[0], v0[1]); w.y = cvt_pk_bf16(v0[2], v0[3]); w.z = cvt_pk_bf16(v1[0], v1[1]); w.w = cvt_pk_bf16(v1[2], v1[3]);
                    *(u32x4*)(rowp + bj * HALF) = w; } }
    }
};

struct PanelStats {
    unsigned* xbuf;
    unsigned* cnt;
    unsigned* tmo;
    int ntn; float eps;
    unsigned code;
    __device__ __forceinline__ bool run(const f32x4 (&v)[2][2][4][2], const Unit& u, int wr, int wc, int fr, int fq, PG8_LAS unsigned char* lds, int wid, int lane) const {
        typedef float f32x2v __attribute__((ext_vector_type(2)));
        PG8_LAS f32x2v* P = (PG8_LAS f32x2v*)lds;
        PG8_LAS f32x2v* S = (PG8_LAS f32x2v*)(lds + 8192);
        PG8_LAS unsigned* flag = (PG8_LAS unsigned*)(lds + 8192 + 2048);
#pragma unroll
        for (int ai = 0; ai < 2; ++ai)
#pragma unroll
            for (int m = 0; m < 4; ++m) {
                float s = 0.f;
#pragma unroll
                for (int bj = 0; bj < 2; ++bj)
#pragma unroll
                    for (int n = 0; n < 2; ++n) { const f32x4 x = v[ai][bj][m][n]; s += (x[0] + x[1]) + (x[2] + x[3]); }
                s += __shfl_xor(s, 16); s += __shfl_xor(s, 32);
                const float mw = s * (1.0f / 64.0f); float q = 0.f;
#pragma unroll
                for (int bj = 0; bj < 2; ++bj)
#pragma unroll
                    for (int n = 0; n < 2; ++n) { const f32x4 d = v[ai][bj][m][n] - mw; q += (d[0] * d[0] + d[1] * d[1]) + (d[2] * d[2] + d[3] * d[3]); }
                q += __shfl_xor(q, 16); q += __shfl_xor(q, 32);
                if (fq == 0) P[(ai * HALF + wr * 64 + m * 16 + fr) * 4 + wc] = (f32x2v){mw, q};
            }
        asm volatile("s_waitcnt lgkmcnt(0)" ::: "memory"); __builtin_amdgcn_s_barrier(); asm volatile("" ::: "memory");
#if defined(BROKEN_EXCHANGE_NO_WAIT)
#warning BROKEN CONTROL BUILD: the row-statistics exchange does not wait; results are wrong by design
        if (blockIdx.x >= 64) { const long long t0_ = clock64(); while (clock64() - t0_ < 60000) __builtin_amdgcn_s_sleep(8); }
#endif
        const int row = wid * 32 + (lane & 31);
        if (lane < 32) {
            const f32x2v a = P[row * 4 + 0], b = P[row * 4 + 1], c = P[row * 4 + 2], d = P[row * 4 + 3];
            const float mt = (a.x + b.x + c.x + d.x) * 0.25f;
            const float da = a.x - mt, db = b.x - mt, dc = c.x - mt, dd = d.x - mt;
            const float m2 = (a.y + b.y) + (c.y + d.y) + 64.0f * ((da * da + db * db) + (dc * dc + dd * dd));
            unsigned long long* slot = (unsigned long long*)xbuf + ((size_t)(u.pm * BM + row) * 4 + u.pn);
            __hip_atomic_store(slot, ((unsigned long long)__float_as_uint(m2) << 32) | __float_as_uint(mt), __ATOMIC_RELAXED, __HIP_MEMORY_SCOPE_AGENT);
        }
        asm volatile("s_waitcnt vmcnt(0)" ::: "memory");
        if (lane == 0) __hip_atomic_fetch_add(cnt + 64 * u.pm, 1u, __ATOMIC_RELAXED, __HIP_MEMORY_SCOPE_AGENT);
        if (wid == 0) {
            bool dead = false; const unsigned long long t0 = __builtin_amdgcn_s_memrealtime(); const unsigned want = 8u * (unsigned)ntn;
            for (;;) {
#if defined(BROKEN_EXCHANGE_NO_WAIT)
                break;
#endif
                if ((unsigned)__builtin_amdgcn_readfirstlane(__hip_atomic_load(cnt + 64 * u.pm, __ATOMIC_RELAXED, __HIP_MEMORY_SCOPE_AGENT)) >= want) break;
                if (__builtin_amdgcn_s_memrealtime() - t0 > 2000000ull) {
                    if (lane == 0) { unsigned expect = 0u; __hip_atomic_compare_exchange_strong(tmo + 1, &expect, code | (unsigned)(u.pm & 0xff), __ATOMIC_RELAXED, __ATOMIC_RELAXED, __HIP_MEMORY_SCOPE_AGENT);
                                     __hip_atomic_store(tmo, 1u, __ATOMIC_RELAXED, __HIP_MEMORY_SCOPE_AGENT); }
                    dead = true; break; }
                __builtin_amdgcn_s_sleep(2);
            }
            __builtin_amdgcn_fence(__ATOMIC_ACQUIRE, "agent");
            if (lane == 0) flag[0] = dead ? 1u : 0u;
        }
        asm volatile("s_waitcnt vmcnt(0) lgkmcnt(0)" ::: "memory"); __builtin_amdgcn_s_barrier(); asm volatile("" ::: "memory");
        const bool bad = flag[0] != 0u;
        if (lane < 32) {
            const unsigned long long* slot = (const unsigned long long*)xbuf + (size_t)(u.pm * BM + row) * 4; float mt[4], m2[4]; float ms = 0.f;
#pragma unroll
            for (int t = 0; t < 4; ++t) { if (t < ntn) { const unsigned long long w = __hip_atomic_load(slot + t, __ATOMIC_RELAXED, __HIP_MEMORY_SCOPE_AGENT); mt[t] = __uint_as_float((unsigned)w); m2[t] = __uint_as_float((unsigned)(w >> 32)); } else { mt[t] = 0.f; m2[t] = 0.f; } ms += mt[t]; }
            const float mean = ms / (float)ntn; float q = 0.f;
#pragma unroll
            for (int t = 0; t < 4; ++t) if (t < ntn) { const float dm = mt[t] - mean; q += m2[t] + 256.0f * dm * dm; }
            S[row] = (f32x2v){mean, 1.0f / sqrtf(q / (256.0f * (float)ntn) + eps)};
        }
        asm volatile("s_waitcnt lgkmcnt(0)" ::: "memory"); __builtin_amdgcn_s_barrier(); asm volatile("" ::: "memory");
        return bad;
    }
};
struct EpiLnRes {
    static constexpr bool PERM = false, AFTER_DRAIN = true;
    const float* base; float* out; int ldc; const float* bias; PanelStats st; unsigned poison;
    __device__ __forceinline__ void fused(f32x4 (&acc)[2][2][4][2], const Unit& u, int wr, int wc, int fr, int fq, PG8_LAS unsigned char* lds, int wid, int lane) const {
        typedef float f32x2v __attribute__((ext_vector_type(2)));
        const PG8_LAS f32x2v* S = (const PG8_LAS f32x2v*)(lds + 8192);
        const int col0 = u.pn * BM + wc * 32 + 4 * fq;
#pragma unroll
        for (int bj = 0; bj < 2; ++bj)
#pragma unroll
            for (int n = 0; n < 2; ++n) { const f32x4 bv = bias ? *(const f32x4*)(bias + col0 + bj * HALF + n * 16) : (f32x4){0.f, 0.f, 0.f, 0.f};
#pragma unroll
                for (int ai = 0; ai < 2; ++ai)
#pragma unroll
                    for (int m = 0; m < 4; ++m) acc[ai][bj][m][n] += bv; }
        f32x4 pre[4][2][2];
#pragma unroll
        for (int m = 0; m < 4; ++m) { const size_t off = (size_t)(u.pm * BM + wr * 64 + m * 16 + fr) * ldc + col0;
#pragma unroll
            for (int bj = 0; bj < 2; ++bj)
#pragma unroll
                for (int n = 0; n < 2; ++n) pre[m][bj][n] = *(const f32x4*)(base + off + bj * HALF + n * 16); }
        const bool bad = st.run(acc, u, wr, wc, fr, fq, lds, wid, lane) || poison != 0u;
        const float qnan = __builtin_nanf("");
#pragma unroll
        for (int ai = 0; ai < 2; ++ai)
#pragma unroll
            for (int m = 0; m < 4; ++m) { const int r = ai * HALF + wr * 64 + m * 16 + fr; const f32x2v sr = S[r]; const size_t off = (size_t)(u.pm * BM + r) * ldc + col0;
#pragma unroll
                for (int bj = 0; bj < 2; ++bj)
#pragma unroll
                    for (int n = 0; n < 2; ++n) { const f32x4 bs = ai == 0 ? pre[m][bj][n] : *(const f32x4*)(base + off + bj * HALF + n * 16); f32x4 o = bs + (acc[ai][bj][m][n] - sr.x) * sr.y;
                        if (bad) o = (f32x4){qnan, qnan, qnan, qnan}; *(f32x4*)(out + off + bj * HALF + n * 16) = o; }
                if (m & 1) asm volatile("" ::: "memory"); }
    }
};
struct EpiLnResLn {
    static constexpr bool PERM = false, AFTER_DRAIN = true;
    const float* base; float* out; bf16_t* xn; int ldc; const float* bias; PanelStats st1, st2; unsigned poison;
    __device__ __forceinline__ void fused(f32x4 (&acc)[2][2][4][2], const Unit& u, int wr, int wc, int fr, int fq, PG8_LAS unsigned char* lds, int wid, int lane) const {
        typedef float f32x2v __attribute__((ext_vector_type(2))); typedef unsigned u32x2v __attribute__((ext_vector_type(2)));
        const PG8_LAS f32x2v* S = (const PG8_LAS f32x2v*)(lds + 8192);
        const int col0 = u.pn * BM + wc * 32 + 4 * fq;
#pragma unroll
        for (int bj = 0; bj < 2; ++bj)
#pragma unroll
            for (int n = 0; n < 2; ++n) { const f32x4 bv = bias ? *(const f32x4*)(bias + col0 + bj * HALF + n * 16) : (f32x4){0.f, 0.f, 0.f, 0.f};
#pragma unroll
                for (int ai = 0; ai < 2; ++ai)
#pragma unroll
                    for (int m = 0; m < 4; ++m) acc[ai][bj][m][n] += bv; }
        bool bad = st1.run(acc, u, wr, wc, fr, fq, lds, wid, lane) || poison != 0u;
        const float qnan = __builtin_nanf("");
#pragma unroll
        for (int ai = 0; ai < 2; ++ai)
#pragma unroll
            for (int m = 0; m < 4; ++m) { const int r = ai * HALF + wr * 64 + m * 16 + fr; const f32x2v sr = S[r]; const size_t off = (size_t)(u.pm * BM + r) * ldc + col0;
#pragma unroll
                for (int bj = 0; bj < 2; ++bj)
#pragma unroll
                    for (int n = 0; n < 2; ++n) { const f32x4 bs = *(const f32x4*)(base + off + bj * HALF + n * 16); acc[ai][bj][m][n] = bs + (acc[ai][bj][m][n] - sr.x) * sr.y; }
                asm volatile("" : "+v"(acc[ai][0][m][0]), "+v"(acc[ai][0][m][1]), "+v"(acc[ai][1][m][0]), "+v"(acc[ai][1][m][1]));
                if (m & 1) asm volatile("" ::: "memory"); }
        const bool bad1 = bad;
        bad = st2.run(acc, u, wr, wc, fr, fq, lds, wid, lane) || bad;
#pragma unroll
        for (int ai = 0; ai < 2; ++ai)
#pragma unroll
            for (int m = 0; m < 4; ++m) { const int r = ai * HALF + wr * 64 + m * 16 + fr; const f32x2v sr = S[r]; const size_t off = (size_t)(u.pm * BM + r) * ldc + col0;
#pragma unroll
                for (int bj = 0; bj < 2; ++bj)
#pragma unroll
                    for (int n = 0; n < 2; ++n) { const f32x4 x1 = acc[ai][bj][m][n]; *(f32x4*)(out + off + bj * HALF + n * 16) = bad1 ? (f32x4){qnan, qnan, qnan, qnan} : x1;
                        const f32x4 o = (x1 - sr.x) * sr.y; u32x2v w; w.x = cvt_pk_bf16(o[0], o[1]); w.y = cvt_pk_bf16(o[2], o[3]);
                        if (bad) { w.x = 0x7fc07fc0u; w.y = 0x7fc07fc0u; } *(u32x2v*)(xn + off + bj * HALF + n * 16) = w; }
                asm volatile("" ::: "memory"); }
    }
};

template <class Epi, class Sched, bool ALIGN_EPI = false, bool SP2 = false>
__device__ __forceinline__ void gemm_phase(PG8_LAS unsigned char* lds, const Gemm g, const Sched& S, const Epi& E, const int wid_in) {
    const int lane = (int)__builtin_amdgcn_mbcnt_hi(~0u, __builtin_amdgcn_mbcnt_lo(~0u, 0u)), wid = wid_in, tid = wid * 64 + lane, wr = wid >> 2, wc = wid & 3, fr = lane & 15, fq = lane >> 4;
    const int K = g.K, nt = K / BK;
    unsigned voffA[2], voffB[2];
#pragma unroll
    for (int i = 0; i < 2; ++i) { int R, C; stage_rc(tid * 16 + i * 8192, R, C); const int Rb = Epi::PERM ? ((R & ~31) + perm32(R & 31)) : R;
        voffA[i] = (unsigned)(R * K + C) * 2u; voffB[i] = (unsigned)(Rb * K + C) * 2u; }
    const size_t kstep = (size_t)(BK * 2);
    const size_t hstep = (size_t)HALF * K * 2;
    const size_t tstep = 2 * hstep;
    const unsigned ldsw = (unsigned)wid * 1024u;
    const int aoff = lds_byte(wr * 64 + fr, fq * 8), boff = lds_byte(wc * 32 + fr, fq * 8);
#define PG8_SA(b, h) (((b) * 2 + (h)) * HTB)
#define PG8_SB(b, h) ((4 + (b) * 2 + (h)) * HTB)
#define PG8_STAGE(bufoff, gbase, voff) do { _Pragma("unroll") for (int _i = 0; _i < 2; ++_i) \
        __builtin_amdgcn_global_load_lds((const unsigned*)((const char*)(gbase) + (voff)[_i]), (PG8_LAS unsigned*)(lds + (bufoff) + ldsw + _i * 8192), 16, 0, 0); } while (0)
#define PG8_LDA(dst, b, h) do { _Pragma("unroll") for (int m = 0; m < 4; ++m) _Pragma("unroll") for (int k = 0; k < 2; ++k) dst[m][k] = *(const PG8_LAS bf16x8*)(lds + PG8_SA(b, h) + aoff + m * 2048 + k * 1024); } while (0)
#define PG8_LDB(dst, b, h) do { _Pragma("unroll") for (int n = 0; n < 2; ++n) _Pragma("unroll") for (int k = 0; k < 2; ++k) dst[n][k] = *(const PG8_LAS bf16x8*)(lds + PG8_SB(b, h) + boff + n * 2048 + k * 1024); } while (0)
#define PG8_MMA(ai, bj, At, Bt) do { __builtin_amdgcn_s_setprio(1); _Pragma("unroll") for (int m = 0; m < 4; ++m) _Pragma("unroll") for (int n = 0; n < 2; ++n) _Pragma("unroll") for (int k = 0; k < 2; ++k) \
        acc[ai][bj][m][n] = __builtin_amdgcn_mfma_f32_16x16x32_bf16(Bt[n][k], At[m][k], acc[ai][bj][m][n], 0, 0, 0); __builtin_amdgcn_s_setprio(0); } while (0)
#define PG8_WAIT_V(n) asm volatile("s_waitcnt vmcnt(" #n ")" ::: "memory")
#define PG8_WAIT_L(n) asm volatile("s_waitcnt lgkmcnt(" #n ")" ::: "memory")
#define PG8_BAR __builtin_amdgcn_s_barrier()
#define PG8_SCHED __builtin_amdgcn_sched_barrier(0)
    Unit cur, nxt; int ui = 0;
    if (!S.next(0, cur)) return;
    f32x4 acc[2][2][4][2];
#pragma unroll
    for (int a = 0; a < 2; ++a)
#pragma unroll
        for (int b = 0; b < 2; ++b)
#pragma unroll
            for (int m = 0; m < 4; ++m)
#pragma unroll
                for (int n = 0; n < 2; ++n) acc[a][b][m][n] = (f32x4){0.f, 0.f, 0.f, 0.f};
    bf16x8 At[4][2], B0[2][2], B1[2][2];
    const char* cA = (const char*)g.A + (size_t)cur.pm * tstep; const char* cB = (const char*)g.Bt + (size_t)cur.pn * tstep;
    S.a_ready(cur);
    if constexpr (SP2) {
        PG8_STAGE(PG8_SB(0, 0), cB, voffB); PG8_STAGE(PG8_SB(0, 1), cB + hstep, voffB); PG8_STAGE(PG8_SA(0, 0), cA, voffA); PG8_STAGE(PG8_SA(0, 1), cA + hstep, voffA);
        if (wr == 1) PG8_BAR;
        PG8_WAIT_V(2); PG8_BAR;
        PG8_STAGE(PG8_SB(1, 0), cB + kstep, voffB); PG8_STAGE(PG8_SA(1, 0), cA + kstep, voffA); PG8_STAGE(PG8_SB(1, 1), cB + hstep + kstep, voffB);
        PG8_WAIT_V(6); PG8_BAR;
    } else {
        PG8_STAGE(PG8_SB(0, 0), cB, voffB); PG8_STAGE(PG8_SA(0, 0), cA, voffA); PG8_STAGE(PG8_SB(0, 1), cB + hstep, voffB); PG8_STAGE(PG8_SA(0, 1), cA + hstep, voffA);
        if (wr == 1) PG8_BAR;
        PG8_WAIT_V(4); PG8_BAR;
        PG8_STAGE(PG8_SB(1, 0), cB + kstep, voffB); PG8_STAGE(PG8_SA(1, 0), cA + kstep, voffA); PG8_STAGE(PG8_SB(1, 1), cB + hstep + kstep, voffB);
        PG8_WAIT_V(6); PG8_BAR;
    }
    for (;;) {
        const bool has_next = S.next(ui + 1, nxt);
        const char* nA = has_next ? (const char*)g.A + (size_t)nxt.pm * tstep : cA; const char* nB = has_next ? (const char*)g.Bt + (size_t)nxt.pn * tstep : cB;
        for (int t = 0; t < nt; t += 2) {
            const bool last = (t == nt - 2);
            const char* a1 = cA + (size_t)(t + 1) * kstep;
            const char* a2 = last ? nA : cA + (size_t)(t + 2) * kstep; const char* b2 = last ? nB : cB + (size_t)(t + 2) * kstep;
            const char* a3 = a2 + kstep; const char* b3 = b2 + kstep;
            if (last && has_next) S.a_ready(nxt);
            if constexpr (SP2) {
            PG8_LDB(B0, 0, 0); PG8_LDB(B1, 0, 1); PG8_SCHED; PG8_LDA(At, 0, 0); PG8_STAGE(PG8_SA(1, 1), a1 + hstep, voffA);
            PG8_WAIT_V(8); PG8_WAIT_L(0); PG8_BAR; PG8_MMA(0, 0, At, B0); PG8_MMA(0, 1, At, B1); PG8_BAR; PG8_SCHED;
            PG8_LDA(At, 0, 1); PG8_STAGE(PG8_SB(0, 0), b2, voffB); PG8_STAGE(PG8_SB(0, 1), b2 + hstep, voffB); PG8_STAGE(PG8_SA(0, 0), a2, voffA);
            PG8_WAIT_V(8); PG8_WAIT_L(0); PG8_BAR; PG8_MMA(1, 0, At, B0); PG8_MMA(1, 1, At, B1); PG8_BAR; PG8_SCHED;
            PG8_LDB(B0, 1, 0); PG8_LDB(B1, 1, 1); PG8_SCHED; PG8_LDA(At, 1, 0); PG8_STAGE(PG8_SA(0, 1), a2 + hstep, voffA);
            PG8_WAIT_V(8); PG8_WAIT_L(0); PG8_BAR; PG8_MMA(0, 0, At, B0); PG8_MMA(0, 1, At, B1); PG8_BAR; PG8_SCHED;
            PG8_LDA(At, 1, 1); PG8_STAGE(PG8_SB(1, 0), b3, voffB); PG8_STAGE(PG8_SB(1, 1), b3 + hstep, voffB); PG8_STAGE(PG8_SA(1, 0), a3, voffA);
            PG8_WAIT_V(8); PG8_WAIT_L(0); PG8_BAR; PG8_MMA(1, 0, At, B0); PG8_MMA(1, 1, At, B1); PG8_BAR; PG8_SCHED;
            } else {
            PG8_LDB(B0, 0, 0); PG8_SCHED; PG8_LDA(At, 0, 0); PG8_STAGE(PG8_SA(1, 1), a1 + hstep, voffA);
            PG8_WAIT_L(8); PG8_BAR; PG8_WAIT_L(0); PG8_MMA(0, 0, At, B0); PG8_BAR; PG8_SCHED;
            PG8_LDB(B1, 0, 1); PG8_STAGE(PG8_SB(0, 0), b2, voffB);
            PG8_BAR; PG8_WAIT_L(0); PG8_MMA(0, 1, At, B1); PG8_BAR;
            PG8_LDA(At, 0, 1); PG8_STAGE(PG8_SA(0, 0), a2, voffA);
            PG8_BAR; PG8_WAIT_L(0); PG8_MMA(1, 0, At, B0); PG8_BAR; PG8_SCHED;
            PG8_STAGE(PG8_SB(0, 1), b2 + hstep, voffB);
            PG8_WAIT_V(6); PG8_BAR; PG8_MMA(1, 1, At, B1); PG8_BAR;
            PG8_LDB(B0, 1, 0); PG8_SCHED; PG8_LDA(At, 1, 0); PG8_STAGE(PG8_SA(0, 1), a2 + hstep, voffA);
            PG8_WAIT_L(8); PG8_BAR; PG8_WAIT_L(0); PG8_MMA(0, 0, At, B0); PG8_BAR; PG8_SCHED;
            PG8_LDB(B1, 1, 1); PG8_STAGE(PG8_SB(1, 0), b3, voffB);
            PG8_BAR; PG8_WAIT_L(0); PG8_MMA(0, 1, At, B1); PG8_BAR;
            PG8_LDA(At, 1, 1); PG8_STAGE(PG8_SA(1, 0), a3, voffA);
            PG8_BAR; PG8_WAIT_L(0); PG8_MMA(1, 0, At, B0); PG8_BAR; PG8_SCHED;
            PG8_STAGE(PG8_SB(1, 1), b3 + hstep, voffB);
            PG8_WAIT_V(6); PG8_BAR; PG8_MMA(1, 1, At, B1); PG8_BAR;
            }
        }
        if constexpr (ALIGN_EPI) { if (wr == 0) PG8_BAR; }
        if constexpr (!Epi::AFTER_DRAIN) { E(acc, cur, wr, wc, fr, fq); S.done(cur); }
        if (!has_next) break;
#pragma unroll
        for (int a = 0; a < 2; ++a)
#pragma unroll
            for (int b = 0; b < 2; ++b)
#pragma unroll
                for (int m = 0; m < 4; ++m)
#pragma unroll
                    for (int n = 0; n < 2; ++n) acc[a][b][m][n] = (f32x4){0.f, 0.f, 0.f, 0.f};
        cur = nxt; cA = nA; cB = nB; ++ui;
        if constexpr (ALIGN_EPI) { if (wr == 1) PG8_BAR; }
    }
    PG8_WAIT_V(0);
    if constexpr (!ALIGN_EPI) { if (wr == 0) PG8_BAR; }
    PG8_BAR;
    if constexpr (Epi::AFTER_DRAIN) { E.fused(acc, cur, wr, wc, fr, fq, lds, wid, lane); S.done(cur); }
#undef PG8_SA
#undef PG8_SB
#undef PG8_STAGE
#undef PG8_LDA
#undef PG8_LDB
#undef PG8_MMA
#undef PG8_WAIT_V
#undef PG8_WAIT_L
#undef PG8_BAR
#undef PG8_SCHED
}
}
#define LAS __attribute__((address_space(3)))
typedef float f32x4 __attribute__((ext_vector_type(4)));
struct Ctx { int tid, lane, wave, bid, nb, gw, ngw; unsigned char* lds; };

namespace nv {
__device__ __forceinline__ void d_cvt_bf16(const Ctx& c, const float* __restrict__ in, bf16* __restrict__ out, size_t n4) {
    for (size_t i = (size_t)c.bid * 512 + c.tid; i < n4; i += (size_t)c.nb * 512) { f32x4 v = ((const f32x4*)in)[i]; uint2 o; o.x = pk2bf(v.x, v.y); o.y = pk2bf(v.z, v.w); ((uint2*)out)[i] = o; }
}
__device__ __forceinline__ void d_transpose_w(const Ctx& c, const float* __restrict__ W, int K, int N, int Npad, bf16* __restrict__ WT) {
    float* t = (float*)(c.lds) + c.wave * (32 * 33);
    const int tx = c.lane & 31, ty = c.lane >> 5, nbn = Npad / 32, ntile = nbn * (K / 32);
    for (int it = c.gw; it < ntile; it += c.ngw) {
        const int n0 = (it % nbn) * 32, k0 = (it / nbn) * 32;
        for (int i = ty; i < 32; i += 2) { const int n = n0 + tx; t[i * 33 + tx] = (n < N) ? W[(size_t)(k0 + i) * N + n] : 0.f; }
        __builtin_amdgcn_fence(__ATOMIC_RELEASE, "workgroup"); __builtin_amdgcn_wave_barrier();
        for (int i = ty; i < 32; i += 2) WT[(size_t)(n0 + i) * K + k0 + tx] = f2bf(t[tx * 33 + i]);
        __builtin_amdgcn_fence(__ATOMIC_RELEASE, "workgroup"); __builtin_amdgcn_wave_barrier();
    }
}
__device__ __forceinline__ void d_rope_table(const Ctx& c, float2* __restrict__ tab) {
    for (int id = c.bid * 512 + c.tid; id < SEQ * 32; id += c.nb * 512) {
        const int pos = id >> 5, i = id & 31;
        const float inv = (float)pow(10000.0, -(double)i / 32.0);
        const float ang = (float)pos * inv;
        tab[id] = make_float2((float)cos((double)ang), (float)sin((double)ang));
    }
}
__device__ __forceinline__ void d_rotary(const Ctx& c, const bf16* __restrict__ proj, const float2* __restrict__ tab, bf16* __restrict__ qr, bf16* __restrict__ kr) {
    for (size_t id = (size_t)c.bid * 512 + c.tid; id < (size_t)NTOK * 320; id += (size_t)c.nb * 512) {
        const int d = id & 31, hh = (id >> 5) % 10; const size_t t = id / 320; const int pos = (int)(t % SEQ);
        const float2 cs = tab[pos * 32 + d];
        const bf16* src = proj + t * IN_PAD + hh * 64;
        const float t1 = bf2f(src[d]), t2 = bf2f(src[d + 32]);
        const float o1 = t1 * cs.x - t2 * cs.y, o2 = t2 * cs.x + t1 * cs.y;
        bf16* dst = (hh < 8) ? (qr + t * 512 + hh * 64) : (kr + t * 128 + (hh - 8) * 64);
        dst[d] = f2bf(o1); dst[d + 32] = f2bf(o2);
    }
}
__device__ __forceinline__ void d_attn(const Ctx& c, const bf16* __restrict__ qr, const bf16* __restrict__ kr, const bf16* __restrict__ proj, const float* __restrict__ sink, bf16* __restrict__ mix) {
    for (int id = c.bid * 512 + c.tid; id < NTOK * 8; id += c.nb * 512) {
        const int hq = id & 7, t = id >> 3, b = t / SEQ, i = t % SEQ, kvh = hq >> 2;
        float q[64], acc[64];
#pragma unroll
        for (int d = 0; d < 64; ++d) { q[d] = bf2f(qr[(size_t)t * 512 + hq * 64 + d]) * 0.125f; acc[d] = 0.f; }
        float m = sink[hq], l = 1.f;
        const int j0 = max(0, i - 128), j1 = min(SEQ - 1, i + 128);
        for (int j = j0; j <= j1; ++j) {
            const size_t tj = (size_t)b * SEQ + j;
            const uint4* kp = (const uint4*)(kr + tj * 128 + kvh * 64);
            float s = 0.f;
#pragma unroll
            for (int cc = 0; cc < 8; ++cc) { const uint4 w = kp[cc]; const unsigned ww[4] = {w.x, w.y, w.z, w.w};
#pragma unroll
                for (int e = 0; e < 4; ++e) { s += q[cc * 8 + 2 * e] * __uint_as_float(ww[e] << 16) + q[cc * 8 + 2 * e + 1] * __uint_as_float(ww[e] & 0xffff0000u); } }
            if (s > m) { const float f = __expf(m - s); l *= f;
#pragma unroll
                for (int d = 0; d < 64; ++d) acc[d] *= f;
                m = s; }
            const float p = __expf(s - m); l += p;
            const uint4* vp = (const uint4*)(proj + tj * IN_PAD + C_V + kvh * 64);
#pragma unroll
            for (int cc = 0; cc < 8; ++cc) { const uint4 w = vp[cc]; const unsigned ww[4] = {w.x, w.y, w.z, w.w};
#pragma unroll
                for (int e = 0; e < 4; ++e) { acc[cc * 8 + 2 * e] += p * __uint_as_float(ww[e] << 16); acc[cc * 8 + 2 * e + 1] += p * __uint_as_float(ww[e] & 0xffff0000u); } }
        }
        const float il = 1.f / l;
#pragma unroll
        for (int d = 0; d < 64; d += 2) *(unsigned*)(mix + (size_t)t * DM + hq * 64 + d) = pk2bf(acc[d] * il, acc[d + 1] * il);
    }
}
__device__ __forceinline__ void d_scan(const Ctx& c, const bf16* __restrict__ proj, const float* __restrict__ mu_prev, const float* __restrict__ mu_next,
                                       const float* __restrict__ w0, const float* __restrict__ w2, const float* __restrict__ a0, const float* __restrict__ a2,
                                       const float* __restrict__ k_k, const float* __restrict__ k_a, float* __restrict__ ydir) {
    if (c.wave != 0) return;
    for (int unit = c.bid; unit < 128; unit += c.nb) {
    const int b = unit >> 4, h = (unit >> 1) & 7, d = unit & 1, lane = c.lane, ch = h * 64 + lane;
    float (*sh)[64] = (float (*)[64])c.lds;
    const int colx = lane < 32 ? (P_WD + d * 32 + lane) : (P_AD + d * 32 + lane - 32);
    const int cols[4] = {P_R + ch, P_KK + ch, P_VV + ch, colx};
    float mp[4], mn[4];
#pragma unroll
    for (int q = 0; q < 4; ++q) { mp[q] = mu_prev[cols[q]]; mn[q] = mu_next[cols[q]]; }
    float* w2c = (float*)c.lds + 6 * 64 + lane; float* a2c = w2c + 32 * 64;
    for (int j = 0; j < 32; ++j) { w2c[j * 64] = w2[(size_t)(d * 32 + j) * 512 + ch]; a2c[j * 64] = a2[(size_t)(d * 32 + j) * 512 + ch]; }
    const float w0c = w0[d * 512 + ch], a0c = a0[d * 512 + ch], kkc = k_k[ch], kac = k_a[ch];
    float S[64];
#pragma unroll
    for (int k = 0; k < 64; ++k) S[k] = 0.f;
    const int sgn = d ? -1 : 1; int t = d ? SEQ - 1 : 0;
    const bf16* pb = proj + (size_t)b * SEQ * IN_PAD + C_P;
    float behind[4], cur[4], ahead[4];
#pragma unroll
    for (int q = 0; q < 4; ++q) { behind[q] = 0.f; cur[q] = bf2f(pb[(size_t)t * IN_PAD + cols[q]]); ahead[q] = bf2f(pb[(size_t)(t + sgn) * IN_PAD + cols[q]]); }
    for (int step = 0; step < SEQ; ++step, t += sgn) {
        float ahead2[4]; const int t2 = t + 2 * sgn; const bool ok2 = (t2 >= 0 && t2 < SEQ);
#pragma unroll
        for (int q = 0; q < 4; ++q) ahead2[q] = ok2 ? bf2f(pb[(size_t)t2 * IN_PAD + cols[q]]) : 0.f;
        float sv[4];
#pragma unroll
        for (int q = 0; q < 4; ++q) { const float prv = d ? ahead[q] : behind[q], nxt = d ? behind[q] : ahead[q]; sv[q] = cur[q] + mp[q] * (prv - cur[q]) + mn[q] * (nxt - cur[q]); }
        const float r = sv[0], k = sv[1], v = sv[2];
        sh[5][lane] = lane < 32 ? tanhf(sv[3]) : sv[3];
        __builtin_amdgcn_fence(__ATOMIC_RELEASE, "workgroup"); __builtin_amdgcn_wave_barrier();
        float ws = w0c, as = a0c;
#pragma unroll
        for (int j = 0; j < 32; ++j) { ws += sh[5][j] * w2c[j * 64]; as += sh[5][32 + j] * a2c[j * 64]; }
        const float nsp = -ws; const float sp = (nsp > 20.f) ? nsp : log1pf(__expf(nsp));
        const float wlog = -sp - 0.5f; const float decay = __expf(-__expf(wlog));
        const float a = sigmoidf_(as);
        float kk = k * kkc; const float ss = wave_sum(kk * kk); kk = kk * rsqrtf(fmaxf(ss, 1e-24f));
        const float kd = k * (1.f + (a - 1.f) * kac);
        sh[0][lane] = decay; sh[1][lane] = kk * a; sh[2][lane] = kd; sh[3][lane] = r; sh[4][lane] = kk;
        __builtin_amdgcn_fence(__ATOMIC_RELEASE, "workgroup"); __builtin_amdgcn_wave_barrier();
        float sa = 0.f;
#pragma unroll
        for (int q = 0; q < 64; ++q) sa -= S[q] * sh[4][q];
        float y = 0.f;
#pragma unroll
        for (int q = 0; q < 64; ++q) { S[q] = S[q] * sh[0][q] + sa * sh[1][q] + v * sh[2][q]; y += S[q] * sh[3][q]; }
        ydir[((size_t)d * NTOK + (size_t)b * SEQ + t) * 512 + ch] = y;
        __builtin_amdgcn_fence(__ATOMIC_RELEASE, "workgroup"); __builtin_amdgcn_wave_barrier();
#pragma unroll
        for (int q = 0; q < 4; ++q) { behind[q] = cur[q]; cur[q] = ahead[q]; ahead[q] = ahead2[q]; }
    }
    }
}
template <bool YSINGLE> __device__ __forceinline__ void d_rwkv_out(const Ctx& c, const bf16* __restrict__ proj, const float* __restrict__ ydir, const float* __restrict__ mu_prev, const float* __restrict__ mu_next,
                                           const float* __restrict__ a0, const float* __restrict__ a2, const float* __restrict__ g2, const float* __restrict__ k_a, const float* __restrict__ r_k,
                                           const float* __restrict__ lnx_g, const float* __restrict__ lnx_b, bf16* __restrict__ mix) {
    float* sad = (float*)c.lds; float* sgd = sad + 64; const int ch = c.tid;
    const float mpr = mu_prev[P_R + ch], mnr = mu_next[P_R + ch], mpk = mu_prev[P_KK + ch], mnk = mu_next[P_KK + ch], mpv = mu_prev[P_VV + ch], mnv = mu_next[P_VV + ch];
    const int cx = (ch < 64) ? (P_AD + ch) : (ch < 160 ? P_GD + ch - 64 : 0); const float mpx = mu_prev[cx], mnx = mu_next[cx];
    for (int t = c.bid; t < NTOK; t += c.nb) {
        const int i = t % SEQ; const bf16* p0 = proj + (size_t)t * IN_PAD + C_P;
        const bool hp = i > 0, hn = i < SEQ - 1;
#define SHF(col, mp_, mn_) ({ const float c_ = bf2f(p0[col]); const float pv_ = hp ? bf2f(p0[(col) - IN_PAD]) : 0.f, nx_ = hn ? bf2f(p0[(col) + IN_PAD]) : 0.f; c_ + (mp_) * (pv_ - c_) + (mn_) * (nx_ - c_); })
        if (ch < 64) sad[ch] = SHF(cx, mpx, mnx);
        else if (ch < 160) sgd[ch - 64] = sigmoidf_(SHF(cx, mpx, mnx));
        const float r = SHF(P_R + ch, mpr, mnr), k = SHF(P_KK + ch, mpk, mnk), v = SHF(P_VV + ch, mpv, mnv);
#undef SHF
        __syncthreads();
        asm volatile("" ::: "memory");
        float as0 = a0[ch], as1 = a0[512 + ch];
#pragma unroll 4
        for (int j = 0; j < 32; ++j) { as0 += sad[j] * a2[(size_t)j * 512 + ch]; as1 += sad[32 + j] * a2[(size_t)(32 + j) * 512 + ch]; }
        const float am = 0.5f * (sigmoidf_(as0) + sigmoidf_(as1));
        float g = 0.f;
#pragma unroll 4
        for (int j = 0; j < 96; ++j) g += sgd[j] * g2[(size_t)j * 512 + ch];
        const float y = YSINGLE ? ydir[(size_t)t * 512 + ch] : (ydir[(size_t)t * 512 + ch] + ydir[((size_t)NTOK + t) * 512 + ch]);
        const float mu = wave_sum(y) * (1.f / 64.f); const float dy = y - mu; const float var = wave_sum(dy * dy) * (1.f / 64.f);
        const float yn = dy * rsqrtf(var + GN_EPS) * lnx_g[ch] + lnx_b[ch];
        const float kmean = k * (1.f + (am - 1.f) * k_a[ch]);
        const float bonus = wave_sum(r * kmean * r_k[ch]) * v;
        mix[(size_t)t * DM + 512 + ch] = f2bf((yn + bonus) * g);
        __syncthreads();
    }
}
__device__ __forceinline__ void d_ln1(const Ctx& c, const float* y1, const float* __restrict__ g, const float* __restrict__ bta, float* h1f, bf16* __restrict__ h1b) {
    for (int row = c.gw; row < NTOK; row += c.ngw) {
        const int lane = c.lane;
        const f32x4* xr = (const f32x4*)(y1 + (size_t)row * DM) + lane;
        f32x4 v[4]; float s = 0.f;
#pragma unroll
        for (int j = 0; j < 4; ++j) { v[j] = xr[64 * j]; s += (v[j].x + v[j].y) + (v[j].z + v[j].w); }
        const float mean = wave_sum(s) * (1.f / DM); float s2 = 0.f;
#pragma unroll
        for (int j = 0; j < 4; ++j) { v[j] = v[j] - mean; s2 += (v[j].x * v[j].x + v[j].y * v[j].y) + (v[j].z * v[j].z + v[j].w * v[j].w); }
        const float rstd = rsqrtf(wave_sum(s2) * (1.f / DM) + LN_EPS);
#pragma unroll
        for (int j = 0; j < 4; ++j) { const f32x4 gg = ((const f32x4*)g)[64 * j + lane], bb = ((const f32x4*)bta)[64 * j + lane];
            const f32x4 o = v[j] * rstd * gg + bb;
            ((f32x4*)(h1f + (size_t)row * DM))[64 * j + lane] = o;
            uint2 w; w.x = pk2bf(o.x, o.y); w.y = pk2bf(o.z, o.w); ((uint2*)(h1b + (size_t)row * DM))[64 * j + lane] = w; }
    }
}
__device__ __forceinline__ void d_peer_topk(const Ctx& c, const bf16* __restrict__ qb, const float* __restrict__ keys, int* __restrict__ idx, float* __restrict__ gate) {
    float* keysT = (float*)c.lds; float* sq = keysT + 2 * 128 * 128; float* sc = sq + 256; float* s12 = sc + 256; int* i12 = (int*)(s12 + 32);
    const int tid = c.tid, lane = c.lane, wave = c.wave;
    for (int item = c.bid; item < 8 * 64; item += c.nb) {
        const int h = item & 7, grp = item >> 3;
        __syncthreads();
        for (int e = tid; e < 2 * 128 * 128; e += 512) { const int p = e >> 14, n = (e >> 7) & 127, cc = e & 127; keysT[(p * 128 + cc) * 128 + n] = keys[(size_t)h * 32768 + e]; }
        __syncthreads();
        for (int tt = 0; tt < 512; ++tt) {
            const size_t t = (size_t)grp * 512 + tt;
            if (tid < 256) sq[tid] = bf2f(qb[t * PEER_Q + h * 256 + tid]);
            __syncthreads();
            if (tid < 256) { const int p = tid >> 7, n = tid & 127; float s = 0.f; const float* kt = keysT + p * 16384 + n; const float* qq = sq + p * 128;
                for (int cc = 0; cc < 128; ++cc) s += qq[cc] * kt[cc * 128];
                sc[tid] = s; }
            __syncthreads();
            if (wave < 2) {
                float v0 = sc[wave * 128 + lane], v1 = sc[wave * 128 + 64 + lane];
                for (int r = 0; r < 16; ++r) {
                    float bv; int bi; if (v1 > v0) { bv = v1; bi = lane + 64; } else { bv = v0; bi = lane; }
#pragma unroll
                    for (int o = 1; o < 64; o <<= 1) { const float ov = __shfl_xor(bv, o); const int oi = __shfl_xor(bi, o); if (ov > bv || (ov == bv && oi < bi)) { bv = ov; bi = oi; } }
                    if (lane == 0) { s12[wave * 16 + r] = bv; i12[wave * 16 + r] = bi; }
                    if (bi == lane) v0 = -INFINITY; if (bi == lane + 64) v1 = -INFINITY;
                }
            }
            __syncthreads();
            if (wave == 0) {
                float cv[4];
#pragma unroll
                for (int j = 0; j < 4; ++j) { const int f = lane + 64 * j; cv[j] = s12[f >> 4] + s12[16 + (f & 15)]; }
                float mycs = 0.f; int myid = 0;
                for (int r = 0; r < 16; ++r) {
                    float bv = cv[0]; int bi = lane;
#pragma unroll
                    for (int j = 1; j < 4; ++j) if (cv[j] > bv) { bv = cv[j]; bi = lane + 64 * j; }
#pragma unroll
                    for (int o = 1; o < 64; o <<= 1) { const float ov = __shfl_xor(bv, o); const int oi = __shfl_xor(bi, o); if (ov > bv || (ov == bv && oi < bi)) { bv = ov; bi = oi; } }
                    if (lane == r) { mycs = bv; myid = i12[bi >> 4] * 128 + i12[16 + (bi & 15)]; }
#pragma unroll
                    for (int j = 0; j < 4; ++j) if (bi == lane + 64 * j) cv[j] = -INFINITY;
                }
                float mx = (lane < 16) ? mycs : -INFINITY;
#pragma unroll
                for (int o = 1; o < 64; o <<= 1) mx = fmaxf(mx, __shfl_xor(mx, o));
                const float e = (lane < 16) ? __expf(mycs - mx) : 0.f; const float den = wave_sum(e);
                if (lane < 16) { idx[t * 128 + h * 16 + lane] = myid; gate[t * 128 + h * 16 + lane] = e / den; }
            }
            __syncthreads();
        }
    }
}
__device__ __forceinline__ void d_peer_gather(const Ctx& c, const float* __restrict__ h1f, const int* __restrict__ idx, const float* __restrict__ gate, const float* __restrict__ u, const float* __restrict__ v,
                                              const float* __restrict__ g, const float* __restrict__ bta, float* __restrict__ out) {
    const int lane = c.lane;
    for (int t = c.gw; t < NTOK; t += c.ngw) {
        f32x4 hv[4], f[4];
#pragma unroll
        for (int j = 0; j < 4; ++j) { hv[j] = ((const f32x4*)(h1f + (size_t)t * DM))[64 * j + lane]; f[j] = (f32x4){0.f, 0.f, 0.f, 0.f}; }
        for (int e = 0; e < 128; ++e) {
            const int id = idx[(size_t)t * 128 + e]; const float gt = gate[(size_t)t * 128 + e];
            const f32x4* ur = (const f32x4*)(u + (size_t)id * DM); const f32x4* vr = (const f32x4*)(v + (size_t)id * DM);
            float z = 0.f;
#pragma unroll
            for (int j = 0; j < 4; ++j) { const f32x4 w = ur[64 * j + lane]; z += (w.x * hv[j].x + w.y * hv[j].y) + (w.z * hv[j].z + w.w * hv[j].w); }
            z = wave_sum(z);
            const float act = gt * 0.5f * z * (1.f + erff(z * 0.70710678118654752f));
#pragma unroll
            for (int j = 0; j < 4; ++j) { const f32x4 w = vr[64 * j + lane]; f[j] += act * w; }
        }
        float s = 0.f;
#pragma unroll
        for (int j = 0; j < 4; ++j) { f[j] = DN_ALPHA * hv[j] + f[j]; s += (f[j].x + f[j].y) + (f[j].z + f[j].w); }
        const float mean = wave_sum(s) * (1.f / DM); float s2 = 0.f;
#pragma unroll
        for (int j = 0; j < 4; ++j) { f[j] = f[j] - mean; s2 += (f[j].x * f[j].x + f[j].y * f[j].y) + (f[j].z * f[j].z + f[j].w * f[j].w); }
        const float rstd = rsqrtf(wave_sum(s2) * (1.f / DM) + LN_EPS);
#pragma unroll
        for (int j = 0; j < 4; ++j) { const f32x4 gg = ((const f32x4*)g)[64 * j + lane], bb = ((const f32x4*)bta)[64 * j + lane];
            ((f32x4*)(out + (size_t)t * DM))[64 * j + lane] = f[j] * rstd * gg + bb; }
    }
}
}
namespace pe {
typedef __bf16 bf16x2_t __attribute__((ext_vector_type(2)));
__device__ __forceinline__ float dot2(unsigned a, unsigned b, float c) { return __builtin_amdgcn_fdot2_f32_bf16(__builtin_bit_cast(bf16x2_t, a), __builtin_bit_cast(bf16x2_t, b), c, false); }
__device__ __forceinline__ float gelu_erf(float z) { return 0.5f * z * (1.f + erff(z * 0.70710678118654752f)); }
constexpr int GE = 4;
struct Rows { uint4 a[GE], b[GE]; };
__device__ __forceinline__ void load_rows(Rows& r, const bf16* __restrict__ tab, int i0, int i1, int lane, int g) {
#pragma unroll
    for (int j = 0; j < GE; ++j) { const int e = g * GE + j; const int id = __builtin_amdgcn_readlane((e & 64) ? i1 : i0, e & 63);
        const uint4* p = (const uint4*)(tab + (size_t)id * DM) + lane; r.a[j] = p[0]; r.b[j] = p[64]; }
}
__device__ __forceinline__ void d_peer_gather(const Ctx& c, const bf16* __restrict__ h1b, const int* __restrict__ idx, const float* __restrict__ gate, const bf16* __restrict__ ub, const bf16* __restrict__ vb,
                                              const float* __restrict__ g, const float* __restrict__ bta, float* __restrict__ out) {
    const int lane = c.lane;
    for (int t = c.gw; t < NTOK; t += c.ngw) {
        const uint4* hp = (const uint4*)(h1b + (size_t)t * DM) + lane; const uint4 h0 = hp[0], h1 = hp[64];
        const unsigned hw[8] = {h0.x, h0.y, h0.z, h0.w, h1.x, h1.y, h1.z, h1.w};
        const int i0 = idx[(size_t)t * 128 + lane], i1 = idx[(size_t)t * 128 + 64 + lane];
        const float g0 = gate[(size_t)t * 128 + lane], g1 = gate[(size_t)t * 128 + 64 + lane];
        float f[16];
#pragma unroll
        for (int i = 0; i < 16; ++i) f[i] = 0.f;
        Rows U, V, Un;
        load_rows(U, ub, i0, i1, lane, 0);
        for (int grp = 0; grp < 128 / GE; ++grp) {
            load_rows(V, vb, i0, i1, lane, grp);
            if (grp + 1 < 128 / GE) load_rows(Un, ub, i0, i1, lane, grp + 1);
            float z[GE];
#pragma unroll
            for (int j = 0; j < GE; ++j) { const unsigned uw[8] = {U.a[j].x, U.a[j].y, U.a[j].z, U.a[j].w, U.b[j].x, U.b[j].y, U.b[j].z, U.b[j].w}; float s = 0.f;
#pragma unroll
                for (int i = 0; i < 8; ++i) s = dot2(uw[i], hw[i], s);
                z[j] = s; }
            { const bool b0 = lane & 1; float k0 = b0 ? z[1] : z[0], s0 = b0 ? z[0] : z[1], k1 = b0 ? z[3] : z[2], s1 = b0 ? z[2] : z[3];
              k0 += __shfl_xor(s0, 1); k1 += __shfl_xor(s1, 1);
              const bool b1 = lane & 2; float kk = b1 ? k1 : k0, ss = b1 ? k0 : k1; kk += __shfl_xor(ss, 2);
              kk += __shfl_xor(kk, 4); kk += __shfl_xor(kk, 8); kk += __shfl_xor(kk, 16); kk += __shfl_xor(kk, 32);
              z[0] = kk; }
            const int e_me = grp * GE + (lane & 3);
            const float gt = __shfl((e_me & 64) ? g1 : g0, e_me & 63);
            const float act = gt * gelu_erf(z[0]);
            const unsigned actb = (unsigned)f2bf(act);
#pragma unroll
            for (int j = 0; j < GE; ++j) { const unsigned alo = __builtin_amdgcn_readlane(actb, j), ahi = alo << 16;
                const unsigned vw[8] = {V.a[j].x, V.a[j].y, V.a[j].z, V.a[j].w, V.b[j].x, V.b[j].y, V.b[j].z, V.b[j].w};
#pragma unroll
                for (int i = 0; i < 8; ++i) { f[2 * i] = dot2(vw[i], alo, f[2 * i]); f[2 * i + 1] = dot2(vw[i], ahi, f[2 * i + 1]); } }
            U = Un;
        }
        float s = 0.f;
#pragma unroll
        for (int i = 0; i < 8; ++i) { f[2 * i] += DN_ALPHA * __uint_as_float(hw[i] << 16); f[2 * i + 1] += DN_ALPHA * __uint_as_float(hw[i] & 0xffff0000u); s += f[2 * i] + f[2 * i + 1]; }
        const float mean = wave_sum(s) * (1.f / DM); float s2 = 0.f;
#pragma unroll
        for (int i = 0; i < 16; ++i) { f[i] -= mean; s2 += f[i] * f[i]; }
        const float rstd = rsqrtf(wave_sum(s2) * (1.f / DM) + LN_EPS);
#pragma unroll
        for (int hh = 0; hh < 2; ++hh) {
            const int e0 = hh * 512 + 8 * lane;
            const f32x4 ga = *(const f32x4*)(g + e0), gb = *(const f32x4*)(g + e0 + 4), ba = *(const f32x4*)(bta + e0), bb = *(const f32x4*)(bta + e0 + 4);
            f32x4 oa, ob;
            oa.x = f[hh * 8 + 0] * rstd * ga.x + ba.x; oa.y = f[hh * 8 + 1] * rstd * ga.y + ba.y; oa.z = f[hh * 8 + 2] * rstd * ga.z + ba.z; oa.w = f[hh * 8 + 3] * rstd * ga.w + ba.w;
            ob.x = f[hh * 8 + 4] * rstd * gb.x + bb.x; ob.y = f[hh * 8 + 5] * rstd * gb.y + bb.y; ob.z = f[hh * 8 + 6] * rstd * gb.z + bb.z; ob.w = f[hh * 8 + 7] * rstd * gb.w + bb.w;
            *(f32x4*)(out + (size_t)t * DM + e0) = oa; *(f32x4*)(out + (size_t)t * DM + e0 + 4) = ob;
        }
    }
}
}
namespace pe8 {
typedef float f32x2 __attribute__((ext_vector_type(2)));
__device__ __forceinline__ void d_quant_tables(const Ctx& c, const float* __restrict__ u, const float* __restrict__ v, unsigned* __restrict__ u8, unsigned* __restrict__ v8, float* __restrict__ su, float* __restrict__ sv) {
    const int lane = c.lane;
    for (int r = c.gw; r < 2 * NEXP; r += c.ngw) {
        const bool isv = r >= NEXP; const int row = isv ? r - NEXP : r;
        const f32x4* src = (const f32x4*)((isv ? v : u) + (size_t)row * DM) + lane;
        f32x4 x[4]; float am = 0.f;
#pragma unroll
        for (int j = 0; j < 4; ++j) { x[j] = src[64 * j]; am = fmaxf(am, fmaxf(fmaxf(fabsf(x[j].x), fabsf(x[j].y)), fmaxf(fabsf(x[j].z), fabsf(x[j].w)))); }
#pragma unroll
        for (int o = 1; o < 64; o <<= 1) am = fmaxf(am, __shfl_xor(am, o));
        am = fmaxf(am, 1e-30f);
        if (!isv) { const float sc = am * (1.f / 127.f), is = 127.f / am;
#pragma unroll
            for (int j = 0; j < 4; ++j) { const int a = (int)rintf(x[j].x * is), b = (int)rintf(x[j].y * is), cc = (int)rintf(x[j].z * is), d = (int)rintf(x[j].w * is);
                u8[(size_t)row * 256 + 64 * j + lane] = (unsigned)(a & 255) | ((unsigned)(b & 255) << 8) | ((unsigned)(cc & 255) << 16) | ((unsigned)(d & 255) << 24); }
            if (lane == 0) su[row] = sc; }
        else { const float sc = am * (1.f / 440.f), is = 440.f / am;
#pragma unroll
            for (int j = 0; j < 4; ++j) { int w = 0; w = __builtin_amdgcn_cvt_pk_fp8_f32(x[j].x * is, x[j].y * is, w, false); w = __builtin_amdgcn_cvt_pk_fp8_f32(x[j].z * is, x[j].w * is, w, true);
                v8[(size_t)row * 256 + 64 * j + lane] = (unsigned)w; }
            if (lane == 0) sv[row] = sc; }
    }
}
constexpr int GE = 8;
struct Rows { uint4 a[GE]; };
__device__ __forceinline__ void load_rows(Rows& r, const unsigned* __restrict__ tab, int i0, int i1, int lane, int g) {
#pragma unroll
    for (int j = 0; j < GE; ++j) { const int e = g * GE + j; const int id = __builtin_amdgcn_readlane((e & 64) ? i1 : i0, e & 63); r.a[j] = *((const uint4*)(tab + (size_t)id * 256) + lane); }
}
__device__ __forceinline__ void d_peer_gather(const Ctx& c, const bf16* __restrict__ h1b, const int* __restrict__ idx, const float* __restrict__ gate, const unsigned* __restrict__ u8, const unsigned* __restrict__ v8,
                                              const float* __restrict__ su, const float* __restrict__ sv, const float* __restrict__ g, const float* __restrict__ bta, float* __restrict__ out) {
    const int lane = c.lane;
    for (int t = c.gw; t < NTOK; t += c.ngw) {
        const uint4* hp = (const uint4*)(h1b + (size_t)t * DM) + 2 * lane; const uint4 ha = hp[0], hb = hp[1];
        const unsigned hw[8] = {ha.x, ha.y, ha.z, ha.w, hb.x, hb.y, hb.z, hb.w};
        float hf[16]; float am = 0.f;
#pragma unroll
        for (int i = 0; i < 8; ++i) { hf[2 * i] = __uint_as_float(hw[i] << 16); hf[2 * i + 1] = __uint_as_float(hw[i] & 0xffff0000u); am = fmaxf(am, fmaxf(fabsf(hf[2 * i]), fabsf(hf[2 * i + 1]))); }
#pragma unroll
        for (int o = 1; o < 64; o <<= 1) am = fmaxf(am, __shfl_xor(am, o));
        am = fmaxf(am, 1e-30f);
        const float sh = am * (1.f / 127.f), ish = 127.f / am;
        int hq[4];
#pragma unroll
        for (int w = 0; w < 4; ++w) { const int a = (int)rintf(hf[4 * w] * ish), b = (int)rintf(hf[4 * w + 1] * ish), cc = (int)rintf(hf[4 * w + 2] * ish), d = (int)rintf(hf[4 * w + 3] * ish);
            hq[w] = (int)((unsigned)(a & 255) | ((unsigned)(b & 255) << 8) | ((unsigned)(cc & 255) << 16) | ((unsigned)(d & 255) << 24)); }
        const int i0 = idx[(size_t)t * 128 + lane], i1 = idx[(size_t)t * 128 + 64 + lane];
        const float g0 = gate[(size_t)t * 128 + lane], g1 = gate[(size_t)t * 128 + 64 + lane];
        float f[16];
#pragma unroll
        for (int i = 0; i < 16; ++i) f[i] = 0.f;
        Rows U, V, Un;
        load_rows(U, u8, i0, i1, lane, 0);
        float sun, svn;
        { const int e_me = lane & 7; const int id = __shfl((e_me & 64) ? i1 : i0, e_me & 63); sun = su[id]; svn = sv[id]; }
#pragma unroll 1
        for (int grp = 0; grp < 128 / GE; ++grp) {
            load_rows(V, v8, i0, i1, lane, grp);
            const float suc = sun, svc = svn;
            if (grp + 1 < 128 / GE) { load_rows(Un, u8, i0, i1, lane, grp + 1); const int e_n = (grp + 1) * GE + (lane & 7); const int id = __shfl((e_n & 64) ? i1 : i0, e_n & 63); sun = su[id]; svn = sv[id]; }
            int z[GE];
#pragma unroll
            for (int j = 0; j < GE; ++j) { int s = __builtin_amdgcn_sdot4((int)U.a[j].x, hq[0], 0, false); s = __builtin_amdgcn_sdot4((int)U.a[j].y, hq[1], s, false);
                s = __builtin_amdgcn_sdot4((int)U.a[j].z, hq[2], s, false); s = __builtin_amdgcn_sdot4((int)U.a[j].w, hq[3], s, false); z[j] = s; }
            int zz;
            { const bool b0 = lane & 1, b1 = lane & 2, b2 = lane & 4;
              int k0 = b0 ? z[1] : z[0], s0 = b0 ? z[0] : z[1], k1 = b0 ? z[3] : z[2], s1 = b0 ? z[2] : z[3], k2 = b0 ? z[5] : z[4], s2 = b0 ? z[4] : z[5], k3 = b0 ? z[7] : z[6], s3 = b0 ? z[6] : z[7];
              k0 += __shfl_xor(s0, 1); k1 += __shfl_xor(s1, 1); k2 += __shfl_xor(s2, 1); k3 += __shfl_xor(s3, 1);
              int m0 = b1 ? k1 : k0, t0_ = b1 ? k0 : k1, m1 = b1 ? k3 : k2, t1_ = b1 ? k2 : k3;
              m0 += __shfl_xor(t0_, 2); m1 += __shfl_xor(t1_, 2);
              int q0 = b2 ? m1 : m0, r0 = b2 ? m0 : m1; q0 += __shfl_xor(r0, 4);
              q0 += __shfl_xor(q0, 8); q0 += __shfl_xor(q0, 16); q0 += __shfl_xor(q0, 32); zz = q0; }
            const int e_me = grp * GE + (lane & 7);
            const float gt = __shfl((e_me & 64) ? g1 : g0, e_me & 63);
            const float zf = (float)zz * sh * suc;
            const float act = gt * pe::gelu_erf(zf) * svc;
#pragma unroll
            for (int j = 0; j < GE; ++j) { const float aj = __uint_as_float(__builtin_amdgcn_readlane(__float_as_uint(act), j));
                const unsigned vw[4] = {V.a[j].x, V.a[j].y, V.a[j].z, V.a[j].w};
#pragma unroll
                for (int w = 0; w < 4; ++w) { const f32x2 lo = __builtin_amdgcn_cvt_pk_f32_fp8((int)vw[w], false), hi = __builtin_amdgcn_cvt_pk_f32_fp8((int)vw[w], true);
                    f[4 * w] += aj * lo.x; f[4 * w + 1] += aj * lo.y; f[4 * w + 2] += aj * hi.x; f[4 * w + 3] += aj * hi.y; }
                __builtin_amdgcn_sched_barrier(0); }
            U = Un;
        }
        float s = 0.f;
#pragma unroll
        for (int i = 0; i < 16; ++i) { f[i] += DN_ALPHA * hf[i]; s += f[i]; }
        const float mean = wave_sum(s) * (1.f / DM); float s2 = 0.f;
#pragma unroll
        for (int i = 0; i < 16; ++i) { f[i] -= mean; s2 += f[i] * f[i]; }
        const float rstd = rsqrtf(wave_sum(s2) * (1.f / DM) + LN_EPS);
        const int e0 = 16 * lane;
#pragma unroll
        for (int q = 0; q < 4; ++q) { const f32x4 ga = *(const f32x4*)(g + e0 + 4 * q), ba = *(const f32x4*)(bta + e0 + 4 * q); f32x4 o;
            o.x = f[4 * q] * rstd * ga.x + ba.x; o.y = f[4 * q + 1] * rstd * ga.y + ba.y; o.z = f[4 * q + 2] * rstd * ga.z + ba.z; o.w = f[4 * q + 3] * rstd * ga.w + ba.w;
            *(f32x4*)(out + (size_t)t * DM + e0 + 4 * q) = o; }
    }
}
}
namespace rw {
typedef short bf16x8 __attribute__((ext_vector_type(8)));
typedef short s16x4 __attribute__((ext_vector_type(4)));
typedef float f32x16 __attribute__((ext_vector_type(16)));
typedef float f32x2_t __attribute__((ext_vector_type(2)));
typedef __bf16 bf16x2_t __attribute__((ext_vector_type(2)));
typedef unsigned u32x4 __attribute__((ext_vector_type(4)));
typedef unsigned u32x2 __attribute__((ext_vector_type(2)));
typedef LAS unsigned char* lptr;
#define MFMA32(a, b, c) __builtin_amdgcn_mfma_f32_32x32x16_bf16((a), (b), (c), 0, 0, 0)
#define DI __device__ __forceinline__
constexpr int UNIT_BYTES = 10 * 2048;
constexpr int STG_STRIDE = 392;
constexpr int CST_OFF = 131072, GC_OFF = 131072 + 4096;

DI int crow(int i, int h) { return (i & 3) + 8 * (i >> 2) + 4 * h; }
DI unsigned cvtpk(float lo, float hi) { f32x2_t v = {lo, hi}; bf16x2_t b = __builtin_convertvector(v, bf16x2_t); return __builtin_bit_cast(unsigned, b); }
DI bf16x8 pack(const f32x16& x, int s) { u32x4 p; p[0] = cvtpk(x[8 * s], x[8 * s + 1]); p[1] = cvtpk(x[8 * s + 2], x[8 * s + 3]); p[2] = cvtpk(x[8 * s + 4], x[8 * s + 5]); p[3] = cvtpk(x[8 * s + 6], x[8 * s + 7]); return __builtin_bit_cast(bf16x8, p); }
DI bf16x8 frag4(unsigned a, unsigned b, unsigned c, unsigned d) { u32x4 p = {a, b, c, d}; return __builtin_bit_cast(bf16x8, p); }
DI float lo_f(unsigned w) { return __uint_as_float(w << 16); }
DI float hi_f(unsigned w) { return __uint_as_float(w & 0xffff0000u); }
DI int img_off(int row, int slot) { return row * 128 + ((slot ^ ((((row >> 1) & 1) << 3) | ((row >> 2) & 3))) << 3); }
DI s16x4 tr_read(lptr p) { return __builtin_bit_cast(s16x4, __builtin_amdgcn_ds_read_tr16_b64_v4i16((LAS s16x4*)p)); }
DI bf16x8 trfrag(lptr img, int tau, int s, int lane) {
    const int h = lane >> 5, gg = (lane >> 4) & 1, l16 = lane & 15, q = l16 >> 2, p = l16 & 3, slot = 8 * tau + 4 * gg + p, r0 = 16 * s + 4 * h + q;
    const s16x4 lo = tr_read(img + img_off(r0, slot)), hi = tr_read(img + img_off(r0 + 8, slot));
    return __builtin_shufflevector(lo, hi, 0, 1, 2, 3, 4, 5, 6, 7);
}
template <int CTRL, int RMASK> DI float dpp0(float x) { return __uint_as_float(__builtin_amdgcn_update_dpp(0u, __float_as_uint(x), CTRL, RMASK, 0xf, false)); }
DI float prefix32(float x) {
    x += dpp0<0x111, 0xf>(x); x += dpp0<0x112, 0xf>(x); x += dpp0<0x114, 0xf>(x); x += dpp0<0x118, 0xf>(x);
    x += dpp0<0x142, 0xa>(x);
    return x;
}
DI float fsig(float x) { return __builtin_amdgcn_rcpf(1.f + __expf(-x)); }
DI void store_tile(unsigned char* dst, const f32x16& x, int lane) {
    u32x4 a, b; a[0] = cvtpk(x[0], x[1]); a[1] = cvtpk(x[2], x[3]); a[2] = cvtpk(x[4], x[5]); a[3] = cvtpk(x[6], x[7]);
    b[0] = cvtpk(x[8], x[9]); b[1] = cvtpk(x[10], x[11]); b[2] = cvtpk(x[12], x[13]); b[3] = cvtpk(x[14], x[15]);
    u32x4* d = (u32x4*)(dst + lane * 32); d[0] = a; d[1] = b;
}

DI void d_lowrank_t(const Ctx& c, const float* __restrict__ w2, const float* __restrict__ a2, bf16* __restrict__ w2t, bf16* __restrict__ a2t) {
    for (int id = c.bid * 512 + c.tid; id < 2 * 512 * 32; id += c.nb * 512) { const int j = id & 31, ch = (id >> 5) & 511, d = id >> 14;
        w2t[id] = f2bf(w2[(size_t)(d * 32 + j) * 512 + ch]); a2t[id] = f2bf(a2[(size_t)(d * 32 + j) * 512 + ch]); }
}

DI void d_g2_t(const Ctx& c, const float* __restrict__ g2, bf16* __restrict__ g2t) {
    for (int id = c.bid * 512 + c.tid; id < 512 * 96; id += c.nb * 512) { const int j = id % 96, ch = id / 96; g2t[id] = f2bf(g2[(size_t)j * 512 + ch]); }
}
constexpr int O_MPV = 0, O_MNV = 512, O_LG = 1024, O_LB = 1536, O_MPG = 2048, O_MNG = 2144, O_A0 = 2240, O_KA = 3264, O_RK = 3776, O_MPR = 4288, O_MNR = 4800, O_MPK = 5312, O_MNK = 5824, O_MPA = 6336, O_MNA = 6400, O_END = 6464;
DI void d_out(const Ctx& c, const bf16* __restrict__ proj_, const float* __restrict__ ybuf_, const float* __restrict__ mu_prev, const float* __restrict__ mu_next,
              const float* __restrict__ a0, const float* __restrict__ k_a, const float* __restrict__ r_k, const bf16* __restrict__ a2t_, const bf16* __restrict__ g2t_,
              const float* __restrict__ lnx_g, const float* __restrict__ lnx_b, bf16* __restrict__ mix_) {
    const int lane0 = c.lane;
    LAS float* cs0 = (LAS float*)((lptr)c.lds);
    __syncthreads();
    for (int i = c.tid; i < O_END; i += 512) { float v;
        if (i < O_MNV) v = mu_prev[P_VV + i]; else if (i < O_LG) v = mu_next[P_VV + i - O_MNV]; else if (i < O_LB) v = lnx_g[i - O_LG]; else if (i < O_MPG) v = lnx_b[i - O_LB];
        else if (i < O_MNG) v = mu_prev[P_GD + i - O_MPG]; else if (i < O_A0) v = mu_next[P_GD + i - O_MNG]; else if (i < O_KA) v = a0[i - O_A0]; else if (i < O_RK) v = k_a[i - O_KA];
        else if (i < O_MPR) v = r_k[i - O_RK]; else if (i < O_MNR) v = mu_prev[P_R + i - O_MPR]; else if (i < O_MPK) v = mu_next[P_R + i - O_MNR]; else if (i < O_MNK) v = mu_prev[P_KK + i - O_MPK];
        else if (i < O_MPA) v = mu_next[P_KK + i - O_MNK]; else if (i < O_MNA) v = mu_prev[P_AD + i - O_MPA]; else v = mu_next[P_AD + i - O_MNA];
        cs0[i] = v; }
    if (c.tid == 0) { LAS unsigned long long* pp_ = (LAS unsigned long long*)(cs0 + O_END); pp_[0] = (unsigned long long)proj_; pp_[1] = (unsigned long long)ybuf_; pp_[2] = (unsigned long long)mix_; pp_[3] = (unsigned long long)a2t_; pp_[4] = (unsigned long long)g2t_; }
    __syncthreads();
    for (int wt = c.gw; wt < (NTOK / 32) * 2; wt += c.ngw) {
        int lane = lane0; asm volatile("" : "+v"(lane));
        const int n = lane & 31, hh = lane >> 5;
        LAS float* cs = cs0 + (lane - lane0);
        const LAS unsigned long long* pl_ = (const LAS unsigned long long*)(cs + O_END);
        const bf16* proj = (const bf16*)pl_[0]; const float* ybuf = (const float*)pl_[1]; bf16* mix = (bf16*)pl_[2]; const bf16* a2t = (const bf16*)pl_[3]; const bf16* g2t = (const bf16*)pl_[4];
        const int tile = wt >> 1, hg = wt & 1, t0 = tile * 32, tg = t0 + n, ti = tg % SEQ;
        const bool hp = ti > 0, hn = ti < SEQ - 1; const int po = hp ? IN_PAD : 0, no_ = hn ? IN_PAD : 0;
        const bf16* prow = proj + (size_t)tg * IN_PAD + C_P;
        bf16x8 sgf[6], adf[4];
#pragma unroll
        for (int ks = 0; ks < 10; ++ks) { const int col = ks < 6 ? P_GD + 16 * ks + 8 * hh : P_AD + 16 * (ks - 6) + 8 * hh; const int mo = ks < 6 ? O_MPG + 16 * ks + 8 * hh : O_MPA + 16 * (ks - 6) + 8 * hh, no = ks < 6 ? mo + 96 : mo + 64;
            const bf16* pc_ = prow + col;
            const u32x4 cc = *(const u32x4*)pc_, pp = *(const u32x4*)(pc_ - po), nn = *(const u32x4*)(pc_ + no_);
            const unsigned cw[4] = {cc[0], cc[1], cc[2], cc[3]}, pw[4] = {hp ? pp[0] : 0u, hp ? pp[1] : 0u, hp ? pp[2] : 0u, hp ? pp[3] : 0u}, nw[4] = {hn ? nn[0] : 0u, hn ? nn[1] : 0u, hn ? nn[2] : 0u, hn ? nn[3] : 0u}; unsigned o[4];
#pragma unroll
            for (int e = 0; e < 4; ++e) { const float c0 = lo_f(cw[e]), c1 = hi_f(cw[e]);
                float x0 = c0 + cs[mo + 2 * e] * (lo_f(pw[e]) - c0) + cs[no + 2 * e] * (lo_f(nw[e]) - c0), x1 = c1 + cs[mo + 2 * e + 1] * (hi_f(pw[e]) - c1) + cs[no + 2 * e + 1] * (hi_f(nw[e]) - c1);
                if (ks < 6) { x0 = fsig(x0); x1 = fsig(x1); }
                o[e] = cvtpk(x0, x1); }
            if (ks < 6) sgf[ks] = frag4(o[0], o[1], o[2], o[3]); else adf[ks - 6] = frag4(o[0], o[1], o[2], o[3]);
            __builtin_amdgcn_sched_barrier(0); }
#pragma unroll 1
        for (int hq = 0; hq < 4; ++hq) {
            const int hd = hg * 4 + hq;
            float bs = 0.f;
#pragma unroll
            for (int ct = 0; ct < 2; ++ct) {
                f32x16 a0t = {0.f}, a1t = {0.f}; const int chrow = 64 * hd + 32 * ct + n;
                const bf16* ar0 = a2t + (size_t)chrow * 32 + 8 * hh; const bf16* ar1 = a2t + (size_t)(512 + chrow) * 32 + 8 * hh;
                a0t = MFMA32(*(const bf16x8*)ar0, adf[0], a0t); a0t = MFMA32(*(const bf16x8*)(ar0 + 16), adf[1], a0t);
                a1t = MFMA32(*(const bf16x8*)ar1, adf[2], a1t); a1t = MFMA32(*(const bf16x8*)(ar1 + 16), adf[3], a1t);
#pragma unroll
                for (int q = 0; q < 4; ++q) { const int ch = 64 * hd + 32 * ct + 8 * q + 4 * hh; const bf16* rp_ = prow + P_R + ch; const bf16* kp_ = prow + P_KK + ch; const u32x2 z2 = {0u, 0u};
                    const u32x2 rc = *(const u32x2*)rp_; u32x2 rpv = *(const u32x2*)(rp_ - po), rnx = *(const u32x2*)(rp_ + no_); rpv = hp ? rpv : z2; rnx = hn ? rnx : z2;
                    const u32x2 kc = *(const u32x2*)kp_; u32x2 kpv = *(const u32x2*)(kp_ - po), knx = *(const u32x2*)(kp_ + no_); kpv = hp ? kpv : z2; knx = hn ? knx : z2;
                    const float rcf[4] = {lo_f(rc.x), hi_f(rc.x), lo_f(rc.y), hi_f(rc.y)}, rpf[4] = {lo_f(rpv.x), hi_f(rpv.x), lo_f(rpv.y), hi_f(rpv.y)}, rnf[4] = {lo_f(rnx.x), hi_f(rnx.x), lo_f(rnx.y), hi_f(rnx.y)};
                    const float kcf[4] = {lo_f(kc.x), hi_f(kc.x), lo_f(kc.y), hi_f(kc.y)}, kpf[4] = {lo_f(kpv.x), hi_f(kpv.x), lo_f(kpv.y), hi_f(kpv.y)}, knf[4] = {lo_f(knx.x), hi_f(knx.x), lo_f(knx.y), hi_f(knx.y)};
#pragma unroll
                    for (int e = 0; e < 4; ++e) { const int cx = ch + e;
                        const float rf = rcf[e] + cs[O_MPR + cx] * (rpf[e] - rcf[e]) + cs[O_MNR + cx] * (rnf[e] - rcf[e]);
                        const float kf = kcf[e] + cs[O_MPK + cx] * (kpf[e] - kcf[e]) + cs[O_MNK + cx] * (knf[e] - kcf[e]);
                        const float am = 0.5f * (fsig(a0t[4 * q + e] + cs[O_A0 + cx]) + fsig(a1t[4 * q + e] + cs[O_A0 + 512 + cx]));
                        bs += rf * kf * (1.f + (am - 1.f) * cs[O_KA + cx]) * cs[O_RK + cx]; }
                    __builtin_amdgcn_sched_barrier(0); }
            }
            bs += __shfl_xor(bs, 32);
            f32x16 gt[2];
#pragma unroll
            for (int ct = 0; ct < 2; ++ct) { f32x16 acc = {0.f}; const bf16* grow = g2t + (size_t)(64 * hd + 32 * ct + n) * 96 + 8 * hh;
#pragma unroll
                for (int ks = 0; ks < 6; ++ks) acc = MFMA32(*(const bf16x8*)(grow + 16 * ks), sgf[ks], acc);
                gt[ct] = acc; }
            float yv[32]; float s1 = 0.f;
#pragma unroll
            for (int ct = 0; ct < 2; ++ct)
#pragma unroll
                for (int q = 0; q < 4; ++q) { const f32x4 y4 = *(const f32x4*)(ybuf + (size_t)tg * 512 + 64 * hd + 32 * ct + 8 * q + 4 * hh);
                    yv[16 * ct + 4 * q] = y4.x; yv[16 * ct + 4 * q + 1] = y4.y; yv[16 * ct + 4 * q + 2] = y4.z; yv[16 * ct + 4 * q + 3] = y4.w; s1 += (y4.x + y4.y) + (y4.z + y4.w); }
            s1 += __shfl_xor(s1, 32);
            const float mean = s1 * (1.f / 64.f); float s2 = 0.f;
#pragma unroll
            for (int i = 0; i < 32; ++i) { yv[i] -= mean; s2 += yv[i] * yv[i]; }
            s2 += __shfl_xor(s2, 32);
            const float rstd = rsqrtf(s2 * (1.f / 64.f) + GN_EPS);
#pragma unroll
            for (int ct = 0; ct < 2; ++ct)
#pragma unroll
                for (int q = 0; q < 4; ++q) { const int ch = 64 * hd + 32 * ct + 8 * q + 4 * hh; const bf16* vp = prow + P_VV + ch;
                    const u32x2 z2 = {0u, 0u}; const u32x2 vc = *(const u32x2*)vp; u32x2 vpv = *(const u32x2*)(vp - po), vnx = *(const u32x2*)(vp + no_); vpv = hp ? vpv : z2; vnx = hn ? vnx : z2;
                    const float vcf[4] = {lo_f(vc.x), hi_f(vc.x), lo_f(vc.y), hi_f(vc.y)}, vpf[4] = {lo_f(vpv.x), hi_f(vpv.x), lo_f(vpv.y), hi_f(vpv.y)}, vnf[4] = {lo_f(vnx.x), hi_f(vnx.x), lo_f(vnx.y), hi_f(vnx.y)};
                    float o[4];
#pragma unroll
                    for (int e = 0; e < 4; ++e) { const float vf = vcf[e] + cs[O_MPV + ch + e] * (vpf[e] - vcf[e]) + cs[O_MNV + ch + e] * (vnf[e] - vcf[e]);
                        o[e] = (yv[16 * ct + 4 * q + e] * rstd * cs[O_LG + ch + e] + cs[O_LB + ch + e] + bs * vf) * gt[ct][4 * q + e]; }
                    *(u32x2*)(mix + (size_t)tg * DM + 512 + ch) = (u32x2){cvtpk(o[0], o[1]), cvtpk(o[2], o[3])}; }
            __builtin_amdgcn_sched_barrier(0);
        }
    }
}
DI void d_prep(const Ctx& c, int d, const bf16* __restrict__ proj, const float* __restrict__ mu_prev, const float* __restrict__ mu_next,
               const float* __restrict__ w0, const float* __restrict__ a0, const float* __restrict__ k_k, const float* __restrict__ k_a,
               const bf16* __restrict__ w2t, const bf16* __restrict__ a2t, unsigned char* __restrict__ UO, float* __restrict__ ybuf) {
    const int lane = c.lane, n = lane & 31, h = lane >> 5, hd = c.bid & 7;
    lptr L = (lptr)c.lds + c.wave * 16384;
    LAS float* cst = (LAS float*)((lptr)c.lds + CST_OFF);
    LAS float* gC = (LAS float*)((lptr)c.lds + GC_OFF) + c.wave * 64;
    __syncthreads();
    for (int i = c.tid; i < 768; i += 512) { float v;
        if (i < 640) { const int vec = i >> 6, ch = i & 63, gch = 64 * hd + ch;
            v = vec == 0 ? mu_prev[P_R + gch] : vec == 1 ? mu_next[P_R + gch] : vec == 2 ? mu_prev[P_KK + gch] : vec == 3 ? mu_next[P_KK + gch] : vec == 4 ? mu_prev[P_VV + gch] : vec == 5 ? mu_next[P_VV + gch]
              : vec == 6 ? w0[d * 512 + gch] : vec == 7 ? a0[d * 512 + gch] : vec == 8 ? k_k[gch] : k_a[gch]; }
        else { const int vec = (i - 640) >> 5, j = i & 31; const int col = (vec < 2 ? P_WD : P_AD) + 32 * d + j; v = (vec & 1) ? mu_next[col] : mu_prev[col]; }
        cst[i] = v; }
    __syncthreads();
    const int nper = (c.nb >> 3) * 8;
    for (int u = (c.bid >> 3) * 8 + c.wave; u < 1024; u += nper) {
        const int b = u >> 7, c32 = u & 127;
        const int tok0 = d ? SEQ - 32 * (c32 + 1) : 32 * c32;
        const bf16* prow = proj + (size_t)b * SEQ * IN_PAD + C_P;
#pragma unroll 1
        for (int it = 0; it < 13; ++it) { const int pid = it * 64 + lane; if (pid < 816) { const int rho = pid / 24, w = pid % 24, mat = w >> 3, pc = w & 7, tok = tok0 - 1 + rho;
                uint4 val = make_uint4(0, 0, 0, 0);
                if (tok >= 0 && tok < SEQ) val = *(const uint4*)(prow + (size_t)tok * IN_PAD + mat * 512 + 64 * hd + pc * 8);
                LAS u32x2* dp = (LAS u32x2*)(L + rho * STG_STRIDE + mat * 128 + pc * 16); dp[0] = (u32x2){val.x, val.y}; dp[1] = (u32x2){val.z, val.w}; } }
        const int rho = d ? 32 - n : n + 1, tok = tok0 - 1 + rho;
        bf16x8 wdf[2], adf[2];
        {
            const bool hp = tok > 0, hn = tok < SEQ - 1;
#pragma unroll
            for (int s = 0; s < 2; ++s) {
                const bf16* pc_ = prow + (size_t)tok * IN_PAD + 32 * d + 16 * s + 8 * h;
                const uint4 z4 = make_uint4(0, 0, 0, 0);
                const uint4 wc = *(const uint4*)(pc_ + P_WD), ac = *(const uint4*)(pc_ + P_AD);
                const uint4 wp = hp ? *(const uint4*)(pc_ + P_WD - IN_PAD) : z4, ap = hp ? *(const uint4*)(pc_ + P_AD - IN_PAD) : z4;
                const uint4 wn = hn ? *(const uint4*)(pc_ + P_WD + IN_PAD) : z4, an = hn ? *(const uint4*)(pc_ + P_AD + IN_PAD) : z4;
                const unsigned wcw[4] = {wc.x, wc.y, wc.z, wc.w}, wpw[4] = {wp.x, wp.y, wp.z, wp.w}, wnw[4] = {wn.x, wn.y, wn.z, wn.w};
                const unsigned acw[4] = {ac.x, ac.y, ac.z, ac.w}, apw[4] = {ap.x, ap.y, ap.z, ap.w}, anw[4] = {an.x, an.y, an.z, an.w};
                unsigned wo[4], ao[4];
#pragma unroll
                for (int e = 0; e < 4; ++e) { const int j = 16 * s + 8 * h + 2 * e;
                    const float mpw0 = cst[640 + j], mpw1 = cst[640 + j + 1], mnw0 = cst[672 + j], mnw1 = cst[672 + j + 1], mpa0 = cst[704 + j], mpa1 = cst[704 + j + 1], mna0 = cst[736 + j], mna1 = cst[736 + j + 1];
                    float c0 = lo_f(wcw[e]), c1 = hi_f(wcw[e]);
                    float x0 = c0 + mpw0 * (lo_f(wpw[e]) - c0) + mnw0 * (lo_f(wnw[e]) - c0), x1 = c1 + mpw1 * (hi_f(wpw[e]) - c1) + mnw1 * (hi_f(wnw[e]) - c1);
                    x0 = 1.f - 2.f * __builtin_amdgcn_rcpf(__expf(2.f * x0) + 1.f); x1 = 1.f - 2.f * __builtin_amdgcn_rcpf(__expf(2.f * x1) + 1.f);
                    wo[e] = cvtpk(x0, x1);
                    c0 = lo_f(acw[e]); c1 = hi_f(acw[e]);
                    x0 = c0 + mpa0 * (lo_f(apw[e]) - c0) + mna0 * (lo_f(anw[e]) - c0); x1 = c1 + mpa1 * (hi_f(apw[e]) - c1) + mna1 * (hi_f(anw[e]) - c1);
                    ao[e] = cvtpk(x0, x1); }
                wdf[s] = frag4(wo[0], wo[1], wo[2], wo[3]); adf[s] = frag4(ao[0], ao[1], ao[2], ao[3]);
                __builtin_amdgcn_sched_barrier(0);
            }
        }
        float lw[32], av[32];
        {
            const f32x16 zz = {0.f};
            int opq = 0; asm volatile("" : "+v"(opq));
#pragma unroll
            for (int tau = 0; tau < 2; ++tau) {
                const bf16* wrow = w2t + ((d * 512 + 64 * hd + 32 * tau + n + opq) * 32 + 8 * (h + opq));
                const bf16* arow = a2t + ((d * 512 + 64 * hd + 32 * tau + n + opq) * 32 + 8 * (h + opq));
                const bf16x8 wa0 = *(const bf16x8*)wrow, wa1 = *(const bf16x8*)(wrow + 16), aa0 = *(const bf16x8*)arow, aa1 = *(const bf16x8*)(arow + 16);
                f32x16 cw = MFMA32(wa0, wdf[0], zz); cw = MFMA32(wa1, wdf[1], cw);
                f32x16 ca = MFMA32(aa0, adf[0], zz); ca = MFMA32(aa1, adf[1], ca);
#pragma unroll
                for (int i = 0; i < 16; ++i) { const int ch = 32 * tau + 8 * (i >> 2) + 4 * h + (i & 3);
                    lw[16 * tau + i] = -0.60653066f * fsig(cw[i] + cst[6 * 64 + ch]); av[16 * tau + i] = fsig(ca[i] + cst[7 * 64 + ch]); }
                __builtin_amdgcn_sched_barrier(0);
            }
        }
        unsigned ge[32], avp[16];
#pragma unroll
        for (int m = 0; m < 32; ++m) { const float clm = prefix32(lw[m]); const float eg = __expf(clm); ge[m] = cvtpk(eg, eg * __expf(-lw[m])); if (n == 31) gC[8 * (m >> 2) + 4 * h + (m & 3)] = eg; }
#pragma unroll
        for (int m = 0; m < 16; ++m) avp[m] = cvtpk(av[2 * m], av[2 * m + 1]);
        __builtin_amdgcn_sched_barrier(0);
        unsigned pA[16], pB[16], pK[16], pR[16], pV[16];
        {
            unsigned kfp[16]; float ss = 0.f;
            lptr sb = L + rho * STG_STRIDE + 8 * h;
#pragma unroll
            for (int q = 0; q < 8; ++q) {
                const u32x2 cu = *(LAS u32x2*)(sb + 128 + 16 * q), pu_ = *(LAS u32x2*)(sb + 128 + 16 * q - STG_STRIDE), nu = *(LAS u32x2*)(sb + 128 + 16 * q + STG_STRIDE);
                const float cc[4] = {lo_f(cu.x), hi_f(cu.x), lo_f(cu.y), hi_f(cu.y)}, pp[4] = {lo_f(pu_.x), hi_f(pu_.x), lo_f(pu_.y), hi_f(pu_.y)}, nn[4] = {lo_f(nu.x), hi_f(nu.x), lo_f(nu.y), hi_f(nu.y)};
                float xk[4];
#pragma unroll
                for (int e = 0; e < 4; ++e) { const int ch = 8 * q + 4 * h + e; const float x = cc[e] + cst[2 * 64 + ch] * (pp[e] - cc[e]) + cst[3 * 64 + ch] * (nn[e] - cc[e]);
                    xk[e] = x; const float kr_ = x * cst[8 * 64 + ch]; ss += kr_ * kr_; }
                kfp[2 * q] = cvtpk(xk[0], xk[1]); kfp[2 * q + 1] = cvtpk(xk[2], xk[3]);
                __builtin_amdgcn_sched_barrier(0);
            }
            ss += __shfl_xor(ss, 32);
            const float inv = rsqrtf(fmaxf(ss, 1e-24f));
#pragma unroll
            for (int q = 0; q < 8; ++q) {
                const u32x2 cu = *(LAS u32x2*)(sb + 16 * q), pu_ = *(LAS u32x2*)(sb + 16 * q - STG_STRIDE), nu = *(LAS u32x2*)(sb + 16 * q + STG_STRIDE);
                const u32x2 cv = *(LAS u32x2*)(sb + 256 + 16 * q), pv_ = *(LAS u32x2*)(sb + 256 + 16 * q - STG_STRIDE), nv_ = *(LAS u32x2*)(sb + 256 + 16 * q + STG_STRIDE);
                const float rc[4] = {lo_f(cu.x), hi_f(cu.x), lo_f(cu.y), hi_f(cu.y)}, rp[4] = {lo_f(pu_.x), hi_f(pu_.x), lo_f(pu_.y), hi_f(pu_.y)}, rn[4] = {lo_f(nu.x), hi_f(nu.x), lo_f(nu.y), hi_f(nu.y)};
                const float vc[4] = {lo_f(cv.x), hi_f(cv.x), lo_f(cv.y), hi_f(cv.y)}, vp[4] = {lo_f(pv_.x), hi_f(pv_.x), lo_f(pv_.y), hi_f(pv_.y)}, vn[4] = {lo_f(nv_.x), hi_f(nv_.x), lo_f(nv_.y), hi_f(nv_.y)};
                float oa[4], ob[4], ok[4], orr[4], ov[4];
#pragma unroll
                for (int e = 0; e < 4; ++e) { const int ch = 8 * q + 4 * h + e, m = 4 * q + e;
                    const float rf = rc[e] + cst[0 * 64 + ch] * (rp[e] - rc[e]) + cst[1 * 64 + ch] * (rn[e] - rc[e]);
                    const float vf = vc[e] + cst[4 * 64 + ch] * (vp[e] - vc[e]) + cst[5 * 64 + ch] * (vn[e] - vc[e]);
                    const float eg = lo_f(ge[m]), ieg = __builtin_amdgcn_rcpf(eg), egm1 = hi_f(ge[m]);
                    const float kfm = (m & 1) ? hi_f(kfp[m >> 1]) : lo_f(kfp[m >> 1]), avm = (m & 1) ? hi_f(avp[m >> 1]) : lo_f(avp[m >> 1]);
                    const float kkn = kfm * cst[8 * 64 + ch] * inv;
                    oa[e] = -kkn * egm1; ob[e] = kkn * avm * ieg; ok[e] = kfm * (1.f + (avm - 1.f) * cst[9 * 64 + ch]) * ieg; orr[e] = rf * eg; ov[e] = vf; }
                pA[2 * q] = cvtpk(oa[0], oa[1]); pA[2 * q + 1] = cvtpk(oa[2], oa[3]); pB[2 * q] = cvtpk(ob[0], ob[1]); pB[2 * q + 1] = cvtpk(ob[2], ob[3]);
                pK[2 * q] = cvtpk(ok[0], ok[1]); pK[2 * q + 1] = cvtpk(ok[2], ok[3]); pR[2 * q] = cvtpk(orr[0], orr[1]); pR[2 * q + 1] = cvtpk(orr[2], orr[3]);
                pV[2 * q] = cvtpk(ov[0], ov[1]); pV[2 * q + 1] = cvtpk(ov[2], ov[3]);
                __builtin_amdgcn_sched_barrier(0);
            }
        }
        __builtin_amdgcn_fence(__ATOMIC_RELEASE, "workgroup"); __builtin_amdgcn_wave_barrier();
#pragma unroll
        for (int q = 0; q < 8; ++q) { const int off = img_off(n, 2 * q + h);
            *(LAS u32x2*)(L + off) = (u32x2){pA[2 * q], pA[2 * q + 1]}; *(LAS u32x2*)(L + 4096 + off) = (u32x2){pB[2 * q], pB[2 * q + 1]};
            *(LAS u32x2*)(L + 8192 + off) = (u32x2){pK[2 * q], pK[2 * q + 1]}; *(LAS u32x2*)(L + 12288 + off) = (u32x2){pV[2 * q], pV[2 * q + 1]}; }
        __builtin_amdgcn_fence(__ATOMIC_RELEASE, "workgroup"); __builtin_amdgcn_wave_barrier();
        const f32x16 Z16 = {0.f};
        f32x16 Lab = Z16, LabT = Z16, LakT = Z16, MrbT = Z16, MrkT = Z16;
#pragma unroll
        for (int ks = 0; ks < 4; ++ks) {
            const bf16x8 fA = frag4(pA[4 * ks], pA[4 * ks + 1], pA[4 * ks + 2], pA[4 * ks + 3]), fB = frag4(pB[4 * ks], pB[4 * ks + 1], pB[4 * ks + 2], pB[4 * ks + 3]);
            const bf16x8 fK = frag4(pK[4 * ks], pK[4 * ks + 1], pK[4 * ks + 2], pK[4 * ks + 3]), fR = frag4(pR[4 * ks], pR[4 * ks + 1], pR[4 * ks + 2], pR[4 * ks + 3]);
            Lab = MFMA32(fA, fB, Lab); LabT = MFMA32(fB, fA, LabT); LakT = MFMA32(fK, fA, LakT); MrbT = MFMA32(fB, fR, MrbT); MrkT = MFMA32(fK, fR, MrkT);
        }
#pragma unroll
        for (int i = 0; i < 16; ++i) { const int rr = crow(i, h);
            Lab[i] = (n < rr) ? Lab[i] : 0.f; LabT[i] = (rr < n) ? LabT[i] : 0.f; LakT[i] = (rr < n) ? LakT[i] : 0.f;
            MrbT[i] = (rr <= n) ? MrbT[i] : 0.f; MrkT[i] = (rr <= n) ? MrkT[i] : 0.f; }
        const bf16x8 pLk0 = pack(LakT, 0), pLk1 = pack(LakT, 1), pMb0 = pack(MrbT, 0), pMb1 = pack(MrbT, 1), pMk0 = pack(MrkT, 0), pMk1 = pack(MrkT, 1);
        __builtin_amdgcn_sched_barrier(0);
        f32x16 Pc = Lab, Ptc = LabT, Rtc = LabT;
#pragma unroll
        for (int i = 0; i < 16; ++i) Rtc[i] += (crow(i, h) == n) ? 1.f : 0.f;
#pragma unroll
        for (int lvl = 0; lvl < 4; ++lvl) {
            const bf16x8 pP0 = pack(Pc, 0), pP1 = pack(Pc, 1), pT0 = pack(Ptc, 0), pT1 = pack(Ptc, 1);
            f32x16 nPc = MFMA32(pT0, pP0, Z16); nPc = MFMA32(pT1, pP1, nPc);
            if (lvl < 3) { f32x16 nPt = MFMA32(pP0, pT0, Z16); nPt = MFMA32(pP1, pT1, nPt); Ptc = nPt; }
            const bf16x8 pN0 = pack(nPc, 0), pN1 = pack(nPc, 1), pR0 = pack(Rtc, 0), pR1 = pack(Rtc, 1);
            Rtc = MFMA32(pN0, pR0, Rtc); Rtc = MFMA32(pN1, pR1, Rtc);
            Pc = nPc;
        }
        const bf16x8 pT0 = pack(Rtc, 0), pT1 = pack(Rtc, 1);
        bf16x8 vt[2][2];
#pragma unroll
        for (int tau = 0; tau < 2; ++tau) { vt[tau][0] = trfrag(L + 12288, tau, 0, lane); vt[tau][1] = trfrag(L + 12288, tau, 1, lane); }
        bf16x8 pW1[2][2], pW2[2][2];
#pragma unroll
        for (int tau = 0; tau < 2; ++tau) {
            f32x16 lv = MFMA32(pLk0, vt[tau][0], Z16); lv = MFMA32(pLk1, vt[tau][1], lv);
            const bf16x8 a0f = trfrag(L, tau, 0, lane), a1f = trfrag(L, tau, 1, lane);
            f32x16 w1 = MFMA32(pT0, a0f, Z16); w1 = MFMA32(pT1, a1f, w1);
            const bf16x8 l0 = pack(lv, 0), l1 = pack(lv, 1);
            f32x16 w2_ = MFMA32(pT0, l0, Z16); w2_ = MFMA32(pT1, l1, w2_);
            pW1[tau][0] = pack(w1, 0); pW1[tau][1] = pack(w1, 1); pW2[tau][0] = pack(w2_, 0); pW2[tau][1] = pack(w2_, 1);
        }
        int opq2 = 0; asm volatile("" : "+v"(opq2));
        const int lane_o = lane + opq2, n_o = n + opq2;
        unsigned char* uo = UO + ((size_t)(b * 8 + hd) * 128 + c32) * UNIT_BYTES;
#pragma unroll
        for (int kap = 0; kap < 2; ++kap) { f32x16 q1;
#pragma unroll
            for (int i = 0; i < 16; ++i) q1[i] = (i & 1) ? hi_f(pR[8 * kap + (i >> 1)]) : lo_f(pR[8 * kap + (i >> 1)]);
            q1 = MFMA32(pW1[kap][0], pMb0, q1); q1 = MFMA32(pW1[kap][1], pMb1, q1);
            store_tile(uo + kap * 2048, q1, lane_o); }
#pragma unroll
        for (int tau = 0; tau < 2; ++tau) { f32x16 q2 = MFMA32(pMb0, pW2[tau][0], Z16); q2 = MFMA32(pMb1, pW2[tau][1], q2); q2 = MFMA32(pMk0, vt[tau][0], q2); q2 = MFMA32(pMk1, vt[tau][1], q2);
#pragma unroll
            for (int i = 0; i < 16; ++i) { const int s = crow(i, h), tk = d ? tok0 + 31 - s : tok0 + s; float* yp = ybuf + ((size_t)b * SEQ + tk) * 512 + 64 * hd + 32 * tau + n_o;
                if (d) *yp += q2[i]; else *yp = q2[i]; } }
        __builtin_amdgcn_fence(__ATOMIC_RELEASE, "workgroup"); __builtin_amdgcn_wave_barrier();
#pragma unroll
        for (int tp = 0; tp < 2; ++tp) {
            const bf16x8 b0f = trfrag(L + 4096, tp, 0, lane), b1f = trfrag(L + 4096, tp, 1, lane), k0f = trfrag(L + 8192, tp, 0, lane), k1f = trfrag(L + 8192, tp, 1, lane);
            const float gcl = gC[32 * tp + n];
#pragma unroll
            for (int kap = 0; kap < 2; ++kap) { f32x16 g = MFMA32(pW1[kap][0], b0f, Z16); g = MFMA32(pW1[kap][1], b1f, g);
#pragma unroll
                for (int i = 0; i < 16; ++i) g[i] = (g[i] + ((kap == tp && crow(i, h) == n) ? 1.f : 0.f)) * gcl;
                store_tile(uo + (2 + 2 * kap + tp) * 2048, g, lane_o); }
#pragma unroll
            for (int tau = 0; tau < 2; ++tau) { f32x16 ht = MFMA32(b0f, pW2[tau][0], Z16); ht = MFMA32(b1f, pW2[tau][1], ht); ht = MFMA32(k0f, vt[tau][0], ht); ht = MFMA32(k1f, vt[tau][1], ht);
#pragma unroll
                for (int i = 0; i < 16; ++i) ht[i] *= gC[32 * tp + crow(i, h)];
                store_tile(uo + (6 + 2 * tp + tau) * 2048, ht, lane_o); }
        }
        __builtin_amdgcn_fence(__ATOMIC_RELEASE, "workgroup"); __builtin_amdgcn_wave_barrier();
    }
}

DI void d_seq(const Ctx& c, int d, const unsigned char* __restrict__ UO, float* __restrict__ ybuf) {
    if (c.wave >= 2) return;
    const int lane = c.lane, n = lane & 31, h = lane >> 5, tau = c.wave;
    for (int chain = c.bid; chain < 64; chain += c.nb) {
        const int b = chain >> 3, hd = chain & 7;
        const unsigned char* ub = UO + (size_t)chain * 128 * UNIT_BYTES + lane * 32;
        const f32x16 Z16 = {0.f};
        f32x16 X0 = Z16, X1 = Z16;
        u32x4 T[8][2];
        auto loadu = [&](int c32) {
            const unsigned char* p = ub + (size_t)c32 * UNIT_BYTES;
#pragma unroll
            for (int k = 0; k < 6; ++k) { T[k][0] = *(const u32x4*)(p + k * 2048); T[k][1] = *(const u32x4*)(p + k * 2048 + 16); }
#pragma unroll
            for (int tp = 0; tp < 2; ++tp) { T[6 + tp][0] = *(const u32x4*)(p + (6 + 2 * tp + tau) * 2048); T[6 + tp][1] = *(const u32x4*)(p + (6 + 2 * tp + tau) * 2048 + 16); }
        };
        loadu(0);
#pragma unroll 1
        for (int c32 = 0; c32 < 128; ++c32) {
            const int tok0 = d ? SEQ - 32 * (c32 + 1) : 32 * c32;
            float* yb = ybuf + ((size_t)b * SEQ) * 512 + 64 * hd + 32 * tau + n;
            f32x16 y;
#pragma unroll
            for (int i = 0; i < 16; ++i) { const int s = crow(i, h), tk = d ? tok0 + 31 - s : tok0 + s; y[i] = yb[(size_t)tk * 512]; }
            const bf16x8 x00 = pack(X0, 0), x01 = pack(X0, 1), x10 = pack(X1, 0), x11 = pack(X1, 1);
            f32x16 n0, n1;
#pragma unroll
            for (int i = 0; i < 8; ++i) { n0[2 * i] = lo_f(T[6][i >> 2][i & 3]); n0[2 * i + 1] = hi_f(T[6][i >> 2][i & 3]); n1[2 * i] = lo_f(T[7][i >> 2][i & 3]); n1[2 * i + 1] = hi_f(T[7][i >> 2][i & 3]); }
#define FR(t, s) __builtin_bit_cast(bf16x8, T[t][s])
            n0 = MFMA32(FR(2, 0), x00, n0); n1 = MFMA32(FR(3, 0), x00, n1);
            n0 = MFMA32(FR(2, 1), x01, n0); n1 = MFMA32(FR(3, 1), x01, n1);
            n0 = MFMA32(FR(4, 0), x10, n0); n1 = MFMA32(FR(5, 0), x10, n1);
            n0 = MFMA32(FR(4, 1), x11, n0); n1 = MFMA32(FR(5, 1), x11, n1);
            y = MFMA32(FR(0, 0), x00, y); y = MFMA32(FR(0, 1), x01, y); y = MFMA32(FR(1, 0), x10, y); y = MFMA32(FR(1, 1), x11, y);
#undef FR
            if (c32 + 1 < 128) loadu(c32 + 1);
#pragma unroll
            for (int i = 0; i < 16; ++i) { const int s = crow(i, h), tk = d ? tok0 + 31 - s : tok0 + s; yb[(size_t)tk * 512] = y[i]; }
            X0 = n0; X1 = n1;
        }
    }
}
#undef DI
}

namespace pk {
typedef short bf16x8 __attribute__((ext_vector_type(8)));
typedef float f32x16 __attribute__((ext_vector_type(16)));
typedef unsigned u32x4 __attribute__((ext_vector_type(4)));
typedef LAS unsigned char* lptr;
#define DI __device__ __forceinline__
DI float fmx(float a, float b) { float r; asm("v_max_f32 %0, %1, %2" : "=v"(r) : "v"(a), "v"(b)); return r; }
DI float fmn(float a, float b) { float r; asm("v_min_f32 %0, %1, %2" : "=v"(r) : "v"(a), "v"(b)); return r; }
DI void ce(float& hi, float& lo) { const float a = fmx(hi, lo), b = fmn(hi, lo); hi = a; lo = b; }
template <int N> DI void sort_desc(float (&v)[N]) {
#pragma unroll
    for (int k = 2; k <= N; k <<= 1)
#pragma unroll
        for (int j = k >> 1; j > 0; j >>= 1)
#pragma unroll
            for (int i = 0; i < N; ++i) { const int l = i ^ j; if (l > i) { if ((i & k) == 0) ce(v[i], v[l]); else ce(v[l], v[i]); } }
}
DI void merge16(float (&v)[16]) {
#pragma unroll
    for (int j = 8; j > 0; j >>= 1)
#pragma unroll
        for (int i = 0; i < 16; ++i) { const int l = i ^ j; if (l > i) ce(v[i], v[l]); }
}
DI void top_merge(float (&a)[16], const float (&b)[16]) {
#pragma unroll
    for (int i = 0; i < 16; ++i) a[i] = fmx(a[i], b[15 - i]);
    merge16(a);
}
DI float setcode(float v, unsigned code, unsigned mask) { return __uint_as_float((__float_as_uint(v) & ~mask) | code); }

DI void d_peer_topk(const Ctx& c, const bf16* __restrict__ qb, const float* __restrict__ keys, int* __restrict__ idx, float* __restrict__ gate) {
    const int lane = c.lane, n = lane & 31, hh = lane >> 5, hd = c.bid & 7;
    lptr KL = (lptr)c.lds;
    lptr TB = (lptr)c.lds + 65536 + c.wave * 2048;
    __syncthreads();
    for (int e = c.tid; e < 2 * 128 * 16; e += 512) {
        const int row = e >> 4, ch = e & 15; const float* src = keys + (size_t)hd * 32768 + row * 128 + ch * 8;
        const f32x4 a = *(const f32x4*)src, b = *(const f32x4*)(src + 4);
        u32x4 w; w[0] = pk2bf(a.x, a.y); w[1] = pk2bf(a.z, a.w); w[2] = pk2bf(b.x, b.y); w[3] = pk2bf(b.z, b.w);
        *(LAS u32x4*)(KL + row * 256 + ((ch ^ (row & 15)) << 4)) = w; }
    __syncthreads();
    const int nper = (c.nb >> 3) * 8;
    for (int tile = (c.bid >> 3) * 8 + c.wave; tile < NTOK / 32; tile += nper) {
        const int t0 = tile * 32;
        float sp[2][16];
#pragma unroll
        for (int p = 0; p < 2; ++p) {
            bf16x8 qf[8];
            { const bf16* qrow = qb + (size_t)(t0 + n) * PEER_Q + hd * 256 + p * 128 + 8 * hh;
#pragma unroll
              for (int ks = 0; ks < 8; ++ks) qf[ks] = *(const bf16x8*)(qrow + 16 * ks); }
            float top[16];
#pragma unroll
            for (int j = 0; j < 4; ++j) {
                f32x16 acc = {0.f};
                const int row = p * 128 + 32 * j + n;
#pragma unroll
                for (int ks = 0; ks < 8; ++ks) { const bf16x8 kfr = *(LAS bf16x8*)(KL + row * 256 + (((2 * ks + hh) ^ (row & 15)) << 4));
                    acc = __builtin_amdgcn_mfma_f32_32x32x16_bf16(kfr, qf[ks], acc, 0, 0, 0); }
                float g[16];
#pragma unroll
                for (int i = 0; i < 16; ++i) { const int key = 32 * j + (i & 3) + 8 * (i >> 2) + 4 * hh; g[i] = setcode(acc[i], 127u - (unsigned)key, 127u); }
                sort_desc<16>(g);
                if (j == 0) {
#pragma unroll
                    for (int i = 0; i < 16; ++i) top[i] = g[i];
                } else top_merge(top, g);
            }
            float oth[16];
#pragma unroll
            for (int i = 0; i < 16; ++i) oth[i] = __shfl_xor(top[i], 32);
            top_merge(top, oth);
#pragma unroll
            for (int i = 0; i < 16; ++i) sp[p][i] = top[i];
        }
        {
            unsigned w[8];
#pragma unroll
            for (int q = 0; q < 8; ++q) { const int p = q >> 2, a0 = (q & 3) * 4; w[q] = 0;
#pragma unroll
                for (int e = 0; e < 4; ++e) w[q] |= (127u - (__float_as_uint(sp[p][a0 + e]) & 127u)) << (8 * e); }
            *(LAS u32x4*)(TB + lane * 32) = (u32x4){w[0], w[1], w[2], w[3]}; *(LAS u32x4*)(TB + lane * 32 + 16) = (u32x4){w[4], w[5], w[6], w[7]};
        }
        float cd[64];
        {
            int cnt = 0;
#pragma unroll
            for (int a = 0; a < 16; ++a)
#pragma unroll
                for (int b = 0; b < 16; ++b) if ((a + 1) * (b + 1) <= 16) { cd[cnt] = setcode(sp[0][a] + sp[1][b], 255u - (unsigned)(a * 16 + b), 255u); ++cnt; }
#pragma unroll
            for (int i = 50; i < 64; ++i) cd[i] = -INFINITY;
        }
        sort_desc<64>(cd);
        const float mx = cd[0]; float ex[16]; float den = 0.f;
#pragma unroll
        for (int k = 0; k < 16; ++k) { ex[k] = __expf(cd[k] - mx); den += ex[k]; }
        const float rden = 1.f / den;
        const size_t ob = (size_t)(t0 + n) * 128 + hd * 16;
        if (hh == 0) {
            int id[16];
#pragma unroll
            for (int k = 0; k < 16; ++k) { const unsigned flat = 255u - (__float_as_uint(cd[k]) & 255u); const unsigned i1 = *(LAS unsigned char*)(TB + lane * 32 + (flat >> 4)), i2 = *(LAS unsigned char*)(TB + lane * 32 + 16 + (flat & 15)); id[k] = (int)(i1 * 128 + i2); }
#pragma unroll
            for (int k = 0; k < 4; ++k) *(int4*)(idx + ob + 4 * k) = make_int4(id[4 * k], id[4 * k + 1], id[4 * k + 2], id[4 * k + 3]);
        } else {
#pragma unroll
            for (int k = 0; k < 4; ++k) *(f32x4*)(gate + ob + 4 * k) = (f32x4){ex[4 * k] * rden, ex[4 * k + 1] * rden, ex[4 * k + 2] * rden, ex[4 * k + 3] * rden};
        }
    }
}
#undef DI
}
namespace pg8 {
struct EpiResF32 {
    static constexpr bool PERM = false, AFTER_DRAIN = false;
    const float* base; float* out; int ldc; float alpha;
    __device__ __forceinline__ void operator()(const f32x4 (&acc)[2][2][4][2], const Unit& u, int wr, int wc, int fr, int fq) const {
        const int col0 = u.pn * BM + wc * 32 + 4 * fq;
#pragma unroll
        for (int ai = 0; ai < 2; ++ai)
#pragma unroll
            for (int m = 0; m < 4; ++m) { const int r = ai * HALF + wr * 64 + m * 16 + fr; const size_t off = (size_t)(u.pm * BM + r) * ldc + col0;
#pragma unroll
                for (int bj = 0; bj < 2; ++bj)
#pragma unroll
                    for (int n = 0; n < 2; ++n) { const f32x4 bs = *(const f32x4*)(base + off + bj * HALF + n * 16); *(f32x4*)(out + off + bj * HALF + n * 16) = bs * alpha + acc[ai][bj][m][n]; } }
    }
};
}
#define XB_TMO      128
#define XB_XCNT(j)  (256  + 64 * (j))
#define XB_XSUB(j)  (1280 + 64 * (j))
#define XB_XGEN(j)  (2304 + 64 * (j))
#define XB_TOP      3328
#define XB_TOPGEN   3392
#define XCD_BAR_WORDS 3456
#define XB_SPIN_CAP (1u << 18)

__device__ __forceinline__ unsigned xb_ld(unsigned* p)              { return __hip_atomic_load(p, __ATOMIC_RELAXED, __HIP_MEMORY_SCOPE_AGENT); }
__device__ __forceinline__ unsigned xb_add(unsigned* p, unsigned v) { return __hip_atomic_fetch_add(p, v, __ATOMIC_RELAXED, __HIP_MEMORY_SCOPE_AGENT); }
__device__ __forceinline__ unsigned xb_xcc_id() { return (unsigned)__builtin_amdgcn_s_getreg((3 << 11) | 20) & 0xFu; }
#define XB_SPIN(cond, bar) do { unsigned _sp = 0; while (cond) { __builtin_amdgcn_s_sleep(1); \
    if ((++_sp & 255u) == 0u) { if (xb_ld(&(bar)[XB_TMO])) break; if (_sp > XB_SPIN_CAP) { atomicAdd(&(bar)[XB_TMO], 1u); break; } } } } while (0)

struct XcdBarrier {
    unsigned* bar; unsigned x;
    volatile LAS unsigned* st;
};

__device__ __forceinline__ XcdBarrier xcd_barrier_post(unsigned* bar, volatile LAS unsigned* st, int tid) {
    XcdBarrier b; b.bar = bar; b.x = xb_xcc_id(); b.st = st;
    if (tid == 0) (void)xb_add(&bar[XB_XCNT(b.x)], 1u);
    return b;
}
__device__ __forceinline__ void xcd_barrier_complete(unsigned* bar, unsigned x, unsigned& nloc, unsigned& nx) {
    const unsigned G = gridDim.x * gridDim.y * gridDim.z;
    unsigned sum, cnt, mine, sp = 0u;
    for (;;) {
        sum = 0u; cnt = 0u; mine = 0u;
#pragma unroll
        for (unsigned j = 0; j < 16; ++j) { const unsigned c = xb_ld(&bar[XB_XCNT(j)]); sum += c; cnt += (c > 0u) ? 1u : 0u; mine = (j == x) ? c : mine; }
        if (sum == G) break;
        __builtin_amdgcn_s_sleep(1);
        if ((++sp & 255u) == 0u) { if (xb_ld(&bar[XB_TMO])) break; if (sp > XB_SPIN_CAP) { atomicAdd(&bar[XB_TMO], 1u); break; } }
    }
    nloc = mine > 0u ? mine : 1u; nx = cnt > 0u ? cnt : 1u;
}

__device__ __forceinline__ void xcd_barrier(const XcdBarrier& b, int tid) {
    asm volatile("s_waitcnt vmcnt(0)" ::: "memory");
    __syncthreads();
    if (tid == 0) {
        unsigned* bar = b.bar;
        __builtin_amdgcn_s_waitcnt(0);
        unsigned nloc = b.st[0], nx = b.st[1];
        if (nloc == 0u) { xcd_barrier_complete(bar, b.x, nloc, nx); b.st[0] = nloc; b.st[1] = nx; }
        const unsigned old = xb_add(&bar[XB_XSUB(b.x)], 1u);
        const unsigned gen = old / nloc;
        if (old + 1u == (gen + 1u) * nloc) {
            __builtin_amdgcn_fence(__ATOMIC_RELEASE, "agent");
            asm volatile("s_waitcnt vmcnt(0)" ::: "memory");
            const unsigned og = xb_add(&bar[XB_TOP], 1u);
            const unsigned tg = og / nx;
            if (og + 1u == (tg + 1u) * nx) xb_add(&bar[XB_TOPGEN], 1u);
            else XB_SPIN(xb_ld(&bar[XB_TOPGEN]) == tg, bar);
            __builtin_amdgcn_fence(__ATOMIC_ACQUIRE, "agent");
            xb_add(&bar[XB_XGEN(b.x)], 1u);
            asm volatile("s_waitcnt vmcnt(0)" ::: "memory");
        } else {
            XB_SPIN(xb_ld(&bar[XB_XGEN(b.x)]) == gen, bar);
            __builtin_amdgcn_fence(__ATOMIC_ACQUIRE, "agent");
            asm volatile("s_waitcnt vmcnt(0)" ::: "memory");
        }
    }
    __syncthreads();
}

constexpr size_t MiB = 1u << 20;
constexpr int LDS_BYTES = 147456;
constexpr int NPHASE = 14;
struct Params { const float* in[24]; float* out; unsigned char* ws; int ph_lo, ph_hi; };

__global__ void __launch_bounds__(512, 2) mega(Params p) {
    extern __shared__ __attribute__((aligned(16))) unsigned char lds[];
    cg::grid_group grid = cg::this_grid();
    Ctx c; c.wave = __builtin_amdgcn_readfirstlane(threadIdx.x >> 6); c.lane = (int)__builtin_amdgcn_mbcnt_hi(~0u, __builtin_amdgcn_mbcnt_lo(~0u, 0u)); c.tid = c.wave * 64 + c.lane; c.bid = blockIdx.x; c.nb = gridDim.x; c.gw = c.bid * 8 + c.wave; c.ngw = c.nb * 8; c.lds = lds;
#define LND(ptr) ((ptr) + ({ int z_ = 0; asm volatile("" : "+s"(z_)); z_; }))
#define WSP(T, mb) ((T*)(LND(p.ws) + (size_t)(mb) * MiB))
#define x LND(p.in[0])
#define w_in LND(p.in[1])
#define mu_prev LND(p.in[2])
#define mu_next LND(p.in[3])
#define w0 LND(p.in[4])
#define w2 LND(p.in[5])
#define a0 LND(p.in[6])
#define a2 LND(p.in[7])
#define g2 LND(p.in[8])
#define k_k LND(p.in[9])
#define k_a LND(p.in[10])
#define r_k LND(p.in[11])
#define lnx_g LND(p.in[12])
#define lnx_b LND(p.in[13])
#define sink LND(p.in[14])
#define w_out LND(p.in[15])
#define ln1_g LND(p.in[16])
#define ln1_b LND(p.in[17])
#define wq LND(p.in[18])
#define keys LND(p.in[19])
#define pu LND(p.in[20])
#define pv LND(p.in[21])
#define ln2_g LND(p.in[22])
#define ln2_b LND(p.in[23])
#define out LND(p.out)
#define rope WSP(float2, 1)
#define w2t WSP(bf16, 2)
#define a2t ((bf16*)(LND(p.ws) + 2 * MiB + 65536))
#define g2t ((bf16*)(LND(p.ws) + 2 * MiB + 131072))
#define bscp WSP(float, 3)
#define w_in_t WSP(bf16, 4)
#define w_out_t WSP(bf16, 10)
#define wq_t WSP(bf16, 12)
#define xb WSP(bf16, 16)
#define qr WSP(bf16, 16)
#define kr WSP(bf16, 48)
#define ybuf WSP(float, 16)
#define ub WSP(bf16, 16)
#define u8t WSP(unsigned, 16)
#define v8t WSP(unsigned, 32)
#define su8 WSP(float, 48)
#define sv8 WSP(float, 49)
#define vb WSP(bf16, 48)
#define proj WSP(bf16, 80)
#define y1 WSP(float, 80)
#define idx WSP(int, 208)
#define gate WSP(float, 224)
#define mix WSP(bf16, 240)
#define UO WSP(unsigned char, 304)
#define qb WSP(bf16, 304)
#define h1b WSP(bf16, 432)
    volatile LAS unsigned* bst = (volatile LAS unsigned*)((LAS unsigned char*)lds + (LDS_BYTES - 64));
    if (c.tid < 2) bst[c.tid] = 0u;
    __syncthreads();
    const XcdBarrier bar = xcd_barrier_post((unsigned*)p.ws, bst, c.tid);
    const int lo = p.ph_lo, hi = p.ph_hi;
#ifndef PH_MASK
#define PH_MASK 0xFFFF
#endif
#define IN(k) (((PH_MASK >> (k)) & 1) && lo <= (k) && (k) < hi)
#define RELANE() do { c.lane = (int)__builtin_amdgcn_mbcnt_hi(~0u, __builtin_amdgcn_mbcnt_lo(~0u, 0u)); c.tid = c.wave * 64 + c.lane; } while (0)
#define GBAR() do { RELANE(); xcd_barrier(bar, c.tid); } while (0)
#define SEAM(k) do { if (IN(k) && IN((k) + 1)) { if ((k) == 0) grid.sync(); else GBAR(); } RELANE(); } while (0)
#ifndef REPEAT_MASK
#define REPEAT_MASK 0
#endif
#define PHASE(k, ...) do { if (IN(k)) { RELANE(); __VA_ARGS__; if ((REPEAT_MASK >> (k)) & 1) { GBAR(); RELANE(); __VA_ARGS__; } } SEAM(k); } while (0)
#define GEMM_PHASE(EPI, A_, Bt_, N_, ...) do { pg8::Gemm g{A_, Bt_, NTOK, N_, DM}; pg8::StaticOrder S; S.init(NTOK, N_, c.nb, c.bid); EPI E{__VA_ARGS__}; \
        pg8::gemm_phase<EPI, pg8::StaticOrder, true, true>((PG8_LAS unsigned char*)lds, g, S, E, c.wave); } while (0)
    PHASE(0, nv::d_cvt_bf16(c, x, xb, (size_t)NTOK * DM / 4); nv::d_transpose_w(c, w_in, DM, IN_COLS, IN_PAD, w_in_t); nv::d_transpose_w(c, w_out, DM, DM, DM, w_out_t);
             nv::d_transpose_w(c, wq, DM, PEER_Q, PEER_Q, wq_t); nv::d_rope_table(c, rope); rw::d_lowrank_t(c, w2, a2, w2t, a2t); rw::d_g2_t(c, g2, g2t));
    PHASE(1, GEMM_PHASE(pg8::EpiBf16<0>, xb, w_in_t, IN_PAD, proj, IN_PAD, nullptr, 0, 0, 1.f));
    PHASE(2, nv::d_rotary(c, proj, rope, qr, kr));
    PHASE(3, nv::d_attn(c, qr, kr, proj, sink, mix));
    PHASE(4, rw::d_prep(c, 0, proj, mu_prev, mu_next, w0, a0, k_k, k_a, w2t, a2t, UO, ybuf));
    PHASE(5, rw::d_seq(c, 0, UO, ybuf));
    PHASE(6, rw::d_prep(c, 1, proj, mu_prev, mu_next, w0, a0, k_k, k_a, w2t, a2t, UO, ybuf));
    PHASE(7, rw::d_seq(c, 1, UO, ybuf));
    PHASE(8, rw::d_out(c, proj, ybuf, mu_prev, mu_next, a0, k_a, r_k, a2t, g2t, lnx_g, lnx_b, mix));
    PHASE(9, GEMM_PHASE(pg8::EpiResF32, mix, w_out_t, DM, x, y1, DM, DN_ALPHA));
    PHASE(10, { float* y1p = y1; nv::d_ln1(c, y1p, ln1_g, ln1_b, y1p, h1b); } pe8::d_quant_tables(c, pu, pv, u8t, v8t, su8, sv8));
    PHASE(11, GEMM_PHASE(pg8::EpiBf16<0>, h1b, wq_t, PEER_Q, qb, PEER_Q, nullptr, 0, 0, 1.f));
    PHASE(12, pk::d_peer_topk(c, qb, keys, idx, gate));
    PHASE(13, pe8::d_peer_gather(c, h1b, idx, gate, u8t, v8t, su8, sv8, ln2_g, ln2_b, out));
#undef IN
#undef SEAM
}
#undef x
#undef out
#undef proj
#undef mix
#undef idx
#undef gate
#undef keys
#undef rope
#undef w0
#undef w2
#undef a0
#undef a2
#undef g2
#undef sink
#undef qr
#undef kr
#undef ub
#undef vb
#undef qb
#undef xb
#undef y1
#undef UO
#undef ybuf
#undef pu
#undef pv

#ifndef N_LAUNCHES
#define N_LAUNCHES 1
#endif
extern "C" void kernel_launch(void* const* d_in, const int* in_sizes, int n_in, void* d_out, int out_size, void* d_ws, size_t ws_size, hipStream_t stream) {
    static int grid = 0;
    if (grid == 0) {
        if (n_in != 24 || in_sizes[0] != NTOK * DM || out_size != NTOK * DM || ws_size < 496 * MiB) { fprintf(stderr, "kernel_launch: unexpected shapes/ws (n_in %d, ws %zu)\n", n_in, ws_size); grid = -1; return; }
        int dev = 0, cus = 0, per_cu = 0;
        if (hipGetDevice(&dev) != hipSuccess || hipDeviceGetAttribute(&cus, hipDeviceAttributeMultiprocessorCount, dev) != hipSuccess) { grid = -1; return; }
        if (hipFuncSetAttribute((const void*)mega, hipFuncAttributeMaxDynamicSharedMemorySize, LDS_BYTES) != hipSuccess) { fprintf(stderr, "kernel_launch: hipFuncSetAttribute failed\n"); grid = -1; return; }
        if (hipOccupancyMaxActiveBlocksPerMultiprocessor(&per_cu, (const void*)mega, 512, LDS_BYTES) != hipSuccess || per_cu < 1) { fprintf(stderr, "kernel_launch: occupancy query failed (%d)\n", per_cu); (void)hipGetLastError(); grid = -1; return; }
        grid = cus * per_cu;
        fprintf(stderr, "kernel_launch: cus %d per_cu %d grid %d\n", cus, per_cu, grid);
    }
    if (grid < 0) return;
    if (hipMemsetAsync(d_ws, 0, 65536, stream) != hipSuccess) { fprintf(stderr, "kernel_launch: memset failed\n"); return; }
    Params p{};
    for (int i = 0; i < 24; ++i) p.in[i] = (const float*)d_in[i];
    p.out = (float*)d_out; p.ws = (unsigned char*)d_ws;
#if N_LAUNCHES == 1
    p.ph_lo = 0; p.ph_hi = NPHASE;
    void* args[] = {&p};
    hipError_t e = hipLaunchCooperativeKernel((const void*)mega, dim3(grid), dim3(512), args, LDS_BYTES, stream);
    if (e != hipSuccess) fprintf(stderr, "cooperative launch failed: %s (grid %d)\n", hipGetErrorString(e), grid);
#else
    for (int k = 0; k < NPHASE; ++k) { p.ph_lo = k; p.ph_hi = k + 1; hipLaunchKernelGGL(mega, dim3(grid), dim3(512), LDS_BYTES, stream, p); }
#endif
}
```

```cpp
#include <hip/hip_runtime.h>
#include <hip/hip_cooperative_groups.h>
#include <cstdio>
#include <cstdint>
#include <cmath>
namespace cg = cooperative_groups;

constexpr int BATCH = 8, SEQ = 4096, DM = 1024, NTOK = BATCH * SEQ;
constexpr int IN_COLS = 2528, IN_PAD = 2560;
constexpr int C_Q = 0, C_K = 512, C_V = 640, C_P = 768;
constexpr int P_R = 0, P_KK = 512, P_VV = 1024, P_WD = 1536, P_AD = 1600, P_GD = 1664, RW_COLS = 1760;
constexpr int NEXP = 16384, PEER_Q = 2048;
constexpr float LN_EPS = 1e-5f, GN_EPS = 64e-5f;
constexpr float DN_ALPHA = 1.189207115002721f;

typedef unsigned short bf16;
__device__ __forceinline__ float bf2f(bf16 v) { return __uint_as_float(((unsigned)v) << 16); }
__device__ __forceinline__ bf16 f2bf(float f) { unsigned u = __float_as_uint(f); return (bf16)((u + 0x7fffu + ((u >> 16) & 1u)) >> 16); }
__device__ __forceinline__ unsigned pk2bf(float lo, float hi) { return (unsigned)f2bf(lo) | ((unsigned)f2bf(hi) << 16); }
__device__ __forceinline__ float wave_sum(float v) {
#pragma unroll
    for (int o = 1; o < 64; o <<= 1) v += __shfl_xor(v, o);
    return v;
}
__device__ __forceinline__ float sigmoidf_(float x) { return 1.f / (1.f + __expf(-x)); }
namespace pg8 {
#define PG8_LAS __attribute__((address_space(3)))
typedef unsigned short bf16_t;
typedef short bf16x8 __attribute__((ext_vector_type(8)));
typedef float f32x4 __attribute__((ext_vector_type(4)));
typedef unsigned u32x4 __attribute__((ext_vector_type(4)));
constexpr int BM = 256, BK = 64, HALF = 128, HTB = HALF * BK * 2  , STAGE_BYTES = 8 * HTB, NXCD = 8, WGM = 8;

__host__ __device__ __forceinline__ int lds_byte(int r, int c) { const int st = (r >> 4) * 2 + (c >> 5), rr = r & 15, cc = c & 31, ob = rr * 64 + cc * 2; return st * 1024 + (ob ^ (((ob >> 9) & 1) << 5)); }
__host__ __device__ __forceinline__ void stage_rc(int b, int& R, int& C) { const int st = b / 1024, sb = b % 1024, swz = sb ^ (((sb >> 9) & 1) << 5); R = (st >> 1) * 16 + swz / 64; C = (st & 1) * 32 + (swz % 64) / 2; }
__host__ __device__ __forceinline__ int perm32(int rho) { const int n = rho >> 4, i = rho & 15; return 8 * (i >> 2) + 4 * n + (i & 3); }

struct Unit { int pm, pn; };
struct Gemm { const bf16_t* A; const bf16_t* Bt; int M, N, K; };

struct StaticOrder {
    int nM, nN, nwg, G, c;
    __host__ __device__ void init(int M, int N, int G_, int c_) { nM = M / BM; nN = N / BM; nwg = nM * nN; G = G_; c = c_; }
    __host__ __device__ bool next(int i, Unit& u) const {
        const long L = (long)i * G + c; if (L >= nwg) return false;
        int wgid = (int)L; { const int q = nwg / NXCD, r = nwg % NXCD, xcd = wgid % NXCD, off = wgid / NXCD; wgid = (xcd < r ? xcd * (q + 1) : r * (q + 1) + (xcd - r) * q) + off; }
        const int nig = WGM * nN, gid = wgid / nig, fm = gid * WGM, gsz = (nM - fm) < WGM ? (nM - fm) : WGM;
        u.pm = fm + ((wgid % nig) % gsz); u.pn = (wgid % nig) / gsz; return true;
    }
    __device__ __forceinline__ void a_ready(const Unit&) const {}
    __device__ __forceinline__ void done(const Unit&) const {}
};

__device__ __forceinline__ unsigned cvt_pk_bf16(float lo, float hi) { unsigned r; asm volatile("v_cvt_pk_bf16_f32 %0, %1, %2" : "=v"(r) : "v"(lo), "v"(hi)); return r; }
typedef float f32x2 __attribute__((ext_vector_type(2)));
__device__ __forceinline__ f32x2 gelu_pk(f32x2 v) {
    const f32x2 av = __builtin_elementwise_abs(v), d = av * 0.2316418882f + 1.0f;
    f32x2 t; t.x = __builtin_amdgcn_rcpf(d.x); t.y = __builtin_amdgcn_rcpf(d.y);
    f32x2 q = t * 0.5307027145f + (-0.7265760135f); q = q * t + 0.7107068705f; q = q * t + (-0.142248368f); q = q * t + 0.127414796f; q = q * t;
    const f32x2 s = (v * v) * (-0.72134752044f);
    f32x2 e; e.x = __builtin_amdgcn_exp2f(s.x); e.y = __builtin_amdgcn_exp2f(s.y);
    const f32x2 m = v * (q * e), r = v - m;
    f32x2 o; o.x = v.x < 0.f ? m.x : r.x; o.y = v.y < 0.f ? m.y : r.y; return o;
}

template <int ACT  > struct EpiBf16 {
    static constexpr bool PERM = true, AFTER_DRAIN = false; static_assert(ACT == 0 || ACT == 1, "EpiBf16: ACT is 0 (none) or 1 (gelu_pk)");
    bf16_t* O; int ldc; const float* bias; int split_cols; size_t split_stride; float scale0;
    __device__ __forceinline__ void operator()(const f32x4 (&acc)[2][2][4][2], const Unit& u, int wr, int wc, int fr, int fq) const {
        const int row0 = u.pm * BM + wr * 64 + fr; int colt = u.pn * BM; bf16_t* base = O;
        float sc = 1.f; if (split_cols) { const int t = colt / split_cols; base += (size_t)t * split_stride; colt -= t * split_cols; if (t == 0) sc = scale0; }
        const int col0 = colt + wc * 32 + 8 * fq, bcol0 = u.pn * BM + wc * 32 + 8 * fq;
        f32x4 bv[2][2];
#pragma unroll
        for (int bj = 0; bj < 2; ++bj)
#pragma unroll
            for (int n = 0; n < 2; ++n) bv[bj][n] = bias ? *(const f32x4*)(bias + bcol0 + bj * HALF + 4 * n) : (f32x4){0.f, 0.f, 0.f, 0.f};
#pragma unroll
        for (int ai = 0; ai < 2; ++ai)
#pragma unroll
            for (int m = 0; m < 4; ++m) { bf16_t* rowp = base + (size_t)(row0 + ai * HALF + m * 16) * ldc + col0;
#pragma unroll
                for (int bj = 0; bj < 2; ++bj) { f32x4 v0 = acc[ai][bj][m][0] + bv[bj][0], v1 = acc[ai][bj][m][1] + bv[bj][1];
                    if (ACT == 1) { f32x2 a = gelu_pk((f32x2){v0[0], v0[1]}), b = gelu_pk((f32x2){v0[2], v0[3]}), c = gelu_pk((f32x2){v1[0], v1[1]}), d = gelu_pk((f32x2){v1[2], v1[3]});
                        v0 = (f32x4){a.x, a.y, b.x, b.y}; v1 = (f32x4){c.x, c.y, d.x, d.y}; }
                    v0 = v0 * sc; v1 = v1 * sc; u32x4 w; w.x = cvt_pk_bf16(v0[0], v0[1]); w.y = cvt_pk_bf16(v0[2], v0[3]); w.z = cvt_pk_bf16(v1[0], v1[1]); w.w = cvt_pk_bf16(v1[2], v1[3]);
                    *(u32x4*)(rowp + bj * HALF) = w; } }
    }
};

struct PanelStats {
    unsigned* xbuf;
    unsigned* cnt;
    unsigned* tmo;
    int ntn; float eps;
    unsigned code;
    __device__ __forceinline__ bool run(const f32x4 (&v)[2][2][4][2], const Unit& u, int wr, int wc, int fr, int fq, PG8_LAS unsigned char* lds, int wid, int lane) const {
        typedef float f32x2v __attribute__((ext_vector_type(2)));
        PG8_LAS f32x2v* P = (PG8_LAS f32x2v*)lds;
        PG8_LAS f32x2v* S = (PG8_LAS f32x2v*)(lds + 8192);
        PG8_LAS unsigned* flag = (PG8_LAS unsigned*)(lds + 8192 + 2048);
#pragma unroll
        for (int ai = 0; ai < 2; ++ai)
#pragma unroll
            for (int m = 0; m < 4; ++m) {
                float s = 0.f;
#pragma unroll
                for (int bj = 0; bj < 2; ++bj)
#pragma unroll
                    for (int n = 0; n < 2; ++n) { const f32x4 x = v[ai][bj][m][n]; s += (x[0] + x[1]) + (x[2] + x[3]); }
                s += __shfl_xor(s, 16); s += __shfl_xor(s, 32);
                const float mw = s * (1.0f / 64.0f); float q = 0.f;
#pragma unroll
                for (int bj = 0; bj < 2; ++bj)
#pragma unroll
                    for (int n = 0; n < 2; ++n) { const f32x4 d = v[ai][bj][m][n] - mw; q += (d[0] * d[0] + d[1] * d[1]) + (d[2] * d[2] + d[3] * d[3]); }
                q += __shfl_xor(q, 16); q += __shfl_xor(q, 32);
                if (fq == 0) P[(ai * HALF + wr * 64 + m * 16 + fr) * 4 + wc] = (f32x2v){mw, q};
            }
        asm volatile("s_waitcnt lgkmcnt(0)" ::: "memory"); __builtin_amdgcn_s_barrier(); asm volatile("" ::: "memory");
#if defined(BROKEN_EXCHANGE_NO_WAIT)
#warning BROKEN CONTROL BUILD: the row-statistics exchange does not wait; results are wrong by design
        if (blockIdx.x >= 64) { const long long t0_ = clock64(); while (clock64() - t0_ < 60000) __builtin_amdgcn_s_sleep(8); }
#endif
        const int row = wid * 32 + (lane & 31);
        if (lane < 32) {
            const f32x2v a = P[row * 4 + 0], b = P[row * 4 + 1], c = P[row * 4 + 2], d = P[row * 4 + 3];
            const float mt = (a.x + b.x + c.x + d.x) * 0.25f;
            const float da = a.x - mt, db = b.x - mt, dc = c.x - mt, dd = d.x - mt;
            const float m2 = (a.y + b.y) + (c.y + d.y) + 64.0f * ((da * da + db * db) + (dc * dc + dd * dd));
            unsigned long long* slot = (unsigned long long*)xbuf + ((size_t)(u.pm * BM + row) * 4 + u.pn);
            __hip_atomic_store(slot, ((unsigned long long)__float_as_uint(m2) << 32) | __float_as_uint(mt), __ATOMIC_RELAXED, __HIP_MEMORY_SCOPE_AGENT);
        }
        asm volatile("s_waitcnt vmcnt(0)" ::: "memory");
        if (lane == 0) __hip_atomic_fetch_add(cnt + 64 * u.pm, 1u, __ATOMIC_RELAXED, __HIP_MEMORY_SCOPE_AGENT);
        if (wid == 0) {
            bool dead = false; const unsigned long long t0 = __builtin_amdgcn_s_memrealtime(); const unsigned want = 8u * (unsigned)ntn;
            for (;;) {
#if defined(BROKEN_EXCHANGE_NO_WAIT)
                break;
#endif
                if ((unsigned)__builtin_amdgcn_readfirstlane(__hip_atomic_load(cnt + 64 * u.pm, __ATOMIC_RELAXED, __HIP_MEMORY_SCOPE_AGENT)) >= want) break;
                if (__builtin_amdgcn_s_memrealtime() - t0 > 2000000ull) {
                    if (lane == 0) { unsigned expect = 0u; __hip_atomic_compare_exchange_strong(tmo + 1, &expect, code | (unsigned)(u.pm & 0xff), __ATOMIC_RELAXED, __ATOMIC_RELAXED, __HIP_MEMORY_SCOPE_AGENT);
                                     __hip_atomic_store(tmo, 1u, __ATOMIC_RELAXED, __HIP_MEMORY_SCOPE_AGENT); }
                    dead = true; break; }
                __builtin_amdgcn_s_sleep(2);
            }
            __builtin_amdgcn_fence(__ATOMIC_ACQUIRE, "agent");
            if (lane == 0) flag[0] = dead ? 1u : 0u;
        }
        asm volatile("s_waitcnt vmcnt(0) lgkmcnt(0)" ::: "memory"); __builtin_amdgcn_s_barrier(); asm volatile("" ::: "memory");
        const bool bad = flag[0] != 0u;
        if (lane < 32) {
            const unsigned long long* slot = (const unsigned long long*)xbuf + (size_t)(u.pm * BM + row) * 4; float mt[4], m2[4]; float ms = 0.f;
#pragma unroll
            for (int t = 0; t < 4; ++t) { if (t < ntn) { const unsigned long long w = __hip_atomic_load(slot + t, __ATOMIC_RELAXED, __HIP_MEMORY_SCOPE_AGENT); mt[t] = __uint_as_float((unsigned)w); m2[t] = __uint_as_float((unsigned)(w >> 32)); } else { mt[t] = 0.f; m2[t] = 0.f; } ms += mt[t]; }
            const float mean = ms / (float)ntn; float q = 0.f;
#pragma unroll
            for (int t = 0; t < 4; ++t) if (t < ntn) { const float dm = mt[t] - mean; q += m2[t] + 256.0f * dm * dm; }
            S[row] = (f32x2v){mean, 1.0f / sqrtf(q / (256.0f * (float)ntn) + eps)};
        }
        asm volatile("s_waitcnt lgkmcnt(0)" ::: "memory"); __builtin_amdgcn_s_barrier(); asm volatile("" ::: "memory");
        return bad;
    }
};
struct EpiLnRes {
    static constexpr bool PERM = false, AFTER_DRAIN = true;
    const float* base; float* out; int ldc; const float* bias; PanelStats st; unsigned poison;
    __device__ __forceinline__ void fused(f32x4 (&acc)[2][2][4][2], const Unit& u, int wr, int wc, int fr, int fq, PG8_LAS unsigned char* lds, int wid, int lane) const {
        typedef float f32x2v __attribute__((ext_vector_type(2)));
        const PG8_LAS f32x2v* S = (const PG8_LAS f32x2v*)(lds + 8192);
        const int col0 = u.pn * BM + wc * 32 + 4 * fq;
#pragma unroll
        for (int bj = 0; bj < 2; ++bj)
#pragma unroll
            for (int n = 0; n < 2; ++n) { const f32x4 bv = bias ? *(const f32x4*)(bias + col0 + bj * HALF + n * 16) : (f32x4){0.f, 0.f, 0.f, 0.f};
#pragma unroll
                for (int ai = 0; ai < 2; ++ai)
#pragma unroll
                    for (int m = 0; m < 4; ++m) acc[ai][bj][m][n] += bv; }
        f32x4 pre[4][2][2];
#pragma unroll
        for (int m = 0; m < 4; ++m) { const size_t off = (size_t)(u.pm * BM + wr * 64 + m * 16 + fr) * ldc + col0;
#pragma unroll
            for (int bj = 0; bj < 2; ++bj)
#pragma unroll
                for (int n = 0; n < 2; ++n) pre[m][bj][n] = *(const f32x4*)(base + off + bj * HALF + n * 16); }
        const bool bad = st.run(acc, u, wr, wc, fr, fq, lds, wid, lane) || poison != 0u;
        const float qnan = __builtin_nanf("");
#pragma unroll
        for (int ai = 0; ai < 2; ++ai)
#pragma unroll
            for (int m = 0; m < 4; ++m) { const int r = ai * HALF + wr * 64 + m * 16 + fr; const f32x2v sr = S[r]; const size_t off = (size_t)(u.pm * BM + r) * ldc + col0;
#pragma unroll
                for (int bj = 0; bj < 2; ++bj)
#pragma unroll
                    for (int n = 0; n < 2; ++n) { const f32x4 bs = ai == 0 ? pre[m][bj][n] : *(const f32x4*)(base + off + bj * HALF + n * 16); f32x4 o = bs + (acc[ai][bj][m][n] - sr.x) * sr.y;
                        if (bad) o = (f32x4){qnan, qnan, qnan, qnan}; *(f32x4*)(out + off + bj * HALF + n * 16) = o; }
                if (m & 1) asm volatile("" ::: "memory"); }
    }
};
struct EpiLnResLn {
    static constexpr bool PERM = false, AFTER_DRAIN = true;
    const float* base; float* out; bf16_t* xn; int ldc; const float* bias; PanelStats st1, st2; unsigned poison;
    __device__ __forceinline__ void fused(f32x4 (&acc)[2][2][4][2], const Unit& u, int wr, int wc, int fr, int fq, PG8_LAS unsigned char* lds, int wid, int lane) const {
        typedef float f32x2v __attribute__((ext_vector_type(2))); typedef unsigned u32x2v __attribute__((ext_vector_type(2)));
        const PG8_LAS f32x2v* S = (const PG8_LAS f32x2v*)(lds + 8192);
        const int col0 = u.pn * BM + wc * 32 + 4 * fq;
#pragma unroll
        for (int bj = 0; bj < 2; ++bj)
#pragma unroll
            for (int n = 0; n < 2; ++n) { const f32x4 bv = bias ? *(const f32x4*)(bias + col0 + bj * HALF + n * 16) : (f32x4){0.f, 0.f, 0.f, 0.f};
#pragma unroll
                for (int ai = 0; ai < 2; ++ai)
#pragma unroll
                    for (int m = 0; m < 4; ++m) acc[ai][bj][m][n] += bv; }
        bool bad = st1.run(acc, u, wr, wc, fr, fq, lds, wid, lane) || poison != 0u;
        const float qnan = __builtin_nanf("");
#pragma unroll
        for (int ai = 0; ai < 2; ++ai)
#pragma unroll
            for (int m = 0; m < 4; ++m) { const int r = ai * HALF + wr * 64 + m * 16 + fr; const f32x2v sr = S[r]; const size_t off = (size_t)(u.pm * BM + r) * ldc + col0;
#pragma unroll
                for (int bj = 0; bj < 2; ++bj)
#pragma unroll
                    for (int n = 0; n < 2; ++n) { const f32x4 bs = *(const f32x4*)(base + off + bj * HALF + n * 16); acc[ai][bj][m][n] = bs + (acc[ai][bj][m][n] - sr.x) * sr.y; }
                asm volatile("" : "+v"(acc[ai][0][m][0]), "+v"(acc[ai][0][m][1]), "+v"(acc[ai][1][m][0]), "+v"(acc[ai][1][m][1]));
                if (m & 1) asm volatile("" ::: "memory"); }
        const bool bad1 = bad;
        bad = st2.run(acc, u, wr, wc, fr, fq, lds, wid, lane) || bad;
#pragma unroll
        for (int ai = 0; ai < 2; ++ai)
#pragma unroll
            for (int m = 0; m < 4; ++m) { const int r = ai * HALF + wr * 64 + m * 16 + fr; const f32x2v sr = S[r]; const size_t off = (size_t)(u.pm * BM + r) * ldc + col0;
#pragma unroll
                for (int bj = 0; bj < 2; ++bj)
#pragma unroll
                    for (int n = 0; n < 2; ++n) { const f32x4 x1 = acc[ai][bj][m][n]; *(f32x4*)(out + off + bj * HALF + n * 16) = bad1 ? (f32x4){qnan, qnan, qnan, qnan} : x1;
                        const f32x4 o = (x1 - sr.x) * sr.y; u32x2v w; w.x = cvt_pk_bf16(o[0], o[1]); w.y = cvt_pk_bf16(o[2], o[3]);
                        if (bad) { w.x = 0x7fc07fc0u; w.y = 0x7fc07fc0u; } *(u32x2v*)(xn + off + bj * HALF + n * 16) = w; }
                asm volatile("" ::: "memory"); }
    }
};

template <class Epi, class Sched, bool ALIGN_EPI = false, bool SP2 = false>
__device__ __forceinline__ void gemm_phase(PG8_LAS unsigned char* lds, const Gemm g, const Sched& S, const Epi& E, const int wid_in) {
    const int lane = (int)__builtin_amdgcn_mbcnt_hi(~0u, __builtin_amdgcn_mbcnt_lo(~0u, 0u)), wid = wid_in, tid = wid * 64 + lane, wr = wid >> 2, wc = wid & 3, fr = lane & 15, fq = lane >> 4;
    const int K = g.K, nt = K / BK;
    unsigned voffA[2], voffB[2];
#pragma unroll
    for (int i = 0; i < 2; ++i) { int R, C; stage_rc(tid * 16 + i * 8192, R, C); const int Rb = Epi::PERM ? ((R & ~31) + perm32(R & 31)) : R;
        voffA[i] = (unsigned)(R * K + C) * 2u; voffB[i] = (unsigned)(Rb * K + C) * 2u; }
    const size_t kstep = (size_t)(BK * 2);
    const size_t hstep = (size_t)HALF * K * 2;
    const size_t tstep = 2 * hstep;
    const unsigned ldsw = (unsigned)wid * 1024u;
    const int aoff = lds_byte(wr * 64 + fr, fq * 8), boff = lds_byte(wc * 32 + fr, fq * 8);
#define PG8_SA(b, h) (((b) * 2 + (h)) * HTB)
#define PG8_SB(b, h) ((4 + (b) * 2 + (h)) * HTB)
#define PG8_STAGE(bufoff, gbase, voff) do { _Pragma("unroll") for (int _i = 0; _i < 2; ++_i) \
        __builtin_amdgcn_global_load_lds((const unsigned*)((const char*)(gbase) + (voff)[_i]), (PG8_LAS unsigned*)(lds + (bufoff) + ldsw + _i * 8192), 16, 0, 0); } while (0)
#define PG8_LDA(dst, b, h) do { _Pragma("unroll") for (int m = 0; m < 4; ++m) _Pragma("unroll") for (int k = 0; k < 2; ++k) dst[m][k] = *(const PG8_LAS bf16x8*)(lds + PG8_SA(b, h) + aoff + m * 2048 + k * 1024); } while (0)
#define PG8_LDB(dst, b, h) do { _Pragma("unroll") for (int n = 0; n < 2; ++n) _Pragma("unroll") for (int k = 0; k < 2; ++k) dst[n][k] = *(const PG8_LAS bf16x8*)(lds + PG8_SB(b, h) + boff + n * 2048 + k * 1024); } while (0)
#define PG8_MMA(ai, bj, At, Bt) do { __builtin_amdgcn_s_setprio(1); _Pragma("unroll") for (int m = 0; m < 4; ++m) _Pragma("unroll") for (int n = 0; n < 2; ++n) _Pragma("unroll") for (int k = 0; k < 2; ++k) \
        acc[ai][bj][m][n] = __builtin_amdgcn_mfma_f32_16x16x32_bf16(Bt[n][k], At[m][k], acc[ai][bj][m][n], 0, 0, 0); __builtin_amdgcn_s_setprio(0); } while (0)
#define PG8_WAIT_V(n) asm volatile("s_waitcnt vmcnt(" #n ")" ::: "memory")
#define PG8_WAIT_L(n) asm volatile("s_waitcnt lgkmcnt(" #n ")" ::: "memory")
#define PG8_BAR __builtin_amdgcn_s_barrier()
#define PG8_SCHED __builtin_amdgcn_sched_barrier(0)
    Unit cur, nxt; int ui = 0;
    if (!S.next(0, cur)) return;
    f32x4 acc[2][2][4][2];
#pragma unroll
    for (int a = 0; a < 2; ++a)
#pragma unroll
        for (int b = 0; b < 2; ++b)
#pragma unroll
            for (int m = 0; m < 4; ++m)
#pragma unroll
                for (int n = 0; n < 2; ++n) acc[a][b][m][n] = (f32x4){0.f, 0.f, 0.f, 0.f};
    bf16x8 At[4][2], B0[2][2], B1[2][2];
    const char* cA = (const char*)g.A + (size_t)cur.pm * tstep; const char* cB = (const char*)g.Bt + (size_t)cur.pn * tstep;
    S.a_ready(cur);
    if constexpr (SP2) {
        PG8_STAGE(PG8_SB(0, 0), cB, voffB); PG8_STAGE(PG8_SB(0, 1), cB + hstep, voffB); PG8_STAGE(PG8_SA(0, 0), cA, voffA); PG8_STAGE(PG8_SA(0, 1), cA + hstep, voffA);
        if (wr == 1) PG8_BAR;
        PG8_WAIT_V(2); PG8_BAR;
        PG8_STAGE(PG8_SB(1, 0), cB + kstep, voffB); PG8_STAGE(PG8_SA(1, 0), cA + kstep, voffA); PG8_STAGE(PG8_SB(1, 1), cB + hstep + kstep, voffB);
        PG8_WAIT_V(6); PG8_BAR;
    } else {
        PG8_STAGE(PG8_SB(0, 0), cB, voffB); PG8_STAGE(PG8_SA(0, 0), cA, voffA); PG8_STAGE(PG8_SB(0, 1), cB + hstep, voffB); PG8_STAGE(PG8_SA(0, 1), cA + hstep, voffA);
        if (wr == 1) PG8_BAR;
        PG8_WAIT_V(4); PG8_BAR;
        PG8_STAGE(PG8_SB(1, 0), cB + kstep, voffB); PG8_STAGE(PG8_SA(1, 0), cA + kstep, voffA); PG8_STAGE(PG8_SB(1, 1), cB + hstep + kstep, voffB);
        PG8_WAIT_V(6); PG8_BAR;
    }
    for (;;) {
        const bool has_next = S.next(ui + 1, nxt);
        const char* nA = has_next ? (const char*)g.A + (size_t)nxt.pm * tstep : cA; const char* nB = has_next ? (const char*)g.Bt + (size_t)nxt.pn * tstep : cB;
        for (int t = 0; t < nt; t += 2) {
            const bool last = (t == nt - 2);
            const char* a1 = cA + (size_t)(t + 1) * kstep;
            const char* a2 = last ? nA : cA + (size_t)(t + 2) * kstep; const char* b2 = last ? nB : cB + (size_t)(t + 2) * kstep;
            const char* a3 = a2 + kstep; const char* b3 = b2 + kstep;
            if (last && has_next) S.a_ready(nxt);
            if constexpr (SP2) {
            PG8_LDB(B0, 0, 0); PG8_LDB(B1, 0, 1); PG8_SCHED; PG8_LDA(At, 0, 0); PG8_STAGE(PG8_SA(1, 1), a1 + hstep, voffA);
            PG8_WAIT_V(8); PG8_WAIT_L(0); PG8_BAR; PG8_MMA(0, 0, At, B0); PG8_MMA(0, 1, At, B1); PG8_BAR; PG8_SCHED;
            PG8_LDA(At, 0, 1); PG8_STAGE(PG8_SB(0, 0), b2, voffB); PG8_STAGE(PG8_SB(0, 1), b2 + hstep, voffB); PG8_STAGE(PG8_SA(0, 0), a2, voffA);
            PG8_WAIT_V(8); PG8_WAIT_L(0); PG8_BAR; PG8_MMA(1, 0, At, B0); PG8_MMA(1, 1, At, B1); PG8_BAR; PG8_SCHED;
            PG8_LDB(B0, 1, 0); PG8_LDB(B1, 1, 1); PG8_SCHED; PG8_LDA(At, 1, 0); PG8_STAGE(PG8_SA(0, 1), a2 + hstep, voffA);
            PG8_WAIT_V(8); PG8_WAIT_L(0); PG8_BAR; PG8_MMA(0, 0, At, B0); PG8_MMA(0, 1, At, B1); PG8_BAR; PG8_SCHED;
            PG8_LDA(At, 1, 1); PG8_STAGE(PG8_SB(1, 0), b3, voffB); PG8_STAGE(PG8_SB(1, 1), b3 + hstep, voffB); PG8_STAGE(PG8_SA(1, 0), a3, voffA);
            PG8_WAIT_V(8); PG8_WAIT_L(0); PG8_BAR; PG8_MMA(1, 0, At, B0); PG8_MMA(1, 1, At, B1); PG8_BAR; PG8_SCHED;
            } else {
            PG8_LDB(B0, 0, 0); PG8_SCHED; PG8_LDA(At, 0, 0); PG8_STAGE(PG8_SA(1, 1), a1 + hstep, voffA);
            PG8_WAIT_L(8); PG8_BAR; PG8_WAIT_L(0); PG8_MMA(0, 0, At, B0); PG8_BAR; PG8_SCHED;
            PG8_LDB(B1, 0, 1); PG8_STAGE(PG8_SB(0, 0), b2, voffB);
            PG8_BAR; PG8_WAIT_L(0); PG8_MMA(0, 1, At, B1); PG8_BAR;
            PG8_LDA(At, 0, 1); PG8_STAGE(PG8_SA(0, 0), a2, voffA);
            PG8_BAR; PG8_WAIT_L(0); PG8_MMA(1, 0, At, B0); PG8_BAR; PG8_SCHED;
            PG8_STAGE(PG8_SB(0, 1), b2 + hstep, voffB);
            PG8_WAIT_V(6); PG8_BAR; PG8_MMA(1, 1, At, B1); PG8_BAR;
            PG8_LDB(B0, 1, 0); PG8_SCHED; PG8_LDA(At, 1, 0); PG8_STAGE(PG8_SA(0, 1), a2 + hstep, voffA);
            PG8_WAIT_L(8); PG8_BAR; PG8_WAIT_L(0); PG8_MMA(0, 0, At, B0); PG8_BAR; PG8_SCHED;
            PG8_LDB(B1, 1, 1); PG8_STAGE(PG8_SB(1, 0), b3, voffB);
            PG8_BAR; PG8_WAIT_L(0); PG8_MMA(0, 1, At, B1); PG8_BAR;
            PG8_LDA(At, 1, 1); PG8_STAGE(PG8_SA(1, 0), a3, voffA);
            PG8_BAR; PG8_WAIT_L(0); PG8_MMA(1, 0, At, B0); PG8_BAR; PG8_SCHED;
            PG8_STAGE(PG8_SB(1, 1), b3 + hstep, voffB);
            PG8_WAIT_V(6); PG8_BAR; PG8_MMA(1, 1, At, B1); PG8_BAR;
            }
        }
        if constexpr (ALIGN_EPI) { if (wr == 0) PG8_BAR; }
        if constexpr (!Epi::AFTER_DRAIN) { E(acc, cur, wr, wc, fr, fq); S.done(cur); }
        if (!has_next) break;
#pragma unroll
        for (int a = 0; a < 2; ++a)
#pragma unroll
            for (int b = 0; b < 2; ++b)
#pragma unroll
                for (int m = 0; m < 4; ++m)
#pragma unroll
                    for (int n = 0; n < 2; ++n) acc[a][b][m][n] = (f32x4){0.f, 0.f, 0.f, 0.f};
        cur = nxt; cA = nA; cB = nB; ++ui;
        if constexpr (ALIGN_EPI) { if (wr == 1) PG8_BAR; }
    }
    PG8_WAIT_V(0);
    if constexpr (!ALIGN_EPI) { if (wr == 0) PG8_BAR; }
    PG8_BAR;
    if constexpr (Epi::AFTER_DRAIN) { E.fused(acc, cur, wr, wc, fr, fq, lds, wid, lane); S.done(cur); }
#undef PG8_SA
#undef PG8_SB
#undef PG8_STAGE
#undef PG8_LDA
#undef PG8_LDB
#undef PG8_MMA
#undef PG8_WAIT_V
#undef PG8_WAIT_L
#undef PG8_BAR
#undef PG8_SCHED
}
}
#define LAS __attribute__((address_space(3)))
typedef float f32x4 __attribute__((ext_vector_type(4)));
struct Ctx { int tid, lane, wave, bid, nb, gw, ngw; unsigned char* lds; };

namespace nv {
__device__ __forceinline__ void d_cvt_bf16(const Ctx& c, const float* __restrict__ in, bf16* __restrict__ out, size_t n4) {
    for (size_t i = (size_t)c.bid * 512 + c.tid; i < n4; i += (size_t)c.nb * 512) { f32x4 v = ((const f32x4*)in)[i]; uint2 o; o.x = pk2bf(v.x, v.y); o.y = pk2bf(v.z, v.w); ((uint2*)out)[i] = o; }
}
__device__ __forceinline__ void d_transpose_w(const Ctx& c, const float* __restrict__ W, int K, int N, int Npad, bf16* __restrict__ WT) {
    float* t = (float*)(c.lds) + c.wave * (32 * 33);
    const int tx = c.lane & 31, ty = c.lane >> 5, nbn = Npad / 32, ntile = nbn * (K / 32);
    for (int it = c.gw; it < ntile; it += c.ngw) {
        const int n0 = (it % nbn) * 32, k0 = (it / nbn) * 32;
        for (int i = ty; i < 32; i += 2) { const int n = n0 + tx; t[i * 33 + tx] = (n < N) ? W[(size_t)(k0 + i) * N + n] : 0.f; }
        __builtin_amdgcn_fence(__ATOMIC_RELEASE, "workgroup"); __builtin_amdgcn_wave_barrier();
        for (int i = ty; i < 32; i += 2) WT[(size_t)(n0 + i) * K + k0 + tx] = f2bf(t[tx * 33 + i]);
        __builtin_amdgcn_fence(__ATOMIC_RELEASE, "workgroup"); __builtin_amdgcn_wave_barrier();
    }
}
__device__ __forceinline__ void d_rope_table(const Ctx& c, float2* __restrict__ tab) {
    for (int id = c.bid * 512 + c.tid; id < SEQ * 32; id += c.nb * 512) {
        const int pos = id >> 5, i = id & 31;
        const float inv = (float)pow(10000.0, -(double)i / 32.0);
        const float ang = (float)pos * inv;
        tab[id] = make_float2((float)cos((double)ang), (float)sin((double)ang));
    }
}
__device__ __forceinline__ void d_rotary(const Ctx& c, const bf16* __restrict__ proj, const float2* __restrict__ tab, bf16* __restrict__ qr, bf16* __restrict__ kr) {
    for (size_t id = (size_t)c.bid * 512 + c.tid; id < (size_t)NTOK * 320; id += (size_t)c.nb * 512) {
        const int d = id & 31, hh = (id >> 5) % 10; const size_t t = id / 320; const int pos = (int)(t % SEQ);
        const float2 cs = tab[pos * 32 + d];
        const bf16* src = proj + t * IN_PAD + hh * 64;
        const float t1 = bf2f(src[d]), t2 = bf2f(src[d + 32]);
        const float o1 = t1 * cs.x - t2 * cs.y, o2 = t2 * cs.x + t1 * cs.y;
        bf16* dst = (hh < 8) ? (qr + t * 512 + hh * 64) : (kr + t * 128 + (hh - 8) * 64);
        dst[d] = f2bf(o1); dst[d + 32] = f2bf(o2);
    }
}
__device__ __forceinline__ void d_attn(const Ctx& c, const bf16* __restrict__ qr, const bf16* __restrict__ kr, const bf16* __restrict__ proj, const float* __restrict__ sink, bf16* __restrict__ mix) {
    for (int id = c.bid * 512 + c.tid; id < NTOK * 8; id += c.nb * 512) {
        const int hq = id & 7, t = id >> 3, b = t / SEQ, i = t % SEQ, kvh = hq >> 2;
        float q[64], acc[64];
#pragma unroll
        for (int d = 0; d < 64; ++d) { q[d] = bf2f(qr[(size_t)t * 512 + hq * 64 + d]) * 0.125f; acc[d] = 0.f; }
        float m = sink[hq], l = 1.f;
        const int j0 = max(0, i - 128), j1 = min(SEQ - 1, i + 128);
        for (int j = j0; j <= j1; ++j) {
            const size_t tj = (size_t)b * SEQ + j;
            const uint4* kp = (const uint4*)(kr + tj * 128 + kvh * 64);
            float s = 0.f;
#pragma unroll
            for (int cc = 0; cc < 8; ++cc) { const uint4 w = kp[cc]; const unsigned ww[4] = {w.x, w.y, w.z, w.w};
#pragma unroll
                for (int e = 0; e < 4; ++e) { s += q[cc * 8 + 2 * e] * __uint_as_float(ww[e] << 16) + q[cc * 8 + 2 * e + 1] * __uint_as_float(ww[e] & 0xffff0000u); } }
            if (s > m) { const float f = __expf(m - s); l *= f;
#pragma unroll
                for (int d = 0; d < 64; ++d) acc[d] *= f;
                m = s; }
            const float p = __expf(s - m); l += p;
            const uint4* vp = (const uint4*)(proj + tj * IN_PAD + C_V + kvh * 64);
#pragma unroll
            for (int cc = 0; cc < 8; ++cc) { const uint4 w = vp[cc]; const unsigned ww[4] = {w.x, w.y, w.z, w.w};
#pragma unroll
                for (int e = 0; e < 4; ++e) { acc[cc * 8 + 2 * e] += p * __uint_as_float(ww[e] << 16); acc[cc * 8 + 2 * e + 1] += p * __uint_as_float(ww[e] & 0xffff0000u); } }
        }
        const float il = 1.f / l;
#pragma unroll
        for (int d = 0; d < 64; d += 2) *(unsigned*)(mix + (size_t)t * DM + hq * 64 + d) = pk2bf(acc[d] * il, acc[d + 1] * il);
    }
}
__device__ __forceinline__ void d_scan(const Ctx& c, const bf16* __restrict__ proj, const float* __restrict__ mu_prev, const float* __restrict__ mu_next,
                                       const float* __restrict__ w0, const float* __restrict__ w2, const float* __restrict__ a0, const float* __restrict__ a2,
                                       const float* __restrict__ k_k, const float* __restrict__ k_a, float* __restrict__ ydir) {
    if (c.wave != 0) return;
    for (int unit = c.bid; unit < 128; unit += c.nb) {
    const int b = unit >> 4, h = (unit >> 1) & 7, d = unit & 1, lane = c.lane, ch = h * 64 + lane;
    float (*sh)[64] = (float (*)[64])c.lds;
    const int colx = lane < 32 ? (P_WD + d * 32 + lane) : (P_AD + d * 32 + lane - 32);
    const int cols[4] = {P_R + ch, P_KK + ch, P_VV + ch, colx};
    float mp[4], mn[4];
#pragma unroll
    for (int q = 0; q < 4; ++q) { mp[q] = mu_prev[cols[q]]; mn[q] = mu_next[cols[q]]; }
    float* w2c = (float*)c.lds + 6 * 64 + lane; float* a2c = w2c + 32 * 64;
    for (int j = 0; j < 32; ++j) { w2c[j * 64] = w2[(size_t)(d * 32 + j) * 512 + ch]; a2c[j * 64] = a2[(size_t)(d * 32 + j) * 512 + ch]; }
    const float w0c = w0[d * 512 + ch], a0c = a0[d * 512 + ch], kkc = k_k[ch], kac = k_a[ch];
    float S[64];
#pragma unroll
    for (int k = 0; k < 64; ++k) S[k] = 0.f;
    const int sgn = d ? -1 : 1; int t = d ? SEQ - 1 : 0;
    const bf16* pb = proj + (size_t)b * SEQ * IN_PAD + C_P;
    float behind[4], cur[4], ahead[4];
#pragma unroll
    for (int q = 0; q < 4; ++q) { behind[q] = 0.f; cur[q] = bf2f(pb[(size_t)t * IN_PAD + cols[q]]); ahead[q] = bf2f(pb[(size_t)(t + sgn) * IN_PAD + cols[q]]); }
    for (int step = 0; step < SEQ; ++step, t += sgn) {
        float ahead2[4]; const int t2 = t + 2 * sgn; const bool ok2 = (t2 >= 0 && t2 < SEQ);
#pragma unroll
        for (int q = 0; q < 4; ++q) ahead2[q] = ok2 ? bf2f(pb[(size_t)t2 * IN_PAD + cols[q]]) : 0.f;
        float sv[4];
#pragma unroll
        for (int q = 0; q < 4; ++q) { const float prv = d ? ahead[q] : behind[q], nxt = d ? behind[q] : ahead[q]; sv[q] = cur[q] + mp[q] * (prv - cur[q]) + mn[q] * (nxt - cur[q]); }
        const float r = sv[0], k = sv[1], v = sv[2];
        sh[5][lane] = lane < 32 ? tanhf(sv[3]) : sv[3];
        __builtin_amdgcn_fence(__ATOMIC_RELEASE, "workgroup"); __builtin_amdgcn_wave_barrier();
        float ws = w0c, as = a0c;
#pragma unroll
        for (int j = 0; j < 32; ++j) { ws += sh[5][j] * w2c[j * 64]; as += sh[5][32 + j] * a2c[j * 64]; }
        const float nsp = -ws; const float sp = (nsp > 20.f) ? nsp : log1pf(__expf(nsp));
        const float wlog = -sp - 0.5f; const float decay = __expf(-__expf(wlog));
        const float a = sigmoidf_(as);
        float kk = k * kkc; const float ss = wave_sum(kk * kk); kk = kk * rsqrtf(fmaxf(ss, 1e-24f));
        const float kd = k * (1.f + (a - 1.f) * kac);
        sh[0][lane] = decay; sh[1][lane] = kk * a; sh[2][lane] = kd; sh[3][lane] = r; sh[4][lane] = kk;
        __builtin_amdgcn_fence(__ATOMIC_RELEASE, "workgroup"); __builtin_amdgcn_wave_barrier();
        float sa = 0.f;
#pragma unroll
        for (int q = 0; q < 64; ++q) sa -= S[q] * sh[4][q];
        float y = 0.f;
#pragma unroll
        for (int q = 0; q < 64; ++q) { S[q] = S[q] * sh[0][q] + sa * sh[1][q] + v * sh[2][q]; y += S[q] * sh[3][q]; }
        ydir[((size_t)d * NTOK + (size_t)b * SEQ + t) * 512 + ch] = y;
        __builtin_amdgcn_fence(__ATOMIC_RELEASE, "workgroup"); __builtin_amdgcn_wave_barrier();
#pragma unroll
        for (int q = 0; q < 4; ++q) { behind[q] = cur[q]; cur[q] = ahead[q]; ahead[q] = ahead2[q]; }
    }
    }
}
template <bool YSINGLE> __device__ __forceinline__ void d_rwkv_out(const Ctx& c, const bf16* __restrict__ proj, const float* __restrict__ ydir, const float* __restrict__ mu_prev, const float* __restrict__ mu_next,
                                           const float* __restrict__ a0, const float* __restrict__ a2, const float* __restrict__ g2, const float* __restrict__ k_a, const float* __restrict__ r_k,
                                           const float* __restrict__ lnx_g, const float* __restrict__ lnx_b, bf16* __restrict__ mix) {
    float* sad = (float*)c.lds; float* sgd = sad + 64; const int ch = c.tid;
    const float mpr = mu_prev[P_R + ch], mnr = mu_next[P_R + ch], mpk = mu_prev[P_KK + ch], mnk = mu_next[P_KK + ch], mpv = mu_prev[P_VV + ch], mnv = mu_next[P_VV + ch];
    const int cx = (ch < 64) ? (P_AD + ch) : (ch < 160 ? P_GD + ch - 64 : 0); const float mpx = mu_prev[cx], mnx = mu_next[cx];
    for (int t = c.bid; t < NTOK; t += c.nb) {
        const int i = t % SEQ; const bf16* p0 = proj + (size_t)t * IN_PAD + C_P;
        const bool hp = i > 0, hn = i < SEQ - 1;
#define SHF(col, mp_, mn_) ({ const float c_ = bf2f(p0[col]); const float pv_ = hp ? bf2f(p0[(col) - IN_PAD]) : 0.f, nx_ = hn ? bf2f(p0[(col) + IN_PAD]) : 0.f; c_ + (mp_) * (pv_ - c_) + (mn_) * (nx_ - c_); })
        if (ch < 64) sad[ch] = SHF(cx, mpx, mnx);
        else if (ch < 160) sgd[ch - 64] = sigmoidf_(SHF(cx, mpx, mnx));
        const float r = SHF(P_R + ch, mpr, mnr), k = SHF(P_KK + ch, mpk, mnk), v = SHF(P_VV + ch, mpv, mnv);
#undef SHF
        __syncthreads();
        asm volatile("" ::: "memory");
        float as0 = a0[ch], as1 = a0[512 + ch];
#pragma unroll 4
        for (int j = 0; j < 32; ++j) { as0 += sad[j] * a2[(size_t)j * 512 + ch]; as1 += sad[32 + j] * a2[(size_t)(32 + j) * 512 + ch]; }
        const float am = 0.5f * (sigmoidf_(as0) + sigmoidf_(as1));
        float g = 0.f;
#pragma unroll 4
        for (int j = 0; j < 96; ++j) g += sgd[j] * g2[(size_t)j * 512 + ch];
        const float y = YSINGLE ? ydir[(size_t)t * 512 + ch] : (ydir[(size_t)t * 512 + ch] + ydir[((size_t)NTOK + t) * 512 + ch]);
        const float mu = wave_sum(y) * (1.f / 64.f); const float dy = y - mu; const float var = wave_sum(dy * dy) * (1.f / 64.f);
        const float yn = dy * rsqrtf(var + GN_EPS) * lnx_g[ch] + lnx_b[ch];
        const float kmean = k * (1.f + (am - 1.f) * k_a[ch]);
        const float bonus = wave_sum(r * kmean * r_k[ch]) * v;
        mix[(size_t)t * DM + 512 + ch] = f2bf((yn + bonus) * g);
        __syncthreads();
    }
}
__device__ __forceinline__ void d_ln1(const Ctx& c, const float* y1, const float* __restrict__ g, const float* __restrict__ bta, float* h1f, bf16* __restrict__ h1b) {
    for (int row = c.gw; row < NTOK; row += c.ngw) {
        const int lane = c.lane;
        const f32x4* xr = (const f32x4*)(y1 + (size_t)row * DM) + lane;
        f32x4 v[4]; float s = 0.f;
#pragma unroll
        for (int j = 0; j < 4; ++j) { v[j] = xr[64 * j]; s += (v[j].x + v[j].y) + (v[j].z + v[j].w); }
        const float mean = wave_sum(s) * (1.f / DM); float s2 = 0.f;
#pragma unroll
        for (int j = 0; j < 4; ++j) { v[j] = v[j] - mean; s2 += (v[j].x * v[j].x + v[j].y * v[j].y) + (v[j].z * v[j].z + v[j].w * v[j].w); }
        const float rstd = rsqrtf(wave_sum(s2) * (1.f / DM) + LN_EPS);
#pragma unroll
        for (int j = 0; j < 4; ++j) { const f32x4 gg = ((const f32x4*)g)[64 * j + lane], bb = ((const f32x4*)bta)[64 * j + lane];
            const f32x4 o = v[j] * rstd * gg + bb;
            ((f32x4*)(h1f + (size_t)row * DM))[64 * j + lane] = o;
            uint2 w; w.x = pk2bf(o.x, o.y); w.y = pk2bf(o.z, o.w); ((uint2*)(h1b + (size_t)row * DM))[64 * j + lane] = w; }
    }
}
__device__ __forceinline__ void d_peer_topk(const Ctx& c, const bf16* __restrict__ qb, const float* __restrict__ keys, int* __restrict__ idx, float* __restrict__ gate) {
    float* keysT = (float*)c.lds; float* sq = keysT + 2 * 128 * 128; float* sc = sq + 256; float* s12 = sc + 256; int* i12 = (int*)(s12 + 32);
    const int tid = c.tid, lane = c.lane, wave = c.wave;
    for (int item = c.bid; item < 8 * 64; item += c.nb) {
        const int h = item & 7, grp = item >> 3;
        __syncthreads();
        for (int e = tid; e < 2 * 128 * 128; e += 512) { const int p = e >> 14, n = (e >> 7) & 127, cc = e & 127; keysT[(p * 128 + cc) * 128 + n] = keys[(size_t)h * 32768 + e]; }
        __syncthreads();
        for (int tt = 0; tt < 512; ++tt) {
            const size_t t = (size_t)grp * 512 + tt;
            if (tid < 256) sq[tid] = bf2f(qb[t * PEER_Q + h * 256 + tid]);
            __syncthreads();
            if (tid < 256) { const int p = tid >> 7, n = tid & 127; float s = 0.f; const float* kt = keysT + p * 16384 + n; const float* qq = sq + p * 128;
                for (int cc = 0; cc < 128; ++cc) s += qq[cc] * kt[cc * 128];
                sc[tid] = s; }
            __syncthreads();
            if (wave < 2) {
                float v0 = sc[wave * 128 + lane], v1 = sc[wave * 128 + 64 + lane];
                for (int r = 0; r < 16; ++r) {
                    float bv; int bi; if (v1 > v0) { bv = v1; bi = lane + 64; } else { bv = v0; bi = lane; }
#pragma unroll
                    for (int o = 1; o < 64; o <<= 1) { const float ov = __shfl_xor(bv, o); const int oi = __shfl_xor(bi, o); if (ov > bv || (ov == bv && oi < bi)) { bv = ov; bi = oi; } }
                    if (lane == 0) { s12[wave * 16 + r] = bv; i12[wave * 16 + r] = bi; }
                    if (bi == lane) v0 = -INFINITY; if (bi == lane + 64) v1 = -INFINITY;
                }
            }
            __syncthreads();
            if (wave == 0) {
                float cv[4];
#pragma unroll
                for (int j = 0; j < 4; ++j) { const int f = lane + 64 * j; cv[j] = s12[f >> 4] + s12[16 + (f & 15)]; }
                float mycs = 0.f; int myid = 0;
                for (int r = 0; r < 16; ++r) {
                    float bv = cv[0]; int bi = lane;
#pragma unroll
                    for (int j = 1; j < 4; ++j) if (cv[j] > bv) { bv = cv[j]; bi = lane + 64 * j; }
#pragma unroll
                    for (int o = 1; o < 64; o <<= 1) { const float ov = __shfl_xor(bv, o); const int oi = __shfl_xor(bi, o); if (ov > bv || (ov == bv && oi < bi)) { bv = ov; bi = oi; } }
                    if (lane == r) { mycs = bv; myid = i12[bi >> 4] * 128 + i12[16 + (bi & 15)]; }
#pragma unroll
                    for (int j = 0; j < 4; ++j) if (bi == lane + 64 * j) cv[j] = -INFINITY;
                }
                float mx = (lane < 16) ? mycs : -INFINITY;
#pragma unroll
                for (int o = 1; o < 64; o <<= 1) mx = fmaxf(mx, __shfl_xor(mx, o));
                const float e = (lane < 16) ? __expf(mycs - mx) : 0.f; const float den = wave_sum(e);
                if (lane < 16) { idx[t * 128 + h * 16 + lane] = myid; gate[t * 128 + h * 16 + lane] = e / den; }
            }
            __syncthreads();
        }
    }
}
__device__ __forceinline__ void d_peer_gather(const Ctx& c, const float* __restrict__ h1f, const int* __restrict__ idx, const float* __restrict__ gate, const float* __restrict__ u, const float* __restrict__ v,
                                              const float* __restrict__ g, const float* __restrict__ bta, float* __restrict__ out) {
    const int lane = c.lane;
    for (int t = c.gw; t < NTOK; t += c.ngw) {
        f32x4 hv[4], f[4];
#pragma unroll
        for (int j = 0; j < 4; ++j) { hv[j] = ((const f32x4*)(h1f + (size_t)t * DM))[64 * j + lane]; f[j] = (f32x4){0.f, 0.f, 0.f, 0.f}; }
        for (int e = 0; e < 128; ++e) {
            const int id = idx[(size_t)t * 128 + e]; const float gt = gate[(size_t)t * 128 + e];
            const f32x4* ur = (const f32x4*)(u + (size_t)id * DM); const f32x4* vr = (const f32x4*)(v + (size_t)id * DM);
            float z = 0.f;
#pragma unroll
            for (int j = 0; j < 4; ++j) { const f32x4 w = ur[64 * j + lane]; z += (w.x * hv[j].x + w.y * hv[j].y) + (w.z * hv[j].z + w.w * hv[j].w); }
            z = wave_sum(z);
            const float act = gt * 0.5f * z * (1.f + erff(z * 0.70710678118654752f));
#pragma unroll
            for (int j = 0; j < 4; ++j) { const f32x4 w = vr[64 * j + lane]; f[j] += act * w; }
        }
        float s = 0.f;
#pragma unroll
        for (int j = 0; j < 4; ++j) { f[j] = DN_ALPHA * hv[j] + f[j]; s += (f[j].x + f[j].y) + (f[j].z + f[j].w); }
        const float mean = wave_sum(s) * (1.f / DM); float s2 = 0.f;
#pragma unroll
        for (int j = 0; j < 4; ++j) { f[j] = f[j] - mean; s2 += (f[j].x * f[j].x + f[j].y * f[j].y) + (f[j].z * f[j].z + f[j].w * f[j].w); }
        const float rstd = rsqrtf(wave_sum(s2) * (1.f / DM) + LN_EPS);
#pragma unroll
        for (int j = 0; j < 4; ++j) { const f32x4 gg = ((const f32x4*)g)[64 * j + lane], bb = ((const f32x4*)bta)[64 * j + lane];
            ((f32x4*)(out + (size_t)t * DM))[64 * j + lane] = f[j] * rstd * gg + bb; }
    }
}
}
namespace pe {
typedef __bf16 bf16x2_t __attribute__((ext_vector_type(2)));
__device__ __forceinline__ float dot2(unsigned a, unsigned b, float c) { return __builtin_amdgcn_fdot2_f32_bf16(__builtin_bit_cast(bf16x2_t, a), __builtin_bit_cast(bf16x2_t, b), c, false); }
__device__ __forceinline__ float gelu_erf(float z) { return 0.5f * z * (1.f + erff(z * 0.70710678118654752f)); }
constexpr int GE = 4;
struct Rows { uint4 a[GE], b[GE]; };
__device__ __forceinline__ void load_rows(Rows& r, const bf16* __restrict__ tab, int i0, int i1, int lane, int g) {
#pragma unroll
    for (int j = 0; j < GE; ++j) { const int e = g * GE + j; const int id = __builtin_amdgcn_readlane((e & 64) ? i1 : i0, e & 63);
        const uint4* p = (const uint4*)(tab + (size_t)id * DM) + lane; r.a[j] = p[0]; r.b[j] = p[64]; }
}
__device__ __forceinline__ void d_peer_gather(const Ctx& c, const bf16* __restrict__ h1b, const int* __restrict__ idx, const float* __restrict__ gate, const bf16* __restrict__ ub, const bf16* __restrict__ vb,
                                              const float* __restrict__ g, const float* __restrict__ bta, float* __restrict__ out) {
    const int lane = c.lane;
    for (int t = c.gw; t < NTOK; t += c.ngw) {
        const uint4* hp = (const uint4*)(h1b + (size_t)t * DM) + lane; const uint4 h0 = hp[0], h1 = hp[64];
        const unsigned hw[8] = {h0.x, h0.y, h0.z, h0.w, h1.x, h1.y, h1.z, h1.w};
        const int i0 = idx[(size_t)t * 128 + lane], i1 = idx[(size_t)t * 128 + 64 + lane];
        const float g0 = gate[(size_t)t * 128 + lane], g1 = gate[(size_t)t * 128 + 64 + lane];
        float f[16];
#pragma unroll
        for (int i = 0; i < 16; ++i) f[i] = 0.f;
        Rows U, V, Un;
        load_rows(U, ub, i0, i1, lane, 0);
        for (int grp = 0; grp < 128 / GE; ++grp) {
            load_rows(V, vb, i0, i1, lane, grp);
            if (grp + 1 < 128 / GE) load_rows(Un, ub, i0, i1, lane, grp + 1);
            float z[GE];
#pragma unroll
            for (int j = 0; j < GE; ++j) { const unsigned uw[8] = {U.a[j].x, U.a[j].y, U.a[j].z, U.a[j].w, U.b[j].x, U.b[j].y, U.b[j].z, U.b[j].w}; float s = 0.f;
#pragma unroll
                for (int i = 0; i < 8; ++i) s = dot2(uw[i], hw[i], s);
                z[j] = s; }
            { const bool b0 = lane & 1; float k0 = b0 ? z[1] : z[0], s0 = b0 ? z[0] : z[1], k1 = b0 ? z[3] : z[2], s1 = b0 ? z[2] : z[3];
              k0 += __shfl_xor(s0, 1); k1 += __shfl_xor(s1, 1);
              const bool b1 = lane & 2; float kk = b1 ? k1 : k0, ss = b1 ? k0 : k1; kk += __shfl_xor(ss, 2);
              kk += __shfl_xor(kk, 4); kk += __shfl_xor(kk, 8); kk += __shfl_xor(kk, 16); kk += __shfl_xor(kk, 32);
              z[0] = kk; }
            const int e_me = grp * GE + (lane & 3);
            const float gt = __shfl((e_me & 64) ? g1 : g0, e_me & 63);
            const float act = gt * gelu_erf(z[0]);
            const unsigned actb = (unsigned)f2bf(act);
#pragma unroll
            for (int j = 0; j < GE; ++j) { const unsigned alo = __builtin_amdgcn_readlane(actb, j), ahi = alo << 16;
                const unsigned vw[8] = {V.a[j].x, V.a[j].y, V.a[j].z, V.a[j].w, V.b[j].x, V.b[j].y, V.b[j].z, V.b[j].w};
#pragma unroll
                for (int i = 0; i < 8; ++i) { f[2 * i] = dot2(vw[i], alo, f[2 * i]); f[2 * i + 1] = dot2(vw[i], ahi, f[2 * i + 1]); } }
            U = Un;
        }
        float s = 0.f;
#pragma unroll
        for (int i = 0; i < 8; ++i) { f[2 * i] += DN_ALPHA * __uint_as_float(hw[i] << 16); f[2 * i + 1] += DN_ALPHA * __uint_as_float(hw[i] & 0xffff0000u); s += f[2 * i] + f[2 * i + 1]; }
        const float mean = wave_sum(s) * (1.f / DM); float s2 = 0.f;
#pragma unroll
        for (int i = 0; i < 16; ++i) { f[i] -= mean; s2 += f[i] * f[i]; }
        const float rstd = rsqrtf(wave_sum(s2) * (1.f / DM) + LN_EPS);
#pragma unroll
        for (int hh = 0; hh < 2; ++hh) {
            const int e0 = hh * 512 + 8 * lane;
            const f32x4 ga = *(const f32x4*)(g + e0), gb = *(const f32x4*)(g + e0 + 4), ba = *(const f32x4*)(bta + e0), bb = *(const f32x4*)(bta + e0 + 4);
            f32x4 oa, ob;
            oa.x = f[hh * 8 + 0] * rstd * ga.x + ba.x; oa.y = f[hh * 8 + 1] * rstd * ga.y + ba.y; oa.z = f[hh * 8 + 2] * rstd * ga.z + ba.z; oa.w = f[hh * 8 + 3] * rstd * ga.w + ba.w;
            ob.x = f[hh * 8 + 4] * rstd * gb.x + bb.x; ob.y = f[hh * 8 + 5] * rstd * gb.y + bb.y; ob.z = f[hh * 8 + 6] * rstd * gb.z + bb.z; ob.w = f[hh * 8 + 7] * rstd * gb.w + bb.w;
            *(f32x4*)(out + (size_t)t * DM + e0) = oa; *(f32x4*)(out + (size_t)t * DM + e0 + 4) = ob;
        }
    }
}
}
namespace pe8 {
typedef float f32x2 __attribute__((ext_vector_type(2)));
__device__ __forceinline__ void d_quant_tables(const Ctx& c, const float* __restrict__ u, const float* __restrict__ v, unsigned* __restrict__ u8, unsigned* __restrict__ v8, float* __restrict__ su, float* __restrict__ sv) {
    const int lane = c.lane;
    for (int r = c.gw; r < 2 * NEXP; r += c.ngw) {
        const bool isv = r >= NEXP; const int row = isv ? r - NEXP : r;
        const f32x4* src = (const f32x4*)((isv ? v : u) + (size_t)row * DM) + lane;
        f32x4 x[4]; float am = 0.f;
#pragma unroll
        for (int j = 0; j < 4; ++j) { x[j] = src[64 * j]; am = fmaxf(am, fmaxf(fmaxf(fabsf(x[j].x), fabsf(x[j].y)), fmaxf(fabsf(x[j].z), fabsf(x[j].w)))); }
#pragma unroll
        for (int o = 1; o < 64; o <<= 1) am = fmaxf(am, __shfl_xor(am, o));
        am = fmaxf(am, 1e-30f);
        if (!isv) { const float sc = am * (1.f / 127.f), is = 127.f / am;
#pragma unroll
            for (int j = 0; j < 4; ++j) { const int a = (int)rintf(x[j].x * is), b = (int)rintf(x[j].y * is), cc = (int)rintf(x[j].z * is), d = (int)rintf(x[j].w * is);
                u8[(size_t)row * 256 + 64 * j + lane] = (unsigned)(a & 255) | ((unsigned)(b & 255) << 8) | ((unsigned)(cc & 255) << 16) | ((unsigned)(d & 255) << 24); }
            if (lane == 0) su[row] = sc; }
        else { const float sc = am * (1.f / 440.f), is = 440.f / am;
#pragma unroll
            for (int j = 0; j < 4; ++j) { int w = 0; w = __builtin_amdgcn_cvt_pk_fp8_f32(x[j].x * is, x[j].y * is, w, false); w = __builtin_amdgcn_cvt_pk_fp8_f32(x[j].z * is, x[j].w * is, w, true);
                v8[(size_t)row * 256 + 64 * j + lane] = (unsigned)w; }
            if (lane == 0) sv[row] = sc; }
    }
}
constexpr int GE = 8;
struct Rows { uint4 a[GE]; };
__device__ __forceinline__ void load_rows(Rows& r, const unsigned* __restrict__ tab, int i0, int i1, int lane, int g) {
#pragma unroll
    for (int j = 0; j < GE; ++j) { const int e = g * GE + j; const int id = __builtin_amdgcn_readlane((e & 64) ? i1 : i0, e & 63); r.a[j] = *((const uint4*)(tab + (size_t)id * 256) + lane); }
}
__device__ __forceinline__ void d_peer_gather(const Ctx& c, const bf16* __restrict__ h1b, const int* __restrict__ idx, const float* __restrict__ gate, const unsigned* __restrict__ u8, const unsigned* __restrict__ v8,
                                              const float* __restrict__ su, const float* __restrict__ sv, const float* __restrict__ g, const float* __restrict__ bta, float* __restrict__ out) {
    const int lane = c.lane;
    for (int t = c.gw; t < NTOK; t += c.ngw) {
        const uint4* hp = (const uint4*)(h1b + (size_t)t * DM) + 2 * lane; const uint4 ha = hp[0], hb = hp[1];
        const unsigned hw[8] = {ha.x, ha.y, ha.z, ha.w, hb.x, hb.y, hb.z, hb.w};
        float hf[16]; float am = 0.f;
#pragma unroll
        for (int i = 0; i < 8; ++i) { hf[2 * i] = __uint_as_float(hw[i] << 16); hf[2 * i + 1] = __uint_as_float(hw[i] & 0xffff0000u); am = fmaxf(am, fmaxf(fabsf(hf[2 * i]), fabsf(hf[2 * i + 1]))); }
#pragma unroll
        for (int o = 1; o < 64; o <<= 1) am = fmaxf(am, __shfl_xor(am, o));
        am = fmaxf(am, 1e-30f);
        const float sh = am * (1.f / 127.f), ish = 127.f / am;
        int hq[4];
#pragma unroll
        for (int w = 0; w < 4; ++w) { const int a = (int)rintf(hf[4 * w] * ish), b = (int)rintf(hf[4 * w + 1] * ish), cc = (int)rintf(hf[4 * w + 2] * ish), d = (int)rintf(hf[4 * w + 3] * ish);
            hq[w] = (int)((unsigned)(a & 255) | ((unsigned)(b & 255) << 8) | ((unsigned)(cc & 255) << 16) | ((unsigned)(d & 255) << 24)); }
        const int i0 = idx[(size_t)t * 128 + lane], i1 = idx[(size_t)t * 128 + 64 + lane];
        const float g0 = gate[(size_t)t * 128 + lane], g1 = gate[(size_t)t * 128 + 64 + lane];
        float f[16];
#pragma unroll
        for (int i = 0; i < 16; ++i) f[i] = 0.f;
        Rows U, V, Un;
        load_rows(U, u8, i0, i1, lane, 0);
        float sun, svn;
        { const int e_me = lane & 7; const int id = __shfl((e_me & 64) ? i1 : i0, e_me & 63); sun = su[id]; svn = sv[id]; }
#pragma unroll 1
        for (int grp = 0; grp < 128 / GE; ++grp) {
            load_rows(V, v8, i0, i1, lane, grp);
            const float suc = sun, svc = svn;
            if (grp + 1 < 128 / GE) { load_rows(Un, u8, i0, i1, lane, grp + 1); const int e_n = (grp + 1) * GE + (lane & 7); const int id = __shfl((e_n & 64) ? i1 : i0, e_n & 63); sun = su[id]; svn = sv[id]; }
            int z[GE];
#pragma unroll
            for (int j = 0; j < GE; ++j) { int s = __builtin_amdgcn_sdot4((int)U.a[j].x, hq[0], 0, false); s = __builtin_amdgcn_sdot4((int)U.a[j].y, hq[1], s, false);
                s = __builtin_amdgcn_sdot4((int)U.a[j].z, hq[2], s, false); s = __builtin_amdgcn_sdot4((int)U.a[j].w, hq[3], s, false); z[j] = s; }
            int zz;
            { const bool b0 = lane & 1, b1 = lane & 2, b2 = lane & 4;
              int k0 = b0 ? z[1] : z[0], s0 = b0 ? z[0] : z[1], k1 = b0 ? z[3] : z[2], s1 = b0 ? z[2] : z[3], k2 = b0 ? z[5] : z[4], s2 = b0 ? z[4] : z[5], k3 = b0 ? z[7] : z[6], s3 = b0 ? z[6] : z[7];
              k0 += __shfl_xor(s0, 1); k1 += __shfl_xor(s1, 1); k2 += __shfl_xor(s2, 1); k3 += __shfl_xor(s3, 1);
              int m0 = b1 ? k1 : k0, t0_ = b1 ? k0 : k1, m1 = b1 ? k3 : k2, t1_ = b1 ? k2 : k3;
              m0 += __shfl_xor(t0_, 2); m1 += __shfl_xor(t1_, 2);
              int q0 = b2 ? m1 : m0, r0 = b2 ? m0 : m1; q0 += __shfl_xor(r0, 4);
              q0 += __shfl_xor(q0, 8); q0 += __shfl_xor(q0, 16); q0 += __shfl_xor(q0, 32); zz = q0; }
            const int e_me = grp * GE + (lane & 7);
            const float gt = __shfl((e_me & 64) ? g1 : g0, e_me & 63);
            const float zf = (float)zz * sh * suc;
            const float act = gt * pe::gelu_erf(zf) * svc;
#pragma unroll
            for (int j = 0; j < GE; ++j) { const float aj = __uint_as_float(__builtin_amdgcn_readlane(__float_as_uint(act), j));
                const unsigned vw[4] = {V.a[j].x, V.a[j].y, V.a[j].z, V.a[j].w};
#pragma unroll
                for (int w = 0; w < 4; ++w) { const f32x2 lo = __builtin_amdgcn_cvt_pk_f32_fp8((int)vw[w], false), hi = __builtin_amdgcn_cvt_pk_f32_fp8((int)vw[w], true);
                    f[4 * w] += aj * lo.x; f[4 * w + 1] += aj * lo.y; f[4 * w + 2] += aj * hi.x; f[4 * w + 3] += aj * hi.y; }
                __builtin_amdgcn_sched_barrier(0); }
            U = Un;
        }
        float s = 0.f;
#pragma unroll
        for (int i = 0; i < 16; ++i) { f[i] += DN_ALPHA * hf[i]; s += f[i]; }
        const float mean = wave_sum(s) * (1.f / DM); float s2 = 0.f;
#pragma unroll
        for (int i = 0; i < 16; ++i) { f[i] -= mean; s2 += f[i] * f[i]; }
        const float rstd = rsqrtf(wave_sum(s2) * (1.f / DM) + LN_EPS);
        const int e0 = 16 * lane;
#pragma unroll
        for (int q = 0; q < 4; ++q) { const f32x4 ga = *(const f32x4*)(g + e0 + 4 * q), ba = *(const f32x4*)(bta + e0 + 4 * q); f32x4 o;
            o.x = f[4 * q] * rstd * ga.x + ba.x; o.y = f[4 * q + 1] * rstd * ga.y + ba.y; o.z = f[4 * q + 2] * rstd * ga.z + ba.z; o.w = f[4 * q + 3] * rstd * ga.w + ba.w;
            *(f32x4*)(out + (size_t)t * DM + e0 + 4 * q) = o; }
    }
}
}
namespace rw {
typedef short bf16x8 __attribute__((ext_vector_type(8)));
typedef short s16x4 __attribute__((ext_vector_type(4)));
typedef float f32x16 __attribute__((ext_vector_type(16)));
typedef float f32x2_t __attribute__((ext_vector_type(2)));
typedef __bf16 bf16x2_t __attribute__((ext_vector_type(2)));
typedef unsigned u32x4 __attribute__((ext_vector_type(4)));
typedef unsigned u32x2 __attribute__((ext_vector_type(2)));
typedef LAS unsigned char* lptr;
#define MFMA32(a, b, c) __builtin_amdgcn_mfma_f32_32x32x16_bf16((a), (b), (c), 0, 0, 0)
#define DI __device__ __forceinline__
constexpr int UNIT_BYTES = 10 * 2048;
constexpr int STG_STRIDE = 392;
constexpr int CST_OFF = 131072, GC_OFF = 131072 + 4096;

DI int crow(int i, int h) { return (i & 3) + 8 * (i >> 2) + 4 * h; }
DI unsigned cvtpk(float lo, float hi) { f32x2_t v = {lo, hi}; bf16x2_t b = __builtin_convertvector(v, bf16x2_t); return __builtin_bit_cast(unsigned, b); }
DI bf16x8 pack(const f32x16& x, int s) { u32x4 p; p[0] = cvtpk(x[8 * s], x[8 * s + 1]); p[1] = cvtpk(x[8 * s + 2], x[8 * s + 3]); p[2] = cvtpk(x[8 * s + 4], x[8 * s + 5]); p[3] = cvtpk(x[8 * s + 6], x[8 * s + 7]); return __builtin_bit_cast(bf16x8, p); }
DI bf16x8 frag4(unsigned a, unsigned b, unsigned c, unsigned d) { u32x4 p = {a, b, c, d}; return __builtin_bit_cast(bf16x8, p); }
DI float lo_f(unsigned w) { return __uint_as_float(w << 16); }
DI float hi_f(unsigned w) { return __uint_as_float(w & 0xffff0000u); }
DI int img_off(int row, int slot) { return row * 128 + ((slot ^ ((((row >> 1) & 1) << 3) | ((row >> 2) & 3))) << 3); }
DI s16x4 tr_read(lptr p) { return __builtin_bit_cast(s16x4, __builtin_amdgcn_ds_read_tr16_b64_v4i16((LAS s16x4*)p)); }
DI bf16x8 trfrag(lptr img, int tau, int s, int lane) {
    const int h = lane >> 5, gg = (lane >> 4) & 1, l16 = lane & 15, q = l16 >> 2, p = l16 & 3, slot = 8 * tau + 4 * gg + p, r0 = 16 * s + 4 * h + q;
    const s16x4 lo = tr_read(img + img_off(r0, slot)), hi = tr_read(img + img_off(r0 + 8, slot));
    return __builtin_shufflevector(lo, hi, 0, 1, 2, 3, 4, 5, 6, 7);
}
template <int CTRL, int RMASK> DI float dpp0(float x) { return __uint_as_float(__builtin_amdgcn_update_dpp(0u, __float_as_uint(x), CTRL, RMASK, 0xf, false)); }
DI float prefix32(float x) {
    x += dpp0<0x111, 0xf>(x); x += dpp0<0x112, 0xf>(x); x += dpp0<0x114, 0xf>(x); x += dpp0<0x118, 0xf>(x);
    x += dpp0<0x142, 0xa>(x);
    return x;
}
DI float fsig(float x) { return __builtin_amdgcn_rcpf(1.f + __expf(-x)); }
DI void store_tile(unsigned char* dst, const f32x16& x, int lane) {
    u32x4 a, b; a[0] = cvtpk(x[0], x[1]); a[1] = cvtpk(x[2], x[3]); a[2] = cvtpk(x[4], x[5]); a[3] = cvtpk(x[6], x[7]);
    b[0] = cvtpk(x[8], x[9]); b[1] = cvtpk(x[10], x[11]); b[2] = cvtpk(x[12], x[13]); b[3] = cvtpk(x[14], x[15]);
    u32x4* d = (u32x4*)(dst + lane * 32); d[0] = a; d[1] = b;
}

DI void d_lowrank_t(const Ctx& c, const float* __restrict__ w2, const float* __restrict__ a2, bf16* __restrict__ w2t, bf16* __restrict__ a2t) {
    for (int id = c.bid * 512 + c.tid; id < 2 * 512 * 32; id += c.nb * 512) { const int j = id & 31, ch = (id >> 5) & 511, d = id >> 14;
        w2t[id] = f2bf(w2[(size_t)(d * 32 + j) * 512 + ch]); a2t[id] = f2bf(a2[(size_t)(d * 32 + j) * 512 + ch]); }
}

DI void d_g2_t(const Ctx& c, const float* __restrict__ g2, bf16* __restrict__ g2t) {
    for (int id = c.bid * 512 + c.tid; id < 512 * 96; id += c.nb * 512) { const int j = id % 96, ch = id / 96; g2t[id] = f2bf(g2[(size_t)j * 512 + ch]); }
}
constexpr int O_MPV = 0, O_MNV = 512, O_LG = 1024, O_LB = 1536, O_MPG = 2048, O_MNG = 2144, O_A0 = 2240, O_KA = 3264, O_RK = 3776, O_MPR = 4288, O_MNR = 4800, O_MPK = 5312, O_MNK = 5824, O_MPA = 6336, O_MNA = 6400, O_END = 6464;
DI void d_out(const Ctx& c, const bf16* __restrict__ proj_, const float* __restrict__ ybuf_, const float* __restrict__ mu_prev, const float* __restrict__ mu_next,
              const float* __restrict__ a0, const float* __restrict__ k_a, const float* __restrict__ r_k, const bf16* __restrict__ a2t_, const bf16* __restrict__ g2t_,
              const float* __restrict__ lnx_g, const float* __restrict__ lnx_b, bf16* __restrict__ mix_) {
    const int lane0 = c.lane;
    LAS float* cs0 = (LAS float*)((lptr)c.lds);
    __syncthreads();
    for (int i = c.tid; i < O_END; i += 512) { float v;
        if (i < O_MNV) v = mu_prev[P_VV + i]; else if (i < O_LG) v = mu_next[P_VV + i - O_MNV]; else if (i < O_LB) v = lnx_g[i - O_LG]; else if (i < O_MPG) v = lnx_b[i - O_LB];
        else if (i < O_MNG) v = mu_prev[P_GD + i - O_MPG]; else if (i < O_A0) v = mu_next[P_GD + i - O_MNG]; else if (i < O_KA) v = a0[i - O_A0]; else if (i < O_RK) v = k_a[i - O_KA];
        else if (i < O_MPR) v = r_k[i - O_RK]; else if (i < O_MNR) v = mu_prev[P_R + i - O_MPR]; else if (i < O_MPK) v = mu_next[P_R + i - O_MNR]; else if (i < O_MNK) v = mu_prev[P_KK + i - O_MPK];
        else if (i < O_MPA) v = mu_next[P_KK + i - O_MNK]; else if (i < O_MNA) v = mu_prev[P_AD + i - O_MPA]; else v = mu_next[P_AD + i - O_MNA];
        cs0[i] = v; }
    if (c.tid == 0) { LAS unsigned long long* pp_ = (LAS unsigned long long*)(cs0 + O_END); pp_[0] = (unsigned long long)proj_; pp_[1] = (unsigned long long)ybuf_; pp_[2] = (unsigned long long)mix_; pp_[3] = (unsigned long long)a2t_; pp_[4] = (unsigned long long)g2t_; }
    __syncthreads();
    for (int wt = c.gw; wt < (NTOK / 32) * 2; wt += c.ngw) {
        int lane = lane0; asm volatile("" : "+v"(lane));
        const int n = lane & 31, hh = lane >> 5;
        LAS float* cs = cs0 + (lane - lane0);
        const LAS unsigned long long* pl_ = (const LAS unsigned long long*)(cs + O_END);
        const bf16* proj = (const bf16*)pl_[0]; const float* ybuf = (const float*)pl_[1]; bf16* mix = (bf16*)pl_[2]; const bf16* a2t = (const bf16*)pl_[3]; const bf16* g2t = (const bf16*)pl_[4];
        const int tile = wt >> 1, hg = wt & 1, t0 = tile * 32, tg = t0 + n, ti = tg % SEQ;
        const bool hp = ti > 0, hn = ti < SEQ - 1; const int po = hp ? IN_PAD : 0, no_ = hn ? IN_PAD : 0;
        const bf16* prow = proj + (size_t)tg * IN_PAD + C_P;
        bf16x8 sgf[6], adf[4];
#pragma unroll
        for (int ks = 0; ks < 10; ++ks) { const int col = ks < 6 ? P_GD + 16 * ks + 8 * hh : P_AD + 16 * (ks - 6) + 8 * hh; const int mo = ks < 6 ? O_MPG + 16 * ks + 8 * hh : O_MPA + 16 * (ks - 6) + 8 * hh, no = ks < 6 ? mo + 96 : mo + 64;
            const bf16* pc_ = prow + col;
            const u32x4 cc = *(const u32x4*)pc_, pp = *(const u32x4*)(pc_ - po), nn = *(const u32x4*)(pc_ + no_);
            const unsigned cw[4] = {cc[0], cc[1], cc[2], cc[3]}, pw[4] = {hp ? pp[0] : 0u, hp ? pp[1] : 0u, hp ? pp[2] : 0u, hp ? pp[3] : 0u}, nw[4] = {hn ? nn[0] : 0u, hn ? nn[1] : 0u, hn ? nn[2] : 0u, hn ? nn[3] : 0u}; unsigned o[4];
#pragma unroll
            for (int e = 0; e < 4; ++e) { const float c0 = lo_f(cw[e]), c1 = hi_f(cw[e]);
                float x0 = c0 + cs[mo + 2 * e] * (lo_f(pw[e]) - c0) + cs[no + 2 * e] * (lo_f(nw[e]) - c0), x1 = c1 + cs[mo + 2 * e + 1] * (hi_f(pw[e]) - c1) + cs[no + 2 * e + 1] * (hi_f(nw[e]) - c1);
                if (ks < 6) { x0 = fsig(x0); x1 = fsig(x1); }
                o[e] = cvtpk(x0, x1); }
            if (ks < 6) sgf[ks] = frag4(o[0], o[1], o[2], o[3]); else adf[ks - 6] = frag4(o[0], o[1], o[2], o[3]);
            __builtin_amdgcn_sched_barrier(0); }
#pragma unroll 1
        for (int hq = 0; hq < 4; ++hq) {
            const int hd = hg * 4 + hq;
            float bs = 0.f;
#pragma unroll
            for (int ct = 0; ct < 2; ++ct) {
                f32x16 a0t = {0.f}, a1t = {0.f}; const int chrow = 64 * hd + 32 * ct + n;
                const bf16* ar0 = a2t + (size_t)chrow * 32 + 8 * hh; const bf16* ar1 = a2t + (size_t)(512 + chrow) * 32 + 8 * hh;
                a0t = MFMA32(*(const bf16x8*)ar0, adf[0], a0t); a0t = MFMA32(*(const bf16x8*)(ar0 + 16), adf[1], a0t);
                a1t = MFMA32(*(const bf16x8*)ar1, adf[2], a1t); a1t = MFMA32(*(const bf16x8*)(ar1 + 16), adf[3], a1t);
#pragma unroll
                for (int q = 0; q < 4; ++q) { const int ch = 64 * hd + 32 * ct + 8 * q + 4 * hh; const bf16* rp_ = prow + P_R + ch; const bf16* kp_ = prow + P_KK + ch; const u32x2 z2 = {0u, 0u};
                    const u32x2 rc = *(const u32x2*)rp_; u32x2 rpv = *(const u32x2*)(rp_ - po), rnx = *(const u32x2*)(rp_ + no_); rpv = hp ? rpv : z2; rnx = hn ? rnx : z2;
                    const u32x2 kc = *(const u32x2*)kp_; u32x2 kpv = *(const u32x2*)(kp_ - po), knx = *(const u32x2*)(kp_ + no_); kpv = hp ? kpv : z2; knx = hn ? knx : z2;
                    const float rcf[4] = {lo_f(rc.x), hi_f(rc.x), lo_f(rc.y), hi_f(rc.y)}, rpf[4] = {lo_f(rpv.x), hi_f(rpv.x), lo_f(rpv.y), hi_f(rpv.y)}, rnf[4] = {lo_f(rnx.x), hi_f(rnx.x), lo_f(rnx.y), hi_f(rnx.y)};
                    const float kcf[4] = {lo_f(kc.x), hi_f(kc.x), lo_f(kc.y), hi_f(kc.y)}, kpf[4] = {lo_f(kpv.x), hi_f(kpv.x), lo_f(kpv.y), hi_f(kpv.y)}, knf[4] = {lo_f(knx.x), hi_f(knx.x), lo_f(knx.y), hi_f(knx.y)};
#pragma unroll
                    for (int e = 0; e < 4; ++e) { const int cx = ch + e;
                        const float rf = rcf[e] + cs[O_MPR + cx] * (rpf[e] - rcf[e]) + cs[O_MNR + cx] * (rnf[e] - rcf[e]);
                        const float kf = kcf[e] + cs[O_MPK + cx] * (kpf[e] - kcf[e]) + cs[O_MNK + cx] * (knf[e] - kcf[e]);
                        const float am = 0.5f * (fsig(a0t[4 * q + e] + cs[O_A0 + cx]) + fsig(a1t[4 * q + e] + cs[O_A0 + 512 + cx]));
                        bs += rf * kf * (1.f + (am - 1.f) * cs[O_KA + cx]) * cs[O_RK + cx]; }
                    __builtin_amdgcn_sched_barrier(0); }
            }
            bs += __shfl_xor(bs, 32);
            f32x16 gt[2];
#pragma unroll
            for (int ct = 0; ct < 2; ++ct) { f32x16 acc = {0.f}; const bf16* grow = g2t + (size_t)(64 * hd + 32 * ct + n) * 96 + 8 * hh;
#pragma unroll
                for (int ks = 0; ks < 6; ++ks) acc = MFMA32(*(const bf16x8*)(grow + 16 * ks), sgf[ks], acc);
                gt[ct] = acc; }
            float yv[32]; float s1 = 0.f;
#pragma unroll
            for (int ct = 0; ct < 2; ++ct)
#pragma unroll
                for (int q = 0; q < 4; ++q) { const f32x4 y4 = *(const f32x4*)(ybuf + (size_t)tg * 512 + 64 * hd + 32 * ct + 8 * q + 4 * hh);
                    yv[16 * ct + 4 * q] = y4.x; yv[16 * ct + 4 * q + 1] = y4.y; yv[16 * ct + 4 * q + 2] = y4.z; yv[16 * ct + 4 * q + 3] = y4.w; s1 += (y4.x + y4.y) + (y4.z + y4.w); }
            s1 += __shfl_xor(s1, 32);
            const float mean = s1 * (1.f / 64.f); float s2 = 0.f;
#pragma unroll
            for (int i = 0; i < 32; ++i) { yv[i] -= mean; s2 += yv[i] * yv[i]; }
            s2 += __shfl_xor(s2, 32);
            const float rstd = rsqrtf(s2 * (1.f / 64.f) + GN_EPS);
#pragma unroll
            for (int ct = 0; ct < 2; ++ct)
#pragma unroll
                for (int q = 0; q < 4; ++q) { const int ch = 64 * hd + 32 * ct + 8 * q + 4 * hh; const bf16* vp = prow + P_VV + ch;
                    const u32x2 z2 = {0u, 0u}; const u32x2 vc = *(const u32x2*)vp; u32x2 vpv = *(const u32x2*)(vp - po), vnx = *(const u32x2*)(vp + no_); vpv = hp ? vpv : z2; vnx = hn ? vnx : z2;
                    const float vcf[4] = {lo_f(vc.x), hi_f(vc.x), lo_f(vc.y), hi_f(vc.y)}, vpf[4] = {lo_f(vpv.x), hi_f(vpv.x), lo_f(vpv.y), hi_f(vpv.y)}, vnf[4] = {lo_f(vnx.x), hi_f(vnx.x), lo_f(vnx.y), hi_f(vnx.y)};
                    float o[4];
#pragma unroll
                    for (int e = 0; e < 4; ++e) { const float vf = vcf[e] + cs[O_MPV + ch + e] * (vpf[e] - vcf[e]) + cs[O_MNV + ch + e] * (vnf[e] - vcf[e]);
                        o[e] = (yv[16 * ct + 4 * q + e] * rstd * cs[O_LG + ch + e] + cs[O_LB + ch + e] + bs * vf) * gt[ct][4 * q + e]; }
                    *(u32x2*)(mix + (size_t)tg * DM + 512 + ch) = (u32x2){cvtpk(o[0], o[1]), cvtpk(o[2], o[3])}; }
            __builtin_amdgcn_sched_barrier(0);
        }
    }
}
DI void d_prep(const Ctx& c, int d, const bf16* __restrict__ proj, const float* __restrict__ mu_prev, const float* __restrict__ mu_next,
               const float* __restrict__ w0, const float* __restrict__ a0, const float* __restrict__ k_k, const float* __restrict__ k_a,
               const bf16* __restrict__ w2t, const bf16* __restrict__ a2t, unsigned char* __restrict__ UO, float* __restrict__ ybuf) {
    const int lane = c.lane, n = lane & 31, h = lane >> 5, hd = c.bid & 7;
    lptr L = (lptr)c.lds + c.wave * 16384;
    LAS float* cst = (LAS float*)((lptr)c.lds + CST_OFF);
    LAS float* gC = (LAS float*)((lptr)c.lds + GC_OFF) + c.wave * 64;
    __syncthreads();
    for (int i = c.tid; i < 768; i += 512) { float v;
        if (i < 640) { const int vec = i >> 6, ch = i & 63, gch = 64 * hd + ch;
            v = vec == 0 ? mu_prev[P_R + gch] : vec == 1 ? mu_next[P_R + gch] : vec == 2 ? mu_prev[P_KK + gch] : vec == 3 ? mu_next[P_KK + gch] : vec == 4 ? mu_prev[P_VV + gch] : vec == 5 ? mu_next[P_VV + gch]
              : vec == 6 ? w0[d * 512 + gch] : vec == 7 ? a0[d * 512 + gch] : vec == 8 ? k_k[gch] : k_a[gch]; }
        else { const int vec = (i - 640) >> 5, j = i & 31; const int col = (vec < 2 ? P_WD : P_AD) + 32 * d + j; v = (vec & 1) ? mu_next[col] : mu_prev[col]; }
        cst[i] = v; }
    __syncthreads();
    const int nper = (c.nb >> 3) * 8;
    for (int u = (c.bid >> 3) * 8 + c.wave; u < 1024; u += nper) {
        const int b = u >> 7, c32 = u & 127;
        const int tok0 = d ? SEQ - 32 * (c32 + 1) : 32 * c32;
        const bf16* prow = proj + (size_t)b * SEQ * IN_PAD + C_P;
#pragma unroll 1
        for (int it = 0; it < 13; ++it) { const int pid = it * 64 + lane; if (pid < 816) { const int rho = pid / 24, w = pid % 24, mat = w >> 3, pc = w & 7, tok = tok0 - 1 + rho;
                uint4 val = make_uint4(0, 0, 0, 0);
                if (tok >= 0 && tok < SEQ) val = *(const uint4*)(prow + (size_t)tok * IN_PAD + mat * 512 + 64 * hd + pc * 8);
                LAS u32x2* dp = (LAS u32x2*)(L + rho * STG_STRIDE + mat * 128 + pc * 16); dp[0] = (u32x2){val.x, val.y}; dp[1] = (u32x2){val.z, val.w}; } }
        const int rho = d ? 32 - n : n + 1, tok = tok0 - 1 + rho;
        bf16x8 wdf[2], adf[2];
        {
            const bool hp = tok > 0, hn = tok < SEQ - 1;
#pragma unroll
            for (int s = 0; s < 2; ++s) {
                const bf16* pc_ = prow + (size_t)tok * IN_PAD + 32 * d + 16 * s + 8 * h;
                const uint4 z4 = make_uint4(0, 0, 0, 0);
                const uint4 wc = *(const uint4*)(pc_ + P_WD), ac = *(const uint4*)(pc_ + P_AD);
                const uint4 wp = hp ? *(const uint4*)(pc_ + P_WD - IN_PAD) : z4, ap = hp ? *(const uint4*)(pc_ + P_AD - IN_PAD) : z4;
                const uint4 wn = hn ? *(const uint4*)(pc_ + P_WD + IN_PAD) : z4, an = hn ? *(const uint4*)(pc_ + P_AD + IN_PAD) : z4;
                const unsigned wcw[4] = {wc.x, wc.y, wc.z, wc.w}, wpw[4] = {wp.x, wp.y, wp.z, wp.w}, wnw[4] = {wn.x, wn.y, wn.z, wn.w};
                const unsigned acw[4] = {ac.x, ac.y, ac.z, ac.w}, apw[4] = {ap.x, ap.y, ap.z, ap.w}, anw[4] = {an.x, an.y, an.z, an.w};
                unsigned wo[4], ao[4];
#pragma unroll
                for (int e = 0; e < 4; ++e) { const int j = 16 * s + 8 * h + 2 * e;
                    const float mpw0 = cst[640 + j], mpw1 = cst[640 + j + 1], mnw0 = cst[672 + j], mnw1 = cst[672 + j + 1], mpa0 = cst[704 + j], mpa1 = cst[704 + j + 1], mna0 = cst[736 + j], mna1 = cst[736 + j + 1];
                    float c0 = lo_f(wcw[e]), c1 = hi_f(wcw[e]);
                    float x0 = c0 + mpw0 * (lo_f(wpw[e]) - c0) + mnw0 * (lo_f(wnw[e]) - c0), x1 = c1 + mpw1 * (hi_f(wpw[e]) - c1) + mnw1 * (hi_f(wnw[e]) - c1);
                    x0 = 1.f - 2.f * __builtin_amdgcn_rcpf(__expf(2.f * x0) + 1.f); x1 = 1.f - 2.f * __builtin_amdgcn_rcpf(__expf(2.f * x1) + 1.f);
                    wo[e] = cvtpk(x0, x1);
                    c0 = lo_f(acw[e]); c1 = hi_f(acw[e]);
                    x0 = c0 + mpa0 * (lo_f(apw[e]) - c0) + mna0 * (lo_f(anw[e]) - c0); x1 = c1 + mpa1 * (hi_f(apw[e]) - c1) + mna1 * (hi_f(anw[e]) - c1);
                    ao[e] = cvtpk(x0, x1); }
                wdf[s] = frag4(wo[0], wo[1], wo[2], wo[3]); adf[s] = frag4(ao[0], ao[1], ao[2], ao[3]);
                __builtin_amdgcn_sched_barrier(0);
            }
        }
        float lw[32], av[32];
        {
            const f32x16 zz = {0.f};
            int opq = 0; asm volatile("" : "+v"(opq));
#pragma unroll
            for (int tau = 0; tau < 2; ++tau) {
                const bf16* wrow = w2t + ((d * 512 + 64 * hd + 32 * tau + n + opq) * 32 + 8 * (h + opq));
                const bf16* arow = a2t + ((d * 512 + 64 * hd + 32 * tau + n + opq) * 32 + 8 * (h + opq));
                const bf16x8 wa0 = *(const bf16x8*)wrow, wa1 = *(const bf16x8*)(wrow + 16), aa0 = *(const bf16x8*)arow, aa1 = *(const bf16x8*)(arow + 16);
                f32x16 cw = MFMA32(wa0, wdf[0], zz); cw = MFMA32(wa1, wdf[1], cw);
                f32x16 ca = MFMA32(aa0, adf[0], zz); ca = MFMA32(aa1, adf[1], ca);
#pragma unroll
                for (int i = 0; i < 16; ++i) { const int ch = 32 * tau + 8 * (i >> 2) + 4 * h + (i & 3);
                    lw[16 * tau + i] = -0.60653066f * fsig(cw[i] + cst[6 * 64 + ch]); av[16 * tau + i] = fsig(ca[i] + cst[7 * 64 + ch]); }
                __builtin_amdgcn_sched_barrier(0);
            }
        }
        unsigned ge[32], avp[16];
#pragma unroll
        for (int m = 0; m < 32; ++m) { const float clm = prefix32(lw[m]); const float eg = __expf(clm); ge[m] = cvtpk(eg, eg * __expf(-lw[m])); if (n == 31) gC[8 * (m >> 2) + 4 * h + (m & 3)] = eg; }
#pragma unroll
        for (int m = 0; m < 16; ++m) avp[m] = cvtpk(av[2 * m], av[2 * m + 1]);
        __builtin_amdgcn_sched_barrier(0);
        unsigned pA[16], pB[16], pK[16], pR[16], pV[16];
        {
            unsigned kfp[16]; float ss = 0.f;
            lptr sb = L + rho * STG_STRIDE + 8 * h;
#pragma unroll
            for (int q = 0; q < 8; ++q) {
                const u32x2 cu = *(LAS u32x2*)(sb + 128 + 16 * q), pu_ = *(LAS u32x2*)(sb + 128 + 16 * q - STG_STRIDE), nu = *(LAS u32x2*)(sb + 128 + 16 * q + STG_STRIDE);
                const float cc[4] = {lo_f(cu.x), hi_f(cu.x), lo_f(cu.y), hi_f(cu.y)}, pp[4] = {lo_f(pu_.x), hi_f(pu_.x), lo_f(pu_.y), hi_f(pu_.y)}, nn[4] = {lo_f(nu.x), hi_f(nu.x), lo_f(nu.y), hi_f(nu.y)};
                float xk[4];
#pragma unroll
                for (int e = 0; e < 4; ++e) { const int ch = 8 * q + 4 * h + e; const float x = cc[e] + cst[2 * 64 + ch] * (pp[e] - cc[e]) + cst[3 * 64 + ch] * (nn[e] - cc[e]);
                    xk[e] = x; const float kr_ = x * cst[8 * 64 + ch]; ss += kr_ * kr_; }
                kfp[2 * q] = cvtpk(xk[0], xk[1]); kfp[2 * q + 1] = cvtpk(xk[2], xk[3]);
                __builtin_amdgcn_sched_barrier(0);
            }
            ss += __shfl_xor(ss, 32);
            const float inv = rsqrtf(fmaxf(ss, 1e-24f));
#pragma unroll
            for (int q = 0; q < 8; ++q) {
                const u32x2 cu = *(LAS u32x2*)(sb + 16 * q), pu_ = *(LAS u32x2*)(sb + 16 * q - STG_STRIDE), nu = *(LAS u32x2*)(sb + 16 * q + STG_STRIDE);
                const u32x2 cv = *(LAS u32x2*)(sb + 256 + 16 * q), pv_ = *(LAS u32x2*)(sb + 256 + 16 * q - STG_STRIDE), nv_ = *(LAS u32x2*)(sb + 256 + 16 * q + STG_STRIDE);
                const float rc[4] = {lo_f(cu.x), hi_f(cu.x), lo_f(cu.y), hi_f(cu.y)}, rp[4] = {lo_f(pu_.x), hi_f(pu_.x), lo_f(pu_.y), hi_f(pu_.y)}, rn[4] = {lo_f(nu.x), hi_f(nu.x), lo_f(nu.y), hi_f(nu.y)};
                const float vc[4] = {lo_f(cv.x), hi_f(cv.x), lo_f(cv.y), hi_f(cv.y)}, vp[4] = {lo_f(pv_.x), hi_f(pv_.x), lo_f(pv_.y), hi_f(pv_.y)}, vn[4] = {lo_f(nv_.x), hi_f(nv_.x), lo_f(nv_.y), hi_f(nv_.y)};
                float oa[4], ob[4], ok[4], orr[4], ov[4];
#pragma unroll
                for (int e = 0; e < 4; ++e) { const int ch = 8 * q + 4 * h + e, m = 4 * q + e;
                    const float rf = rc[e] + cst[0 * 64 + ch] * (rp[e] - rc[e]) + cst[1 * 64 + ch] * (rn[e] - rc[e]);
                    const float vf = vc[e] + cst[4 * 64 + ch] * (vp[e] - vc[e]) + cst[5 * 64 + ch] * (vn[e] - vc[e]);
                    const float eg = lo_f(ge[m]), ieg = __builtin_amdgcn_rcpf(eg), egm1 = hi_f(ge[m]);
                    const float kfm = (m & 1) ? hi_f(kfp[m >> 1]) : lo_f(kfp[m >> 1]), avm = (m & 1) ? hi_f(avp[m >> 1]) : lo_f(avp[m >> 1]);
                    const float kkn = kfm * cst[8 * 64 + ch] * inv;
                    oa[e] = -kkn * egm1; ob[e] = kkn * avm * ieg; ok[e] = kfm * (1.f + (avm - 1.f) * cst[9 * 64 + ch]) * ieg; orr[e] = rf * eg; ov[e] = vf; }
                pA[2 * q] = cvtpk(oa[0], oa[1]); pA[2 * q + 1] = cvtpk(oa[2], oa[3]); pB[2 * q] = cvtpk(ob[0], ob[1]); pB[2 * q + 1] = cvtpk(ob[2], ob[3]);
                pK[2 * q] = cvtpk(ok[0], ok[1]); pK[2 * q + 1] = cvtpk(ok[2], ok[3]); pR[2 * q] = cvtpk(orr[0], orr[1]); pR[2 * q + 1] = cvtpk(orr[2], orr[3]);
                pV[2 * q] = cvtpk(ov[0], ov[1]); pV[2 * q + 1] = cvtpk(ov[2], ov[3]);
                __builtin_amdgcn_sched_barrier(0);
            }
        }
        __builtin_amdgcn_fence(__ATOMIC_RELEASE, "workgroup"); __builtin_amdgcn_wave_barrier();
#pragma unroll
        for (int q = 0; q < 8; ++q) { const int off = img_off(n, 2 * q + h);
            *(LAS u32x2*)(L + off) = (u32x2){pA[2 * q], pA[2 * q + 1]}; *(LAS u32x2*)(L + 4096 + off) = (u32x2){pB[2 * q], pB[2 * q + 1]};
            *(LAS u32x2*)(L + 8192 + off) = (u32x2){pK[2 * q], pK[2 * q + 1]}; *(LAS u32x2*)(L + 12288 + off) = (u32x2){pV[2 * q], pV[2 * q + 1]}; }
        __builtin_amdgcn_fence(__ATOMIC_RELEASE, "workgroup"); __builtin_amdgcn_wave_barrier();
        const f32x16 Z16 = {0.f};
        f32x16 Lab = Z16, LabT = Z16, LakT = Z16, MrbT = Z16, MrkT = Z16;
#pragma unroll
        for (int ks = 0; ks < 4; ++ks) {
            const bf16x8 fA = frag4(pA[4 * ks], pA[4 * ks + 1], pA[4 * ks + 2], pA[4 * ks + 3]), fB = frag4(pB[4 * ks], pB[4 * ks + 1], pB[4 * ks + 2], pB[4 * ks + 3]);
            const bf16x8 fK = frag4(pK[4 * ks], pK[4 * ks + 1], pK[4 * ks + 2], pK[4 * ks + 3]), fR = frag4(pR[4 * ks], pR[4 * ks + 1], pR[4 * ks + 2], pR[4 * ks + 3]);
            Lab = MFMA32(fA, fB, Lab); LabT = MFMA32(fB, fA, LabT); LakT = MFMA32(fK, fA, LakT); MrbT = MFMA32(fB, fR, MrbT); MrkT = MFMA32(fK, fR, MrkT);
        }
#pragma unroll
        for (int i = 0; i < 16; ++i) { const int rr = crow(i, h);
            Lab[i] = (n < rr) ? Lab[i] : 0.f; LabT[i] = (rr < n) ? LabT[i] : 0.f; LakT[i] = (rr < n) ? LakT[i] : 0.f;
            MrbT[i] = (rr <= n) ? MrbT[i] : 0.f; MrkT[i] = (rr <= n) ? MrkT[i] : 0.f; }
        const bf16x8 pLk0 = pack(LakT, 0), pLk1 = pack(LakT, 1), pMb0 = pack(MrbT, 0), pMb1 = pack(MrbT, 1), pMk0 = pack(MrkT, 0), pMk1 = pack(MrkT, 1);
        __builtin_amdgcn_sched_barrier(0);
        f32x16 Pc = Lab, Ptc = LabT, Rtc = LabT;
#pragma unroll
        for (int i = 0; i < 16; ++i) Rtc[i] += (crow(i, h) == n) ? 1.f : 0.f;
#pragma unroll
        for (int lvl = 0; lvl < 4; ++lvl) {
            const bf16x8 pP0 = pack(Pc, 0), pP1 = pack(Pc, 1), pT0 = pack(Ptc, 0), pT1 = pack(Ptc, 1);
            f32x16 nPc = MFMA32(pT0, pP0, Z16); nPc = MFMA32(pT1, pP1, nPc);
            if (lvl < 3) { f32x16 nPt = MFMA32(pP0, pT0, Z16); nPt = MFMA32(pP1, pT1, nPt); Ptc = nPt; }
            const bf16x8 pN0 = pack(nPc, 0), pN1 = pack(nPc, 1), pR0 = pack(Rtc, 0), pR1 = pack(Rtc, 1);
            Rtc = MFMA32(pN0, pR0, Rtc); Rtc = MFMA32(pN1, pR1, Rtc);
            Pc = nPc;
        }
        const bf16x8 pT0 = pack(Rtc, 0), pT1 = pack(Rtc, 1);
        bf16x8 vt[2][2];
#pragma unroll
        for (int tau = 0; tau < 2; ++tau) { vt[tau][0] = trfrag(L + 12288, tau, 0, lane); vt[tau][1] = trfrag(L + 12288, tau, 1, lane); }
        bf16x8 pW1[2][2], pW2[2][2];
#pragma unroll
        for (int tau = 0; tau < 2; ++tau) {
            f32x16 lv = MFMA32(pLk0, vt[tau][0], Z16); lv = MFMA32(pLk1, vt[tau][1], lv);
            const bf16x8 a0f = trfrag(L, tau, 0, lane), a1f = trfrag(L, tau, 1, lane);
            f32x16 w1 = MFMA32(pT0, a0f, Z16); w1 = MFMA32(pT1, a1f, w1);
            const bf16x8 l0 = pack(lv, 0), l1 = pack(lv, 1);
            f32x16 w2_ = MFMA32(pT0, l0, Z16); w2_ = MFMA32(pT1, l1, w2_);
            pW1[tau][0] = pack(w1, 0); pW1[tau][1] = pack(w1, 1); pW2[tau][0] = pack(w2_, 0); pW2[tau][1] = pack(w2_, 1);
        }
        int opq2 = 0; asm volatile("" : "+v"(opq2));
        const int lane_o = lane + opq2, n_o = n + opq2;
        unsigned char* uo = UO + ((size_t)(b * 8 + hd) * 128 + c32) * UNIT_BYTES;
#pragma unroll
        for (int kap = 0; kap < 2; ++kap) { f32x16 q1;
#pragma unroll
            for (int i = 0; i < 16; ++i) q1[i] = (i & 1) ? hi_f(pR[8 * kap + (i >> 1)]) : lo_f(pR[8 * kap + (i >> 1)]);
            q1 = MFMA32(pW1[kap][0], pMb0, q1); q1 = MFMA32(pW1[kap][1], pMb1, q1);
            store_tile(uo + kap * 2048, q1, lane_o); }
#pragma unroll
        for (int tau = 0; tau < 2; ++tau) { f32x16 q2 = MFMA32(pMb0, pW2[tau][0], Z16); q2 = MFMA32(pMb1, pW2[tau][1], q2); q2 = MFMA32(pMk0, vt[tau][0], q2); q2 = MFMA32(pMk1, vt[tau][1], q2);
#pragma unroll
            for (int i = 0; i < 16; ++i) { const int s = crow(i, h), tk = d ? tok0 + 31 - s : tok0 + s; float* yp = ybuf + ((size_t)b * SEQ + tk) * 512 + 64 * hd + 32 * tau + n_o;
                if (d) *yp += q2[i]; else *yp = q2[i]; } }
        __builtin_amdgcn_fence(__ATOMIC_RELEASE, "workgroup"); __builtin_amdgcn_wave_barrier();
#pragma unroll
        for (int tp = 0; tp < 2; ++tp) {
            const bf16x8 b0f = trfrag(L + 4096, tp, 0, lane), b1f = trfrag(L + 4096, tp, 1, lane), k0f = trfrag(L + 8192, tp, 0, lane), k1f = trfrag(L + 8192, tp, 1, lane);
            const float gcl = gC[32 * tp + n];
#pragma unroll
            for (int kap = 0; kap < 2; ++kap) { f32x16 g = MFMA32(pW1[kap][0], b0f, Z16); g = MFMA32(pW1[kap][1], b1f, g);
#pragma unroll
                for (int i = 0; i < 16; ++i) g[i] = (g[i] + ((kap == tp && crow(i, h) == n) ? 1.f : 0.f)) * gcl;
                store_tile(uo + (2 + 2 * kap + tp) * 2048, g, lane_o); }
#pragma unroll
            for (int tau = 0; tau < 2; ++tau) { f32x16 ht = MFMA32(b0f, pW2[tau][0], Z16); ht = MFMA32(b1f, pW2[tau][1], ht); ht = MFMA32(k0f, vt[tau][0], ht); ht = MFMA32(k1f, vt[tau][1], ht);
#pragma unroll
                for (int i = 0; i < 16; ++i) ht[i] *= gC[32 * tp + crow(i, h)];
                store_tile(uo + (6 + 2 * tp + tau) * 2048, ht, lane_o); }
        }
        __builtin_amdgcn_fence(__ATOMIC_RELEASE, "workgroup"); __builtin_amdgcn_wave_barrier();
    }
}

DI void d_seq(const Ctx& c, int d, const unsigned char* __restrict__ UO, float* __restrict__ ybuf) {
    if (c.wave >= 2) return;
    const int lane = c.lane, n = lane & 31, h = lane >> 5, tau = c.wave;
    for (int chain = c.bid; chain < 64; chain += c.nb) {
        const int b = chain >> 3, hd = chain & 7;
        const unsigned char* ub = UO + (size_t)chain * 128 * UNIT_BYTES + lane * 32;
        const f32x16 Z16 = {0.f};
        f32x16 X0 = Z16, X1 = Z16;
        u32x4 T[8][2];
        auto loadu = [&](int c32) {
            const unsigned char* p = ub + (size_t)c32 * UNIT_BYTES;
#pragma unroll
            for (int k = 0; k < 6; ++k) { T[k][0] = *(const u32x4*)(p + k * 2048); T[k][1] = *(const u32x4*)(p + k * 2048 + 16); }
#pragma unroll
            for (int tp = 0; tp < 2; ++tp) { T[6 + tp][0] = *(const u32x4*)(p + (6 + 2 * tp + tau) * 2048); T[6 + tp][1] = *(const u32x4*)(p + (6 + 2 * tp + tau) * 2048 + 16); }
        };
        loadu(0);
#pragma unroll 1
        for (int c32 = 0; c32 < 128; ++c32) {
            const int tok0 = d ? SEQ - 32 * (c32 + 1) : 32 * c32;
            float* yb = ybuf + ((size_t)b * SEQ) * 512 + 64 * hd + 32 * tau + n;
            f32x16 y;
#pragma unroll
            for (int i = 0; i < 16; ++i) { const int s = crow(i, h), tk = d ? tok0 + 31 - s : tok0 + s; y[i] = yb[(size_t)tk * 512]; }
            const bf16x8 x00 = pack(X0, 0), x01 = pack(X0, 1), x10 = pack(X1, 0), x11 = pack(X1, 1);
            f32x16 n0, n1;
#pragma unroll
            for (int i = 0; i < 8; ++i) { n0[2 * i] = lo_f(T[6][i >> 2][i & 3]); n0[2 * i + 1] = hi_f(T[6][i >> 2][i & 3]); n1[2 * i] = lo_f(T[7][i >> 2][i & 3]); n1[2 * i + 1] = hi_f(T[7][i >> 2][i & 3]); }
#define FR(t, s) __builtin_bit_cast(bf16x8, T[t][s])
            n0 = MFMA32(FR(2, 0), x00, n0); n1 = MFMA32(FR(3, 0), x00, n1);
            n0 = MFMA32(FR(2, 1), x01, n0); n1 = MFMA32(FR(3, 1), x01, n1);
            n0 = MFMA32(FR(4, 0), x10, n0); n1 = MFMA32(FR(5, 0), x10, n1);
            n0 = MFMA32(FR(4, 1), x11, n0); n1 = MFMA32(FR(5, 1), x11, n1);
            y = MFMA32(FR(0, 0), x00, y); y = MFMA32(FR(0, 1), x01, y); y = MFMA32(FR(1, 0), x10, y); y = MFMA32(FR(1, 1), x11, y);
#undef FR
            if (c32 + 1 < 128) loadu(c32 + 1);
#pragma unroll
            for (int i = 0; i < 16; ++i) { const int s = crow(i, h), tk = d ? tok0 + 31 - s : tok0 + s; yb[(size_t)tk * 512] = y[i]; }
            X0 = n0; X1 = n1;
        }
    }
}
#undef DI
}

namespace pk {
typedef short bf16x8 __attribute__((ext_vector_type(8)));
typedef float f32x16 __attribute__((ext_vector_type(16)));
typedef unsigned u32x4 __attribute__((ext_vector_type(4)));
typedef LAS unsigned char* lptr;
#define DI __device__ __forceinline__
DI float fmx(float a, float b) { float r; asm("v_max_f32 %0, %1, %2" : "=v"(r) : "v"(a), "v"(b)); return r; }
DI float fmn(float a, float b) { float r; asm("v_min_f32 %0, %1, %2" : "=v"(r) : "v"(a), "v"(b)); return r; }
DI void ce(float& hi, float& lo) { const float a = fmx(hi, lo), b = fmn(hi, lo); hi = a; lo = b; }
template <int N> DI void sort_desc(float (&v)[N]) {
#pragma unroll
    for (int k = 2; k <= N; k <<= 1)
#pragma unroll
        for (int j = k >> 1; j > 0; j >>= 1)
#pragma unroll
            for (int i = 0; i < N; ++i) { const int l = i ^ j; if (l > i) { if ((i & k) == 0) ce(v[i], v[l]); else ce(v[l], v[i]); } }
}
DI void merge16(float (&v)[16]) {
#pragma unroll
    for (int j = 8; j > 0; j >>= 1)
#pragma unroll
        for (int i = 0; i < 16; ++i) { const int l = i ^ j; if (l > i) ce(v[i], v[l]); }
}
DI void top_merge(float (&a)[16], const float (&b)[16]) {
#pragma unroll
    for (int i = 0; i < 16; ++i) a[i] = fmx(a[i], b[15 - i]);
    merge16(a);
}
DI float setcode(float v, unsigned code, unsigned mask) { return __uint_as_float((__float_as_uint(v) & ~mask) | code); }

DI void d_peer_topk(const Ctx& c, const bf16* __restrict__ qb, const float* __restrict__ keys, int* __restrict__ idx, float* __restrict__ gate) {
    const int lane = c.lane, n = lane & 31, hh = lane >> 5, hd = c.bid & 7;
    lptr KL = (lptr)c.lds;
    lptr TB = (lptr)c.lds + 65536 + c.wave * 2048;
    __syncthreads();
    for (int e = c.tid; e < 2 * 128 * 16; e += 512) {
        const int row = e >> 4, ch = e & 15; const float* src = keys + (size_t)hd * 32768 + row * 128 + ch * 8;
        const f32x4 a = *(const f32x4*)src, b = *(const f32x4*)(src + 4);
        u32x4 w; w[0] = pk2bf(a.x, a.y); w[1] = pk2bf(a.z, a.w); w[2] = pk2bf(b.x, b.y); w[3] = pk2bf(b.z, b.w);
        *(LAS u32x4*)(KL + row * 256 + ((ch ^ (row & 15)) << 4)) = w; }
    __syncthreads();
    const int nper = (c.nb >> 3) * 8;
    for (int tile = (c.bid >> 3) * 8 + c.wave; tile < NTOK / 32; tile += nper) {
        const int t0 = tile * 32;
        float sp[2][16];
#pragma unroll
        for (int p = 0; p < 2; ++p) {
            bf16x8 qf[8];
            { const bf16* qrow = qb + (size_t)(t0 + n) * PEER_Q + hd * 256 + p * 128 + 8 * hh;
#pragma unroll
              for (int ks = 0; ks < 8; ++ks) qf[ks] = *(const bf16x8*)(qrow + 16 * ks); }
            float top[16];
#pragma unroll
            for (int j = 0; j < 4; ++j) {
                f32x16 acc = {0.f};
                const int row = p * 128 + 32 * j + n;
#pragma unroll
                for (int ks = 0; ks < 8; ++ks) { const bf16x8 kfr = *(LAS bf16x8*)(KL + row * 256 + (((2 * ks + hh) ^ (row & 15)) << 4));
                    acc = __builtin_amdgcn_mfma_f32_32x32x16_bf16(kfr, qf[ks], acc, 0, 0, 0); }
                float g[16];
#pragma unroll
                for (int i = 0; i < 16; ++i) { const int key = 32 * j + (i & 3) + 8 * (i >> 2) + 4 * hh; g[i] = setcode(acc[i], 127u - (unsigned)key, 127u); }
                sort_desc<16>(g);
                if (j == 0) {
#pragma unroll
                    for (int i = 0; i < 16; ++i) top[i] = g[i];
                } else top_merge(top, g);
            }
            float oth[16];
#pragma unroll
            for (int i = 0; i < 16; ++i) oth[i] = __shfl_xor(top[i], 32);
            top_merge(top, oth);
#pragma unroll
            for (int i = 0; i < 16; ++i) sp[p][i] = top[i];
        }
        {
            unsigned w[8];
#pragma unroll
            for (int q = 0; q < 8; ++q) { const int p = q >> 2, a0 = (q & 3) * 4; w[q] = 0;
#pragma unroll
                for (int e = 0; e < 4; ++e) w[q] |= (127u - (__float_as_uint(sp[p][a0 + e]) & 127u)) << (8 * e); }
            *(LAS u32x4*)(TB + lane * 32) = (u32x4){w[0], w[1], w[2], w[3]}; *(LAS u32x4*)(TB + lane * 32 + 16) = (u32x4){w[4], w[5], w[6], w[7]};
        }
        float cd[64];
        {
            int cnt = 0;
#pragma unroll
            for (int a = 0; a < 16; ++a)
#pragma unroll
                for (int b = 0; b < 16; ++b) if ((a + 1) * (b + 1) <= 16) { cd[cnt] = setcode(sp[0][a] + sp[1][b], 255u - (unsigned)(a * 16 + b), 255u); ++cnt; }
#pragma unroll
            for (int i = 50; i < 64; ++i) cd[i] = -INFINITY;
        }
        sort_desc<64>(cd);
        const float mx = cd[0]; float ex[16]; float den = 0.f;
#pragma unroll
        for (int k = 0; k < 16; ++k) { ex[k] = __expf(cd[k] - mx); den += ex[k]; }
        const float rden = 1.f / den;
        const size_t ob = (size_t)(t0 + n) * 128 + hd * 16;
        if (hh == 0) {
            int id[16];
#pragma unroll
            for (int k = 0; k < 16; ++k) { const unsigned flat = 255u - (__float_as_uint(cd[k]) & 255u); const unsigned i1 = *(LAS unsigned char*)(TB + lane * 32 + (flat >> 4)), i2 = *(LAS unsigned char*)(TB + lane * 32 + 16 + (flat & 15)); id[k] = (int)(i1 * 128 + i2); }
#pragma unroll
            for (int k = 0; k < 4; ++k) *(int4*)(idx + ob + 4 * k) = make_int4(id[4 * k], id[4 * k + 1], id[4 * k + 2], id[4 * k + 3]);
        } else {
#pragma unroll
            for (int k = 0; k < 4; ++k) *(f32x4*)(gate + ob + 4 * k) = (f32x4){ex[4 * k] * rden, ex[4 * k + 1] * rden, ex[4 * k + 2] * rden, ex[4 * k + 3] * rden};
        }
    }
}
#undef DI
}
namespace at {
typedef short bf16x8 __attribute__((ext_vector_type(8)));
typedef float f32x16 __attribute__((ext_vector_type(16)));
typedef unsigned u32x2 __attribute__((ext_vector_type(2)));
typedef unsigned u32x4 __attribute__((ext_vector_type(4)));
#define DI __device__ __forceinline__
DI void d_vt(const Ctx& c, const bf16* __restrict__ proj, bf16* __restrict__ vT) {
    LAS bf16* tl = (LAS bf16*)((LAS unsigned char*)c.lds) + c.wave * (64 * 66);
    const int lane = c.lane;
    for (int wt = c.gw; wt < BATCH * 2 * (SEQ / 64); wt += c.ngw) {
        const int tk0 = (wt % (SEQ / 64)) * 64, kvh = (wt / (SEQ / 64)) & 1, b = wt / (2 * (SEQ / 64));
        const u32x4* src = (const u32x4*)(proj + ((size_t)b * SEQ + tk0 + lane) * IN_PAD + C_V + kvh * 64);
#pragma unroll
        for (int q = 0; q < 8; ++q) { const u32x4 w = src[q];
#pragma unroll
            for (int e = 0; e < 4; ++e) *(LAS unsigned*)(tl + lane * 66 + q * 8 + 2 * e) = w[e]; }
        __builtin_amdgcn_fence(__ATOMIC_RELEASE, "workgroup"); __builtin_amdgcn_wave_barrier();
        unsigned o[32];
#pragma unroll
        for (int t = 0; t < 32; ++t) o[t] = (unsigned)tl[(2 * t) * 66 + lane] | ((unsigned)tl[(2 * t + 1) * 66 + lane] << 16);
        u32x4* dst = (u32x4*)(vT + ((size_t)(b * 2 + kvh) * 64 + lane) * SEQ + tk0);
#pragma unroll
        for (int q = 0; q < 8; ++q) dst[q] = (u32x4){o[4 * q], o[4 * q + 1], o[4 * q + 2], o[4 * q + 3]};
        __builtin_amdgcn_fence(__ATOMIC_RELEASE, "workgroup"); __builtin_amdgcn_wave_barrier();
    }
}
DI unsigned cvtpk(float lo, float hi) { typedef float f2 __attribute__((ext_vector_type(2))); typedef __bf16 b2 __attribute__((ext_vector_type(2))); f2 v = {lo, hi}; b2 r = __builtin_convertvector(v, b2); return __builtin_bit_cast(unsigned, r); }
DI bf16x8 pack(const f32x16& x, int s) { u32x4 p; p[0] = cvtpk(x[8 * s], x[8 * s + 1]); p[1] = cvtpk(x[8 * s + 2], x[8 * s + 3]); p[2] = cvtpk(x[8 * s + 4], x[8 * s + 5]); p[3] = cvtpk(x[8 * s + 6], x[8 * s + 7]); return __builtin_bit_cast(bf16x8, p); }
DI void d_attn(const Ctx& c, const bf16* __restrict__ qr, const bf16* __restrict__ kr, const bf16* __restrict__ vT, const float* __restrict__ sink, bf16* __restrict__ mix) {
    const int lane0 = c.lane;
    constexpr float C2 = 0.125f * 1.4426950408889634f, L2E = 1.4426950408889634f;
    for (int u = c.gw; u < BATCH * (SEQ / 32) * 8; u += c.ngw) {
        int lane = lane0; asm volatile("" : "+v"(lane));
        const int n = lane & 31, hh = lane >> 5;
        const int hq = u & 7, qt = (u >> 3) & (SEQ / 32 - 1), b = u >> 10, kvh = hq >> 2, q0 = qt * 32;
        bf16x8 qf[4];
        { const bf16* qp = qr + ((size_t)b * SEQ + q0 + n) * 512 + hq * 64 + 8 * hh;
#pragma unroll
          for (int ks = 0; ks < 4; ++ks) qf[ks] = *(const bf16x8*)(qp + 16 * ks); }
        float m = sink[hq] * L2E, l = hh ? 0.f : 1.f;
        f32x16 O0 = {0.f}, O1 = {0.f};
        const bf16* kbase = kr + ((size_t)b * SEQ + n) * 128 + kvh * 64 + 8 * hh;
        const bf16* vbase = vT + ((size_t)(b * 2 + kvh) * 64 + n) * SEQ + 4 * hh;
#pragma unroll 1
        for (int j = 0; j < 9; ++j) {
            const int kt0 = q0 - 128 + 32 * j;
            if (kt0 < 0 || kt0 >= SEQ) continue;
            const bf16* kp = kbase + (size_t)kt0 * 128;
            f32x16 S = {0.f};
#pragma unroll
            for (int ks = 0; ks < 4; ++ks) S = __builtin_amdgcn_mfma_f32_32x32x16_bf16(*(const bf16x8*)(kp + 16 * ks), qf[ks], S, 0, 0, 0);
            bf16x8 vf[2][2];
#pragma unroll
            for (int dt = 0; dt < 2; ++dt)
#pragma unroll
                for (int s = 0; s < 2; ++s) { const bf16* vp = vbase + (size_t)(32 * dt) * SEQ + kt0 + 16 * s; const u32x2 a = *(const u32x2*)vp, bq = *(const u32x2*)(vp + 8);
                    vf[dt][s] = __builtin_bit_cast(bf16x8, (u32x4){a[0], a[1], bq[0], bq[1]}); }
            float mt = -INFINITY;
#pragma unroll
            for (int i = 0; i < 16; ++i) { const int rr = (i & 3) + 8 * (i >> 2) + 4 * hh; float s = S[i] * C2;
                if (j == 0) s = (rr < n) ? -INFINITY : s;
                if (j == 8) s = (rr > n) ? -INFINITY : s;
                S[i] = s; mt = fmaxf(mt, s); }
            mt = fmaxf(mt, __shfl_xor(mt, 32));
            const float mn = fmaxf(m, mt), alpha = __builtin_amdgcn_exp2f(m - mn);
            m = mn; l *= alpha;
#pragma unroll
            for (int i = 0; i < 16; ++i) { O0[i] *= alpha; O1[i] *= alpha; const float p = __builtin_amdgcn_exp2f(S[i] - mn); S[i] = p; l += p; }
            const bf16x8 p0 = pack(S, 0), p1 = pack(S, 1);
            O0 = __builtin_amdgcn_mfma_f32_32x32x16_bf16(vf[0][0], p0, O0, 0, 0, 0); O0 = __builtin_amdgcn_mfma_f32_32x32x16_bf16(vf[0][1], p1, O0, 0, 0, 0);
            O1 = __builtin_amdgcn_mfma_f32_32x32x16_bf16(vf[1][0], p0, O1, 0, 0, 0); O1 = __builtin_amdgcn_mfma_f32_32x32x16_bf16(vf[1][1], p1, O1, 0, 0, 0);
        }
        l += __shfl_xor(l, 32);
        const float inv = 1.f / l;
        bf16* op = mix + ((size_t)b * SEQ + q0 + n) * DM + hq * 64 + 4 * hh;
#pragma unroll
        for (int g = 0; g < 4; ++g) { *(u32x2*)(op + 8 * g) = (u32x2){cvtpk(O0[4 * g] * inv, O0[4 * g + 1] * inv), cvtpk(O0[4 * g + 2] * inv, O0[4 * g + 3] * inv)};
            *(u32x2*)(op + 32 + 8 * g) = (u32x2){cvtpk(O1[4 * g] * inv, O1[4 * g + 1] * inv), cvtpk(O1[4 * g + 2] * inv, O1[4 * g + 3] * inv)}; }
    }
}
#undef DI
}
namespace pg8 {
struct EpiResF32 {
    static constexpr bool PERM = false, AFTER_DRAIN = false;
    const float* base; float* out; int ldc; float alpha;
    __device__ __forceinline__ void operator()(const f32x4 (&acc)[2][2][4][2], const Unit& u, int wr, int wc, int fr, int fq) const {
        const int col0 = u.pn * BM + wc * 32 + 4 * fq;
#pragma unroll
        for (int ai = 0; ai < 2; ++ai)
#pragma unroll
            for (int m = 0; m < 4; ++m) { const int r = ai * HALF + wr * 64 + m * 16 + fr; const size_t off = (size_t)(u.pm * BM + r) * ldc + col0;
#pragma unroll
                for (int bj = 0; bj < 2; ++bj)
#pragma unroll
                    for (int n = 0; n < 2; ++n) { const f32x4 bs = *(const f32x4*)(base + off + bj * HALF + n * 16); *(f32x4*)(out + off + bj * HALF + n * 16) = bs * alpha + acc[ai][bj][m][n]; } }
    }
};
}
#define XB_TMO      128
#define XB_XCNT(j)  (256  + 64 * (j))
#define XB_XSUB(j)  (1280 + 64 * (j))
#define XB_XGEN(j)  (2304 + 64 * (j))
#define XB_TOP      3328
#define XB_TOPGEN   3392
#define XCD_BAR_WORDS 3456
#define XB_SPIN_CAP (1u << 18)

__device__ __forceinline__ unsigned xb_ld(unsigned* p)              { return __hip_atomic_load(p, __ATOMIC_RELAXED, __HIP_MEMORY_SCOPE_AGENT); }
__device__ __forceinline__ unsigned xb_add(unsigned* p, unsigned v) { return __hip_atomic_fetch_add(p, v, __ATOMIC_RELAXED, __HIP_MEMORY_SCOPE_AGENT); }
__device__ __forceinline__ unsigned xb_xcc_id() { return (unsigned)__builtin_amdgcn_s_getreg((3 << 11) | 20) & 0xFu; }
#define XB_SPIN(cond, bar) do { unsigned _sp = 0; while (cond) { __builtin_amdgcn_s_sleep(1); \
    if ((++_sp & 255u) == 0u) { if (xb_ld(&(bar)[XB_TMO])) break; if (_sp > XB_SPIN_CAP) { atomicAdd(&(bar)[XB_TMO], 1u); break; } } } } while (0)

struct XcdBarrier {
    unsigned* bar; unsigned x;
    volatile LAS unsigned* st;
};

__device__ __forceinline__ XcdBarrier xcd_barrier_post(unsigned* bar, volatile LAS unsigned* st, int tid) {
    XcdBarrier b; b.bar = bar; b.x = xb_xcc_id(); b.st = st;
    if (tid == 0) (void)xb_add(&bar[XB_XCNT(b.x)], 1u);
    return b;
}
__device__ __forceinline__ void xcd_barrier_complete(unsigned* bar, unsigned x, unsigned& nloc, unsigned& nx) {
    const unsigned G = gridDim.x * gridDim.y * gridDim.z;
    unsigned sum, cnt, mine, sp = 0u;
    for (;;) {
        sum = 0u; cnt = 0u; mine = 0u;
#pragma unroll
        for (unsigned j = 0; j < 16; ++j) { const unsigned c = xb_ld(&bar[XB_XCNT(j)]); sum += c; cnt += (c > 0u) ? 1u : 0u; mine = (j == x) ? c : mine; }
        if (sum == G) break;
        __builtin_amdgcn_s_sleep(1);
        if ((++sp & 255u) == 0u) { if (xb_ld(&bar[XB_TMO])) break; if (sp > XB_SPIN_CAP) { atomicAdd(&bar[XB_TMO], 1u); break; } }
    }
    nloc = mine > 0u ? mine : 1u; nx = cnt > 0u ? cnt : 1u;
}

__device__ __forceinline__ void xcd_barrier(const XcdBarrier& b, int tid) {
    asm volatile("s_waitcnt vmcnt(0)" ::: "memory");
    __syncthreads();
    if (tid == 0) {
        unsigned* bar = b.bar;
        __builtin_amdgcn_s_waitcnt(0);
        unsigned nloc = b.st[0], nx = b.st[1];
        if (nloc == 0u) { xcd_barrier_complete(bar, b.x, nloc, nx); b.st[0] = nloc; b.st[1] = nx; }
        const unsigned old = xb_add(&bar[XB_XSUB(b.x)], 1u);
        const unsigned gen = old / nloc;
        if (old + 1u == (gen + 1u) * nloc) {
            __builtin_amdgcn_fence(__ATOMIC_RELEASE, "agent");
            asm volatile("s_waitcnt vmcnt(0)" ::: "memory");
            const unsigned og = xb_add(&bar[XB_TOP], 1u);
            const unsigned tg = og / nx;
            if (og + 1u == (tg + 1u) * nx) xb_add(&bar[XB_TOPGEN], 1u);
            else XB_SPIN(xb_ld(&bar[XB_TOPGEN]) == tg, bar);
            __builtin_amdgcn_fence(__ATOMIC_ACQUIRE, "agent");
            xb_add(&bar[XB_XGEN(b.x)], 1u);
            asm volatile("s_waitcnt vmcnt(0)" ::: "memory");
        } else {
            XB_SPIN(xb_ld(&bar[XB_XGEN(b.x)]) == gen, bar);
            __builtin_amdgcn_fence(__ATOMIC_ACQUIRE, "agent");
            asm volatile("s_waitcnt vmcnt(0)" ::: "memory");
        }
    }
    __syncthreads();
}

constexpr size_t MiB = 1u << 20;
constexpr int LDS_BYTES = 147456;
constexpr int NPHASE = 14;
struct Params { const float* in[24]; float* out; unsigned char* ws; int ph_lo, ph_hi; };

__global__ void __launch_bounds__(512, 2) mega(Params p) {
    extern __shared__ __attribute__((aligned(16))) unsigned char lds[];
    cg::grid_group grid = cg::this_grid();
    Ctx c; c.wave = __builtin_amdgcn_readfirstlane(threadIdx.x >> 6); c.lane = (int)__builtin_amdgcn_mbcnt_hi(~0u, __builtin_amdgcn_mbcnt_lo(~0u, 0u)); c.tid = c.wave * 64 + c.lane; c.bid = blockIdx.x; c.nb = gridDim.x; c.gw = c.bid * 8 + c.wave; c.ngw = c.nb * 8; c.lds = lds;
#define LND(ptr) ((ptr) + ({ int z_ = 0; asm volatile("" : "+s"(z_)); z_; }))
#define WSP(T, mb) ((T*)(LND(p.ws) + (size_t)(mb) * MiB))
#define x LND(p.in[0])
#define w_in LND(p.in[1])
#define mu_prev LND(p.in[2])
#define mu_next LND(p.in[3])
#define w0 LND(p.in[4])
#define w2 LND(p.in[5])
#define a0 LND(p.in[6])
#define a2 LND(p.in[7])
#define g2 LND(p.in[8])
#define k_k LND(p.in[9])
#define k_a LND(p.in[10])
#define r_k LND(p.in[11])
#define lnx_g LND(p.in[12])
#define lnx_b LND(p.in[13])
#define sink LND(p.in[14])
#define w_out LND(p.in[15])
#define ln1_g LND(p.in[16])
#define ln1_b LND(p.in[17])
#define wq LND(p.in[18])
#define keys LND(p.in[19])
#define pu LND(p.in[20])
#define pv LND(p.in[21])
#define ln2_g LND(p.in[22])
#define ln2_b LND(p.in[23])
#define out LND(p.out)
#define rope WSP(float2, 1)
#define w2t WSP(bf16, 2)
#define a2t ((bf16*)(LND(p.ws) + 2 * MiB + 65536))
#define g2t ((bf16*)(LND(p.ws) + 2 * MiB + 131072))
#define bscp WSP(float, 3)
#define w_in_t WSP(bf16, 4)
#define w_out_t WSP(bf16, 10)
#define wq_t WSP(bf16, 12)
#define xb WSP(bf16, 16)
#define qr WSP(bf16, 16)
#define kr WSP(bf16, 48)
#define vTp WSP(bf16, 56)
#define ybuf WSP(float, 16)
#define ub WSP(bf16, 16)
#define u8t WSP(unsigned, 16)
#define v8t WSP(unsigned, 32)
#define su8 WSP(float, 48)
#define sv8 WSP(float, 49)
#define vb WSP(bf16, 48)
#define proj WSP(bf16, 80)
#define y1 WSP(float, 80)
#define idx WSP(int, 208)
#define gate WSP(float, 224)
#define mix WSP(bf16, 240)
#define UO WSP(unsigned char, 304)
#define qb WSP(bf16, 304)
#define h1b WSP(bf16, 432)
    volatile LAS unsigned* bst = (volatile LAS unsigned*)((LAS unsigned char*)lds + (LDS_BYTES - 64));
    if (c.tid < 2) bst[c.tid] = 0u;
    __syncthreads();
    const XcdBarrier bar = xcd_barrier_post((unsigned*)p.ws, bst, c.tid);
    const int lo = p.ph_lo, hi = p.ph_hi;
#ifndef PH_MASK
#define PH_MASK 0xFFFF
#endif
#define IN(k) (((PH_MASK >> (k)) & 1) && lo <= (k) && (k) < hi)
#define RELANE() do { c.lane = (int)__builtin_amdgcn_mbcnt_hi(~0u, __builtin_amdgcn_mbcnt_lo(~0u, 0u)); c.tid = c.wave * 64 + c.lane; } while (0)
#define GBAR() do { RELANE(); xcd_barrier(bar, c.tid); } while (0)
#define SEAM(k) do { if (IN(k) && IN((k) + 1)) { if ((k) == 0) grid.sync(); else GBAR(); } RELANE(); } while (0)
#ifndef REPEAT_MASK
#define REPEAT_MASK 0
#endif
#define PHASE(k, ...) do { if (IN(k)) { RELANE(); __VA_ARGS__; if ((REPEAT_MASK >> (k)) & 1) { GBAR(); RELANE(); __VA_ARGS__; } } SEAM(k); } while (0)
#define GEMM_PHASE(EPI, A_, Bt_, N_, ...) do { pg8::Gemm g{A_, Bt_, NTOK, N_, DM}; pg8::StaticOrder S; S.init(NTOK, N_, c.nb, c.bid); EPI E{__VA_ARGS__}; \
        pg8::gemm_phase<EPI, pg8::StaticOrder, true, true>((PG8_LAS unsigned char*)lds, g, S, E, c.wave); } while (0)
    PHASE(0, nv::d_cvt_bf16(c, x, xb, (size_t)NTOK * DM / 4); nv::d_transpose_w(c, w_in, DM, IN_COLS, IN_PAD, w_in_t); nv::d_transpose_w(c, w_out, DM, DM, DM, w_out_t);
             nv::d_transpose_w(c, wq, DM, PEER_Q, PEER_Q, wq_t); nv::d_rope_table(c, rope); rw::d_lowrank_t(c, w2, a2, w2t, a2t); rw::d_g2_t(c, g2, g2t));
    PHASE(1, GEMM_PHASE(pg8::EpiBf16<0>, xb, w_in_t, IN_PAD, proj, IN_PAD, nullptr, 0, 0, 1.f));
    PHASE(2, nv::d_rotary(c, proj, rope, qr, kr); at::d_vt(c, proj, vTp));
    PHASE(3, at::d_attn(c, qr, kr, vTp, sink, mix));
    PHASE(4, rw::d_prep(c, 0, proj, mu_prev, mu_next, w0, a0, k_k, k_a, w2t, a2t, UO, ybuf));
    PHASE(5, rw::d_seq(c, 0, UO, ybuf));
    PHASE(6, rw::d_prep(c, 1, proj, mu_prev, mu_next, w0, a0, k_k, k_a, w2t, a2t, UO, ybuf));
    PHASE(7, rw::d_seq(c, 1, UO, ybuf));
    PHASE(8, rw::d_out(c, proj, ybuf, mu_prev, mu_next, a0, k_a, r_k, a2t, g2t, lnx_g, lnx_b, mix));
    PHASE(9, GEMM_PHASE(pg8::EpiResF32, mix, w_out_t, DM, x, y1, DM, DN_ALPHA));
    PHASE(10, { float* y1p = y1; nv::d_ln1(c, y1p, ln1_g, ln1_b, y1p, h1b); } pe8::d_quant_tables(c, pu, pv, u8t, v8t, su8, sv8));
    PHASE(11, GEMM_PHASE(pg8::EpiBf16<0>, h1b, wq_t, PEER_Q, qb, PEER_Q, nullptr, 0, 0, 1.f));
    PHASE(12, pk::d_peer_topk(c, qb, keys, idx, gate));
    PHASE(13, pe8::d_peer_gather(c, h1b, idx, gate, u8t, v8t, su8, sv8, ln2_g, ln2_b, out));
#undef IN
#undef SEAM
}
#undef x
#undef out
#undef proj
#undef mix
#undef idx
#undef gate
#undef keys
#undef rope
#undef w0
#undef w2
#undef a0
#undef a2
#undef g2
#undef sink
#undef qr
#undef kr
#undef ub
#undef vb
#undef qb
#undef xb
#undef y1
#undef UO
#undef ybuf
#undef pu
#undef pv

#ifndef N_LAUNCHES
#define N_LAUNCHES 1
#endif
extern "C" void kernel_launch(void* const* d_in, const int* in_sizes, int n_in, void* d_out, int out_size, void* d_ws, size_t ws_size, hipStream_t stream) {
    static int grid = 0;
    if (grid == 0) {
        if (n_in != 24 || in_sizes[0] != NTOK * DM || out_size != NTOK * DM || ws_size < 496 * MiB) { fprintf(stderr, "kernel_launch: unexpected shapes/ws (n_in %d, ws %zu)\n", n_in, ws_size); grid = -1; return; }
        int dev = 0, cus = 0, per_cu = 0;
        if (hipGetDevice(&dev) != hipSuccess || hipDeviceGetAttribute(&cus, hipDeviceAttributeMultiprocessorCount, dev) != hipSuccess) { grid = -1; return; }
        if (hipFuncSetAttribute((const void*)mega, hipFuncAttributeMaxDynamicSharedMemorySize, LDS_BYTES) != hipSuccess) { fprintf(stderr, "kernel_launch: hipFuncSetAttribute failed\n"); grid = -1; return; }
        if (hipOccupancyMaxActiveBlocksPerMultiprocessor(&per_cu, (const void*)mega, 512, LDS_BYTES) != hipSuccess || per_cu < 1) { fprintf(stderr, "kernel_launch: occupancy query failed (%d)\n", per_cu); (void)hipGetLastError(); grid = -1; return; }
        grid = cus * per_cu;
        fprintf(stderr, "kernel_launch: cus %d per_cu %d grid %d\n", cus, per_cu, grid);
    }
    if (grid < 0) return;
    if (hipMemsetAsync(d_ws, 0, 65536, stream) != hipSuccess) { fprintf(stderr, "kernel_launch: memset failed\n"); return; }
    Params p{};
    for (int i = 0; i < 24; ++i) p.in[i] = (const float*)d_in[i];
    p.out = (float*)d_out; p.ws = (unsigned char*)d_ws;
#if N_LAUNCHES == 1
    p.ph_lo = 0; p.ph_hi = NPHASE;
    void* args[] = {&p};
    hipError_t e = hipLaunchCooperativeKernel((const void*)mega, dim3(grid), dim3(512), args, LDS_BYTES, stream);
    if (e != hipSuccess) fprintf(stderr, "cooperative launch failed: %s (grid %d)\n", hipGetErrorString(e), grid);
#else
    for (int k = 0; k < NPHASE; ++k) { p.ph_lo = k; p.ph_hi = k + 1; hipLaunchKernelGGL(mega, dim3(grid), dim3(512), LDS_BYTES, stream, p); }
#endif
}
```

```cpp
#include <hip/hip_runtime.h>
#include <hip/hip_cooperative_groups.h>
#include <cstdio>
#include <cstdint>
#include <cmath>
namespace cg = cooperative_groups;

constexpr int BATCH = 8, SEQ = 4096, DM = 1024, NTOK = BATCH * SEQ;
constexpr int IN_COLS = 2528, IN_PAD = 2560;
constexpr int C_Q = 0, C_K = 512, C_V = 640, C_P = 768;
constexpr int P_R = 0, P_KK = 512, P_VV = 1024, P_WD = 1536, P_AD = 1600, P_GD = 1664, RW_COLS = 1760;
constexpr int NEXP = 16384, PEER_Q = 2048;
constexpr float LN_EPS = 1e-5f, GN_EPS = 64e-5f;
constexpr float DN_ALPHA = 1.189207115002721f;

typedef unsigned short bf16;
__device__ __forceinline__ float bf2f(bf16 v) { return __uint_as_float(((unsigned)v) << 16); }
__device__ __forceinline__ bf16 f2bf(float f) { unsigned u = __float_as_uint(f); return (bf16)((u + 0x7fffu + ((u >> 16) & 1u)) >> 16); }
__device__ __forceinline__ unsigned pk2bf(float lo, float hi) { return (unsigned)f2bf(lo) | ((unsigned)f2bf(hi) << 16); }
__device__ __forceinline__ float wave_sum(float v) {
#pragma unroll
    for (int o = 1; o < 64; o <<= 1) v += __shfl_xor(v, o);
    return v;
}
__device__ __forceinline__ float sigmoidf_(float x) { return 1.f / (1.f + __expf(-x)); }
namespace pg8 {
#define PG8_LAS __attribute__((address_space(3)))
typedef unsigned short bf16_t;
typedef short bf16x8 __attribute__((ext_vector_type(8)));
typedef float f32x4 __attribute__((ext_vector_type(4)));
typedef unsigned u32x4 __attribute__((ext_vector_type(4)));
constexpr int BM = 256, BK = 64, HALF = 128, HTB = HALF * BK * 2  , STAGE_BYTES = 8 * HTB, NXCD = 8, WGM = 8;

__host__ __device__ __forceinline__ int lds_byte(int r, int c) { const int st = (r >> 4) * 2 + (c >> 5), rr = r & 15, cc = c & 31, ob = rr * 64 + cc * 2; return st * 1024 + (ob ^ (((ob >> 9) & 1) << 5)); }
__host__ __device__ __forceinline__ void stage_rc(int b, int& R, int& C) { const int st = b / 1024, sb = b % 1024, swz = sb ^ (((sb >> 9) & 1) << 5); R = (st >> 1) * 16 + swz / 64; C = (st & 1) * 32 + (swz % 64) / 2; }
__host__ __device__ __forceinline__ int perm32(int rho) { const int n = rho >> 4, i = rho & 15; return 8 * (i >> 2) + 4 * n + (i & 3); }

struct Unit { int pm, pn; };
struct Gemm { const bf16_t* A; const bf16_t* Bt; int M, N, K; };

struct StaticOrder {
    int nM, nN, nwg, G, c;
    __host__ __device__ void init(int M, int N, int G_, int c_) { nM = M / BM; nN = N / BM; nwg = nM * nN; G = G_; c = c_; }
    __host__ __device__ bool next(int i, Unit& u) const {
        const long L = (long)i * G + c; if (L >= nwg) return false;
        int wgid = (int)L; { const int q = nwg / NXCD, r = nwg % NXCD, xcd = wgid % NXCD, off = wgid / NXCD; wgid = (xcd < r ? xcd * (q + 1) : r * (q + 1) + (xcd - r) * q) + off; }
        const int nig = WGM * nN, gid = wgid / nig, fm = gid * WGM, gsz = (nM - fm) < WGM ? (nM - fm) : WGM;
        u.pm = fm + ((wgid % nig) % gsz); u.pn = (wgid % nig) / gsz; return true;
    }
    __device__ __forceinline__ void a_ready(const Unit&) const {}
    __device__ __forceinline__ void done(const Unit&) const {}
};

__device__ __forceinline__ unsigned cvt_pk_bf16(float lo, float hi) { unsigned r; asm volatile("v_cvt_pk_bf16_f32 %0, %1, %2" : "=v"(r) : "v"(lo), "v"(hi)); return r; }
typedef float f32x2 __attribute__((ext_vector_type(2)));
__device__ __forceinline__ f32x2 gelu_pk(f32x2 v) {
    const f32x2 av = __builtin_elementwise_abs(v), d = av * 0.2316418882f + 1.0f;
    f32x2 t; t.x = __builtin_amdgcn_rcpf(d.x); t.y = __builtin_amdgcn_rcpf(d.y);
    f32x2 q = t * 0.5307027145f + (-0.7265760135f); q = q * t + 0.7107068705f; q = q * t + (-0.142248368f); q = q * t + 0.127414796f; q = q * t;
    const f32x2 s = (v * v) * (-0.72134752044f);
    f32x2 e; e.x = __builtin_amdgcn_exp2f(s.x); e.y = __builtin_amdgcn_exp2f(s.y);
    const f32x2 m = v * (q * e), r = v - m;
    f32x2 o; o.x = v.x < 0.f ? m.x : r.x; o.y = v.y < 0.f ? m.y : r.y; return o;
}

template <int ACT  > struct EpiBf16 {
    static constexpr bool PERM = true, AFTER_DRAIN = false; static_assert(ACT == 0 || ACT == 1, "EpiBf16: ACT is 0 (none) or 1 (gelu_pk)");
    bf16_t* O; int ldc; const float* bias; int split_cols; size_t split_stride; float scale0;
    __device__ __forceinline__ void operator()(const f32x4 (&acc)[2][2][4][2], const Unit& u, int wr, int wc, int fr, int fq) const {
        const int row0 = u.pm * BM + wr * 64 + fr; int colt = u.pn * BM; bf16_t* base = O;
        float sc = 1.f; if (split_cols) { const int t = colt / split_cols; base += (size_t)t * split_stride; colt -= t * split_cols; if (t == 0) sc = scale0; }
        const int col0 = colt + wc * 32 + 8 * fq, bcol0 = u.pn * BM + wc * 32 + 8 * fq;
        f32x4 bv[2][2];
#pragma unroll
        for (int bj = 0; bj < 2; ++bj)
#pragma unroll
            for (int n = 0; n < 2; ++n) bv[bj][n] = bias ? *(const f32x4*)(bias + bcol0 + bj * HALF + 4 * n) : (f32x4){0.f, 0.f, 0.f, 0.f};
#pragma unroll
        for (int ai = 0; ai < 2; ++ai)
#pragma unroll
            for (int m = 0; m < 4; ++m) { bf16_t* rowp = base + (size_t)(row0 + ai * HALF + m * 16) * ldc + col0;
#pragma unroll
                for (int bj = 0; bj < 2; ++bj) { f32x4 v0 = acc[ai][bj][m][0] + bv[bj][0], v1 = acc[ai][bj][m][1] + bv[bj][1];
                    if (ACT == 1) { f32x2 a = gelu_pk((f32x2){v0[0], v0[1]}), b = gelu_pk((f32x2){v0[2], v0[3]}), c = gelu_pk((f32x2){v1[0], v1[1]}), d = gelu_pk((f32x2){v1[2], v1[3]});
                        v0 = (f32x4){a.x, a.y, b.x, b.y}; v1 = (f32x4){c.x, c.y, d.x, d.y}; }
                    v0 = v0 * sc; v1 = v1 * sc; u32x4 w; w.x = cvt_pk_bf16(v0[0], v0[1]); w.y = cvt_pk_bf16(v0[2], v0[3]); w.z = cvt_pk_bf16(v1[0], v1[1]); w.w = cvt_pk_bf16(v1[2], v1[3]);
                    *(u32x4*)(rowp + bj * HALF) = w; } }
    }
};

struct PanelStats {
    unsigned* xbuf;
    unsigned* cnt;
    unsigned* tmo;
    int ntn; float eps;
    unsigned code;
    __device__ __forceinline__ bool run(const f32x4 (&v)[2][2][4][2], const Unit& u, int wr, int wc, int fr, int fq, PG8_LAS unsigned char* lds, int wid, int lane) const {
        typedef float f32x2v __attribute__((ext_vector_type(2)));
        PG8_LAS f32x2v* P = (PG8_LAS f32x2v*)lds;
        PG8_LAS f32x2v* S = (PG8_LAS f32x2v*)(lds + 8192);
        PG8_LAS unsigned* flag = (PG8_LAS unsigned*)(lds + 8192 + 2048);
#pragma unroll
        for (int ai = 0; ai < 2; ++ai)
#pragma unroll
            for (int m = 0; m < 4; ++m) {
                float s = 0.f;
#pragma unroll
                for (int bj = 0; bj < 2; ++bj)
#pragma unroll
                    for (int n = 0; n < 2; ++n) { const f32x4 x = v[ai][bj][m][n]; s += (x[0] + x[1]) + (x[2] + x[3]); }
                s += __shfl_xor(s, 16); s += __shfl_xor(s, 32);
                const float mw = s * (1.0f / 64.0f); float q = 0.f;
#pragma unroll
                for (int bj = 0; bj < 2; ++bj)
#pragma unroll
                    for (int n = 0; n < 2; ++n) { const f32x4 d = v[ai][bj][m][n] - mw; q += (d[0] * d[0] + d[1] * d[1]) + (d[2] * d[2] + d[3] * d[3]); }
                q += __shfl_xor(q, 16); q += __shfl_xor(q, 32);
                if (fq == 0) P[(ai * HALF + wr * 64 + m * 16 + fr) * 4 + wc] = (f32x2v){mw, q};
            }
        asm volatile("s_waitcnt lgkmcnt(0)" ::: "memory"); __builtin_amdgcn_s_barrier(); asm volatile("" ::: "memory");
#if defined(BROKEN_EXCHANGE_NO_WAIT)
#warning BROKEN CONTROL BUILD: the row-statistics exchange does not wait; results are wrong by design
        if (blockIdx.x >= 64) { const long long t0_ = clock64(); while (clock64() - t0_ < 60000) __builtin_amdgcn_s_sleep(8); }
#endif
        const int row = wid * 32 + (lane & 31);
        if (lane < 32) {
            const f32x2v a = P[row * 4 + 0], b = P[row * 4 + 1], c = P[row * 4 + 2], d = P[row * 4 + 3];
            const float mt = (a.x + b.x + c.x + d.x) * 0.25f;
            const float da = a.x - mt, db = b.x - mt, dc = c.x - mt, dd = d.x - mt;
            const float m2 = (a.y + b.y) + (c.y + d.y) + 64.0f * ((da * da + db * db) + (dc * dc + dd * dd));
            unsigned long long* slot = (unsigned long long*)xbuf + ((size_t)(u.pm * BM + row) * 4 + u.pn);
            __hip_atomic_store(slot, ((unsigned long long)__float_as_uint(m2) << 32) | __float_as_uint(mt), __ATOMIC_RELAXED, __HIP_MEMORY_SCOPE_AGENT);
        }
        asm volatile("s_waitcnt vmcnt(0)" ::: "memory");
        if (lane == 0) __hip_atomic_fetch_add(cnt + 64 * u.pm, 1u, __ATOMIC_RELAXED, __HIP_MEMORY_SCOPE_AGENT);
        if (wid == 0) {
            bool dead = false; const unsigned long long t0 = __builtin_amdgcn_s_memrealtime(); const unsigned want = 8u * (unsigned)ntn;
            for (;;) {
#if defined(BROKEN_EXCHANGE_NO_WAIT)
                break;
#endif
                if ((unsigned)__builtin_amdgcn_readfirstlane(__hip_atomic_load(cnt + 64 * u.pm, __ATOMIC_RELAXED, __HIP_MEMORY_SCOPE_AGENT)) >= want) break;
                if (__builtin_amdgcn_s_memrealtime() - t0 > 2000000ull) {
                    if (lane == 0) { unsigned expect = 0u; __hip_atomic_compare_exchange_strong(tmo + 1, &expect, code | (unsigned)(u.pm & 0xff), __ATOMIC_RELAXED, __ATOMIC_RELAXED, __HIP_MEMORY_SCOPE_AGENT);
                                     __hip_atomic_store(tmo, 1u, __ATOMIC_RELAXED, __HIP_MEMORY_SCOPE_AGENT); }
                    dead = true; break; }
                __builtin_amdgcn_s_sleep(2);
            }
            __builtin_amdgcn_fence(__ATOMIC_ACQUIRE, "agent");
            if (lane == 0) flag[0] = dead ? 1u : 0u;
        }
        asm volatile("s_waitcnt vmcnt(0) lgkmcnt(0)" ::: "memory"); __builtin_amdgcn_s_barrier(); asm volatile("" ::: "memory");
        const bool bad = flag[0] != 0u;
        if (lane < 32) {
            const unsigned long long* slot = (const unsigned long long*)xbuf + (size_t)(u.pm * BM + row) * 4; float mt[4], m2[4]; float ms = 0.f;
#pragma unroll
            for (int t = 0; t < 4; ++t) { if (t < ntn) { const unsigned long long w = __hip_atomic_load(slot + t, __ATOMIC_RELAXED, __HIP_MEMORY_SCOPE_AGENT); mt[t] = __uint_as_float((unsigned)w); m2[t] = __uint_as_float((unsigned)(w >> 32)); } else { mt[t] = 0.f; m2[t] = 0.f; } ms += mt[t]; }
            const float mean = ms / (float)ntn; float q = 0.f;
#pragma unroll
            for (int t = 0; t < 4; ++t) if (t < ntn) { const float dm = mt[t] - mean; q += m2[t] + 256.0f * dm * dm; }
            S[row] = (f32x2v){mean, 1.0f / sqrtf(q / (256.0f * (float)ntn) + eps)};
        }
        asm volatile("s_waitcnt lgkmcnt(0)" ::: "memory"); __builtin_amdgcn_s_barrier(); asm volatile("" ::: "memory");
        return bad;
    }
};
struct EpiLnRes {
    static constexpr bool PERM = false, AFTER_DRAIN = true;
    const float* base; float* out; int ldc; const float* bias; PanelStats st; unsigned poison;
    __device__ __forceinline__ void fused(f32x4 (&acc)[2][2][4][2], const Unit& u, int wr, int wc, int fr, int fq, PG8_LAS unsigned char* lds, int wid, int lane) const {
        typedef float f32x2v __attribute__((ext_vector_type(2)));
        const PG8_LAS f32x2v* S = (const PG8_LAS f32x2v*)(lds + 8192);
        const int col0 = u.pn * BM + wc * 32 + 4 * fq;
#pragma unroll
        for (int bj = 0; bj < 2; ++bj)
#pragma unroll
            for (int n = 0; n < 2; ++n) { const f32x4 bv = bias ? *(const f32x4*)(bias + col0 + bj * HALF + n * 16) : (f32x4){0.f, 0.f, 0.f, 0.f};
#pragma unroll
                for (int ai = 0; ai < 2; ++ai)
#pragma unroll
                    for (int m = 0; m < 4; ++m) acc[ai][bj][m][n] += bv; }
        f32x4 pre[4][2][2];
#pragma unroll
        for (int m = 0; m < 4; ++m) { const size_t off = (size_t)(u.pm * BM + wr * 64 + m * 16 + fr) * ldc + col0;
#pragma unroll
            for (int bj = 0; bj < 2; ++bj)
#pragma unroll
                for (int n = 0; n < 2; ++n) pre[m][bj][n] = *(const f32x4*)(base + off + bj * HALF + n * 16); }
        const bool bad = st.run(acc, u, wr, wc, fr, fq, lds, wid, lane) || poison != 0u;
        const float qnan = __builtin_nanf("");
#pragma unroll
        for (int ai = 0; ai < 2; ++ai)
#pragma unroll
            for (int m = 0; m < 4; ++m) { const int r = ai * HALF + wr * 64 + m * 16 + fr; const f32x2v sr = S[r]; const size_t off = (size_t)(u.pm * BM + r) * ldc + col0;
#pragma unroll
                for (int bj = 0; bj < 2; ++bj)
#pragma unroll
                    for (int n = 0; n < 2; ++n) { const f32x4 bs = ai == 0 ? pre[m][bj][n] : *(const f32x4*)(base + off + bj * HALF + n * 16); f32x4 o = bs + (acc[ai][bj][m][n] - sr.x) * sr.y;
                        if (bad) o = (f32x4){qnan, qnan, qnan, qnan}; *(f32x4*)(out + off + bj * HALF + n * 16) = o; }
                if (m & 1) asm volatile("" ::: "memory"); }
    }
};
struct EpiLnResLn {
    static constexpr bool PERM = false, AFTER_DRAIN = true;
    const float* base; float* out; bf16_t* xn; int ldc; const float* bias; PanelStats st1, st2; unsigned poison;
    __device__ __forceinline__ void fused(f32x4 (&acc)[2][2][4][2], const Unit& u, int wr, int wc, int fr, int fq, PG8_LAS unsigned char* lds, int wid, int lane) const {
        typedef float f32x2v __attribute__((ext_vector_type(2))); typedef unsigned u32x2v __attribute__((ext_vector_type(2)));
        const PG8_LAS f32x2v* S = (const PG8_LAS f32x2v*)(lds + 8192);
        const int col0 = u.pn * BM + wc * 32 + 4 * fq;
#pragma unroll
        for (int bj = 0; bj < 2; ++bj)
#pragma unroll
            for (int n = 0; n < 2; ++n) { const f32x4 bv = bias ? *(const f32x4*)(bias + col0 + bj * HALF + n * 16) : (f32x4){0.f, 0.f, 0.f, 0.f};
#pragma unroll
                for (int ai = 0; ai < 2; ++ai)
#pragma unroll
                    for (int m = 0; m < 4; ++m) acc[ai][bj][m][n] += bv; }
        bool bad = st1.run(acc, u, wr, wc, fr, fq, lds, wid, lane) || poison != 0u;
        const float qnan = __builtin_nanf("");
#pragma unroll
        for (int ai = 0; ai < 2; ++ai)
#pragma unroll
            for (int m = 0; m < 4; ++m) { const int r = ai * HALF + wr * 64 + m * 16 + fr; const f32x2v sr = S[r]; const size_t off = (size_t)(u.pm * BM + r) * ldc + col0;
#pragma unroll
                for (int bj = 0; bj < 2; ++bj)
#pragma unroll
                    for (int n = 0; n < 2; ++n) { const f32x4 bs = *(const f32x4*)(base + off + bj * HALF + n * 16); acc[ai][bj][m][n] = bs + (acc[ai][bj][m][n] - sr.x) * sr.y; }
                asm volatile("" : "+v"(acc[ai][0][m][0]), "+v"(acc[ai][0][m][1]), "+v"(acc[ai][1][m][0]), "+v"(acc[ai][1][m][1]));
                if (m & 1) asm volatile("" ::: "memory"); }
        const bool bad1 = bad;
        bad = st2.run(acc, u, wr, wc, fr, fq, lds, wid, lane) || bad;
#pragma unroll
        for (int ai = 0; ai < 2; ++ai)
#pragma unroll
            for (int m = 0; m < 4; ++m) { const int r = ai * HALF + wr * 64 + m * 16 + fr; const f32x2v sr = S[r]; const size_t off = (size_t)(u.pm * BM + r) * ldc + col0;
#pragma unroll
                for (int bj = 0; bj < 2; ++bj)
#pragma unroll
                    for (int n = 0; n < 2; ++n) { const f32x4 x1 = acc[ai][bj][m][n]; *(f32x4*)(out + off + bj * HALF + n * 16) = bad1 ? (f32x4){qnan, qnan, qnan, qnan} : x1;
                        const f32x4 o = (x1 - sr.x) * sr.y; u32x2v w; w.x = cvt_pk_bf16(o[0], o[1]); w.y = cvt_pk_bf16(o[2], o[3]);
                        if (bad) { w.x = 0x7fc07fc0u; w.y = 0x7fc07fc0u; } *(u32x2v*)(xn + off + bj * HALF + n * 16) = w; }
                asm volatile("" ::: "memory"); }
    }
};

template <class Epi, class Sched, bool ALIGN_EPI = false, bool SP2 = false>
__device__ __forceinline__ void gemm_phase(PG8_LAS unsigned char* lds, const Gemm g, const Sched& S, const Epi& E, const int wid_in) {
    const int lane = (int)__builtin_amdgcn_mbcnt_hi(~0u, __builtin_amdgcn_mbcnt_lo(~0u, 0u)), wid = wid_in, tid = wid * 64 + lane, wr = wid >> 2, wc = wid & 3, fr = lane & 15, fq = lane >> 4;
    const int K = g.K, nt = K / BK;
    unsigned voffA[2], voffB[2];
#pragma unroll
    for (int i = 0; i < 2; ++i) { int R, C; stage_rc(tid * 16 + i * 8192, R, C); const int Rb = Epi::PERM ? ((R & ~31) + perm32(R & 31)) : R;
        voffA[i] = (unsigned)(R * K + C) * 2u; voffB[i] = (unsigned)(Rb * K + C) * 2u; }
    const size_t kstep = (size_t)(BK * 2);
    const size_t hstep = (size_t)HALF * K * 2;
    const size_t tstep = 2 * hstep;
    const unsigned ldsw = (unsigned)wid * 1024u;
    const int aoff = lds_byte(wr * 64 + fr, fq * 8), boff = lds_byte(wc * 32 + fr, fq * 8);
#define PG8_SA(b, h) (((b) * 2 + (h)) * HTB)
#define PG8_SB(b, h) ((4 + (b) * 2 + (h)) * HTB)
#define PG8_STAGE(bufoff, gbase, voff) do { _Pragma("unroll") for (int _i = 0; _i < 2; ++_i) \
        __builtin_amdgcn_global_load_lds((const unsigned*)((const char*)(gbase) + (voff)[_i]), (PG8_LAS unsigned*)(lds + (bufoff) + ldsw + _i * 8192), 16, 0, 0); } while (0)
#define PG8_LDA(dst, b, h) do { _Pragma("unroll") for (int m = 0; m < 4; ++m) _Pragma("unroll") for (int k = 0; k < 2; ++k) dst[m][k] = *(const PG8_LAS bf16x8*)(lds + PG8_SA(b, h) + aoff + m * 2048 + k * 1024); } while (0)
#define PG8_LDB(dst, b, h) do { _Pragma("unroll") for (int n = 0; n < 2; ++n) _Pragma("unroll") for (int k = 0; k < 2; ++k) dst[n][k] = *(const PG8_LAS bf16x8*)(lds + PG8_SB(b, h) + boff + n * 2048 + k * 1024); } while (0)
#define PG8_MMA(ai, bj, At, Bt) do { __builtin_amdgcn_s_setprio(1); _Pragma("unroll") for (int m = 0; m < 4; ++m) _Pragma("unroll") for (int n = 0; n < 2; ++n) _Pragma("unroll") for (int k = 0; k < 2; ++k) \
        acc[ai][bj][m][n] = __builtin_amdgcn_mfma_f32_16x16x32_bf16(Bt[n][k], At[m][k], acc[ai][bj][m][n], 0, 0, 0); __builtin_amdgcn_s_setprio(0); } while (0)
#define PG8_WAIT_V(n) asm volatile("s_waitcnt vmcnt(" #n ")" ::: "memory")
#define PG8_WAIT_L(n) asm volatile("s_waitcnt lgkmcnt(" #n ")" ::: "memory")
#define PG8_BAR __builtin_amdgcn_s_barrier()
#define PG8_SCHED __builtin_amdgcn_sched_barrier(0)
    Unit cur, nxt; int ui = 0;
    if (!S.next(0, cur)) return;
    f32x4 acc[2][2][4][2];
#pragma unroll
    for (int a = 0; a < 2; ++a)
#pragma unroll
        for (int b = 0; b < 2; ++b)
#pragma unroll
            for (int m = 0; m < 4; ++m)
#pragma unroll
                for (int n = 0; n < 2; ++n) acc[a][b][m][n] = (f32x4){0.f, 0.f, 0.f, 0.f};
    bf16x8 At[4][2], B0[2][2], B1[2][2];
    const char* cA = (const char*)g.A + (size_t)cur.pm * tstep; const char* cB = (const char*)g.Bt + (size_t)cur.pn * tstep;
    S.a_ready(cur);
    if constexpr (SP2) {
        PG8_STAGE(PG8_SB(0, 0), cB, voffB); PG8_STAGE(PG8_SB(0, 1), cB + hstep, voffB); PG8_STAGE(PG8_SA(0, 0), cA, voffA); PG8_STAGE(PG8_SA(0, 1), cA + hstep, voffA);
        if (wr == 1) PG8_BAR;
        PG8_WAIT_V(2); PG8_BAR;
        PG8_STAGE(PG8_SB(1, 0), cB + kstep, voffB); PG8_STAGE(PG8_SA(1, 0), cA + kstep, voffA); PG8_STAGE(PG8_SB(1, 1), cB + hstep + kstep, voffB);
        PG8_WAIT_V(6); PG8_BAR;
    } else {
        PG8_STAGE(PG8_SB(0, 0), cB, voffB); PG8_STAGE(PG8_SA(0, 0), cA, voffA); PG8_STAGE(PG8_SB(0, 1), cB + hstep, voffB); PG8_STAGE(PG8_SA(0, 1), cA + hstep, voffA);
        if (wr == 1) PG8_BAR;
        PG8_WAIT_V(4); PG8_BAR;
        PG8_STAGE(PG8_SB(1, 0), cB + kstep, voffB); PG8_STAGE(PG8_SA(1, 0), cA + kstep, voffA); PG8_STAGE(PG8_SB(1, 1), cB + hstep + kstep, voffB);
        PG8_WAIT_V(6); PG8_BAR;
    }
    for (;;) {
        const bool has_next = S.next(ui + 1, nxt);
        const char* nA = has_next ? (const char*)g.A + (size_t)nxt.pm * tstep : cA; const char* nB = has_next ? (const char*)g.Bt + (size_t)nxt.pn * tstep : cB;
        for (int t = 0; t < nt; t += 2) {
            const bool last = (t == nt - 2);
            const char* a1 = cA + (size_t)(t + 1) * kstep;
            const char* a2 = last ? nA : cA + (size_t)(t + 2) * kstep; const char* b2 = last ? nB : cB + (size_t)(t + 2) * kstep;
            const char* a3 = a2 + kstep; const char* b3 = b2 + kstep;
            if (last && has_next) S.a_ready(nxt);
            if constexpr (SP2) {
            PG8_LDB(B0, 0, 0); PG8_LDB(B1, 0, 1); PG8_SCHED; PG8_LDA(At, 0, 0); PG8_STAGE(PG8_SA(1, 1), a1 + hstep, voffA);
            PG8_WAIT_V(8); PG8_WAIT_L(0); PG8_BAR; PG8_MMA(0, 0, At, B0); PG8_MMA(0, 1, At, B1); PG8_BAR; PG8_SCHED;
            PG8_LDA(At, 0, 1); PG8_STAGE(PG8_SB(0, 0), b2, voffB); PG8_STAGE(PG8_SB(0, 1), b2 + hstep, voffB); PG8_STAGE(PG8_SA(0, 0), a2, voffA);
            PG8_WAIT_V(8); PG8_WAIT_L(0); PG8_BAR; PG8_MMA(1, 0, At, B0); PG8_MMA(1, 1, At, B1); PG8_BAR; PG8_SCHED;
            PG8_LDB(B0, 1, 0); PG8_LDB(B1, 1, 1); PG8_SCHED; PG8_LDA(At, 1, 0); PG8_STAGE(PG8_SA(0, 1), a2 + hstep, voffA);
            PG8_WAIT_V(8); PG8_WAIT_L(0); PG8_BAR; PG8_MMA(0, 0, At, B0); PG8_MMA(0, 1, At, B1); PG8_BAR; PG8_SCHED;
            PG8_LDA(At, 1, 1); PG8_STAGE(PG8_SB(1, 0), b3, voffB); PG8_STAGE(PG8_SB(1, 1), b3 + hstep, voffB); PG8_STAGE(PG8_SA(1, 0), a3, voffA);
            PG8_WAIT_V(8); PG8_WAIT_L(0); PG8_BAR; PG8_MMA(1, 0, At, B0); PG8_MMA(1, 1, At, B1); PG8_BAR; PG8_SCHED;
            } else {
            PG8_LDB(B0, 0, 0); PG8_SCHED; PG8_LDA(At, 0, 0); PG8_STAGE(PG8_SA(1, 1), a1 + hstep, voffA);
            PG8_WAIT_L(8); PG8_BAR; PG8_WAIT_L(0); PG8_MMA(0, 0, At, B0); PG8_BAR; PG8_SCHED;
            PG8_LDB(B1, 0, 1); PG8_STAGE(PG8_SB(0, 0), b2, voffB);
            PG8_BAR; PG8_WAIT_L(0); PG8_MMA(0, 1, At, B1); PG8_BAR;
            PG8_LDA(At, 0, 1); PG8_STAGE(PG8_SA(0, 0), a2, voffA);
            PG8_BAR; PG8_WAIT_L(0); PG8_MMA(1, 0, At, B0); PG8_BAR; PG8_SCHED;
            PG8_STAGE(PG8_SB(0, 1), b2 + hstep, voffB);
            PG8_WAIT_V(6); PG8_BAR; PG8_MMA(1, 1, At, B1); PG8_BAR;
            PG8_LDB(B0, 1, 0); PG8_SCHED; PG8_LDA(At, 1, 0); PG8_STAGE(PG8_SA(0, 1), a2 + hstep, voffA);
            PG8_WAIT_L(8); PG8_BAR; PG8_WAIT_L(0); PG8_MMA(0, 0, At, B0); PG8_BAR; PG8_SCHED;
            PG8_LDB(B1, 1, 1); PG8_STAGE(PG8_SB(1, 0), b3, voffB);
            PG8_BAR; PG8_WAIT_L(0); PG8_MMA(0, 1, At, B1); PG8_BAR;
            PG8_LDA(At, 1, 1); PG8_STAGE(PG8_SA(1, 0), a3, voffA);
            PG8_BAR; PG8_WAIT_L(0); PG8_MMA(1, 0, At, B0); PG8_BAR; PG8_SCHED;
            PG8_STAGE(PG8_SB(1, 1), b3 + hstep, voffB);
            PG8_WAIT_V(6); PG8_BAR; PG8_MMA(1, 1, At, B1); PG8_BAR;
            }
        }
        if constexpr (ALIGN_EPI) { if (wr == 0) PG8_BAR; }
        if constexpr (!Epi::AFTER_DRAIN) { E(acc, cur, wr, wc, fr, fq); S.done(cur); }
        if (!has_next) break;
#pragma unroll
        for (int a = 0; a < 2; ++a)
#pragma unroll
            for (int b = 0; b < 2; ++b)
#pragma unroll
                for (int m = 0; m < 4; ++m)
#pragma unroll
                    for (int n = 0; n < 2; ++n) acc[a][b][m][n] = (f32x4){0.f, 0.f, 0.f, 0.f};
        cur = nxt; cA = nA; cB = nB; ++ui;
        if constexpr (ALIGN_EPI) { if (wr == 1) PG8_BAR; }
    }
    PG8_WAIT_V(0);
    if constexpr (!ALIGN_EPI) { if (wr == 0) PG8_BAR; }
    PG8_BAR;
    if constexpr (Epi::AFTER_DRAIN) { E.fused(acc, cur, wr, wc, fr, fq, lds, wid, lane); S.done(cur); }
#undef PG8_SA
#undef PG8_SB
#undef PG8_STAGE
#undef PG8_LDA
#undef PG8_LDB
#undef PG8_MMA
#undef PG8_WAIT_V
#undef PG8_WAIT_L
#undef PG8_BAR
#undef PG8_SCHED
}
}
#define LAS __attribute__((address_space(3)))
typedef float f32x4 __attribute__((ext_vector_type(4)));
struct Ctx { int tid, lane, wave, bid, nb, gw, ngw; unsigned char* lds; };

namespace nv {
__device__ __forceinline__ void d_cvt_bf16(const Ctx& c, const float* __restrict__ in, bf16* __restrict__ out, size_t n4) {
    for (size_t i = (size_t)c.bid * 512 + c.tid; i < n4; i += (size_t)c.nb * 512) { f32x4 v = ((const f32x4*)in)[i]; uint2 o; o.x = pk2bf(v.x, v.y); o.y = pk2bf(v.z, v.w); ((uint2*)out)[i] = o; }
}
__device__ __forceinline__ void d_transpose_w(const Ctx& c, const float* __restrict__ W, int K, int N, int Npad, bf16* __restrict__ WT) {
    float* t = (float*)(c.lds) + c.wave * (32 * 33);
    const int tx = c.lane & 31, ty = c.lane >> 5, nbn = Npad / 32, ntile = nbn * (K / 32);
    for (int it = c.gw; it < ntile; it += c.ngw) {
        const int n0 = (it % nbn) * 32, k0 = (it / nbn) * 32;
        for (int i = ty; i < 32; i += 2) { const int n = n0 + tx; t[i * 33 + tx] = (n < N) ? W[(size_t)(k0 + i) * N + n] : 0.f; }
        __builtin_amdgcn_fence(__ATOMIC_RELEASE, "workgroup"); __builtin_amdgcn_wave_barrier();
        for (int i = ty; i < 32; i += 2) WT[(size_t)(n0 + i) * K + k0 + tx] = f2bf(t[tx * 33 + i]);
        __builtin_amdgcn_fence(__ATOMIC_RELEASE, "workgroup"); __builtin_amdgcn_wave_barrier();
    }
}
__device__ __forceinline__ void d_rope_table(const Ctx& c, float2* __restrict__ tab) {
    for (int id = c.bid * 512 + c.tid; id < SEQ * 32; id += c.nb * 512) {
        const int pos = id >> 5, i = id & 31;
        const float inv = (float)pow(10000.0, -(double)i / 32.0);
        const float ang = (float)pos * inv;
        tab[id] = make_float2((float)cos((double)ang), (float)sin((double)ang));
    }
}
__device__ __forceinline__ void d_rotary(const Ctx& c, const bf16* __restrict__ proj, const float2* __restrict__ tab, bf16* __restrict__ qr, bf16* __restrict__ kr) {
    for (size_t id = (size_t)c.bid * 512 + c.tid; id < (size_t)NTOK * 320; id += (size_t)c.nb * 512) {
        const int d = id & 31, hh = (id >> 5) % 10; const size_t t = id / 320; const int pos = (int)(t % SEQ);
        const float2 cs = tab[pos * 32 + d];
        const bf16* src = proj + t * IN_PAD + hh * 64;
        const float t1 = bf2f(src[d]), t2 = bf2f(src[d + 32]);
        const float o1 = t1 * cs.x - t2 * cs.y, o2 = t2 * cs.x + t1 * cs.y;
        bf16* dst = (hh < 8) ? (qr + t * 512 + hh * 64) : (kr + t * 128 + (hh - 8) * 64);
        dst[d] = f2bf(o1); dst[d + 32] = f2bf(o2);
    }
}
__device__ __forceinline__ void d_attn(const Ctx& c, const bf16* __restrict__ qr, const bf16* __restrict__ kr, const bf16* __restrict__ proj, const float* __restrict__ sink, bf16* __restrict__ mix) {
    for (int id = c.bid * 512 + c.tid; id < NTOK * 8; id += c.nb * 512) {
        const int hq = id & 7, t = id >> 3, b = t / SEQ, i = t % SEQ, kvh = hq >> 2;
        float q[64], acc[64];
#pragma unroll
        for (int d = 0; d < 64; ++d) { q[d] = bf2f(qr[(size_t)t * 512 + hq * 64 + d]) * 0.125f; acc[d] = 0.f; }
        float m = sink[hq], l = 1.f;
        const int j0 = max(0, i - 128), j1 = min(SEQ - 1, i + 128);
        for (int j = j0; j <= j1; ++j) {
            const size_t tj = (size_t)b * SEQ + j;
            const uint4* kp = (const uint4*)(kr + tj * 128 + kvh * 64);
            float s = 0.f;
#pragma unroll
            for (int cc = 0; cc < 8; ++cc) { const uint4 w = kp[cc]; const unsigned ww[4] = {w.x, w.y, w.z, w.w};
#pragma unroll
                for (int e = 0; e < 4; ++e) { s += q[cc * 8 + 2 * e] * __uint_as_float(ww[e] << 16) + q[cc * 8 + 2 * e + 1] * __uint_as_float(ww[e] & 0xffff0000u); } }
            if (s > m) { const float f = __expf(m - s); l *= f;
#pragma unroll
                for (int d = 0; d < 64; ++d) acc[d] *= f;
                m = s; }
            const float p = __expf(s - m); l += p;
            const uint4* vp = (const uint4*)(proj + tj * IN_PAD + C_V + kvh * 64);
#pragma unroll
            for (int cc = 0; cc < 8; ++cc) { const uint4 w = vp[cc]; const unsigned ww[4] = {w.x, w.y, w.z, w.w};
#pragma unroll
                for (int e = 0; e < 4; ++e) { acc[cc * 8 + 2 * e] += p * __uint_as_float(ww[e] << 16); acc[cc * 8 + 2 * e + 1] += p * __uint_as_float(ww[e] & 0xffff0000u); } }
        }
        const float il = 1.f / l;
#pragma unroll
        for (int d = 0; d < 64; d += 2) *(unsigned*)(mix + (size_t)t * DM + hq * 64 + d) = pk2bf(acc[d] * il, acc[d + 1] * il);
    }
}
__device__ __forceinline__ void d_scan(const Ctx& c, const bf16* __restrict__ proj, const float* __restrict__ mu_prev, const float* __restrict__ mu_next,
                                       const float* __restrict__ w0, const float* __restrict__ w2, const float* __restrict__ a0, const float* __restrict__ a2,
                                       const float* __restrict__ k_k, const float* __restrict__ k_a, float* __restrict__ ydir) {
    if (c.wave != 0) return;
    for (int unit = c.bid; unit < 128; unit += c.nb) {
    const int b = unit >> 4, h = (unit >> 1) & 7, d = unit & 1, lane = c.lane, ch = h * 64 + lane;
    float (*sh)[64] = (float (*)[64])c.lds;
    const int colx = lane < 32 ? (P_WD + d * 32 + lane) : (P_AD + d * 32 + lane - 32);
    const int cols[4] = {P_R + ch, P_KK + ch, P_VV + ch, colx};
    float mp[4], mn[4];
#pragma unroll
    for (int q = 0; q < 4; ++q) { mp[q] = mu_prev[cols[q]]; mn[q] = mu_next[cols[q]]; }
    float* w2c = (float*)c.lds + 6 * 64 + lane; float* a2c = w2c + 32 * 64;
    for (int j = 0; j < 32; ++j) { w2c[j * 64] = w2[(size_t)(d * 32 + j) * 512 + ch]; a2c[j * 64] = a2[(size_t)(d * 32 + j) * 512 + ch]; }
    const float w0c = w0[d * 512 + ch], a0c = a0[d * 512 + ch], kkc = k_k[ch], kac = k_a[ch];
    float S[64];
#pragma unroll
    for (int k = 0; k < 64; ++k) S[k] = 0.f;
    const int sgn = d ? -1 : 1; int t = d ? SEQ - 1 : 0;
    const bf16* pb = proj + (size_t)b * SEQ * IN_PAD + C_P;
    float behind[4], cur[4], ahead[4];
#pragma unroll
    for (int q = 0; q < 4; ++q) { behind[q] = 0.f; cur[q] = bf2f(pb[(size_t)t * IN_PAD + cols[q]]); ahead[q] = bf2f(pb[(size_t)(t + sgn) * IN_PAD + cols[q]]); }
    for (int step = 0; step < SEQ; ++step, t += sgn) {
        float ahead2[4]; const int t2 = t + 2 * sgn; const bool ok2 = (t2 >= 0 && t2 < SEQ);
#pragma unroll
        for (int q = 0; q < 4; ++q) ahead2[q] = ok2 ? bf2f(pb[(size_t)t2 * IN_PAD + cols[q]]) : 0.f;
        float sv[4];
#pragma unroll
        for (int q = 0; q < 4; ++q) { const float prv = d ? ahead[q] : behind[q], nxt = d ? behind[q] : ahead[q]; sv[q] = cur[q] + mp[q] * (prv - cur[q]) + mn[q] * (nxt - cur[q]); }
        const float r = sv[0], k = sv[1], v = sv[2];
        sh[5][lane] = lane < 32 ? tanhf(sv[3]) : sv[3];
        __builtin_amdgcn_fence(__ATOMIC_RELEASE, "workgroup"); __builtin_amdgcn_wave_barrier();
        float ws = w0c, as = a0c;
#pragma unroll
        for (int j = 0; j < 32; ++j) { ws += sh[5][j] * w2c[j * 64]; as += sh[5][32 + j] * a2c[j * 64]; }
        const float nsp = -ws; const float sp = (nsp > 20.f) ? nsp : log1pf(__expf(nsp));
        const float wlog = -sp - 0.5f; const float decay = __expf(-__expf(wlog));
        const float a = sigmoidf_(as);
        float kk = k * kkc; const float ss = wave_sum(kk * kk); kk = kk * rsqrtf(fmaxf(ss, 1e-24f));
        const float kd = k * (1.f + (a - 1.f) * kac);
        sh[0][lane] = decay; sh[1][lane] = kk * a; sh[2][lane] = kd; sh[3][lane] = r; sh[4][lane] = kk;
        __builtin_amdgcn_fence(__ATOMIC_RELEASE, "workgroup"); __builtin_amdgcn_wave_barrier();
        float sa = 0.f;
#pragma unroll
        for (int q = 0; q < 64; ++q) sa -= S[q] * sh[4][q];
        float y = 0.f;
#pragma unroll
        for (int q = 0; q < 64; ++q) { S[q] = S[q] * sh[0][q] + sa * sh[1][q] + v * sh[2][q]; y += S[q] * sh[3][q]; }
        ydir[((size_t)d * NTOK + (size_t)b * SEQ + t) * 512 + ch] = y;
        __builtin_amdgcn_fence(__ATOMIC_RELEASE, "workgroup"); __builtin_amdgcn_wave_barrier();
#pragma unroll
        for (int q = 0; q < 4; ++q) { behind[q] = cur[q]; cur[q] = ahead[q]; ahead[q] = ahead2[q]; }
    }
    }
}
template <bool YSINGLE> __device__ __forceinline__ void d_rwkv_out(const Ctx& c, const bf16* __restrict__ proj, const float* __restrict__ ydir, const float* __restrict__ mu_prev, const float* __restrict__ mu_next,
                                           const float* __restrict__ a0, const float* __restrict__ a2, const float* __restrict__ g2, const float* __restrict__ k_a, const float* __restrict__ r_k,
                                           const float* __restrict__ lnx_g, const float* __restrict__ lnx_b, bf16* __restrict__ mix) {
    float* sad = (float*)c.lds; float* sgd = sad + 64; const int ch = c.tid;
    const float mpr = mu_prev[P_R + ch], mnr = mu_next[P_R + ch], mpk = mu_prev[P_KK + ch], mnk = mu_next[P_KK + ch], mpv = mu_prev[P_VV + ch], mnv = mu_next[P_VV + ch];
    const int cx = (ch < 64) ? (P_AD + ch) : (ch < 160 ? P_GD + ch - 64 : 0); const float mpx = mu_prev[cx], mnx = mu_next[cx];
    for (int t = c.bid; t < NTOK; t += c.nb) {
        const int i = t % SEQ; const bf16* p0 = proj + (size_t)t * IN_PAD + C_P;
        const bool hp = i > 0, hn = i < SEQ - 1;
#define SHF(col, mp_, mn_) ({ const float c_ = bf2f(p0[col]); const float pv_ = hp ? bf2f(p0[(col) - IN_PAD]) : 0.f, nx_ = hn ? bf2f(p0[(col) + IN_PAD]) : 0.f; c_ + (mp_) * (pv_ - c_) + (mn_) * (nx_ - c_); })
        if (ch < 64) sad[ch] = SHF(cx, mpx, mnx);
        else if (ch < 160) sgd[ch - 64] = sigmoidf_(SHF(cx, mpx, mnx));
        const float r = SHF(P_R + ch, mpr, mnr), k = SHF(P_KK + ch, mpk, mnk), v = SHF(P_VV + ch, mpv, mnv);
#undef SHF
        __syncthreads();
        asm volatile("" ::: "memory");
        float as0 = a0[ch], as1 = a0[512 + ch];
#pragma unroll 4
        for (int j = 0; j < 32; ++j) { as0 += sad[j] * a2[(size_t)j * 512 + ch]; as1 += sad[32 + j] * a2[(size_t)(32 + j) * 512 + ch]; }
        const float am = 0.5f * (sigmoidf_(as0) + sigmoidf_(as1));
        float g = 0.f;
#pragma unroll 4
        for (int j = 0; j < 96; ++j) g += sgd[j] * g2[(size_t)j * 512 + ch];
        const float y = YSINGLE ? ydir[(size_t)t * 512 + ch] : (ydir[(size_t)t * 512 + ch] + ydir[((size_t)NTOK + t) * 512 + ch]);
        const float mu = wave_sum(y) * (1.f / 64.f); const float dy = y - mu; const float var = wave_sum(dy * dy) * (1.f / 64.f);
        const float yn = dy * rsqrtf(var + GN_EPS) * lnx_g[ch] + lnx_b[ch];
        const float kmean = k * (1.f + (am - 1.f) * k_a[ch]);
        const float bonus = wave_sum(r * kmean * r_k[ch]) * v;
        mix[(size_t)t * DM + 512 + ch] = f2bf((yn + bonus) * g);
        __syncthreads();
    }
}
__device__ __forceinline__ void d_ln1(const Ctx& c, const float* y1, const float* __restrict__ g, const float* __restrict__ bta, float* h1f, bf16* __restrict__ h1b) {
    for (int row = c.gw; row < NTOK; row += c.ngw) {
        const int lane = c.lane;
        const f32x4* xr = (const f32x4*)(y1 + (size_t)row * DM) + lane;
        f32x4 v[4]; float s = 0.f;
#pragma unroll
        for (int j = 0; j < 4; ++j) { v[j] = xr[64 * j]; s += (v[j].x + v[j].y) + (v[j].z + v[j].w); }
        const float mean = wave_sum(s) * (1.f / DM); float s2 = 0.f;
#pragma unroll
        for (int j = 0; j < 4; ++j) { v[j] = v[j] - mean; s2 += (v[j].x * v[j].x + v[j].y * v[j].y) + (v[j].z * v[j].z + v[j].w * v[j].w); }
        const float rstd = rsqrtf(wave_sum(s2) * (1.f / DM) + LN_EPS);
#pragma unroll
        for (int j = 0; j < 4; ++j) { const f32x4 gg = ((const f32x4*)g)[64 * j + lane], bb = ((const f32x4*)bta)[64 * j + lane];
            const f32x4 o = v[j] * rstd * gg + bb;
            ((f32x4*)(h1f + (size_t)row * DM))[64 * j + lane] = o;
            uint2 w; w.x = pk2bf(o.x, o.y); w.y = pk2bf(o.z, o.w); ((uint2*)(h1b + (size_t)row * DM))[64 * j + lane] = w; }
    }
}
__device__ __forceinline__ void d_peer_topk(const Ctx& c, const bf16* __restrict__ qb, const float* __restrict__ keys, int* __restrict__ idx, float* __restrict__ gate) {
    float* keysT = (float*)c.lds; float* sq = keysT + 2 * 128 * 128; float* sc = sq + 256; float* s12 = sc + 256; int* i12 = (int*)(s12 + 32);
    const int tid = c.tid, lane = c.lane, wave = c.wave;
    for (int item = c.bid; item < 8 * 64; item += c.nb) {
        const int h = item & 7, grp = item >> 3;
        __syncthreads();
        for (int e = tid; e < 2 * 128 * 128; e += 512) { const int p = e >> 14, n = (e >> 7) & 127, cc = e & 127; keysT[(p * 128 + cc) * 128 + n] = keys[(size_t)h * 32768 + e]; }
        __syncthreads();
        for (int tt = 0; tt < 512; ++tt) {
            const size_t t = (size_t)grp * 512 + tt;
            if (tid < 256) sq[tid] = bf2f(qb[t * PEER_Q + h * 256 + tid]);
            __syncthreads();
            if (tid < 256) { const int p = tid >> 7, n = tid & 127; float s = 0.f; const float* kt = keysT + p * 16384 + n; const float* qq = sq + p * 128;
                for (int cc = 0; cc < 128; ++cc) s += qq[cc] * kt[cc * 128];
                sc[tid] = s; }
            __syncthreads();
            if (wave < 2) {
                float v0 = sc[wave * 128 + lane], v1 = sc[wave * 128 + 64 + lane];
                for (int r = 0; r < 16; ++r) {
                    float bv; int bi; if (v1 > v0) { bv = v1; bi = lane + 64; } else { bv = v0; bi = lane; }
#pragma unroll
                    for (int o = 1; o < 64; o <<= 1) { const float ov = __shfl_xor(bv, o); const int oi = __shfl_xor(bi, o); if (ov > bv || (ov == bv && oi < bi)) { bv = ov; bi = oi; } }
                    if (lane == 0) { s12[wave * 16 + r] = bv; i12[wave * 16 + r] = bi; }
                    if (bi == lane) v0 = -INFINITY; if (bi == lane + 64) v1 = -INFINITY;
                }
            }
            __syncthreads();
            if (wave == 0) {
                float cv[4];
#pragma unroll
                for (int j = 0; j < 4; ++j) { const int f = lane + 64 * j; cv[j] = s12[f >> 4] + s12[16 + (f & 15)]; }
                float mycs = 0.f; int myid = 0;
                for (int r = 0; r < 16; ++r) {
                    float bv = cv[0]; int bi = lane;
#pragma unroll
                    for (int j = 1; j < 4; ++j) if (cv[j] > bv) { bv = cv[j]; bi = lane + 64 * j; }
#pragma unroll
                    for (int o = 1; o < 64; o <<= 1) { const float ov = __shfl_xor(bv, o); const int oi = __shfl_xor(bi, o); if (ov > bv || (ov == bv && oi < bi)) { bv = ov; bi = oi; } }
                    if (lane == r) { mycs = bv; myid = i12[bi >> 4] * 128 + i12[16 + (bi & 15)]; }
#pragma unroll
                    for (int j = 0; j < 4; ++j) if (bi == lane + 64 * j) cv[j] = -INFINITY;
                }
                float mx = (lane < 16) ? mycs : -INFINITY;
#pragma unroll
                for (int o = 1; o < 64; o <<= 1) mx = fmaxf(mx, __shfl_xor(mx, o));
                const float e = (lane < 16) ? __expf(mycs - mx) : 0.f; const float den = wave_sum(e);
                if (lane < 16) { idx[t * 128 + h * 16 + lane] = myid; gate[t * 128 + h * 16 + lane] = e / den; }
            }
            __syncthreads();
        }
    }
}
__device__ __forceinline__ void d_peer_gather(const Ctx& c, const float* __restrict__ h1f, const int* __restrict__ idx, const float* __restrict__ gate, const float* __restrict__ u, const float* __restrict__ v,
                                              const float* __restrict__ g, const float* __restrict__ bta, float* __restrict__ out) {
    const int lane = c.lane;
    for (int t = c.gw; t < NTOK; t += c.ngw) {
        f32x4 hv[4], f[4];
#pragma unroll
        for (int j = 0; j < 4; ++j) { hv[j] = ((const f32x4*)(h1f + (size_t)t * DM))[64 * j + lane]; f[j] = (f32x4){0.f, 0.f, 0.f, 0.f}; }
        for (int e = 0; e < 128; ++e) {
            const int id = idx[(size_t)t * 128 + e]; const float gt = gate[(size_t)t * 128 + e];
            const f32x4* ur = (const f32x4*)(u + (size_t)id * DM); const f32x4* vr = (const f32x4*)(v + (size_t)id * DM);
            float z = 0.f;
#pragma unroll
            for (int j = 0; j < 4; ++j) { const f32x4 w = ur[64 * j + lane]; z += (w.x * hv[j].x + w.y * hv[j].y) + (w.z * hv[j].z + w.w * hv[j].w); }
            z = wave_sum(z);
            const float act = gt * 0.5f * z * (1.f + erff(z * 0.70710678118654752f));
#pragma unroll
            for (int j = 0; j < 4; ++j) { const f32x4 w = vr[64 * j + lane]; f[j] += act * w; }
        }
        float s = 0.f;
#pragma unroll
        for (int j = 0; j < 4; ++j) { f[j] = DN_ALPHA * hv[j] + f[j]; s += (f[j].x + f[j].y) + (f[j].z + f[j].w); }
        const float mean = wave_sum(s) * (1.f / DM); float s2 = 0.f;
#pragma unroll
        for (int j = 0; j < 4; ++j) { f[j] = f[j] - mean; s2 += (f[j].x * f[j].x + f[j].y * f[j].y) + (f[j].z * f[j].z + f[j].w * f[j].w); }
        const float rstd = rsqrtf(wave_sum(s2) * (1.f / DM) + LN_EPS);
#pragma unroll
        for (int j = 0; j < 4; ++j) { const f32x4 gg = ((const f32x4*)g)[64 * j + lane], bb = ((const f32x4*)bta)[64 * j + lane];
            ((f32x4*)(out + (size_t)t * DM))[64 * j + lane] = f[j] * rstd * gg + bb; }
    }
}
}
namespace pe {
typedef __bf16 bf16x2_t __attribute__((ext_vector_type(2)));
__device__ __forceinline__ float dot2(unsigned a, unsigned b, float c) { return __builtin_amdgcn_fdot2_f32_bf16(__builtin_bit_cast(bf16x2_t, a), __builtin_bit_cast(bf16x2_t, b), c, false); }
__device__ __forceinline__ float gelu_erf(float z) { return 0.5f * z * (1.f + erff(z * 0.70710678118654752f)); }
constexpr int GE = 4;
struct Rows { uint4 a[GE], b[GE]; };
__device__ __forceinline__ void load_rows(Rows& r, const bf16* __restrict__ tab, int i0, int i1, int lane, int g) {
#pragma unroll
    for (int j = 0; j < GE; ++j) { const int e = g * GE + j; const int id = __builtin_amdgcn_readlane((e & 64) ? i1 : i0, e & 63);
        const uint4* p = (const uint4*)(tab + (size_t)id * DM) + lane; r.a[j] = p[0]; r.b[j] = p[64]; }
}
__device__ __forceinline__ void d_peer_gather(const Ctx& c, const bf16* __restrict__ h1b, const int* __restrict__ idx, const float* __restrict__ gate, const bf16* __restrict__ ub, const bf16* __restrict__ vb,
                                              const float* __restrict__ g, const float* __restrict__ bta, float* __restrict__ out) {
    const int lane = c.lane;
    for (int t = c.gw; t < NTOK; t += c.ngw) {
        const uint4* hp = (const uint4*)(h1b + (size_t)t * DM) + lane; const uint4 h0 = hp[0], h1 = hp[64];
        const unsigned hw[8] = {h0.x, h0.y, h0.z, h0.w, h1.x, h1.y, h1.z, h1.w};
        const int i0 = idx[(size_t)t * 128 + lane], i1 = idx[(size_t)t * 128 + 64 + lane];
        const float g0 = gate[(size_t)t * 128 + lane], g1 = gate[(size_t)t * 128 + 64 + lane];
        float f[16];
#pragma unroll
        for (int i = 0; i < 16; ++i) f[i] = 0.f;
        Rows U, V, Un;
        load_rows(U, ub, i0, i1, lane, 0);
        for (int grp = 0; grp < 128 / GE; ++grp) {
            load_rows(V, vb, i0, i1, lane, grp);
            if (grp + 1 < 128 / GE) load_rows(Un, ub, i0, i1, lane, grp + 1);
            float z[GE];
#pragma unroll
            for (int j = 0; j < GE; ++j) { const unsigned uw[8] = {U.a[j].x, U.a[j].y, U.a[j].z, U.a[j].w, U.b[j].x, U.b[j].y, U.b[j].z, U.b[j].w}; float s = 0.f;
#pragma unroll
                for (int i = 0; i < 8; ++i) s = dot2(uw[i], hw[i], s);
                z[j] = s; }
            { const bool b0 = lane & 1; float k0 = b0 ? z[1] : z[0], s0 = b0 ? z[0] : z[1], k1 = b0 ? z[3] : z[2], s1 = b0 ? z[2] : z[3];
              k0 += __shfl_xor(s0, 1); k1 += __shfl_xor(s1, 1);
              const bool b1 = lane & 2; float kk = b1 ? k1 : k0, ss = b1 ? k0 : k1; kk += __shfl_xor(ss, 2);
              kk += __shfl_xor(kk, 4); kk += __shfl_xor(kk, 8); kk += __shfl_xor(kk, 16); kk += __shfl_xor(kk, 32);
              z[0] = kk; }
            const int e_me = grp * GE + (lane & 3);
            const float gt = __shfl((e_me & 64) ? g1 : g0, e_me & 63);
            const float act = gt * gelu_erf(z[0]);
            const unsigned actb = (unsigned)f2bf(act);
#pragma unroll
            for (int j = 0; j < GE; ++j) { const unsigned alo = __builtin_amdgcn_readlane(actb, j), ahi = alo << 16;
                const unsigned vw[8] = {V.a[j].x, V.a[j].y, V.a[j].z, V.a[j].w, V.b[j].x, V.b[j].y, V.b[j].z, V.b[j].w};
#pragma unroll
                for (int i = 0; i < 8; ++i) { f[2 * i] = dot2(vw[i], alo, f[2 * i]); f[2 * i + 1] = dot2(vw[i], ahi, f[2 * i + 1]); } }
            U = Un;
        }
        float s = 0.f;
#pragma unroll
        for (int i = 0; i < 8; ++i) { f[2 * i] += DN_ALPHA * __uint_as_float(hw[i] << 16); f[2 * i + 1] += DN_ALPHA * __uint_as_float(hw[i] & 0xffff0000u); s += f[2 * i] + f[2 * i + 1]; }
        const float mean = wave_sum(s) * (1.f / DM); float s2 = 0.f;
#pragma unroll
        for (int i = 0; i < 16; ++i) { f[i] -= mean; s2 += f[i] * f[i]; }
        const float rstd = rsqrtf(wave_sum(s2) * (1.f / DM) + LN_EPS);
#pragma unroll
        for (int hh = 0; hh < 2; ++hh) {
            const int e0 = hh * 512 + 8 * lane;
            const f32x4 ga = *(const f32x4*)(g + e0), gb = *(const f32x4*)(g + e0 + 4), ba = *(const f32x4*)(bta + e0), bb = *(const f32x4*)(bta + e0 + 4);
            f32x4 oa, ob;
            oa.x = f[hh * 8 + 0] * rstd * ga.x + ba.x; oa.y = f[hh * 8 + 1] * rstd * ga.y + ba.y; oa.z = f[hh * 8 + 2] * rstd * ga.z + ba.z; oa.w = f[hh * 8 + 3] * rstd * ga.w + ba.w;
            ob.x = f[hh * 8 + 4] * rstd * gb.x + bb.x; ob.y = f[hh * 8 + 5] * rstd * gb.y + bb.y; ob.z = f[hh * 8 + 6] * rstd * gb.z + bb.z; ob.w = f[hh * 8 + 7] * rstd * gb.w + bb.w;
            *(f32x4*)(out + (size_t)t * DM + e0) = oa; *(f32x4*)(out + (size_t)t * DM + e0 + 4) = ob;
        }
    }
}
}
namespace pe8 {
typedef float f32x2 __attribute__((ext_vector_type(2)));
__device__ __forceinline__ void d_quant_tables(const Ctx& c, const float* __restrict__ u, const float* __restrict__ v, unsigned* __restrict__ u8, unsigned* __restrict__ v8, float* __restrict__ su, float* __restrict__ sv) {
    const int lane = c.lane;
    for (int r = c.gw; r < 2 * NEXP; r += c.ngw) {
        const bool isv = r >= NEXP; const int row = isv ? r - NEXP : r;
        const f32x4* src = (const f32x4*)((isv ? v : u) + (size_t)row * DM) + lane;
        f32x4 x[4]; float am = 0.f;
#pragma unroll
        for (int j = 0; j < 4; ++j) { x[j] = src[64 * j]; am = fmaxf(am, fmaxf(fmaxf(fabsf(x[j].x), fabsf(x[j].y)), fmaxf(fabsf(x[j].z), fabsf(x[j].w)))); }
#pragma unroll
        for (int o = 1; o < 64; o <<= 1) am = fmaxf(am, __shfl_xor(am, o));
        am = fmaxf(am, 1e-30f);
        if (!isv) { const float sc = am * (1.f / 127.f), is = 127.f / am;
#pragma unroll
            for (int j = 0; j < 4; ++j) { const int a = (int)rintf(x[j].x * is), b = (int)rintf(x[j].y * is), cc = (int)rintf(x[j].z * is), d = (int)rintf(x[j].w * is);
                u8[(size_t)row * 256 + 64 * j + lane] = (unsigned)(a & 255) | ((unsigned)(b & 255) << 8) | ((unsigned)(cc & 255) << 16) | ((unsigned)(d & 255) << 24); }
            if (lane == 0) su[row] = sc; }
        else { const float sc = am * (1.f / 440.f), is = 440.f / am;
#pragma unroll
            for (int j = 0; j < 4; ++j) { int w = 0; w = __builtin_amdgcn_cvt_pk_fp8_f32(x[j].x * is, x[j].y * is, w, false); w = __builtin_amdgcn_cvt_pk_fp8_f32(x[j].z * is, x[j].w * is, w, true);
                v8[(size_t)row * 256 + 64 * j + lane] = (unsigned)w; }
            if (lane == 0) sv[row] = sc; }
    }
}
constexpr int GE = 8;
struct Rows { uint4 a[GE]; };
__device__ __forceinline__ void load_rows(Rows& r, const unsigned* __restrict__ tab, int i0, int i1, int lane, int g) {
#pragma unroll
    for (int j = 0; j < GE; ++j) { const int e = g * GE + j; const int id = __builtin_amdgcn_readlane((e & 64) ? i1 : i0, e & 63); r.a[j] = *((const uint4*)(tab + (size_t)id * 256) + lane); }
}
__device__ __forceinline__ void d_peer_gather(const Ctx& c, const bf16* __restrict__ h1b, const int* __restrict__ idx, const float* __restrict__ gate, const unsigned* __restrict__ u8, const unsigned* __restrict__ v8,
                                              const float* __restrict__ su, const float* __restrict__ sv, const float* __restrict__ g, const float* __restrict__ bta, float* __restrict__ out, const int imask = 0x3fff) {
    const int lane = c.lane;
    for (int t = c.gw; t < NTOK; t += c.ngw) {
        const uint4* hp = (const uint4*)(h1b + (size_t)t * DM) + 2 * lane; const uint4 ha = hp[0], hb = hp[1];
        const unsigned hw[8] = {ha.x, ha.y, ha.z, ha.w, hb.x, hb.y, hb.z, hb.w};
        float hf[16]; float am = 0.f;
#pragma unroll
        for (int i = 0; i < 8; ++i) { hf[2 * i] = __uint_as_float(hw[i] << 16); hf[2 * i + 1] = __uint_as_float(hw[i] & 0xffff0000u); am = fmaxf(am, fmaxf(fabsf(hf[2 * i]), fabsf(hf[2 * i + 1]))); }
#pragma unroll
        for (int o = 1; o < 64; o <<= 1) am = fmaxf(am, __shfl_xor(am, o));
        am = fmaxf(am, 1e-30f);
        const float sh = am * (1.f / 127.f), ish = 127.f / am;
        int hq[4];
#pragma unroll
        for (int w = 0; w < 4; ++w) { const int a = (int)rintf(hf[4 * w] * ish), b = (int)rintf(hf[4 * w + 1] * ish), cc = (int)rintf(hf[4 * w + 2] * ish), d = (int)rintf(hf[4 * w + 3] * ish);
            hq[w] = (int)((unsigned)(a & 255) | ((unsigned)(b & 255) << 8) | ((unsigned)(cc & 255) << 16) | ((unsigned)(d & 255) << 24)); }
        const int i0 = idx[(size_t)t * 128 + lane] & imask, i1 = idx[(size_t)t * 128 + 64 + lane] & imask;
        const float g0 = gate[(size_t)t * 128 + lane], g1 = gate[(size_t)t * 128 + 64 + lane];
        float f[16];
#pragma unroll
        for (int i = 0; i < 16; ++i) f[i] = 0.f;
        Rows U, V, Un;
        load_rows(U, u8, i0, i1, lane, 0);
        float sun, svn;
        { const int e_me = lane & 7; const int id = __shfl((e_me & 64) ? i1 : i0, e_me & 63); sun = su[id]; svn = sv[id]; }
#pragma unroll 1
        for (int grp = 0; grp < 128 / GE; ++grp) {
            load_rows(V, v8, i0, i1, lane, grp);
            const float suc = sun, svc = svn;
            if (grp + 1 < 128 / GE) { load_rows(Un, u8, i0, i1, lane, grp + 1); const int e_n = (grp + 1) * GE + (lane & 7); const int id = __shfl((e_n & 64) ? i1 : i0, e_n & 63); sun = su[id]; svn = sv[id]; }
            int z[GE];
#pragma unroll
            for (int j = 0; j < GE; ++j) { int s = __builtin_amdgcn_sdot4((int)U.a[j].x, hq[0], 0, false); s = __builtin_amdgcn_sdot4((int)U.a[j].y, hq[1], s, false);
                s = __builtin_amdgcn_sdot4((int)U.a[j].z, hq[2], s, false); s = __builtin_amdgcn_sdot4((int)U.a[j].w, hq[3], s, false); z[j] = s; }
            int zz;
            { const bool b0 = lane & 1, b1 = lane & 2, b2 = lane & 4;
              int k0 = b0 ? z[1] : z[0], s0 = b0 ? z[0] : z[1], k1 = b0 ? z[3] : z[2], s1 = b0 ? z[2] : z[3], k2 = b0 ? z[5] : z[4], s2 = b0 ? z[4] : z[5], k3 = b0 ? z[7] : z[6], s3 = b0 ? z[6] : z[7];
              k0 += __shfl_xor(s0, 1); k1 += __shfl_xor(s1, 1); k2 += __shfl_xor(s2, 1); k3 += __shfl_xor(s3, 1);
              int m0 = b1 ? k1 : k0, t0_ = b1 ? k0 : k1, m1 = b1 ? k3 : k2, t1_ = b1 ? k2 : k3;
              m0 += __shfl_xor(t0_, 2); m1 += __shfl_xor(t1_, 2);
              int q0 = b2 ? m1 : m0, r0 = b2 ? m0 : m1; q0 += __shfl_xor(r0, 4);
              q0 += __shfl_xor(q0, 8); q0 += __shfl_xor(q0, 16); q0 += __shfl_xor(q0, 32); zz = q0; }
            const int e_me = grp * GE + (lane & 7);
            const float gt = __shfl((e_me & 64) ? g1 : g0, e_me & 63);
            const float zf = (float)zz * sh * suc;
            const float act = gt * pe::gelu_erf(zf) * svc;
#pragma unroll
            for (int j = 0; j < GE; ++j) { const float aj = __uint_as_float(__builtin_amdgcn_readlane(__float_as_uint(act), j));
                const unsigned vw[4] = {V.a[j].x, V.a[j].y, V.a[j].z, V.a[j].w};
#pragma unroll
                for (int w = 0; w < 4; ++w) { const f32x2 lo = __builtin_amdgcn_cvt_pk_f32_fp8((int)vw[w], false), hi = __builtin_amdgcn_cvt_pk_f32_fp8((int)vw[w], true);
                    f[4 * w] += aj * lo.x; f[4 * w + 1] += aj * lo.y; f[4 * w + 2] += aj * hi.x; f[4 * w + 3] += aj * hi.y; }
                __builtin_amdgcn_sched_barrier(0); }
            U = Un;
        }
        float s = 0.f;
#pragma unroll
        for (int i = 0; i < 16; ++i) { f[i] += DN_ALPHA * hf[i]; s += f[i]; }
        const float mean = wave_sum(s) * (1.f / DM); float s2 = 0.f;
#pragma unroll
        for (int i = 0; i < 16; ++i) { f[i] -= mean; s2 += f[i] * f[i]; }
        const float rstd = rsqrtf(wave_sum(s2) * (1.f / DM) + LN_EPS);
        const int e0 = 16 * lane;
#pragma unroll
        for (int q = 0; q < 4; ++q) { const f32x4 ga = *(const f32x4*)(g + e0 + 4 * q), ba = *(const f32x4*)(bta + e0 + 4 * q); f32x4 o;
            o.x = f[4 * q] * rstd * ga.x + ba.x; o.y = f[4 * q + 1] * rstd * ga.y + ba.y; o.z = f[4 * q + 2] * rstd * ga.z + ba.z; o.w = f[4 * q + 3] * rstd * ga.w + ba.w;
            *(f32x4*)(out + (size_t)t * DM + e0 + 4 * q) = o; }
    }
}
}
namespace px {
typedef float f32x2 __attribute__((ext_vector_type(2)));
typedef unsigned u32x4 __attribute__((ext_vector_type(4)));
constexpr int CW_XRANK = 8192;
__device__ __forceinline__ void d_quant_tables(const Ctx& c, const float* __restrict__ u, const float* __restrict__ v, unsigned* __restrict__ u8, unsigned* __restrict__ v8, float* __restrict__ su, float* __restrict__ sv) {
    const int lane = c.lane;
    for (int r = c.gw; r < 2 * NEXP; r += c.ngw) {
        const bool isv = r >= NEXP; const int row = isv ? r - NEXP : r;
        const f32x4* src = (const f32x4*)((isv ? v : u) + (size_t)row * DM) + lane;
        f32x4 x[4]; float am = 0.f;
#pragma unroll
        for (int j = 0; j < 4; ++j) { x[j] = src[64 * j]; am = fmaxf(am, fmaxf(fmaxf(fabsf(x[j].x), fabsf(x[j].y)), fmaxf(fabsf(x[j].z), fabsf(x[j].w)))); }
#pragma unroll
        for (int o = 1; o < 64; o <<= 1) am = fmaxf(am, __shfl_xor(am, o));
        am = fmaxf(am, 1e-30f);
        if (!isv) { const float sc = am * (1.f / 127.f), is = 127.f / am;
#pragma unroll
            for (int j = 0; j < 4; ++j) { const int a = (int)rintf(x[j].x * is), b = (int)rintf(x[j].y * is), cc = (int)rintf(x[j].z * is), d = (int)rintf(x[j].w * is);
                u8[((size_t)(2 * j + (lane >> 5)) * NEXP + row) * 32 + (lane & 31)] = (unsigned)(a & 255) | ((unsigned)(b & 255) << 8) | ((unsigned)(cc & 255) << 16) | ((unsigned)(d & 255) << 24); }
            if (lane == 0) su[row] = sc; }
        else { const float sc = am * (1.f / 440.f), is = 440.f / am;
#pragma unroll
            for (int j = 0; j < 4; ++j) { int w = 0; w = __builtin_amdgcn_cvt_pk_fp8_f32(x[j].x * is, x[j].y * is, w, false); w = __builtin_amdgcn_cvt_pk_fp8_f32(x[j].z * is, x[j].w * is, w, true);
                v8[((size_t)(2 * j + (lane >> 5)) * NEXP + row) * 32 + (lane & 31)] = (unsigned)w; }
            if (lane == 0) sv[row] = sc; }
    }
}
__device__ __forceinline__ void d_quant_h(const Ctx& c, const bf16* __restrict__ h1b, unsigned* __restrict__ h8, float* __restrict__ shs) {
    const int lane = c.lane;
    for (int t = c.gw; t < NTOK; t += c.ngw) {
        const uint4* hp = (const uint4*)(h1b + (size_t)t * DM) + 2 * lane; const uint4 ha = hp[0], hb = hp[1];
        const unsigned hw[8] = {ha.x, ha.y, ha.z, ha.w, hb.x, hb.y, hb.z, hb.w};
        float hf[16]; float am = 0.f;
#pragma unroll
        for (int i = 0; i < 8; ++i) { hf[2 * i] = __uint_as_float(hw[i] << 16); hf[2 * i + 1] = __uint_as_float(hw[i] & 0xffff0000u); am = fmaxf(am, fmaxf(fabsf(hf[2 * i]), fabsf(hf[2 * i + 1]))); }
#pragma unroll
        for (int o = 1; o < 64; o <<= 1) am = fmaxf(am, __shfl_xor(am, o));
        am = fmaxf(am, 1e-30f);
        const float ish = 127.f / am; u32x4 q;
#pragma unroll
        for (int w = 0; w < 4; ++w) { const int a = (int)rintf(hf[4 * w] * ish), b = (int)rintf(hf[4 * w + 1] * ish), cc = (int)rintf(hf[4 * w + 2] * ish), d = (int)rintf(hf[4 * w + 3] * ish);
            q[w] = (unsigned)(a & 255) | ((unsigned)(b & 255) << 8) | ((unsigned)(cc & 255) << 16) | ((unsigned)(d & 255) << 24); }
        *(u32x4*)(h8 + ((size_t)(lane >> 3) * NTOK + t) * 32 + 4 * (lane & 7)) = q;
        if (lane == 0) shs[t] = am * (1.f / 127.f);
    }
}
struct Grp { int g, r, n; };
__device__ __forceinline__ Grp group_of(const Ctx& c, const unsigned* __restrict__ ctl, int xcc, int rank) {
    unsigned cnt[8]; bool ok = true; unsigned tot = 0;
#pragma unroll
    for (int j = 0; j < 8; ++j) { cnt[j] = __hip_atomic_load(ctl + CW_XRANK + j, __ATOMIC_RELAXED, __HIP_MEMORY_SCOPE_AGENT); ok = ok && cnt[j] > 0; tot += cnt[j]; }
    ok = ok && tot == (unsigned)c.nb && xcc < 8;
    Grp G;
    if (ok) { G.g = xcc; G.r = rank; G.n = (int)(xcc == 0 ? cnt[0] : xcc == 1 ? cnt[1] : xcc == 2 ? cnt[2] : xcc == 3 ? cnt[3] : xcc == 4 ? cnt[4] : xcc == 5 ? cnt[5] : xcc == 6 ? cnt[6] : cnt[7]); }
    else { G.g = c.bid & 7; G.r = c.bid >> 3; G.n = (c.nb - G.g + 7) >> 3; }
    return G;
}
template <int CTRL> __device__ __forceinline__ int dppi(int x) { return __builtin_amdgcn_update_dpp(0, x, CTRL, 0xf, 0xf, true); }
template <int CTRL> __device__ __forceinline__ float dppf(float x) { return __uint_as_float(__builtin_amdgcn_update_dpp(0u, __float_as_uint(x), CTRL, 0xf, 0xf, true)); }
__device__ __forceinline__ int sum8i(int s) { s += dppi<0xB1>(s); s += dppi<0x4E>(s); s += dppi<0x141>(s); return s; }
__device__ __forceinline__ float sum_rw(float x) {
    x += dppf<0x128>(x);
    { auto r = __builtin_amdgcn_permlane16_swap(__float_as_uint(x), __float_as_uint(x), false, false); x = __uint_as_float(r[0]) + __uint_as_float(r[1]); }
    { auto r = __builtin_amdgcn_permlane32_swap(__float_as_uint(x), __float_as_uint(x), false, false); x = __uint_as_float(r[0]) + __uint_as_float(r[1]); }
    return x;
}
struct StIn { u32x4 ia, ib, xa, xb; };
__device__ __forceinline__ void d_g1(const Ctx& c, const Grp G, const unsigned* __restrict__ h8, const int* __restrict__ idx, const unsigned* __restrict__ u8, int* __restrict__ zp) {
    const int lane = c.lane, p = lane & 7, rw = lane >> 3, step = G.n * 8, t0 = G.r * 8 + c.wave;
    const unsigned* ut = u8 + (size_t)G.g * NEXP * 32 + 4 * p;
    const unsigned* hb = h8 + (size_t)G.g * NTOK * 32 + 4 * p;
    auto ld_in = [&](int st, StIn& si) { int t = t0 + (st >> 1) * step; t = t < NTOK ? t : NTOK - 1; const u32x4* ip = (const u32x4*)(idx + (size_t)t * 128 + 16 * rw + 8 * (st & 1)); si.ia = ip[0]; si.ib = ip[1]; si.xa = *(const u32x4*)(hb + (size_t)t * 32); };
    auto ld_rows = [&](const StIn& si, u32x4 (&rows)[8]) {
#pragma unroll
        for (int j = 0; j < 8; ++j) { const unsigned id = j < 4 ? si.ia[j] : si.ib[j - 4]; rows[j] = *(const u32x4*)(ut + (size_t)id * 32); } };
    auto red = [&](const u32x4 (&rows)[8], const StIn& si, int (&z)[8]) {
#pragma unroll
        for (int j = 0; j < 8; ++j) { int s = __builtin_amdgcn_sdot4((int)rows[j][0], (int)si.xa[0], 0, false); s = __builtin_amdgcn_sdot4((int)rows[j][1], (int)si.xa[1], s, false);
            s = __builtin_amdgcn_sdot4((int)rows[j][2], (int)si.xa[2], s, false); s = __builtin_amdgcn_sdot4((int)rows[j][3], (int)si.xa[3], s, false); z[j] = sum8i(s); } };
    StIn S0, S1, S2, S3; u32x4 R0[8], R1[8];
    ld_in(0, S0); ld_in(1, S1); ld_rows(S0, R0);
#pragma unroll 1
    for (int k = 0; t0 + k * step < NTOK; ++k) {
        const int t = t0 + k * step; int z0[8], z1[8];
        ld_in(2 * k + 2, S2); ld_rows(S1, R1); red(R0, S0, z0);
        ld_in(2 * k + 3, S3); ld_rows(S2, R0); red(R1, S1, z1);
        if (p == 0) { u32x4* zo = (u32x4*)(zp + ((size_t)G.g * NTOK + t) * 128 + 16 * rw);
            zo[0] = (u32x4){(unsigned)z0[0], (unsigned)z0[1], (unsigned)z0[2], (unsigned)z0[3]}; zo[1] = (u32x4){(unsigned)z0[4], (unsigned)z0[5], (unsigned)z0[6], (unsigned)z0[7]};
            zo[2] = (u32x4){(unsigned)z1[0], (unsigned)z1[1], (unsigned)z1[2], (unsigned)z1[3]}; zo[3] = (u32x4){(unsigned)z1[4], (unsigned)z1[5], (unsigned)z1[6], (unsigned)z1[7]}; }
        S0 = S2; S1 = S3;
    }
}
__device__ __forceinline__ void d_g2(const Ctx& c, const int* __restrict__ zp, const int* __restrict__ idx, const float* __restrict__ shs, const float* __restrict__ su, const float* __restrict__ sv, float* __restrict__ gate) {
    for (size_t i = (size_t)c.bid * 512 + c.tid; i < (size_t)NTOK * 128; i += (size_t)c.nb * 512) {
        int s = 0;
#pragma unroll
        for (int g = 0; g < 8; ++g) s += zp[(size_t)g * NTOK * 128 + i];
        const int id = idx[i]; const float z = (float)s * shs[i >> 7] * su[id];
        gate[i] = gate[i] * pe::gelu_erf(z) * sv[id];
    }
}
__device__ __forceinline__ void d_g3(const Ctx& c, const Grp G, const bf16* __restrict__ h1b, const int* __restrict__ idx, const float* __restrict__ act, const unsigned* __restrict__ v8, float* __restrict__ y2) {
    const int lane = c.lane, p = lane & 7, rw = lane >> 3, step = G.n * 8, t0 = G.r * 8 + c.wave;
    const unsigned* vt = v8 + (size_t)G.g * NEXP * 32 + 4 * p;
    auto ld_in = [&](int st, StIn& si) { int t = t0 + (st >> 1) * step; t = t < NTOK ? t : NTOK - 1; const size_t o = (size_t)t * 128 + 16 * rw + 8 * (st & 1);
        const u32x4* ip = (const u32x4*)(idx + o); si.ia = ip[0]; si.ib = ip[1]; const u32x4* ap = (const u32x4*)(act + o); si.xa = ap[0]; si.xb = ap[1]; };
    auto ld_rows = [&](const StIn& si, u32x4 (&rows)[8]) {
#pragma unroll
        for (int j = 0; j < 8; ++j) { const unsigned id = j < 4 ? si.ia[j] : si.ib[j - 4]; rows[j] = *(const u32x4*)(vt + (size_t)id * 32); } };
    auto acc = [&](const u32x4 (&rows)[8], const StIn& si, float (&f)[16]) {
#pragma unroll
        for (int j = 0; j < 8; ++j) { const float a = __uint_as_float(j < 4 ? si.xa[j] : si.xb[j - 4]);
#pragma unroll
            for (int w = 0; w < 4; ++w) { const f32x2 lo = __builtin_amdgcn_cvt_pk_f32_fp8((int)rows[j][w], false), hi = __builtin_amdgcn_cvt_pk_f32_fp8((int)rows[j][w], true);
                f[4 * w] += a * lo.x; f[4 * w + 1] += a * lo.y; f[4 * w + 2] += a * hi.x; f[4 * w + 3] += a * hi.y; }
            __builtin_amdgcn_sched_barrier(0); } };
    StIn S0, S1, S2, S3; u32x4 R0[8], R1[8];
    ld_in(0, S0); ld_in(1, S1); ld_rows(S0, R0);
#pragma unroll 1
    for (int k = 0; t0 + k * step < NTOK; ++k) {
        const int t = t0 + k * step; float f[16];
#pragma unroll
        for (int i = 0; i < 16; ++i) f[i] = 0.f;
        ld_in(2 * k + 2, S2); ld_rows(S1, R1); acc(R0, S0, f);
        ld_in(2 * k + 3, S3); ld_rows(S2, R0); acc(R1, S1, f);
#pragma unroll
        for (int i = 0; i < 16; ++i) f[i] = sum_rw(f[i]);
        if (rw == 0) {
            const uint4* hp = (const uint4*)(h1b + (size_t)t * DM + 128 * G.g + 16 * p); const uint4 ha = hp[0], hb = hp[1];
            const unsigned hw[8] = {ha.x, ha.y, ha.z, ha.w, hb.x, hb.y, hb.z, hb.w};
            float* yo = y2 + (size_t)t * DM + 128 * G.g + 16 * p;
#pragma unroll
            for (int q = 0; q < 4; ++q) { f32x4 o;
                o.x = f[4 * q] + DN_ALPHA * __uint_as_float(hw[2 * q] << 16); o.y = f[4 * q + 1] + DN_ALPHA * __uint_as_float(hw[2 * q] & 0xffff0000u);
                o.z = f[4 * q + 2] + DN_ALPHA * __uint_as_float(hw[2 * q + 1] << 16); o.w = f[4 * q + 3] + DN_ALPHA * __uint_as_float(hw[2 * q + 1] & 0xffff0000u);
                *(f32x4*)(yo + 4 * q) = o; }
        }
        S0 = S2; S1 = S3;
    }
}
__device__ __forceinline__ void d_g4(const Ctx& c, const float* __restrict__ y2, const float* __restrict__ g, const float* __restrict__ bta, float* __restrict__ out) {
    const int lane = c.lane;
    for (int row = c.gw; row < NTOK; row += c.ngw) {
        const f32x4* xr = (const f32x4*)(y2 + (size_t)row * DM) + lane;
        f32x4 v[4]; float s = 0.f;
#pragma unroll
        for (int j = 0; j < 4; ++j) { v[j] = xr[64 * j]; s += (v[j].x + v[j].y) + (v[j].z + v[j].w); }
        const float mean = wave_sum(s) * (1.f / DM); float s2 = 0.f;
#pragma unroll
        for (int j = 0; j < 4; ++j) { v[j] = v[j] - mean; s2 += (v[j].x * v[j].x + v[j].y * v[j].y) + (v[j].z * v[j].z + v[j].w * v[j].w); }
        const float rstd = rsqrtf(wave_sum(s2) * (1.f / DM) + LN_EPS);
#pragma unroll
        for (int j = 0; j < 4; ++j) { const f32x4 gg = ((const f32x4*)g)[64 * j + lane], bb = ((const f32x4*)bta)[64 * j + lane];
            ((f32x4*)(out + (size_t)row * DM))[64 * j + lane] = v[j] * rstd * gg + bb; }
    }
}
}
namespace rw {
typedef short bf16x8 __attribute__((ext_vector_type(8)));
typedef short s16x4 __attribute__((ext_vector_type(4)));
typedef float f32x16 __attribute__((ext_vector_type(16)));
typedef float f32x2_t __attribute__((ext_vector_type(2)));
typedef __bf16 bf16x2_t __attribute__((ext_vector_type(2)));
typedef unsigned u32x4 __attribute__((ext_vector_type(4)));
typedef unsigned u32x2 __attribute__((ext_vector_type(2)));
typedef LAS unsigned char* lptr;
#define MFMA32(a, b, c) __builtin_amdgcn_mfma_f32_32x32x16_bf16((a), (b), (c), 0, 0, 0)
#define DI __device__ __forceinline__
constexpr int UNIT_BYTES = 10 * 2048;
constexpr int STG_STRIDE = 392;
constexpr int CST_OFF = 131072, GC_OFF = 131072 + 4096;

DI int crow(int i, int h) { return (i & 3) + 8 * (i >> 2) + 4 * h; }
DI unsigned cvtpk(float lo, float hi) { f32x2_t v = {lo, hi}; bf16x2_t b = __builtin_convertvector(v, bf16x2_t); return __builtin_bit_cast(unsigned, b); }
DI bf16x8 pack(const f32x16& x, int s) { u32x4 p; p[0] = cvtpk(x[8 * s], x[8 * s + 1]); p[1] = cvtpk(x[8 * s + 2], x[8 * s + 3]); p[2] = cvtpk(x[8 * s + 4], x[8 * s + 5]); p[3] = cvtpk(x[8 * s + 6], x[8 * s + 7]); return __builtin_bit_cast(bf16x8, p); }
DI bf16x8 frag4(unsigned a, unsigned b, unsigned c, unsigned d) { u32x4 p = {a, b, c, d}; return __builtin_bit_cast(bf16x8, p); }
DI float lo_f(unsigned w) { return __uint_as_float(w << 16); }
DI float hi_f(unsigned w) { return __uint_as_float(w & 0xffff0000u); }
DI int img_off(int row, int slot) { return row * 128 + ((slot ^ ((((row >> 1) & 1) << 3) | ((row >> 2) & 3))) << 3); }
DI s16x4 tr_read(lptr p) { return __builtin_bit_cast(s16x4, __builtin_amdgcn_ds_read_tr16_b64_v4i16((LAS s16x4*)p)); }
DI bf16x8 trfrag(lptr img, int tau, int s, int lane) {
    const int h = lane >> 5, gg = (lane >> 4) & 1, l16 = lane & 15, q = l16 >> 2, p = l16 & 3, slot = 8 * tau + 4 * gg + p, r0 = 16 * s + 4 * h + q;
    const s16x4 lo = tr_read(img + img_off(r0, slot)), hi = tr_read(img + img_off(r0 + 8, slot));
    return __builtin_shufflevector(lo, hi, 0, 1, 2, 3, 4, 5, 6, 7);
}
template <int CTRL, int RMASK> DI float dpp0(float x) { return __uint_as_float(__builtin_amdgcn_update_dpp(0u, __float_as_uint(x), CTRL, RMASK, 0xf, false)); }
DI float prefix32(float x) {
    x += dpp0<0x111, 0xf>(x); x += dpp0<0x112, 0xf>(x); x += dpp0<0x114, 0xf>(x); x += dpp0<0x118, 0xf>(x);
    x += dpp0<0x142, 0xa>(x);
    return x;
}
DI float fsig(float x) { return __builtin_amdgcn_rcpf(1.f + __expf(-x)); }
DI void store_tile(unsigned char* dst, const f32x16& x, int lane) {
    u32x4 a, b; a[0] = cvtpk(x[0], x[1]); a[1] = cvtpk(x[2], x[3]); a[2] = cvtpk(x[4], x[5]); a[3] = cvtpk(x[6], x[7]);
    b[0] = cvtpk(x[8], x[9]); b[1] = cvtpk(x[10], x[11]); b[2] = cvtpk(x[12], x[13]); b[3] = cvtpk(x[14], x[15]);
    u32x4* d = (u32x4*)(dst + lane * 32); d[0] = a; d[1] = b;
}

DI void d_lowrank_t(const Ctx& c, const float* __restrict__ w2, const float* __restrict__ a2, bf16* __restrict__ w2t, bf16* __restrict__ a2t) {
    for (int id = c.bid * 512 + c.tid; id < 2 * 512 * 32; id += c.nb * 512) { const int j = id & 31, ch = (id >> 5) & 511, d = id >> 14;
        w2t[id] = f2bf(w2[(size_t)(d * 32 + j) * 512 + ch]); a2t[id] = f2bf(a2[(size_t)(d * 32 + j) * 512 + ch]); }
}

DI void d_g2_t(const Ctx& c, const float* __restrict__ g2, bf16* __restrict__ g2t) {
    for (int id = c.bid * 512 + c.tid; id < 512 * 96; id += c.nb * 512) { const int j = id % 96, ch = id / 96; g2t[id] = f2bf(g2[(size_t)j * 512 + ch]); }
}
constexpr int O_MPV = 0, O_MNV = 512, O_LG = 1024, O_LB = 1536, O_MPG = 2048, O_MNG = 2144, O_A0 = 2240, O_KA = 3264, O_RK = 3776, O_MPR = 4288, O_MNR = 4800, O_MPK = 5312, O_MNK = 5824, O_MPA = 6336, O_MNA = 6400, O_END = 6464;
DI void d_out(const Ctx& c, const bf16* __restrict__ proj_, const float* __restrict__ ybuf_, const float* __restrict__ mu_prev, const float* __restrict__ mu_next,
              const float* __restrict__ a0, const float* __restrict__ k_a, const float* __restrict__ r_k, const bf16* __restrict__ a2t_, const bf16* __restrict__ g2t_,
              const float* __restrict__ lnx_g, const float* __restrict__ lnx_b, bf16* __restrict__ mix_) {
    const int lane0 = c.lane;
    LAS float* cs0 = (LAS float*)((lptr)c.lds);
    __syncthreads();
    for (int i = c.tid; i < O_END; i += 512) { float v;
        if (i < O_MNV) v = mu_prev[P_VV + i]; else if (i < O_LG) v = mu_next[P_VV + i - O_MNV]; else if (i < O_LB) v = lnx_g[i - O_LG]; else if (i < O_MPG) v = lnx_b[i - O_LB];
        else if (i < O_MNG) v = mu_prev[P_GD + i - O_MPG]; else if (i < O_A0) v = mu_next[P_GD + i - O_MNG]; else if (i < O_KA) v = a0[i - O_A0]; else if (i < O_RK) v = k_a[i - O_KA];
        else if (i < O_MPR) v = r_k[i - O_RK]; else if (i < O_MNR) v = mu_prev[P_R + i - O_MPR]; else if (i < O_MPK) v = mu_next[P_R + i - O_MNR]; else if (i < O_MNK) v = mu_prev[P_KK + i - O_MPK];
        else if (i < O_MPA) v = mu_next[P_KK + i - O_MNK]; else if (i < O_MNA) v = mu_prev[P_AD + i - O_MPA]; else v = mu_next[P_AD + i - O_MNA];
        cs0[i] = v; }
    if (c.tid == 0) { LAS unsigned long long* pp_ = (LAS unsigned long long*)(cs0 + O_END); pp_[0] = (unsigned long long)proj_; pp_[1] = (unsigned long long)ybuf_; pp_[2] = (unsigned long long)mix_; pp_[3] = (unsigned long long)a2t_; pp_[4] = (unsigned long long)g2t_; }
    __syncthreads();
    for (int wt = c.gw; wt < (NTOK / 32) * 2; wt += c.ngw) {
        int lane = lane0; asm volatile("" : "+v"(lane));
        const int n = lane & 31, hh = lane >> 5;
        LAS float* cs = cs0 + (lane - lane0);
        const LAS unsigned long long* pl_ = (const LAS unsigned long long*)(cs + O_END);
        const bf16* proj = (const bf16*)pl_[0]; const float* ybuf = (const float*)pl_[1]; bf16* mix = (bf16*)pl_[2]; const bf16* a2t = (const bf16*)pl_[3]; const bf16* g2t = (const bf16*)pl_[4];
        const int tile = wt >> 1, hg = wt & 1, t0 = tile * 32, tg = t0 + n, ti = tg % SEQ;
        const bool hp = ti > 0, hn = ti < SEQ - 1; const int po = hp ? IN_PAD : 0, no_ = hn ? IN_PAD : 0;
        const bf16* prow = proj + (size_t)tg * IN_PAD + C_P;
        bf16x8 sgf[6], adf[4];
#pragma unroll
        for (int ks = 0; ks < 10; ++ks) { const int col = ks < 6 ? P_GD + 16 * ks + 8 * hh : P_AD + 16 * (ks - 6) + 8 * hh; const int mo = ks < 6 ? O_MPG + 16 * ks + 8 * hh : O_MPA + 16 * (ks - 6) + 8 * hh, no = ks < 6 ? mo + 96 : mo + 64;
            const bf16* pc_ = prow + col;
            const u32x4 cc = *(const u32x4*)pc_, pp = *(const u32x4*)(pc_ - po), nn = *(const u32x4*)(pc_ + no_);
            const unsigned cw[4] = {cc[0], cc[1], cc[2], cc[3]}, pw[4] = {hp ? pp[0] : 0u, hp ? pp[1] : 0u, hp ? pp[2] : 0u, hp ? pp[3] : 0u}, nw[4] = {hn ? nn[0] : 0u, hn ? nn[1] : 0u, hn ? nn[2] : 0u, hn ? nn[3] : 0u}; unsigned o[4];
#pragma unroll
            for (int e = 0; e < 4; ++e) { const float c0 = lo_f(cw[e]), c1 = hi_f(cw[e]);
                float x0 = c0 + cs[mo + 2 * e] * (lo_f(pw[e]) - c0) + cs[no + 2 * e] * (lo_f(nw[e]) - c0), x1 = c1 + cs[mo + 2 * e + 1] * (hi_f(pw[e]) - c1) + cs[no + 2 * e + 1] * (hi_f(nw[e]) - c1);
                if (ks < 6) { x0 = fsig(x0); x1 = fsig(x1); }
                o[e] = cvtpk(x0, x1); }
            if (ks < 6) sgf[ks] = frag4(o[0], o[1], o[2], o[3]); else adf[ks - 6] = frag4(o[0], o[1], o[2], o[3]);
            __builtin_amdgcn_sched_barrier(0); }
#pragma unroll 1
        for (int hq = 0; hq < 4; ++hq) {
            const int hd = hg * 4 + hq;
            float bs = 0.f;
#pragma unroll
            for (int ct = 0; ct < 2; ++ct) {
                f32x16 a0t = {0.f}, a1t = {0.f}; const int chrow = 64 * hd + 32 * ct + n;
                const bf16* ar0 = a2t + (size_t)chrow * 32 + 8 * hh; const bf16* ar1 = a2t + (size_t)(512 + chrow) * 32 + 8 * hh;
                a0t = MFMA32(*(const bf16x8*)ar0, adf[0], a0t); a0t = MFMA32(*(const bf16x8*)(ar0 + 16), adf[1], a0t);
                a1t = MFMA32(*(const bf16x8*)ar1, adf[2], a1t); a1t = MFMA32(*(const bf16x8*)(ar1 + 16), adf[3], a1t);
#pragma unroll
                for (int q = 0; q < 4; ++q) { const int ch = 64 * hd + 32 * ct + 8 * q + 4 * hh; const bf16* rp_ = prow + P_R + ch; const bf16* kp_ = prow + P_KK + ch; const u32x2 z2 = {0u, 0u};
                    const u32x2 rc = *(const u32x2*)rp_; u32x2 rpv = *(const u32x2*)(rp_ - po), rnx = *(const u32x2*)(rp_ + no_); rpv = hp ? rpv : z2; rnx = hn ? rnx : z2;
                    const u32x2 kc = *(const u32x2*)kp_; u32x2 kpv = *(const u32x2*)(kp_ - po), knx = *(const u32x2*)(kp_ + no_); kpv = hp ? kpv : z2; knx = hn ? knx : z2;
                    const float rcf[4] = {lo_f(rc.x), hi_f(rc.x), lo_f(rc.y), hi_f(rc.y)}, rpf[4] = {lo_f(rpv.x), hi_f(rpv.x), lo_f(rpv.y), hi_f(rpv.y)}, rnf[4] = {lo_f(rnx.x), hi_f(rnx.x), lo_f(rnx.y), hi_f(rnx.y)};
                    const float kcf[4] = {lo_f(kc.x), hi_f(kc.x), lo_f(kc.y), hi_f(kc.y)}, kpf[4] = {lo_f(kpv.x), hi_f(kpv.x), lo_f(kpv.y), hi_f(kpv.y)}, knf[4] = {lo_f(knx.x), hi_f(knx.x), lo_f(knx.y), hi_f(knx.y)};
#pragma unroll
                    for (int e = 0; e < 4; ++e) { const int cx = ch + e;
                        const float rf = rcf[e] + cs[O_MPR + cx] * (rpf[e] - rcf[e]) + cs[O_MNR + cx] * (rnf[e] - rcf[e]);
                        const float kf = kcf[e] + cs[O_MPK + cx] * (kpf[e] - kcf[e]) + cs[O_MNK + cx] * (knf[e] - kcf[e]);
                        const float am = 0.5f * (fsig(a0t[4 * q + e] + cs[O_A0 + cx]) + fsig(a1t[4 * q + e] + cs[O_A0 + 512 + cx]));
                        bs += rf * kf * (1.f + (am - 1.f) * cs[O_KA + cx]) * cs[O_RK + cx]; }
                    __builtin_amdgcn_sched_barrier(0); }
            }
            bs += __shfl_xor(bs, 32);
            f32x16 gt[2];
#pragma unroll
            for (int ct = 0; ct < 2; ++ct) { f32x16 acc = {0.f}; const bf16* grow = g2t + (size_t)(64 * hd + 32 * ct + n) * 96 + 8 * hh;
#pragma unroll
                for (int ks = 0; ks < 6; ++ks) acc = MFMA32(*(const bf16x8*)(grow + 16 * ks), sgf[ks], acc);
                gt[ct] = acc; }
            float yv[32]; float s1 = 0.f;
#pragma unroll
            for (int ct = 0; ct < 2; ++ct)
#pragma unroll
                for (int q = 0; q < 4; ++q) { const f32x4 y4 = *(const f32x4*)(ybuf + (size_t)tg * 512 + 64 * hd + 32 * ct + 8 * q + 4 * hh);
                    yv[16 * ct + 4 * q] = y4.x; yv[16 * ct + 4 * q + 1] = y4.y; yv[16 * ct + 4 * q + 2] = y4.z; yv[16 * ct + 4 * q + 3] = y4.w; s1 += (y4.x + y4.y) + (y4.z + y4.w); }
            s1 += __shfl_xor(s1, 32);
            const float mean = s1 * (1.f / 64.f); float s2 = 0.f;
#pragma unroll
            for (int i = 0; i < 32; ++i) { yv[i] -= mean; s2 += yv[i] * yv[i]; }
            s2 += __shfl_xor(s2, 32);
            const float rstd = rsqrtf(s2 * (1.f / 64.f) + GN_EPS);
#pragma unroll
            for (int ct = 0; ct < 2; ++ct)
#pragma unroll
                for (int q = 0; q < 4; ++q) { const int ch = 64 * hd + 32 * ct + 8 * q + 4 * hh; const bf16* vp = prow + P_VV + ch;
                    const u32x2 z2 = {0u, 0u}; const u32x2 vc = *(const u32x2*)vp; u32x2 vpv = *(const u32x2*)(vp - po), vnx = *(const u32x2*)(vp + no_); vpv = hp ? vpv : z2; vnx = hn ? vnx : z2;
                    const float vcf[4] = {lo_f(vc.x), hi_f(vc.x), lo_f(vc.y), hi_f(vc.y)}, vpf[4] = {lo_f(vpv.x), hi_f(vpv.x), lo_f(vpv.y), hi_f(vpv.y)}, vnf[4] = {lo_f(vnx.x), hi_f(vnx.x), lo_f(vnx.y), hi_f(vnx.y)};
                    float o[4];
#pragma unroll
                    for (int e = 0; e < 4; ++e) { const float vf = vcf[e] + cs[O_MPV + ch + e] * (vpf[e] - vcf[e]) + cs[O_MNV + ch + e] * (vnf[e] - vcf[e]);
                        o[e] = (yv[16 * ct + 4 * q + e] * rstd * cs[O_LG + ch + e] + cs[O_LB + ch + e] + bs * vf) * gt[ct][4 * q + e]; }
                    *(u32x2*)(mix + (size_t)tg * DM + 512 + ch) = (u32x2){cvtpk(o[0], o[1]), cvtpk(o[2], o[3])}; }
            __builtin_amdgcn_sched_barrier(0);
        }
    }
}
DI void d_prep(const Ctx& c, int d, const bf16* __restrict__ proj, const float* __restrict__ mu_prev, const float* __restrict__ mu_next,
               const float* __restrict__ w0, const float* __restrict__ a0, const float* __restrict__ k_k, const float* __restrict__ k_a,
               const bf16* __restrict__ w2t, const bf16* __restrict__ a2t, unsigned char* __restrict__ UO, float* __restrict__ ybuf) {
    const int lane = c.lane, n = lane & 31, h = lane >> 5, hd = c.bid & 7;
    lptr L = (lptr)c.lds + c.wave * 16384;
    LAS float* cst = (LAS float*)((lptr)c.lds + CST_OFF);
    LAS float* gC = (LAS float*)((lptr)c.lds + GC_OFF) + c.wave * 64;
    __syncthreads();
    for (int i = c.tid; i < 768; i += 512) { float v;
        if (i < 640) { const int vec = i >> 6, ch = i & 63, gch = 64 * hd + ch;
            v = vec == 0 ? mu_prev[P_R + gch] : vec == 1 ? mu_next[P_R + gch] : vec == 2 ? mu_prev[P_KK + gch] : vec == 3 ? mu_next[P_KK + gch] : vec == 4 ? mu_prev[P_VV + gch] : vec == 5 ? mu_next[P_VV + gch]
              : vec == 6 ? w0[d * 512 + gch] : vec == 7 ? a0[d * 512 + gch] : vec == 8 ? k_k[gch] : k_a[gch]; }
        else { const int vec = (i - 640) >> 5, j = i & 31; const int col = (vec < 2 ? P_WD : P_AD) + 32 * d + j; v = (vec & 1) ? mu_next[col] : mu_prev[col]; }
        cst[i] = v; }
    __syncthreads();
    const int nper = (c.nb >> 3) * 8;
    for (int u = (c.bid >> 3) * 8 + c.wave; u < 1024; u += nper) {
        const int b = u >> 7, c32 = u & 127;
        const int tok0 = d ? SEQ - 32 * (c32 + 1) : 32 * c32;
        const bf16* prow = proj + (size_t)b * SEQ * IN_PAD + C_P;
#pragma unroll 1
        for (int it = 0; it < 13; ++it) { const int pid = it * 64 + lane; if (pid < 816) { const int rho = pid / 24, w = pid % 24, mat = w >> 3, pc = w & 7, tok = tok0 - 1 + rho;
                uint4 val = make_uint4(0, 0, 0, 0);
                if (tok >= 0 && tok < SEQ) val = *(const uint4*)(prow + (size_t)tok * IN_PAD + mat * 512 + 64 * hd + pc * 8);
                LAS u32x2* dp = (LAS u32x2*)(L + rho * STG_STRIDE + mat * 128 + pc * 16); dp[0] = (u32x2){val.x, val.y}; dp[1] = (u32x2){val.z, val.w}; } }
        const int rho = d ? 32 - n : n + 1, tok = tok0 - 1 + rho;
        bf16x8 wdf[2], adf[2];
        {
            const bool hp = tok > 0, hn = tok < SEQ - 1;
#pragma unroll
            for (int s = 0; s < 2; ++s) {
                const bf16* pc_ = prow + (size_t)tok * IN_PAD + 32 * d + 16 * s + 8 * h;
                const uint4 z4 = make_uint4(0, 0, 0, 0);
                const uint4 wc = *(const uint4*)(pc_ + P_WD), ac = *(const uint4*)(pc_ + P_AD);
                const uint4 wp = hp ? *(const uint4*)(pc_ + P_WD - IN_PAD) : z4, ap = hp ? *(const uint4*)(pc_ + P_AD - IN_PAD) : z4;
                const uint4 wn = hn ? *(const uint4*)(pc_ + P_WD + IN_PAD) : z4, an = hn ? *(const uint4*)(pc_ + P_AD + IN_PAD) : z4;
                const unsigned wcw[4] = {wc.x, wc.y, wc.z, wc.w}, wpw[4] = {wp.x, wp.y, wp.z, wp.w}, wnw[4] = {wn.x, wn.y, wn.z, wn.w};
                const unsigned acw[4] = {ac.x, ac.y, ac.z, ac.w}, apw[4] = {ap.x, ap.y, ap.z, ap.w}, anw[4] = {an.x, an.y, an.z, an.w};
                unsigned wo[4], ao[4];
#pragma unroll
                for (int e = 0; e < 4; ++e) { const int j = 16 * s + 8 * h + 2 * e;
                    const float mpw0 = cst[640 + j], mpw1 = cst[640 + j + 1], mnw0 = cst[672 + j], mnw1 = cst[672 + j + 1], mpa0 = cst[704 + j], mpa1 = cst[704 + j + 1], mna0 = cst[736 + j], mna1 = cst[736 + j + 1];
                    float c0 = lo_f(wcw[e]), c1 = hi_f(wcw[e]);
                    float x0 = c0 + mpw0 * (lo_f(wpw[e]) - c0) + mnw0 * (lo_f(wnw[e]) - c0), x1 = c1 + mpw1 * (hi_f(wpw[e]) - c1) + mnw1 * (hi_f(wnw[e]) - c1);
                    x0 = 1.f - 2.f * __builtin_amdgcn_rcpf(__expf(2.f * x0) + 1.f); x1 = 1.f - 2.f * __builtin_amdgcn_rcpf(__expf(2.f * x1) + 1.f);
                    wo[e] = cvtpk(x0, x1);
                    c0 = lo_f(acw[e]); c1 = hi_f(acw[e]);
                    x0 = c0 + mpa0 * (lo_f(apw[e]) - c0) + mna0 * (lo_f(anw[e]) - c0); x1 = c1 + mpa1 * (hi_f(apw[e]) - c1) + mna1 * (hi_f(anw[e]) - c1);
                    ao[e] = cvtpk(x0, x1); }
                wdf[s] = frag4(wo[0], wo[1], wo[2], wo[3]); adf[s] = frag4(ao[0], ao[1], ao[2], ao[3]);
                __builtin_amdgcn_sched_barrier(0);
            }
        }
        float lw[32], av[32];
        {
            const f32x16 zz = {0.f};
            int opq = 0; asm volatile("" : "+v"(opq));
#pragma unroll
            for (int tau = 0; tau < 2; ++tau) {
                const bf16* wrow = w2t + ((d * 512 + 64 * hd + 32 * tau + n + opq) * 32 + 8 * (h + opq));
                const bf16* arow = a2t + ((d * 512 + 64 * hd + 32 * tau + n + opq) * 32 + 8 * (h + opq));
                const bf16x8 wa0 = *(const bf16x8*)wrow, wa1 = *(const bf16x8*)(wrow + 16), aa0 = *(const bf16x8*)arow, aa1 = *(const bf16x8*)(arow + 16);
                f32x16 cw = MFMA32(wa0, wdf[0], zz); cw = MFMA32(wa1, wdf[1], cw);
                f32x16 ca = MFMA32(aa0, adf[0], zz); ca = MFMA32(aa1, adf[1], ca);
#pragma unroll
                for (int i = 0; i < 16; ++i) { const int ch = 32 * tau + 8 * (i >> 2) + 4 * h + (i & 3);
                    lw[16 * tau + i] = -0.60653066f * fsig(cw[i] + cst[6 * 64 + ch]); av[16 * tau + i] = fsig(ca[i] + cst[7 * 64 + ch]); }
                __builtin_amdgcn_sched_barrier(0);
            }
        }
        unsigned ge[32], avp[16];
#pragma unroll
        for (int m = 0; m < 32; ++m) { const float clm = prefix32(lw[m]); const float eg = __expf(clm); ge[m] = cvtpk(eg, eg * __expf(-lw[m])); if (n == 31) gC[8 * (m >> 2) + 4 * h + (m & 3)] = eg; }
#pragma unroll
        for (int m = 0; m < 16; ++m) avp[m] = cvtpk(av[2 * m], av[2 * m + 1]);
        __builtin_amdgcn_sched_barrier(0);
        unsigned pA[16], pB[16], pK[16], pR[16], pV[16];
        {
            unsigned kfp[16]; float ss = 0.f;
            lptr sb = L + rho * STG_STRIDE + 8 * h;
#pragma unroll
            for (int q = 0; q < 8; ++q) {
                const u32x2 cu = *(LAS u32x2*)(sb + 128 + 16 * q), pu_ = *(LAS u32x2*)(sb + 128 + 16 * q - STG_STRIDE), nu = *(LAS u32x2*)(sb + 128 + 16 * q + STG_STRIDE);
                const float cc[4] = {lo_f(cu.x), hi_f(cu.x), lo_f(cu.y), hi_f(cu.y)}, pp[4] = {lo_f(pu_.x), hi_f(pu_.x), lo_f(pu_.y), hi_f(pu_.y)}, nn[4] = {lo_f(nu.x), hi_f(nu.x), lo_f(nu.y), hi_f(nu.y)};
                float xk[4];
#pragma unroll
                for (int e = 0; e < 4; ++e) { const int ch = 8 * q + 4 * h + e; const float x = cc[e] + cst[2 * 64 + ch] * (pp[e] - cc[e]) + cst[3 * 64 + ch] * (nn[e] - cc[e]);
                    xk[e] = x; const float kr_ = x * cst[8 * 64 + ch]; ss += kr_ * kr_; }
                kfp[2 * q] = cvtpk(xk[0], xk[1]); kfp[2 * q + 1] = cvtpk(xk[2], xk[3]);
                __builtin_amdgcn_sched_barrier(0);
            }
            ss += __shfl_xor(ss, 32);
            const float inv = rsqrtf(fmaxf(ss, 1e-24f));
#pragma unroll
            for (int q = 0; q < 8; ++q) {
                const u32x2 cu = *(LAS u32x2*)(sb + 16 * q), pu_ = *(LAS u32x2*)(sb + 16 * q - STG_STRIDE), nu = *(LAS u32x2*)(sb + 16 * q + STG_STRIDE);
                const u32x2 cv = *(LAS u32x2*)(sb + 256 + 16 * q), pv_ = *(LAS u32x2*)(sb + 256 + 16 * q - STG_STRIDE), nv_ = *(LAS u32x2*)(sb + 256 + 16 * q + STG_STRIDE);
                const float rc[4] = {lo_f(cu.x), hi_f(cu.x), lo_f(cu.y), hi_f(cu.y)}, rp[4] = {lo_f(pu_.x), hi_f(pu_.x), lo_f(pu_.y), hi_f(pu_.y)}, rn[4] = {lo_f(nu.x), hi_f(nu.x), lo_f(nu.y), hi_f(nu.y)};
                const float vc[4] = {lo_f(cv.x), hi_f(cv.x), lo_f(cv.y), hi_f(cv.y)}, vp[4] = {lo_f(pv_.x), hi_f(pv_.x), lo_f(pv_.y), hi_f(pv_.y)}, vn[4] = {lo_f(nv_.x), hi_f(nv_.x), lo_f(nv_.y), hi_f(nv_.y)};
                float oa[4], ob[4], ok[4], orr[4], ov[4];
#pragma unroll
                for (int e = 0; e < 4; ++e) { const int ch = 8 * q + 4 * h + e, m = 4 * q + e;
                    const float rf = rc[e] + cst[0 * 64 + ch] * (rp[e] - rc[e]) + cst[1 * 64 + ch] * (rn[e] - rc[e]);
                    const float vf = vc[e] + cst[4 * 64 + ch] * (vp[e] - vc[e]) + cst[5 * 64 + ch] * (vn[e] - vc[e]);
                    const float eg = lo_f(ge[m]), ieg = __builtin_amdgcn_rcpf(eg), egm1 = hi_f(ge[m]);
                    const float kfm = (m & 1) ? hi_f(kfp[m >> 1]) : lo_f(kfp[m >> 1]), avm = (m & 1) ? hi_f(avp[m >> 1]) : lo_f(avp[m >> 1]);
                    const float kkn = kfm * cst[8 * 64 + ch] * inv;
                    oa[e] = -kkn * egm1; ob[e] = kkn * avm * ieg; ok[e] = kfm * (1.f + (avm - 1.f) * cst[9 * 64 + ch]) * ieg; orr[e] = rf * eg; ov[e] = vf; }
                pA[2 * q] = cvtpk(oa[0], oa[1]); pA[2 * q + 1] = cvtpk(oa[2], oa[3]); pB[2 * q] = cvtpk(ob[0], ob[1]); pB[2 * q + 1] = cvtpk(ob[2], ob[3]);
                pK[2 * q] = cvtpk(ok[0], ok[1]); pK[2 * q + 1] = cvtpk(ok[2], ok[3]); pR[2 * q] = cvtpk(orr[0], orr[1]); pR[2 * q + 1] = cvtpk(orr[2], orr[3]);
                pV[2 * q] = cvtpk(ov[0], ov[1]); pV[2 * q + 1] = cvtpk(ov[2], ov[3]);
                __builtin_amdgcn_sched_barrier(0);
            }
        }
        __builtin_amdgcn_fence(__ATOMIC_RELEASE, "workgroup"); __builtin_amdgcn_wave_barrier();
#pragma unroll
        for (int q = 0; q < 8; ++q) { const int off = img_off(n, 2 * q + h);
            *(LAS u32x2*)(L + off) = (u32x2){pA[2 * q], pA[2 * q + 1]}; *(LAS u32x2*)(L + 4096 + off) = (u32x2){pB[2 * q], pB[2 * q + 1]};
            *(LAS u32x2*)(L + 8192 + off) = (u32x2){pK[2 * q], pK[2 * q + 1]}; *(LAS u32x2*)(L + 12288 + off) = (u32x2){pV[2 * q], pV[2 * q + 1]}; }
        __builtin_amdgcn_fence(__ATOMIC_RELEASE, "workgroup"); __builtin_amdgcn_wave_barrier();
        const f32x16 Z16 = {0.f};
        f32x16 Lab = Z16, LabT = Z16, LakT = Z16, MrbT = Z16, MrkT = Z16;
#pragma unroll
        for (int ks = 0; ks < 4; ++ks) {
            const bf16x8 fA = frag4(pA[4 * ks], pA[4 * ks + 1], pA[4 * ks + 2], pA[4 * ks + 3]), fB = frag4(pB[4 * ks], pB[4 * ks + 1], pB[4 * ks + 2], pB[4 * ks + 3]);
            const bf16x8 fK = frag4(pK[4 * ks], pK[4 * ks + 1], pK[4 * ks + 2], pK[4 * ks + 3]), fR = frag4(pR[4 * ks], pR[4 * ks + 1], pR[4 * ks + 2], pR[4 * ks + 3]);
            Lab = MFMA32(fA, fB, Lab); LabT = MFMA32(fB, fA, LabT); LakT = MFMA32(fK, fA, LakT); MrbT = MFMA32(fB, fR, MrbT); MrkT = MFMA32(fK, fR, MrkT);
        }
#pragma unroll
        for (int i = 0; i < 16; ++i) { const int rr = crow(i, h);
            Lab[i] = (n < rr) ? Lab[i] : 0.f; LabT[i] = (rr < n) ? LabT[i] : 0.f; LakT[i] = (rr < n) ? LakT[i] : 0.f;
            MrbT[i] = (rr <= n) ? MrbT[i] : 0.f; MrkT[i] = (rr <= n) ? MrkT[i] : 0.f; }
        const bf16x8 pLk0 = pack(LakT, 0), pLk1 = pack(LakT, 1), pMb0 = pack(MrbT, 0), pMb1 = pack(MrbT, 1), pMk0 = pack(MrkT, 0), pMk1 = pack(MrkT, 1);
        __builtin_amdgcn_sched_barrier(0);
        f32x16 Pc = Lab, Ptc = LabT, Rtc = LabT;
#pragma unroll
        for (int i = 0; i < 16; ++i) Rtc[i] += (crow(i, h) == n) ? 1.f : 0.f;
#pragma unroll
        for (int lvl = 0; lvl < 4; ++lvl) {
            const bf16x8 pP0 = pack(Pc, 0), pP1 = pack(Pc, 1), pT0 = pack(Ptc, 0), pT1 = pack(Ptc, 1);
            f32x16 nPc = MFMA32(pT0, pP0, Z16); nPc = MFMA32(pT1, pP1, nPc);
            if (lvl < 3) { f32x16 nPt = MFMA32(pP0, pT0, Z16); nPt = MFMA32(pP1, pT1, nPt); Ptc = nPt; }
            const bf16x8 pN0 = pack(nPc, 0), pN1 = pack(nPc, 1), pR0 = pack(Rtc, 0), pR1 = pack(Rtc, 1);
            Rtc = MFMA32(pN0, pR0, Rtc); Rtc = MFMA32(pN1, pR1, Rtc);
            Pc = nPc;
        }
        const bf16x8 pT0 = pack(Rtc, 0), pT1 = pack(Rtc, 1);
        bf16x8 vt[2][2];
#pragma unroll
        for (int tau = 0; tau < 2; ++tau) { vt[tau][0] = trfrag(L + 12288, tau, 0, lane); vt[tau][1] = trfrag(L + 12288, tau, 1, lane); }
        bf16x8 pW1[2][2], pW2[2][2];
#pragma unroll
        for (int tau = 0; tau < 2; ++tau) {
            f32x16 lv = MFMA32(pLk0, vt[tau][0], Z16); lv = MFMA32(pLk1, vt[tau][1], lv);
            const bf16x8 a0f = trfrag(L, tau, 0, lane), a1f = trfrag(L, tau, 1, lane);
            f32x16 w1 = MFMA32(pT0, a0f, Z16); w1 = MFMA32(pT1, a1f, w1);
            const bf16x8 l0 = pack(lv, 0), l1 = pack(lv, 1);
            f32x16 w2_ = MFMA32(pT0, l0, Z16); w2_ = MFMA32(pT1, l1, w2_);
            pW1[tau][0] = pack(w1, 0); pW1[tau][1] = pack(w1, 1); pW2[tau][0] = pack(w2_, 0); pW2[tau][1] = pack(w2_, 1);
        }
        int opq2 = 0; asm volatile("" : "+v"(opq2));
        const int lane_o = lane + opq2, n_o = n + opq2;
        unsigned char* uo = UO + ((size_t)(b * 8 + hd) * 128 + c32) * UNIT_BYTES;
#pragma unroll
        for (int kap = 0; kap < 2; ++kap) { f32x16 q1;
#pragma unroll
            for (int i = 0; i < 16; ++i) q1[i] = (i & 1) ? hi_f(pR[8 * kap + (i >> 1)]) : lo_f(pR[8 * kap + (i >> 1)]);
            q1 = MFMA32(pW1[kap][0], pMb0, q1); q1 = MFMA32(pW1[kap][1], pMb1, q1);
            store_tile(uo + kap * 2048, q1, lane_o); }
#pragma unroll
        for (int tau = 0; tau < 2; ++tau) { f32x16 q2 = MFMA32(pMb0, pW2[tau][0], Z16); q2 = MFMA32(pMb1, pW2[tau][1], q2); q2 = MFMA32(pMk0, vt[tau][0], q2); q2 = MFMA32(pMk1, vt[tau][1], q2);
#pragma unroll
            for (int i = 0; i < 16; ++i) { const int s = crow(i, h), tk = d ? tok0 + 31 - s : tok0 + s; float* yp = ybuf + ((size_t)b * SEQ + tk) * 512 + 64 * hd + 32 * tau + n_o;
                if (d) *yp += q2[i]; else *yp = q2[i]; } }
        __builtin_amdgcn_fence(__ATOMIC_RELEASE, "workgroup"); __builtin_amdgcn_wave_barrier();
#pragma unroll
        for (int tp = 0; tp < 2; ++tp) {
            const bf16x8 b0f = trfrag(L + 4096, tp, 0, lane), b1f = trfrag(L + 4096, tp, 1, lane), k0f = trfrag(L + 8192, tp, 0, lane), k1f = trfrag(L + 8192, tp, 1, lane);
            const float gcl = gC[32 * tp + n];
#pragma unroll
            for (int kap = 0; kap < 2; ++kap) { f32x16 g = MFMA32(pW1[kap][0], b0f, Z16); g = MFMA32(pW1[kap][1], b1f, g);
#pragma unroll
                for (int i = 0; i < 16; ++i) g[i] = (g[i] + ((kap == tp && crow(i, h) == n) ? 1.f : 0.f)) * gcl;
                store_tile(uo + (2 + 2 * kap + tp) * 2048, g, lane_o); }
#pragma unroll
            for (int tau = 0; tau < 2; ++tau) { f32x16 ht = MFMA32(b0f, pW2[tau][0], Z16); ht = MFMA32(b1f, pW2[tau][1], ht); ht = MFMA32(k0f, vt[tau][0], ht); ht = MFMA32(k1f, vt[tau][1], ht);
#pragma unroll
                for (int i = 0; i < 16; ++i) ht[i] *= gC[32 * tp + crow(i, h)];
                store_tile(uo + (6 + 2 * tp + tau) * 2048, ht, lane_o); }
        }
        __builtin_amdgcn_fence(__ATOMIC_RELEASE, "workgroup"); __builtin_amdgcn_wave_barrier();
    }
}

DI void d_seq(const Ctx& c, int d, const unsigned char* __restrict__ UO, float* __restrict__ ybuf, const bool dry) {
    if (c.wave >= 2) return;
    const int lane = c.lane, n = lane & 31, h = lane >> 5, tau = c.wave;
    for (int chain = c.bid; chain < 64; chain += c.nb) {
        const int b = chain >> 3, hd = chain & 7;
        const unsigned char* ub = UO + (size_t)chain * 128 * UNIT_BYTES + lane * 32;
        const f32x16 Z16 = {0.f};
        f32x16 X0 = Z16, X1 = Z16;
        u32x4 T[8][2];
        auto loadu = [&](int c32) {
            const unsigned char* p = ub + (size_t)c32 * UNIT_BYTES;
#pragma unroll
            for (int k = 0; k < 6; ++k) { T[k][0] = *(const u32x4*)(p + k * 2048); T[k][1] = *(const u32x4*)(p + k * 2048 + 16); }
#pragma unroll
            for (int tp = 0; tp < 2; ++tp) { T[6 + tp][0] = *(const u32x4*)(p + (6 + 2 * tp + tau) * 2048); T[6 + tp][1] = *(const u32x4*)(p + (6 + 2 * tp + tau) * 2048 + 16); }
        };
        loadu(0);
#pragma unroll 1
        for (int c32 = 0; c32 < 128; ++c32) {
            const int tok0 = d ? SEQ - 32 * (c32 + 1) : 32 * c32;
            float* yb = ybuf + ((size_t)b * SEQ) * 512 + 64 * hd + 32 * tau + n;
            f32x16 y;
#pragma unroll
            for (int i = 0; i < 16; ++i) { const int s = crow(i, h), tk = d ? tok0 + 31 - s : tok0 + s; y[i] = yb[(size_t)tk * 512]; }
            const bf16x8 x00 = pack(X0, 0), x01 = pack(X0, 1), x10 = pack(X1, 0), x11 = pack(X1, 1);
            f32x16 n0, n1;
#pragma unroll
            for (int i = 0; i < 8; ++i) { n0[2 * i] = lo_f(T[6][i >> 2][i & 3]); n0[2 * i + 1] = hi_f(T[6][i >> 2][i & 3]); n1[2 * i] = lo_f(T[7][i >> 2][i & 3]); n1[2 * i + 1] = hi_f(T[7][i >> 2][i & 3]); }
#define FR(t, s) __builtin_bit_cast(bf16x8, T[t][s])
            n0 = MFMA32(FR(2, 0), x00, n0); n1 = MFMA32(FR(3, 0), x00, n1);
            n0 = MFMA32(FR(2, 1), x01, n0); n1 = MFMA32(FR(3, 1), x01, n1);
            n0 = MFMA32(FR(4, 0), x10, n0); n1 = MFMA32(FR(5, 0), x10, n1);
            n0 = MFMA32(FR(4, 1), x11, n0); n1 = MFMA32(FR(5, 1), x11, n1);
            y = MFMA32(FR(0, 0), x00, y); y = MFMA32(FR(0, 1), x01, y); y = MFMA32(FR(1, 0), x10, y); y = MFMA32(FR(1, 1), x11, y);
#undef FR
            if (c32 + 1 < 128) loadu(c32 + 1);
#pragma unroll
            for (int i = 0; i < 16; ++i) { const int s = crow(i, h), tk = d ? tok0 + 31 - s : tok0 + s; if (!dry) yb[(size_t)tk * 512] = y[i]; else if (y[i] == 1.2345e33f) yb[0] = 0.f; }
            X0 = n0; X1 = n1;
        }
    }
}
#undef DI
}

namespace pk {
typedef short bf16x8 __attribute__((ext_vector_type(8)));
typedef float f32x16 __attribute__((ext_vector_type(16)));
typedef unsigned u32x4 __attribute__((ext_vector_type(4)));
typedef LAS unsigned char* lptr;
#define DI __device__ __forceinline__
DI float fmx(float a, float b) { float r; asm("v_max_f32 %0, %1, %2" : "=v"(r) : "v"(a), "v"(b)); return r; }
DI float fmn(float a, float b) { float r; asm("v_min_f32 %0, %1, %2" : "=v"(r) : "v"(a), "v"(b)); return r; }
DI void ce(float& hi, float& lo) { const float a = fmx(hi, lo), b = fmn(hi, lo); hi = a; lo = b; }
template <int N> DI void sort_desc(float (&v)[N]) {
#pragma unroll
    for (int k = 2; k <= N; k <<= 1)
#pragma unroll
        for (int j = k >> 1; j > 0; j >>= 1)
#pragma unroll
            for (int i = 0; i < N; ++i) { const int l = i ^ j; if (l > i) { if ((i & k) == 0) ce(v[i], v[l]); else ce(v[l], v[i]); } }
}
DI void merge16(float (&v)[16]) {
#pragma unroll
    for (int j = 8; j > 0; j >>= 1)
#pragma unroll
        for (int i = 0; i < 16; ++i) { const int l = i ^ j; if (l > i) ce(v[i], v[l]); }
}
DI void top_merge(float (&a)[16], const float (&b)[16]) {
#pragma unroll
    for (int i = 0; i < 16; ++i) a[i] = fmx(a[i], b[15 - i]);
    merge16(a);
}
DI float setcode(float v, unsigned code, unsigned mask) { return __uint_as_float((__float_as_uint(v) & ~mask) | code); }

DI void d_peer_topk(const Ctx& c, const bf16* __restrict__ qb, const float* __restrict__ keys, int* __restrict__ idx, float* __restrict__ gate) {
    const int lane = c.lane, n = lane & 31, hh = lane >> 5, hd = c.bid & 7;
    lptr KL = (lptr)c.lds;
    lptr TB = (lptr)c.lds + 65536 + c.wave * 2048;
    __syncthreads();
    for (int e = c.tid; e < 2 * 128 * 16; e += 512) {
        const int row = e >> 4, ch = e & 15; const float* src = keys + (size_t)hd * 32768 + row * 128 + ch * 8;
        const f32x4 a = *(const f32x4*)src, b = *(const f32x4*)(src + 4);
        u32x4 w; w[0] = pk2bf(a.x, a.y); w[1] = pk2bf(a.z, a.w); w[2] = pk2bf(b.x, b.y); w[3] = pk2bf(b.z, b.w);
        *(LAS u32x4*)(KL + row * 256 + ((ch ^ (row & 15)) << 4)) = w; }
    __syncthreads();
    const int nper = (c.nb >> 3) * 8;
    for (int tile = (c.bid >> 3) * 8 + c.wave; tile < NTOK / 32; tile += nper) {
        const int t0 = tile * 32;
        float sp[2][16];
#pragma unroll
        for (int p = 0; p < 2; ++p) {
            bf16x8 qf[8];
            { const bf16* qrow = qb + (size_t)(t0 + n) * PEER_Q + hd * 256 + p * 128 + 8 * hh;
#pragma unroll
              for (int ks = 0; ks < 8; ++ks) qf[ks] = *(const bf16x8*)(qrow + 16 * ks); }
            float top[16];
#pragma unroll
            for (int j = 0; j < 4; ++j) {
                f32x16 acc = {0.f};
                const int row = p * 128 + 32 * j + n;
#pragma unroll
                for (int ks = 0; ks < 8; ++ks) { const bf16x8 kfr = *(LAS bf16x8*)(KL + row * 256 + (((2 * ks + hh) ^ (row & 15)) << 4));
                    acc = __builtin_amdgcn_mfma_f32_32x32x16_bf16(kfr, qf[ks], acc, 0, 0, 0); }
                float g[16];
#pragma unroll
                for (int i = 0; i < 16; ++i) { const int key = 32 * j + (i & 3) + 8 * (i >> 2) + 4 * hh; g[i] = setcode(acc[i], 127u - (unsigned)key, 127u); }
                sort_desc<16>(g);
                if (j == 0) {
#pragma unroll
                    for (int i = 0; i < 16; ++i) top[i] = g[i];
                } else top_merge(top, g);
            }
            float oth[16];
#pragma unroll
            for (int i = 0; i < 16; ++i) oth[i] = __shfl_xor(top[i], 32);
            top_merge(top, oth);
#pragma unroll
            for (int i = 0; i < 16; ++i) sp[p][i] = top[i];
        }
        {
            unsigned w[8];
#pragma unroll
            for (int q = 0; q < 8; ++q) { const int p = q >> 2, a0 = (q & 3) * 4; w[q] = 0;
#pragma unroll
                for (int e = 0; e < 4; ++e) w[q] |= (127u - (__float_as_uint(sp[p][a0 + e]) & 127u)) << (8 * e); }
            *(LAS u32x4*)(TB + lane * 32) = (u32x4){w[0], w[1], w[2], w[3]}; *(LAS u32x4*)(TB + lane * 32 + 16) = (u32x4){w[4], w[5], w[6], w[7]};
        }
        float cd[64];
        {
            int cnt = 0;
#pragma unroll
            for (int a = 0; a < 16; ++a)
#pragma unroll
                for (int b = 0; b < 16; ++b) if ((a + 1) * (b + 1) <= 16) { cd[cnt] = setcode(sp[0][a] + sp[1][b], 255u - (unsigned)(a * 16 + b), 255u); ++cnt; }
#pragma unroll
            for (int i = 50; i < 64; ++i) cd[i] = -INFINITY;
        }
        sort_desc<64>(cd);
        const float mx = cd[0]; float ex[16]; float den = 0.f;
#pragma unroll
        for (int k = 0; k < 16; ++k) { ex[k] = __expf(cd[k] - mx); den += ex[k]; }
        const float rden = 1.f / den;
        const size_t ob = (size_t)(t0 + n) * 128 + hd * 16;
        if (hh == 0) {
            int id[16];
#pragma unroll
            for (int k = 0; k < 16; ++k) { const unsigned flat = 255u - (__float_as_uint(cd[k]) & 255u); const unsigned i1 = *(LAS unsigned char*)(TB + lane * 32 + (flat >> 4)), i2 = *(LAS unsigned char*)(TB + lane * 32 + 16 + (flat & 15)); id[k] = (int)(i1 * 128 + i2); }
#pragma unroll
            for (int k = 0; k < 4; ++k) *(int4*)(idx + ob + 4 * k) = make_int4(id[4 * k], id[4 * k + 1], id[4 * k + 2], id[4 * k + 3]);
        } else {
#pragma unroll
            for (int k = 0; k < 4; ++k) *(f32x4*)(gate + ob + 4 * k) = (f32x4){ex[4 * k] * rden, ex[4 * k + 1] * rden, ex[4 * k + 2] * rden, ex[4 * k + 3] * rden};
        }
    }
}
#undef DI
}
namespace at {
typedef short bf16x8 __attribute__((ext_vector_type(8)));
typedef float f32x16 __attribute__((ext_vector_type(16)));
typedef unsigned u32x2 __attribute__((ext_vector_type(2)));
typedef unsigned u32x4 __attribute__((ext_vector_type(4)));
#define DI __device__ __forceinline__
DI void d_vt(const Ctx& c, const bf16* __restrict__ proj, bf16* __restrict__ vT) {
    LAS bf16* tl = (LAS bf16*)((LAS unsigned char*)c.lds) + c.wave * (64 * 66);
    const int lane = c.lane;
    for (int wt = c.gw; wt < BATCH * 2 * (SEQ / 64); wt += c.ngw) {
        const int tk0 = (wt % (SEQ / 64)) * 64, kvh = (wt / (SEQ / 64)) & 1, b = wt / (2 * (SEQ / 64));
        const u32x4* src = (const u32x4*)(proj + ((size_t)b * SEQ + tk0 + lane) * IN_PAD + C_V + kvh * 64);
#pragma unroll
        for (int q = 0; q < 8; ++q) { const u32x4 w = src[q];
#pragma unroll
            for (int e = 0; e < 4; ++e) *(LAS unsigned*)(tl + lane * 66 + q * 8 + 2 * e) = w[e]; }
        __builtin_amdgcn_fence(__ATOMIC_RELEASE, "workgroup"); __builtin_amdgcn_wave_barrier();
        unsigned o[32];
#pragma unroll
        for (int t = 0; t < 32; ++t) o[t] = (unsigned)tl[(2 * t) * 66 + lane] | ((unsigned)tl[(2 * t + 1) * 66 + lane] << 16);
        u32x4* dst = (u32x4*)(vT + ((size_t)(b * 2 + kvh) * 64 + lane) * SEQ + tk0);
#pragma unroll
        for (int q = 0; q < 8; ++q) dst[q] = (u32x4){o[4 * q], o[4 * q + 1], o[4 * q + 2], o[4 * q + 3]};
        __builtin_amdgcn_fence(__ATOMIC_RELEASE, "workgroup"); __builtin_amdgcn_wave_barrier();
    }
}
DI unsigned cvtpk(float lo, float hi) { typedef float f2 __attribute__((ext_vector_type(2))); typedef __bf16 b2 __attribute__((ext_vector_type(2))); f2 v = {lo, hi}; b2 r = __builtin_convertvector(v, b2); return __builtin_bit_cast(unsigned, r); }
DI bf16x8 pack(const f32x16& x, int s) { u32x4 p; p[0] = cvtpk(x[8 * s], x[8 * s + 1]); p[1] = cvtpk(x[8 * s + 2], x[8 * s + 3]); p[2] = cvtpk(x[8 * s + 4], x[8 * s + 5]); p[3] = cvtpk(x[8 * s + 6], x[8 * s + 7]); return __builtin_bit_cast(bf16x8, p); }
DI void d_attn(const Ctx& c, const bf16* __restrict__ qr, const bf16* __restrict__ kr, const bf16* __restrict__ vT, const float* __restrict__ sink, bf16* __restrict__ mix) {
    const int lane0 = c.lane;
    constexpr float C2 = 0.125f * 1.4426950408889634f, L2E = 1.4426950408889634f;
    for (int u = c.gw; u < BATCH * (SEQ / 32) * 8; u += c.ngw) {
        int lane = lane0; asm volatile("" : "+v"(lane));
        const int n = lane & 31, hh = lane >> 5;
        const int hq = u & 7, qt = (u >> 3) & (SEQ / 32 - 1), b = u >> 10, kvh = hq >> 2, q0 = qt * 32;
        bf16x8 qf[4];
        { const bf16* qp = qr + ((size_t)b * SEQ + q0 + n) * 512 + hq * 64 + 8 * hh;
#pragma unroll
          for (int ks = 0; ks < 4; ++ks) qf[ks] = *(const bf16x8*)(qp + 16 * ks); }
        float m = sink[hq] * L2E, l = hh ? 0.f : 1.f;
        f32x16 O0 = {0.f}, O1 = {0.f};
        const bf16* kbase = kr + ((size_t)b * SEQ + n) * 128 + kvh * 64 + 8 * hh;
        const bf16* vbase = vT + ((size_t)(b * 2 + kvh) * 64 + n) * SEQ + 4 * hh;
#pragma unroll 1
        for (int j = 0; j < 9; ++j) {
            const int kt0 = q0 - 128 + 32 * j;
            if (kt0 < 0 || kt0 >= SEQ) continue;
            const bf16* kp = kbase + (size_t)kt0 * 128;
            f32x16 S = {0.f};
#pragma unroll
            for (int ks = 0; ks < 4; ++ks) S = __builtin_amdgcn_mfma_f32_32x32x16_bf16(*(const bf16x8*)(kp + 16 * ks), qf[ks], S, 0, 0, 0);
            bf16x8 vf[2][2];
#pragma unroll
            for (int dt = 0; dt < 2; ++dt)
#pragma unroll
                for (int s = 0; s < 2; ++s) { const bf16* vp = vbase + (size_t)(32 * dt) * SEQ + kt0 + 16 * s; const u32x2 a = *(const u32x2*)vp, bq = *(const u32x2*)(vp + 8);
                    vf[dt][s] = __builtin_bit_cast(bf16x8, (u32x4){a[0], a[1], bq[0], bq[1]}); }
            float mt = -INFINITY;
#pragma unroll
            for (int i = 0; i < 16; ++i) { const int rr = (i & 3) + 8 * (i >> 2) + 4 * hh; float s = S[i] * C2;
                if (j == 0) s = (rr < n) ? -INFINITY : s;
                if (j == 8) s = (rr > n) ? -INFINITY : s;
                S[i] = s; mt = fmaxf(mt, s); }
            mt = fmaxf(mt, __shfl_xor(mt, 32));
            const float mn = fmaxf(m, mt), alpha = __builtin_amdgcn_exp2f(m - mn);
            m = mn; l *= alpha;
#pragma unroll
            for (int i = 0; i < 16; ++i) { O0[i] *= alpha; O1[i] *= alpha; const float p = __builtin_amdgcn_exp2f(S[i] - mn); S[i] = p; l += p; }
            const bf16x8 p0 = pack(S, 0), p1 = pack(S, 1);
            O0 = __builtin_amdgcn_mfma_f32_32x32x16_bf16(vf[0][0], p0, O0, 0, 0, 0); O0 = __builtin_amdgcn_mfma_f32_32x32x16_bf16(vf[0][1], p1, O0, 0, 0, 0);
            O1 = __builtin_amdgcn_mfma_f32_32x32x16_bf16(vf[1][0], p0, O1, 0, 0, 0); O1 = __builtin_amdgcn_mfma_f32_32x32x16_bf16(vf[1][1], p1, O1, 0, 0, 0);
        }
        l += __shfl_xor(l, 32);
        const float inv = 1.f / l;
        bf16* op = mix + ((size_t)b * SEQ + q0 + n) * DM + hq * 64 + 4 * hh;
#pragma unroll
        for (int g = 0; g < 4; ++g) { *(u32x2*)(op + 8 * g) = (u32x2){cvtpk(O0[4 * g] * inv, O0[4 * g + 1] * inv), cvtpk(O0[4 * g + 2] * inv, O0[4 * g + 3] * inv)};
            *(u32x2*)(op + 32 + 8 * g) = (u32x2){cvtpk(O1[4 * g] * inv, O1[4 * g + 1] * inv), cvtpk(O1[4 * g + 2] * inv, O1[4 * g + 3] * inv)}; }
    }
}
#undef DI
}
namespace pg8 {
struct EpiResF32 {
    static constexpr bool PERM = false, AFTER_DRAIN = false;
    const float* base; float* out; int ldc; float alpha;
    __device__ __forceinline__ void operator()(const f32x4 (&acc)[2][2][4][2], const Unit& u, int wr, int wc, int fr, int fq) const {
        const int col0 = u.pn * BM + wc * 32 + 4 * fq;
#pragma unroll
        for (int ai = 0; ai < 2; ++ai)
#pragma unroll
            for (int m = 0; m < 4; ++m) { const int r = ai * HALF + wr * 64 + m * 16 + fr; const size_t off = (size_t)(u.pm * BM + r) * ldc + col0;
#pragma unroll
                for (int bj = 0; bj < 2; ++bj)
#pragma unroll
                    for (int n = 0; n < 2; ++n) { const f32x4 bs = *(const f32x4*)(base + off + bj * HALF + n * 16); *(f32x4*)(out + off + bj * HALF + n * 16) = bs * alpha + acc[ai][bj][m][n]; } }
    }
};
}
#define XB_TMO      128
#define XB_XCNT(j)  (256  + 64 * (j))
#define XB_XSUB(j)  (1280 + 64 * (j))
#define XB_XGEN(j)  (2304 + 64 * (j))
#define XB_TOP      3328
#define XB_TOPGEN   3392
#define XCD_BAR_WORDS 3456
#define XB_SPIN_CAP (1u << 18)

__device__ __forceinline__ unsigned xb_ld(unsigned* p)              { return __hip_atomic_load(p, __ATOMIC_RELAXED, __HIP_MEMORY_SCOPE_AGENT); }
__device__ __forceinline__ unsigned xb_add(unsigned* p, unsigned v) { return __hip_atomic_fetch_add(p, v, __ATOMIC_RELAXED, __HIP_MEMORY_SCOPE_AGENT); }
__device__ __forceinline__ unsigned xb_xcc_id() { return (unsigned)__builtin_amdgcn_s_getreg((3 << 11) | 20) & 0xFu; }
#define XB_SPIN(cond, bar) do { unsigned _sp = 0; while (cond) { __builtin_amdgcn_s_sleep(1); \
    if ((++_sp & 255u) == 0u) { if (xb_ld(&(bar)[XB_TMO])) break; if (_sp > XB_SPIN_CAP) { atomicAdd(&(bar)[XB_TMO], 1u); break; } } } } while (0)

struct XcdBarrier {
    unsigned* bar; unsigned x;
    volatile LAS unsigned* st;
};

__device__ __forceinline__ XcdBarrier xcd_barrier_post(unsigned* bar, volatile LAS unsigned* st, int tid) {
    XcdBarrier b; b.bar = bar; b.x = xb_xcc_id(); b.st = st;
    if (tid == 0) (void)xb_add(&bar[XB_XCNT(b.x)], 1u);
    return b;
}
__device__ __forceinline__ void xcd_barrier_complete(unsigned* bar, unsigned x, unsigned& nloc, unsigned& nx) {
    const unsigned G = gridDim.x * gridDim.y * gridDim.z;
    unsigned sum, cnt, mine, sp = 0u;
    for (;;) {
        sum = 0u; cnt = 0u; mine = 0u;
#pragma unroll
        for (unsigned j = 0; j < 16; ++j) { const unsigned c = xb_ld(&bar[XB_XCNT(j)]); sum += c; cnt += (c > 0u) ? 1u : 0u; mine = (j == x) ? c : mine; }
        if (sum == G) break;
        __builtin_amdgcn_s_sleep(1);
        if ((++sp & 255u) == 0u) { if (xb_ld(&bar[XB_TMO])) break; if (sp > XB_SPIN_CAP) { atomicAdd(&bar[XB_TMO], 1u); break; } }
    }
    nloc = mine > 0u ? mine : 1u; nx = cnt > 0u ? cnt : 1u;
}

__device__ __forceinline__ void xcd_barrier(const XcdBarrier& b, int tid) {
    asm volatile("s_waitcnt vmcnt(0)" ::: "memory");
    __syncthreads();
    if (tid == 0) {
        unsigned* bar = b.bar;
        __builtin_amdgcn_s_waitcnt(0);
        unsigned nloc = b.st[0], nx = b.st[1];
        if (nloc == 0u) { xcd_barrier_complete(bar, b.x, nloc, nx); b.st[0] = nloc; b.st[1] = nx; }
        const unsigned old = xb_add(&bar[XB_XSUB(b.x)], 1u);
        const unsigned gen = old / nloc;
        if (old + 1u == (gen + 1u) * nloc) {
            __builtin_amdgcn_fence(__ATOMIC_RELEASE, "agent");
            asm volatile("s_waitcnt vmcnt(0)" ::: "memory");
            const unsigned og = xb_add(&bar[XB_TOP], 1u);
            const unsigned tg = og / nx;
            if (og + 1u == (tg + 1u) * nx) xb_add(&bar[XB_TOPGEN], 1u);
            else XB_SPIN(xb_ld(&bar[XB_TOPGEN]) == tg, bar);
            __builtin_amdgcn_fence(__ATOMIC_ACQUIRE, "agent");
            xb_add(&bar[XB_XGEN(b.x)], 1u);
            asm volatile("s_waitcnt vmcnt(0)" ::: "memory");
        } else {
            XB_SPIN(xb_ld(&bar[XB_XGEN(b.x)]) == gen, bar);
            __builtin_amdgcn_fence(__ATOMIC_ACQUIRE, "agent");
            asm volatile("s_waitcnt vmcnt(0)" ::: "memory");
        }
    }
    __syncthreads();
}

constexpr size_t MiB = 1u << 20;
constexpr int LDS_BYTES = 147456;
constexpr int NPHASE = 17;
struct Params { const float* in[24]; float* out; unsigned char* ws; int ph_lo, ph_hi; };

__global__ void __launch_bounds__(512, 2) mega(Params p) {
    extern __shared__ __attribute__((aligned(16))) unsigned char lds[];
    cg::grid_group grid = cg::this_grid();
    Ctx c; c.wave = __builtin_amdgcn_readfirstlane(threadIdx.x >> 6); c.lane = (int)__builtin_amdgcn_mbcnt_hi(~0u, __builtin_amdgcn_mbcnt_lo(~0u, 0u)); c.tid = c.wave * 64 + c.lane; c.bid = blockIdx.x; c.nb = gridDim.x; c.gw = c.bid * 8 + c.wave; c.ngw = c.nb * 8; c.lds = lds;
#define LND(ptr) ((ptr) + ({ int z_ = 0; asm volatile("" : "+s"(z_)); z_; }))
#define WSP(T, mb) ((T*)(LND(p.ws) + (size_t)(mb) * MiB))
#define x_in LND(p.in[0])
#define w_in LND(p.in[1])
#define mu_prev LND(p.in[2])
#define mu_next LND(p.in[3])
#define w0 LND(p.in[4])
#define w2 LND(p.in[5])
#define a0 LND(p.in[6])
#define a2 LND(p.in[7])
#define g2 LND(p.in[8])
#define k_k LND(p.in[9])
#define k_a LND(p.in[10])
#define r_k LND(p.in[11])
#define lnx_g LND(p.in[12])
#define lnx_b LND(p.in[13])
#define sink LND(p.in[14])
#define w_out LND(p.in[15])
#define ln1_g LND(p.in[16])
#define ln1_b LND(p.in[17])
#define wq LND(p.in[18])
#define keys LND(p.in[19])
#define pu LND(p.in[20])
#define pv LND(p.in[21])
#define ln2_g LND(p.in[22])
#define ln2_b LND(p.in[23])
#define out LND(p.out)
#define rope WSP(float2, 1)
#define w2t WSP(bf16, 2)
#define a2t ((bf16*)(LND(p.ws) + 2 * MiB + 65536))
#define g2t ((bf16*)(LND(p.ws) + 2 * MiB + 131072))
#define bscp WSP(float, 3)
#define w_in_t WSP(bf16, 4)
#define w_out_t WSP(bf16, 10)
#define wq_t WSP(bf16, 12)
#define xb WSP(bf16, 16)
#define qr WSP(bf16, 16)
#define kr WSP(bf16, 48)
#define vTp WSP(bf16, 56)
#define ybuf WSP(float, 16)
#define ub WSP(bf16, 16)
#define u8t WSP(unsigned, 16)
#define v8t WSP(unsigned, 32)
#define su8 WSP(float, 48)
#define shs WSP(float, 50)
#define h8s WSP(unsigned, 240)
#define zpp WSP(int, 304)
#define sv8 WSP(float, 49)
#define vb WSP(bf16, 48)
#define proj WSP(bf16, 80)
#define y1 WSP(float, 80)
#define idx WSP(int, 208)
#define gate WSP(float, 224)
#define mix WSP(bf16, 240)
#define UO WSP(unsigned char, 304)
#define qb WSP(bf16, 304)
#define h1b WSP(bf16, 432)
    volatile LAS unsigned* bst = (volatile LAS unsigned*)((LAS unsigned char*)lds + (LDS_BYTES - 64));
    if (c.tid < 3) bst[c.tid] = 0u;
    __syncthreads();
    const XcdBarrier bar = xcd_barrier_post((unsigned*)p.ws, bst, c.tid);
    if (c.tid == 0) bst[2] = xb_add((unsigned*)p.ws + px::CW_XRANK + (bar.x & 7u), 1u);
    __syncthreads();
    const int my_xcc = (int)bar.x, my_rank = (int)bst[2];
    const int lo = p.ph_lo, hi = p.ph_hi;
#ifndef PH_MASK
#define PH_MASK 0xFFFFFFFFu
#endif
#define IN(k) (((PH_MASK >> (k)) & 1) && lo <= (k) && (k) < hi)
#define RELANE() do { c.lane = (int)__builtin_amdgcn_mbcnt_hi(~0u, __builtin_amdgcn_mbcnt_lo(~0u, 0u)); c.tid = c.wave * 64 + c.lane; } while (0)
#define GBAR() do { RELANE(); xcd_barrier(bar, c.tid); } while (0)
#define SEAM(k) do { if (IN(k) && IN((k) + 1)) { if ((k) == 0) grid.sync(); else GBAR(); } RELANE(); } while (0)
#ifndef PROBE_IMASK
#define PROBE_IMASK 0x3fff
#endif
#ifndef REPEAT_MASK
#define REPEAT_MASK 0
#endif
#define PHASE(k, ...) do { if (IN(k)) { RELANE(); { const bool DRY = false; (void)DRY; __VA_ARGS__; } if ((REPEAT_MASK >> (k)) & 1) { GBAR(); RELANE(); const bool DRY = true; (void)DRY; __VA_ARGS__; } } SEAM(k); } while (0)
#define GEMM_PHASE(EPI, A_, Bt_, N_, ...) do { pg8::Gemm g{A_, Bt_, NTOK, N_, DM}; pg8::StaticOrder S; S.init(NTOK, N_, c.nb, c.bid); EPI E{__VA_ARGS__}; \
        pg8::gemm_phase<EPI, pg8::StaticOrder, true, true>((PG8_LAS unsigned char*)lds, g, S, E, c.wave); } while (0)
    PHASE(0, nv::d_cvt_bf16(c, x_in, xb, (size_t)NTOK * DM / 4); nv::d_transpose_w(c, w_in, DM, IN_COLS, IN_PAD, w_in_t); nv::d_transpose_w(c, w_out, DM, DM, DM, w_out_t);
             nv::d_transpose_w(c, wq, DM, PEER_Q, PEER_Q, wq_t); nv::d_rope_table(c, rope); rw::d_lowrank_t(c, w2, a2, w2t, a2t); rw::d_g2_t(c, g2, g2t));
    PHASE(1, GEMM_PHASE(pg8::EpiBf16<0>, xb, w_in_t, IN_PAD, proj, IN_PAD, nullptr, 0, 0, 1.f));
    PHASE(2, nv::d_rotary(c, proj, rope, qr, kr); at::d_vt(c, proj, vTp));
    PHASE(3, at::d_attn(c, qr, kr, vTp, sink, mix));
    PHASE(4, rw::d_prep(c, 0, proj, mu_prev, mu_next, w0, a0, k_k, k_a, w2t, a2t, UO, ybuf));
    PHASE(5, rw::d_seq(c, 0, UO, ybuf, DRY));
    PHASE(6, rw::d_prep(c, 1, proj, mu_prev, mu_next, w0, a0, k_k, k_a, w2t, a2t, UO, ybuf));
    PHASE(7, rw::d_seq(c, 1, UO, ybuf, DRY));
    PHASE(8, rw::d_out(c, proj, ybuf, mu_prev, mu_next, a0, k_a, r_k, a2t, g2t, lnx_g, lnx_b, mix));
    PHASE(9, GEMM_PHASE(pg8::EpiResF32, mix, w_out_t, DM, x_in, y1, DM, DN_ALPHA));
    PHASE(10, { float* y1p = y1; nv::d_ln1(c, y1p, ln1_g, ln1_b, DRY ? (float*)qb : y1p, DRY ? (bf16*)qb : h1b); } px::d_quant_tables(c, pu, pv, u8t, v8t, su8, sv8));
    PHASE(11, GEMM_PHASE(pg8::EpiBf16<0>, h1b, wq_t, PEER_Q, qb, PEER_Q, nullptr, 0, 0, 1.f));
    PHASE(12, pk::d_peer_topk(c, qb, keys, idx, gate); px::d_quant_h(c, h1b, h8s, shs));
    PHASE(13, { const px::Grp G = px::group_of(c, (const unsigned*)p.ws, my_xcc, my_rank); px::d_g1(c, G, h8s, idx, u8t, zpp); });
    PHASE(14, px::d_g2(c, zpp, idx, shs, su8, sv8, gate));
    PHASE(15, { const px::Grp G = px::group_of(c, (const unsigned*)p.ws, my_xcc, my_rank); px::d_g3(c, G, h1b, idx, gate, v8t, y1); });
    PHASE(16, px::d_g4(c, y1, ln2_g, ln2_b, out));
#undef IN
#undef SEAM
}
#undef x_in
#undef out
#undef proj
#undef mix
#undef idx
#undef gate
#undef keys
#undef rope
#undef w0
#undef w2
#undef a0
#undef a2
#undef g2
#undef sink
#undef qr
#undef kr
#undef ub
#undef vb
#undef qb
#undef xb
#undef y1
#undef UO
#undef ybuf
#undef pu
#undef pv

#ifndef N_LAUNCHES
#define N_LAUNCHES 1
#endif
extern "C" void kernel_launch(void* const* d_in, const int* in_sizes, int n_in, void* d_out, int out_size, void* d_ws, size_t ws_size, hipStream_t stream) {
    static int grid = 0;
    if (grid == 0) {
        if (n_in != 24 || in_sizes[0] != NTOK * DM || out_size != NTOK * DM || ws_size < 496 * MiB) { fprintf(stderr, "kernel_launch: unexpected shapes/ws (n_in %d, ws %zu)\n", n_in, ws_size); grid = -1; return; }
        int dev = 0, cus = 0, per_cu = 0;
        if (hipGetDevice(&dev) != hipSuccess || hipDeviceGetAttribute(&cus, hipDeviceAttributeMultiprocessorCount, dev) != hipSuccess) { grid = -1; return; }
        if (hipFuncSetAttribute((const void*)mega, hipFuncAttributeMaxDynamicSharedMemorySize, LDS_BYTES) != hipSuccess) { fprintf(stderr, "kernel_launch: hipFuncSetAttribute failed\n"); grid = -1; return; }
        if (hipOccupancyMaxActiveBlocksPerMultiprocessor(&per_cu, (const void*)mega, 512, LDS_BYTES) != hipSuccess || per_cu < 1) { fprintf(stderr, "kernel_launch: occupancy query failed (%d)\n", per_cu); (void)hipGetLastError(); grid = -1; return; }
        grid = cus * per_cu;
        fprintf(stderr, "kernel_launch: cus %d per_cu %d grid %d\n", cus, per_cu, grid);
    }
    if (grid < 0) return;
    if (hipMemsetAsync(d_ws, 0, 65536, stream) != hipSuccess) { fprintf(stderr, "kernel_launch: memset failed\n"); return; }
    Params p{};
    for (int i = 0; i < 24; ++i) p.in[i] = (const float*)d_in[i];
    p.out = (float*)d_out; p.ws = (unsigned char*)d_ws;
#if N_LAUNCHES == 1
    p.ph_lo = 0; p.ph_hi = NPHASE;
    void* args[] = {&p};
    hipError_t e = hipLaunchCooperativeKernel((const void*)mega, dim3(grid), dim3(512), args, LDS_BYTES, stream);
    if (e != hipSuccess) fprintf(stderr, "cooperative launch failed: %s (grid %d)\n", hipGetErrorString(e), grid);
#else
    for (int k = 0; k < NPHASE; ++k) { p.ph_lo = k; p.ph_hi = k + 1; hipLaunchKernelGGL(mega, dim3(grid), dim3(512), LDS_BYTES, stream, p); }
#endif
}
```

```cpp
#include <hip/hip_runtime.h>
#include <hip/hip_cooperative_groups.h>
#include <cstdio>
#include <cstdint>
#include <cmath>
namespace cg = cooperative_groups;

constexpr int BATCH = 8, SEQ = 4096, DM = 1024, NTOK = BATCH * SEQ;
constexpr int IN_COLS = 2528, IN_PAD = 2560;
constexpr int C_Q = 0, C_K = 512, C_V = 640, C_P = 768;
constexpr int P_R = 0, P_KK = 512, P_VV = 1024, P_WD = 1536, P_AD = 1600, P_GD = 1664, RW_COLS = 1760;
constexpr int NEXP = 16384, PEER_Q = 2048;
constexpr float LN_EPS = 1e-5f, GN_EPS = 64e-5f;
constexpr float DN_ALPHA = 1.189207115002721f;

typedef unsigned short bf16;
__device__ __forceinline__ float bf2f(bf16 v) { return __uint_as_float(((unsigned)v) << 16); }
__device__ __forceinline__ bf16 f2bf(float f) { unsigned u = __float_as_uint(f); return (bf16)((u + 0x7fffu + ((u >> 16) & 1u)) >> 16); }
__device__ __forceinline__ unsigned pk2bf(float lo, float hi) { return (unsigned)f2bf(lo) | ((unsigned)f2bf(hi) << 16); }
__device__ __forceinline__ float wave_sum(float v) {
#pragma unroll
    for (int o = 1; o < 64; o <<= 1) v += __shfl_xor(v, o);
    return v;
}
__device__ __forceinline__ float sigmoidf_(float x) { return 1.f / (1.f + __expf(-x)); }
namespace pg8 {
#define PG8_LAS __attribute__((address_space(3)))
typedef unsigned short bf16_t;
typedef short bf16x8 __attribute__((ext_vector_type(8)));
typedef float f32x4 __attribute__((ext_vector_type(4)));
typedef unsigned u32x4 __attribute__((ext_vector_type(4)));
constexpr int BM = 256, BK = 64, HALF = 128, HTB = HALF * BK * 2  , STAGE_BYTES = 8 * HTB, NXCD = 8, WGM = 8;

__host__ __device__ __forceinline__ int lds_byte(int r, int c) { const int st = (r >> 4) * 2 + (c >> 5), rr = r & 15, cc = c & 31, ob = rr * 64 + cc * 2; return st * 1024 + (ob ^ (((ob >> 9) & 1) << 5)); }
__host__ __device__ __forceinline__ void stage_rc(int b, int& R, int& C) { const int st = b / 1024, sb = b % 1024, swz = sb ^ (((sb >> 9) & 1) << 5); R = (st >> 1) * 16 + swz / 64; C = (st & 1) * 32 + (swz % 64) / 2; }
__host__ __device__ __forceinline__ int perm32(int rho) { const int n = rho >> 4, i = rho & 15; return 8 * (i >> 2) + 4 * n + (i & 3); }

struct Unit { int pm, pn; };
struct Gemm { const bf16_t* A; const bf16_t* Bt; int M, N, K; };

struct StaticOrder {
    int nM, nN, nwg, G, c;
    __host__ __device__ void init(int M, int N, int G_, int c_) { nM = M / BM; nN = N / BM; nwg = nM * nN; G = G_; c = c_; }
    __host__ __device__ bool next(int i, Unit& u) const {
        const long L = (long)i * G + c; if (L >= nwg) return false;
        int wgid = (int)L; { const int q = nwg / NXCD, r = nwg % NXCD, xcd = wgid % NXCD, off = wgid / NXCD; wgid = (xcd < r ? xcd * (q + 1) : r * (q + 1) + (xcd - r) * q) + off; }
        const int nig = WGM * nN, gid = wgid / nig, fm = gid * WGM, gsz = (nM - fm) < WGM ? (nM - fm) : WGM;
        u.pm = fm + ((wgid % nig) % gsz); u.pn = (wgid % nig) / gsz; return true;
    }
    __device__ __forceinline__ void a_ready(const Unit&) const {}
    __device__ __forceinline__ void done(const Unit&) const {}
};

__device__ __forceinline__ unsigned cvt_pk_bf16(float lo, float hi) { unsigned r; asm volatile("v_cvt_pk_bf16_f32 %0, %1, %2" : "=v"(r) : "v"(lo), "v"(hi)); return r; }
typedef float f32x2 __attribute__((ext_vector_type(2)));
__device__ __forceinline__ f32x2 gelu_pk(f32x2 v) {
    const f32x2 av = __builtin_elementwise_abs(v), d = av * 0.2316418882f + 1.0f;
    f32x2 t; t.x = __builtin_amdgcn_rcpf(d.x); t.y = __builtin_amdgcn_rcpf(d.y);
    f32x2 q = t * 0.5307027145f + (-0.7265760135f); q = q * t + 0.7107068705f; q = q * t + (-0.142248368f); q = q * t + 0.127414796f; q = q * t;
    const f32x2 s = (v * v) * (-0.72134752044f);
    f32x2 e; e.x = __builtin_amdgcn_exp2f(s.x); e.y = __builtin_amdgcn_exp2f(s.y);
    const f32x2 m = v * (q * e), r = v - m;
    f32x2 o; o.x = v.x < 0.f ? m.x : r.x; o.y = v.y < 0.f ? m.y : r.y; return o;
}

template <int ACT  > struct EpiBf16 {
    static constexpr bool PERM = true, AFTER_DRAIN = false; static_assert(ACT == 0 || ACT == 1, "EpiBf16: ACT is 0 (none) or 1 (gelu_pk)");
    bf16_t* O; int ldc; const float* bias; int split_cols; size_t split_stride; float scale0;
    __device__ __forceinline__ void operator()(const f32x4 (&acc)[2][2][4][2], const Unit& u, int wr, int wc, int fr, int fq) const {
        const int row0 = u.pm * BM + wr * 64 + fr; int colt = u.pn * BM; bf16_t* base = O;
        float sc = 1.f; if (split_cols) { const int t = colt / split_cols; base += (size_t)t * split_stride; colt -= t * split_cols; if (t == 0) sc = scale0; }
        const int col0 = colt + wc * 32 + 8 * fq, bcol0 = u.pn * BM + wc * 32 + 8 * fq;
        f32x4 bv[2][2];
#pragma unroll
        for (int bj = 0; bj < 2; ++bj)
#pragma unroll
            for (int n = 0; n < 2; ++n) bv[bj][n] = bias ? *(const f32x4*)(bias + bcol0 + bj * HALF + 4 * n) : (f32x4){0.f, 0.f, 0.f, 0.f};
#pragma unroll
        for (int ai = 0; ai < 2; ++ai)
#pragma unroll
            for (int m = 0; m < 4; ++m) { bf16_t* rowp = base + (size_t)(row0 + ai * HALF + m * 16) * ldc + col0;
#pragma unroll
                for (int bj = 0; bj < 2; ++bj) { f32x4 v0 = acc[ai][bj][m][0] + bv[bj][0], v1 = acc[ai][bj][m][1] + bv[bj][1];
                    if (ACT == 1) { f32x2 a = gelu_pk((f32x2){v0[0], v0[1]}), b = gelu_pk((f32x2){v0[2], v0[3]}), c = gelu_pk((f32x2){v1[0], v1[1]}), d = gelu_pk((f32x2){v1[2], v1[3]});
                        v0 = (f32x4){a.x, a.y, b.x, b.y}; v1 = (f32x4){c.x, c.y, d.x, d.y}; }
                    v0 = v0 * sc; v1 = v1 * sc; u32x4 w; w.x = cvt_pk_bf16(v0[0], v0[1]); w.y = cvt_pk_bf16(v0[2], v0[3]); w.z = cvt_pk_bf16(v1[0], v1[1]); w.w = cvt_pk_bf16(v1[2], v1[3]);
                    *(u32x4*)(rowp + bj * HALF) = w; } }
    }
};

struct PanelStats {
    unsigned* xbuf;
    unsigned* cnt;
    unsigned* tmo;
    int ntn; float eps;
    unsigned code;
    __device__ __forceinline__ bool run(const f32x4 (&v)[2][2][4][2], const Unit& u, int wr, int wc, int fr, int fq, PG8_LAS unsigned char* lds, int wid, int lane) const {
        typedef float f32x2v __attribute__((ext_vector_type(2)));
        PG8_LAS f32x2v* P = (PG8_LAS f32x2v*)lds;
        PG8_LAS f32x2v* S = (PG8_LAS f32x2v*)(lds + 8192);
        PG8_LAS unsigned* flag = (PG8_LAS unsigned*)(lds + 8192 + 2048);
#pragma unroll
        for (int ai = 0; ai < 2; ++ai)
#pragma unroll
            for (int m = 0; m < 4; ++m) {
                float s = 0.f;
#pragma unroll
                for (int bj = 0; bj < 2; ++bj)
#pragma unroll
                    for (int n = 0; n < 2; ++n) { const f32x4 x = v[ai][bj][m][n]; s += (x[0] + x[1]) + (x[2] + x[3]); }
                s += __shfl_xor(s, 16); s += __shfl_xor(s, 32);
                const float mw = s * (1.0f / 64.0f); float q = 0.f;
#pragma unroll
                for (int bj = 0; bj < 2; ++bj)
#pragma unroll
                    for (int n = 0; n < 2; ++n) { const f32x4 d = v[ai][bj][m][n] - mw; q += (d[0] * d[0] + d[1] * d[1]) + (d[2] * d[2] + d[3] * d[3]); }
                q += __shfl_xor(q, 16); q += __shfl_xor(q, 32);
                if (fq == 0) P[(ai * HALF + wr * 64 + m * 16 + fr) * 4 + wc] = (f32x2v){mw, q};
            }
        asm volatile("s_waitcnt lgkmcnt(0)" ::: "memory"); __builtin_amdgcn_s_barrier(); asm volatile("" ::: "memory");
#if defined(BROKEN_EXCHANGE_NO_WAIT)
#warning BROKEN CONTROL BUILD: the row-statistics exchange does not wait; results are wrong by design
        if (blockIdx.x >= 64) { const long long t0_ = clock64(); while (clock64() - t0_ < 60000) __builtin_amdgcn_s_sleep(8); }
#endif
        const int row = wid * 32 + (lane & 31);
        if (lane < 32) {
            const f32x2v a = P[row * 4 + 0], b = P[row * 4 + 1], c = P[row * 4 + 2], d = P[row * 4 + 3];
            const float mt = (a.x + b.x + c.x + d.x) * 0.25f;
            const float da = a.x - mt, db = b.x - mt, dc = c.x - mt, dd = d.x - mt;
            const float m2 = (a.y + b.y) + (c.y + d.y) + 64.0f * ((da * da + db * db) + (dc * dc + dd * dd));
            unsigned long long* slot = (unsigned long long*)xbuf + ((size_t)(u.pm * BM + row) * 4 + u.pn);
            __hip_atomic_store(slot, ((unsigned long long)__float_as_uint(m2) << 32) | __float_as_uint(mt), __ATOMIC_RELAXED, __HIP_MEMORY_SCOPE_AGENT);
        }
        asm volatile("s_waitcnt vmcnt(0)" ::: "memory");
        if (lane == 0) __hip_atomic_fetch_add(cnt + 64 * u.pm, 1u, __ATOMIC_RELAXED, __HIP_MEMORY_SCOPE_AGENT);
        if (wid == 0) {
            bool dead = false; const unsigned long long t0 = __builtin_amdgcn_s_memrealtime(); const unsigned want = 8u * (unsigned)ntn;
            for (;;) {
#if defined(BROKEN_EXCHANGE_NO_WAIT)
                break;
#endif
                if ((unsigned)__builtin_amdgcn_readfirstlane(__hip_atomic_load(cnt + 64 * u.pm, __ATOMIC_RELAXED, __HIP_MEMORY_SCOPE_AGENT)) >= want) break;
                if (__builtin_amdgcn_s_memrealtime() - t0 > 2000000ull) {
                    if (lane == 0) { unsigned expect = 0u; __hip_atomic_compare_exchange_strong(tmo + 1, &expect, code | (unsigned)(u.pm & 0xff), __ATOMIC_RELAXED, __ATOMIC_RELAXED, __HIP_MEMORY_SCOPE_AGENT);
                                     __hip_atomic_store(tmo, 1u, __ATOMIC_RELAXED, __HIP_MEMORY_SCOPE_AGENT); }
                    dead = true; break; }
                __builtin_amdgcn_s_sleep(2);
            }
            __builtin_amdgcn_fence(__ATOMIC_ACQUIRE, "agent");
            if (lane == 0) flag[0] = dead ? 1u : 0u;
        }
        asm volatile("s_waitcnt vmcnt(0) lgkmcnt(0)" ::: "memory"); __builtin_amdgcn_s_barrier(); asm volatile("" ::: "memory");
        const bool bad = flag[0] != 0u;
        if (lane < 32) {
            const unsigned long long* slot = (const unsigned long long*)xbuf + (size_t)(u.pm * BM + row) * 4; float mt[4], m2[4]; float ms = 0.f;
#pragma unroll
            for (int t = 0; t < 4; ++t) { if (t < ntn) { const unsigned long long w = __hip_atomic_load(slot + t, __ATOMIC_RELAXED, __HIP_MEMORY_SCOPE_AGENT); mt[t] = __uint_as_float((unsigned)w); m2[t] = __uint_as_float((unsigned)(w >> 32)); } else { mt[t] = 0.f; m2[t] = 0.f; } ms += mt[t]; }
            const float mean = ms / (float)ntn; float q = 0.f;
#pragma unroll
            for (int t = 0; t < 4; ++t) if (t < ntn) { const float dm = mt[t] - mean; q += m2[t] + 256.0f * dm * dm; }
            S[row] = (f32x2v){mean, 1.0f / sqrtf(q / (256.0f * (float)ntn) + eps)};
        }
        asm volatile("s_waitcnt lgkmcnt(0)" ::: "memory"); __builtin_amdgcn_s_barrier(); asm volatile("" ::: "memory");
        return bad;
    }
};
struct EpiLnRes {
    static constexpr bool PERM = false, AFTER_DRAIN = true;
    const float* base; float* out; int ldc; const float* bias; PanelStats st; unsigned poison;
    __device__ __forceinline__ void fused(f32x4 (&acc)[2][2][4][2], const Unit& u, int wr, int wc, int fr, int fq, PG8_LAS unsigned char* lds, int wid, int lane) const {
        typedef float f32x2v __attribute__((ext_vector_type(2)));
        const PG8_LAS f32x2v* S = (const PG8_LAS f32x2v*)(lds + 8192);
        const int col0 = u.pn * BM + wc * 32 + 4 * fq;
#pragma unroll
        for (int bj = 0; bj < 2; ++bj)
#pragma unroll
            for (int n = 0; n < 2; ++n) { const f32x4 bv = bias ? *(const f32x4*)(bias + col0 + bj * HALF + n * 16) : (f32x4){0.f, 0.f, 0.f, 0.f};
#pragma unroll
                for (int ai = 0; ai < 2; ++ai)
#pragma unroll
                    for (int m = 0; m < 4; ++m) acc[ai][bj][m][n] += bv; }
        f32x4 pre[4][2][2];
#pragma unroll
        for (int m = 0; m < 4; ++m) { const size_t off = (size_t)(u.pm * BM + wr * 64 + m * 16 + fr) * ldc + col0;
#pragma unroll
            for (int bj = 0; bj < 2; ++bj)
#pragma unroll
                for (int n = 0; n < 2; ++n) pre[m][bj][n] = *(const f32x4*)(base + off + bj * HALF + n * 16); }
        const bool bad = st.run(acc, u, wr, wc, fr, fq, lds, wid, lane) || poison != 0u;
        const float qnan = __builtin_nanf("");
#pragma unroll
        for (int ai = 0; ai < 2; ++ai)
#pragma unroll
            for (int m = 0; m < 4; ++m) { const int r = ai * HALF + wr * 64 + m * 16 + fr; const f32x2v sr = S[r]; const size_t off = (size_t)(u.pm * BM + r) * ldc + col0;
#pragma unroll
                for (int bj = 0; bj < 2; ++bj)
#pragma unroll
                    for (int n = 0; n < 2; ++n) { const f32x4 bs = ai == 0 ? pre[m][bj][n] : *(const f32x4*)(base + off + bj * HALF + n * 16); f32x4 o = bs + (acc[ai][bj][m][n] - sr.x) * sr.y;
                        if (bad) o = (f32x4){qnan, qnan, qnan, qnan}; *(f32x4*)(out + off + bj * HALF + n * 16) = o; }
                if (m & 1) asm volatile("" ::: "memory"); }
    }
};
struct EpiLnResLn {
    static constexpr bool PERM = false, AFTER_DRAIN = true;
    const float* base; float* out; bf16_t* xn; int ldc; const float* bias; PanelStats st1, st2; unsigned poison;
    __device__ __forceinline__ void fused(f32x4 (&acc)[2][2][4][2], const Unit& u, int wr, int wc, int fr, int fq, PG8_LAS unsigned char* lds, int wid, int lane) const {
        typedef float f32x2v __attribute__((ext_vector_type(2))); typedef unsigned u32x2v __attribute__((ext_vector_type(2)));
        const PG8_LAS f32x2v* S = (const PG8_LAS f32x2v*)(lds + 8192);
        const int col0 = u.pn * BM + wc * 32 + 4 * fq;
#pragma unroll
        for (int bj = 0; bj < 2; ++bj)
#pragma unroll
            for (int n = 0; n < 2; ++n) { const f32x4 bv = bias ? *(const f32x4*)(bias + col0 + bj * HALF + n * 16) : (f32x4){0.f, 0.f, 0.f, 0.f};
#pragma unroll
                for (int ai = 0; ai < 2; ++ai)
#pragma unroll
                    for (int m = 0; m < 4; ++m) acc[ai][bj][m][n] += bv; }
        bool bad = st1.run(acc, u, wr, wc, fr, fq, lds, wid, lane) || poison != 0u;
        const float qnan = __builtin_nanf("");
#pragma unroll
        for (int ai = 0; ai < 2; ++ai)
#pragma unroll
            for (int m = 0; m < 4; ++m) { const int r = ai * HALF + wr * 64 + m * 16 + fr; const f32x2v sr = S[r]; const size_t off = (size_t)(u.pm * BM + r) * ldc + col0;
#pragma unroll
                for (int bj = 0; bj < 2; ++bj)
#pragma unroll
                    for (int n = 0; n < 2; ++n) { const f32x4 bs = *(const f32x4*)(base + off + bj * HALF + n * 16); acc[ai][bj][m][n] = bs + (acc[ai][bj][m][n] - sr.x) * sr.y; }
                asm volatile("" : "+v"(acc[ai][0][m][0]), "+v"(acc[ai][0][m][1]), "+v"(acc[ai][1][m][0]), "+v"(acc[ai][1][m][1]));
                if (m & 1) asm volatile("" ::: "memory"); }
        const bool bad1 = bad;
        bad = st2.run(acc, u, wr, wc, fr, fq, lds, wid, lane) || bad;
#pragma unroll
        for (int ai = 0; ai < 2; ++ai)
#pragma unroll
            for (int m = 0; m < 4; ++m) { const int r = ai * HALF + wr * 64 + m * 16 + fr; const f32x2v sr = S[r]; const size_t off = (size_t)(u.pm * BM + r) * ldc + col0;
#pragma unroll
                for (int bj = 0; bj < 2; ++bj)
#pragma unroll
                    for (int n = 0; n < 2; ++n) { const f32x4 x1 = acc[ai][bj][m][n]; *(f32x4*)(out + off + bj * HALF + n * 16) = bad1 ? (f32x4){qnan, qnan, qnan, qnan} : x1;
                        const f32x4 o = (x1 - sr.x) * sr.y; u32x2v w; w.x = cvt_pk_bf16(o[0], o[1]); w.y = cvt_pk_bf16(o[2], o[3]);
                        if (bad) { w.x = 0x7fc07fc0u; w.y = 0x7fc07fc0u; } *(u32x2v*)(xn + off + bj * HALF + n * 16) = w; }
                asm volatile("" ::: "memory"); }
    }
};

template <class Epi, class Sched, bool ALIGN_EPI = false, bool SP2 = false>
__device__ __forceinline__ void gemm_phase(PG8_LAS unsigned char* lds, const Gemm g, const Sched& S, const Epi& E, const int wid_in) {
    const int lane = (int)__builtin_amdgcn_mbcnt_hi(~0u, __builtin_amdgcn_mbcnt_lo(~0u, 0u)), wid = wid_in, tid = wid * 64 + lane, wr = wid >> 2, wc = wid & 3, fr = lane & 15, fq = lane >> 4;
    const int K = g.K, nt = K / BK;
    unsigned voffA[2], voffB[2];
#pragma unroll
    for (int i = 0; i < 2; ++i) { int R, C; stage_rc(tid * 16 + i * 8192, R, C); const int Rb = Epi::PERM ? ((R & ~31) + perm32(R & 31)) : R;
        voffA[i] = (unsigned)(R * K + C) * 2u; voffB[i] = (unsigned)(Rb * K + C) * 2u; }
    const size_t kstep = (size_t)(BK * 2);
    const size_t hstep = (size_t)HALF * K * 2;
    const size_t tstep = 2 * hstep;
    const unsigned ldsw = (unsigned)wid * 1024u;
    const int aoff = lds_byte(wr * 64 + fr, fq * 8), boff = lds_byte(wc * 32 + fr, fq * 8);
#define PG8_SA(b, h) (((b) * 2 + (h)) * HTB)
#define PG8_SB(b, h) ((4 + (b) * 2 + (h)) * HTB)
#define PG8_STAGE(bufoff, gbase, voff) do { _Pragma("unroll") for (int _i = 0; _i < 2; ++_i) \
        __builtin_amdgcn_global_load_lds((const unsigned*)((const char*)(gbase) + (voff)[_i]), (PG8_LAS unsigned*)(lds + (bufoff) + ldsw + _i * 8192), 16, 0, 0); } while (0)
#define PG8_LDA(dst, b, h) do { _Pragma("unroll") for (int m = 0; m < 4; ++m) _Pragma("unroll") for (int k = 0; k < 2; ++k) dst[m][k] = *(const PG8_LAS bf16x8*)(lds + PG8_SA(b, h) + aoff + m * 2048 + k * 1024); } while (0)
#define PG8_LDB(dst, b, h) do { _Pragma("unroll") for (int n = 0; n < 2; ++n) _Pragma("unroll") for (int k = 0; k < 2; ++k) dst[n][k] = *(const PG8_LAS bf16x8*)(lds + PG8_SB(b, h) + boff + n * 2048 + k * 1024); } while (0)
#define PG8_MMA(ai, bj, At, Bt) do { __builtin_amdgcn_s_setprio(1); _Pragma("unroll") for (int m = 0; m < 4; ++m) _Pragma("unroll") for (int n = 0; n < 2; ++n) _Pragma("unroll") for (int k = 0; k < 2; ++k) \
        acc[ai][bj][m][n] = __builtin_amdgcn_mfma_f32_16x16x32_bf16(Bt[n][k], At[m][k], acc[ai][bj][m][n], 0, 0, 0); __builtin_amdgcn_s_setprio(0); } while (0)
#define PG8_WAIT_V(n) asm volatile("s_waitcnt vmcnt(" #n ")" ::: "memory")
#define PG8_WAIT_L(n) asm volatile("s_waitcnt lgkmcnt(" #n ")" ::: "memory")
#define PG8_BAR __builtin_amdgcn_s_barrier()
#define PG8_SCHED __builtin_amdgcn_sched_barrier(0)
    Unit cur, nxt; int ui = 0;
    if (!S.next(0, cur)) return;
    f32x4 acc[2][2][4][2];
#pragma unroll
    for (int a = 0; a < 2; ++a)
#pragma unroll
        for (int b = 0; b < 2; ++b)
#pragma unroll
            for (int m = 0; m < 4; ++m)
#pragma unroll
                for (int n = 0; n < 2; ++n) acc[a][b][m][n] = (f32x4){0.f, 0.f, 0.f, 0.f};
    bf16x8 At[4][2], B0[2][2], B1[2][2];
    const char* cA = (const char*)g.A + (size_t)cur.pm * tstep; const char* cB = (const char*)g.Bt + (size_t)cur.pn * tstep;
    S.a_ready(cur);
    if constexpr (SP2) {
        PG8_STAGE(PG8_SB(0, 0), cB, voffB); PG8_STAGE(PG8_SB(0, 1), cB + hstep, voffB); PG8_STAGE(PG8_SA(0, 0), cA, voffA); PG8_STAGE(PG8_SA(0, 1), cA + hstep, voffA);
        if (wr == 1) PG8_BAR;
        PG8_WAIT_V(2); PG8_BAR;
        PG8_STAGE(PG8_SB(1, 0), cB + kstep, voffB); PG8_STAGE(PG8_SA(1, 0), cA + kstep, voffA); PG8_STAGE(PG8_SB(1, 1), cB + hstep + kstep, voffB);
        PG8_WAIT_V(6); PG8_BAR;
    } else {
        PG8_STAGE(PG8_SB(0, 0), cB, voffB); PG8_STAGE(PG8_SA(0, 0), cA, voffA); PG8_STAGE(PG8_SB(0, 1), cB + hstep, voffB); PG8_STAGE(PG8_SA(0, 1), cA + hstep, voffA);
        if (wr == 1) PG8_BAR;
        PG8_WAIT_V(4); PG8_BAR;
        PG8_STAGE(PG8_SB(1, 0), cB + kstep, voffB); PG8_STAGE(PG8_SA(1, 0), cA + kstep, voffA); PG8_STAGE(PG8_SB(1, 1), cB + hstep + kstep, voffB);
        PG8_WAIT_V(6); PG8_BAR;
    }
    for (;;) {
        const bool has_next = S.next(ui + 1, nxt);
        const char* nA = has_next ? (const char*)g.A + (size_t)nxt.pm * tstep : cA; const char* nB = has_next ? (const char*)g.Bt + (size_t)nxt.pn * tstep : cB;
        for (int t = 0; t < nt; t += 2) {
            const bool last = (t == nt - 2);
            const char* a1 = cA + (size_t)(t + 1) * kstep;
            const char* a2 = last ? nA : cA + (size_t)(t + 2) * kstep; const char* b2 = last ? nB : cB + (size_t)(t + 2) * kstep;
            const char* a3 = a2 + kstep; const char* b3 = b2 + kstep;
            if (last && has_next) S.a_ready(nxt);
            if constexpr (SP2) {
            PG8_LDB(B0, 0, 0); PG8_LDB(B1, 0, 1); PG8_SCHED; PG8_LDA(At, 0, 0); PG8_STAGE(PG8_SA(1, 1), a1 + hstep, voffA);
            PG8_WAIT_V(8); PG8_WAIT_L(0); PG8_BAR; PG8_MMA(0, 0, At, B0); PG8_MMA(0, 1, At, B1); PG8_BAR; PG8_SCHED;
            PG8_LDA(At, 0, 1); PG8_STAGE(PG8_SB(0, 0), b2, voffB); PG8_STAGE(PG8_SB(0, 1), b2 + hstep, voffB); PG8_STAGE(PG8_SA(0, 0), a2, voffA);
            PG8_WAIT_V(8); PG8_WAIT_L(0); PG8_BAR; PG8_MMA(1, 0, At, B0); PG8_MMA(1, 1, At, B1); PG8_BAR; PG8_SCHED;
            PG8_LDB(B0, 1, 0); PG8_LDB(B1, 1, 1); PG8_SCHED; PG8_LDA(At, 1, 0); PG8_STAGE(PG8_SA(0, 1), a2 + hstep, voffA);
            PG8_WAIT_V(8); PG8_WAIT_L(0); PG8_BAR; PG8_MMA(0, 0, At, B0); PG8_MMA(0, 1, At, B1); PG8_BAR; PG8_SCHED;
            PG8_LDA(At, 1, 1); PG8_STAGE(PG8_SB(1, 0), b3, voffB); PG8_STAGE(PG8_SB(1, 1), b3 + hstep, voffB); PG8_STAGE(PG8_SA(1, 0), a3, voffA);
            PG8_WAIT_V(8); PG8_WAIT_L(0); PG8_BAR; PG8_MMA(1, 0, At, B0); PG8_MMA(1, 1, At, B1); PG8_BAR; PG8_SCHED;
            } else {
            PG8_LDB(B0, 0, 0); PG8_SCHED; PG8_LDA(At, 0, 0); PG8_STAGE(PG8_SA(1, 1), a1 + hstep, voffA);
            PG8_WAIT_L(8); PG8_BAR; PG8_WAIT_L(0); PG8_MMA(0, 0, At, B0); PG8_BAR; PG8_SCHED;
            PG8_LDB(B1, 0, 1); PG8_STAGE(PG8_SB(0, 0), b2, voffB);
            PG8_BAR; PG8_WAIT_L(0); PG8_MMA(0, 1, At, B1); PG8_BAR;
            PG8_LDA(At, 0, 1); PG8_STAGE(PG8_SA(0, 0), a2, voffA);
            PG8_BAR; PG8_WAIT_L(0); PG8_MMA(1, 0, At, B0); PG8_BAR; PG8_SCHED;
            PG8_STAGE(PG8_SB(0, 1), b2 + hstep, voffB);
            PG8_WAIT_V(6); PG8_BAR; PG8_MMA(1, 1, At, B1); PG8_BAR;
            PG8_LDB(B0, 1, 0); PG8_SCHED; PG8_LDA(At, 1, 0); PG8_STAGE(PG8_SA(0, 1), a2 + hstep, voffA);
            PG8_WAIT_L(8); PG8_BAR; PG8_WAIT_L(0); PG8_MMA(0, 0, At, B0); PG8_BAR; PG8_SCHED;
            PG8_LDB(B1, 1, 1); PG8_STAGE(PG8_SB(1, 0), b3, voffB);
            PG8_BAR; PG8_WAIT_L(0); PG8_MMA(0, 1, At, B1); PG8_BAR;
            PG8_LDA(At, 1, 1); PG8_STAGE(PG8_SA(1, 0), a3, voffA);
            PG8_BAR; PG8_WAIT_L(0); PG8_MMA(1, 0, At, B0); PG8_BAR; PG8_SCHED;
            PG8_STAGE(PG8_SB(1, 1), b3 + hstep, voffB);
            PG8_WAIT_V(6); PG8_BAR; PG8_MMA(1, 1, At, B1); PG8_BAR;
            }
        }
        if constexpr (ALIGN_EPI) { if (wr == 0) PG8_BAR; }
        if constexpr (!Epi::AFTER_DRAIN) { E(acc, cur, wr, wc, fr, fq); S.done(cur); }
        if (!has_next) break;
#pragma unroll
        for (int a = 0; a < 2; ++a)
#pragma unroll
            for (int b = 0; b < 2; ++b)
#pragma unroll
                for (int m = 0; m < 4; ++m)
#pragma unroll
                    for (int n = 0; n < 2; ++n) acc[a][b][m][n] = (f32x4){0.f, 0.f, 0.f, 0.f};
        cur = nxt; cA = nA; cB = nB; ++ui;
        if constexpr (ALIGN_EPI) { if (wr == 1) PG8_BAR; }
    }
    PG8_WAIT_V(0);
    if constexpr (!ALIGN_EPI) { if (wr == 0) PG8_BAR; }
    PG8_BAR;
    if constexpr (Epi::AFTER_DRAIN) { E.fused(acc, cur, wr, wc, fr, fq, lds, wid, lane); S.done(cur); }
#undef PG8_SA
#undef PG8_SB
#undef PG8_STAGE
#undef PG8_LDA
#undef PG8_LDB
#undef PG8_MMA
#undef PG8_WAIT_V
#undef PG8_WAIT_L
#undef PG8_BAR
#undef PG8_SCHED
}
}
#define LAS __attribute__((address_space(3)))
typedef float f32x4 __attribute__((ext_vector_type(4)));
struct Ctx { int tid, lane, wave, bid, nb, gw, ngw; unsigned char* lds; };

namespace nv {
__device__ __forceinline__ void d_cvt_bf16(const Ctx& c, const float* __restrict__ in, bf16* __restrict__ out, size_t n4) {
    for (size_t i = (size_t)c.bid * 512 + c.tid; i < n4; i += (size_t)c.nb * 512) { f32x4 v = ((const f32x4*)in)[i]; uint2 o; o.x = pk2bf(v.x, v.y); o.y = pk2bf(v.z, v.w); ((uint2*)out)[i] = o; }
}
__device__ __forceinline__ void d_transpose_w(const Ctx& c, const float* __restrict__ W, int K, int N, int Npad, bf16* __restrict__ WT) {
    float* t = (float*)(c.lds) + c.wave * (32 * 33);
    const int tx = c.lane & 31, ty = c.lane >> 5, nbn = Npad / 32, ntile = nbn * (K / 32);
    for (int it = c.gw; it < ntile; it += c.ngw) {
        const int n0 = (it % nbn) * 32, k0 = (it / nbn) * 32;
        for (int i = ty; i < 32; i += 2) { const int n = n0 + tx; t[i * 33 + tx] = (n < N) ? W[(size_t)(k0 + i) * N + n] : 0.f; }
        __builtin_amdgcn_fence(__ATOMIC_RELEASE, "workgroup"); __builtin_amdgcn_wave_barrier();
        for (int i = ty; i < 32; i += 2) WT[(size_t)(n0 + i) * K + k0 + tx] = f2bf(t[tx * 33 + i]);
        __builtin_amdgcn_fence(__ATOMIC_RELEASE, "workgroup"); __builtin_amdgcn_wave_barrier();
    }
}
__device__ __forceinline__ void d_rope_table(const Ctx& c, float2* __restrict__ tab) {
    for (int id = c.bid * 512 + c.tid; id < SEQ * 32; id += c.nb * 512) {
        const int pos = id >> 5, i = id & 31;
        const float inv = (float)pow(10000.0, -(double)i / 32.0);
        const float ang = (float)pos * inv;
        tab[id] = make_float2((float)cos((double)ang), (float)sin((double)ang));
    }
}
__device__ __forceinline__ void d_rotary(const Ctx& c, const bf16* __restrict__ proj, const float2* __restrict__ tab, bf16* __restrict__ qr, bf16* __restrict__ kr) {
    for (size_t id = (size_t)c.bid * 512 + c.tid; id < (size_t)NTOK * 320; id += (size_t)c.nb * 512) {
        const int d = id & 31, hh = (id >> 5) % 10; const size_t t = id / 320; const int pos = (int)(t % SEQ);
        const float2 cs = tab[pos * 32 + d];
        const bf16* src = proj + t * IN_PAD + hh * 64;
        const float t1 = bf2f(src[d]), t2 = bf2f(src[d + 32]);
        const float o1 = t1 * cs.x - t2 * cs.y, o2 = t2 * cs.x + t1 * cs.y;
        bf16* dst = (hh < 8) ? (qr + t * 512 + hh * 64) : (kr + t * 128 + (hh - 8) * 64);
        dst[d] = f2bf(o1); dst[d + 32] = f2bf(o2);
    }
}
__device__ __forceinline__ void d_attn(const Ctx& c, const bf16* __restrict__ qr, const bf16* __restrict__ kr, const bf16* __restrict__ proj, const float* __restrict__ sink, bf16* __restrict__ mix) {
    for (int id = c.bid * 512 + c.tid; id < NTOK * 8; id += c.nb * 512) {
        const int hq = id & 7, t = id >> 3, b = t / SEQ, i = t % SEQ, kvh = hq >> 2;
        float q[64], acc[64];
#pragma unroll
        for (int d = 0; d < 64; ++d) { q[d] = bf2f(qr[(size_t)t * 512 + hq * 64 + d]) * 0.125f; acc[d] = 0.f; }
        float m = sink[hq], l = 1.f;
        const int j0 = max(0, i - 128), j1 = min(SEQ - 1, i + 128);
        for (int j = j0; j <= j1; ++j) {
            const size_t tj = (size_t)b * SEQ + j;
            const uint4* kp = (const uint4*)(kr + tj * 128 + kvh * 64);
            float s = 0.f;
#pragma unroll
            for (int cc = 0; cc < 8; ++cc) { const uint4 w = kp[cc]; const unsigned ww[4] = {w.x, w.y, w.z, w.w};
#pragma unroll
                for (int e = 0; e < 4; ++e) { s += q[cc * 8 + 2 * e] * __uint_as_float(ww[e] << 16) + q[cc * 8 + 2 * e + 1] * __uint_as_float(ww[e] & 0xffff0000u); } }
            if (s > m) { const float f = __expf(m - s); l *= f;
#pragma unroll
                for (int d = 0; d < 64; ++d) acc[d] *= f;
                m = s; }
            const float p = __expf(s - m); l += p;
            const uint4* vp = (const uint4*)(proj + tj * IN_PAD + C_V + kvh * 64);
#pragma unroll
            for (int cc = 0; cc < 8; ++cc) { const uint4 w = vp[cc]; const unsigned ww[4] = {w.x, w.y, w.z, w.w};
#pragma unroll
                for (int e = 0; e < 4; ++e) { acc[cc * 8 + 2 * e] += p * __uint_as_float(ww[e] << 16); acc[cc * 8 + 2 * e + 1] += p * __uint_as_float(ww[e] & 0xffff0000u); } }
        }
        const float il = 1.f / l;
#pragma unroll
        for (int d = 0; d < 64; d += 2) *(unsigned*)(mix + (size_t)t * DM + hq * 64 + d) = pk2bf(acc[d] * il, acc[d + 1] * il);
    }
}
__device__ __forceinline__ void d_scan(const Ctx& c, const bf16* __restrict__ proj, const float* __restrict__ mu_prev, const float* __restrict__ mu_next,
                                       const float* __restrict__ w0, const float* __restrict__ w2, const float* __restrict__ a0, const float* __restrict__ a2,
                                       const float* __restrict__ k_k, const float* __restrict__ k_a, float* __restrict__ ydir) {
    if (c.wave != 0) return;
    for (int unit = c.bid; unit < 128; unit += c.nb) {
    const int b = unit >> 4, h = (unit >> 1) & 7, d = unit & 1, lane = c.lane, ch = h * 64 + lane;
    float (*sh)[64] = (float (*)[64])c.lds;
    const int colx = lane < 32 ? (P_WD + d * 32 + lane) : (P_AD + d * 32 + lane - 32);
    const int cols[4] = {P_R + ch, P_KK + ch, P_VV + ch, colx};
    float mp[4], mn[4];
#pragma unroll
    for (int q = 0; q < 4; ++q) { mp[q] = mu_prev[cols[q]]; mn[q] = mu_next[cols[q]]; }
    float* w2c = (float*)c.lds + 6 * 64 + lane; float* a2c = w2c + 32 * 64;
    for (int j = 0; j < 32; ++j) { w2c[j * 64] = w2[(size_t)(d * 32 + j) * 512 + ch]; a2c[j * 64] = a2[(size_t)(d * 32 + j) * 512 + ch]; }
    const float w0c = w0[d * 512 + ch], a0c = a0[d * 512 + ch], kkc = k_k[ch], kac = k_a[ch];
    float S[64];
#pragma unroll
    for (int k = 0; k < 64; ++k) S[k] = 0.f;
    const int sgn = d ? -1 : 1; int t = d ? SEQ - 1 : 0;
    const bf16* pb = proj + (size_t)b * SEQ * IN_PAD + C_P;
    float behind[4], cur[4], ahead[4];
#pragma unroll
    for (int q = 0; q < 4; ++q) { behind[q] = 0.f; cur[q] = bf2f(pb[(size_t)t * IN_PAD + cols[q]]); ahead[q] = bf2f(pb[(size_t)(t + sgn) * IN_PAD + cols[q]]); }
    for (int step = 0; step < SEQ; ++step, t += sgn) {
        float ahead2[4]; const int t2 = t + 2 * sgn; const bool ok2 = (t2 >= 0 && t2 < SEQ);
#pragma unroll
        for (int q = 0; q < 4; ++q) ahead2[q] = ok2 ? bf2f(pb[(size_t)t2 * IN_PAD + cols[q]]) : 0.f;
        float sv[4];
#pragma unroll
        for (int q = 0; q < 4; ++q) { const float prv = d ? ahead[q] : behind[q], nxt = d ? behind[q] : ahead[q]; sv[q] = cur[q] + mp[q] * (prv - cur[q]) + mn[q] * (nxt - cur[q]); }
        const float r = sv[0], k = sv[1], v = sv[2];
        sh[5][lane] = lane < 32 ? tanhf(sv[3]) : sv[3];
        __builtin_amdgcn_fence(__ATOMIC_RELEASE, "workgroup"); __builtin_amdgcn_wave_barrier();
        float ws = w0c, as = a0c;
#pragma unroll
        for (int j = 0; j < 32; ++j) { ws += sh[5][j] * w2c[j * 64]; as += sh[5][32 + j] * a2c[j * 64]; }
        const float nsp = -ws; const float sp = (nsp > 20.f) ? nsp : log1pf(__expf(nsp));
        const float wlog = -sp - 0.5f; const float decay = __expf(-__expf(wlog));
        const float a = sigmoidf_(as);
        float kk = k * kkc; const float ss = wave_sum(kk * kk); kk = kk * rsqrtf(fmaxf(ss, 1e-24f));
        const float kd = k * (1.f + (a - 1.f) * kac);
        sh[0][lane] = decay; sh[1][lane] = kk * a; sh[2][lane] = kd; sh[3][lane] = r; sh[4][lane] = kk;
        __builtin_amdgcn_fence(__ATOMIC_RELEASE, "workgroup"); __builtin_amdgcn_wave_barrier();
        float sa = 0.f;
#pragma unroll
        for (int q = 0; q < 64; ++q) sa -= S[q] * sh[4][q];
        float y = 0.f;
#pragma unroll
        for (int q = 0; q < 64; ++q) { S[q] = S[q] * sh[0][q] + sa * sh[1][q] + v * sh[2][q]; y += S[q] * sh[3][q]; }
        ydir[((size_t)d * NTOK + (size_t)b * SEQ + t) * 512 + ch] = y;
        __builtin_amdgcn_fence(__ATOMIC_RELEASE, "workgroup"); __builtin_amdgcn_wave_barrier();
#pragma unroll
        for (int q = 0; q < 4; ++q) { behind[q] = cur[q]; cur[q] = ahead[q]; ahead[q] = ahead2[q]; }
    }
    }
}
template <bool YSINGLE> __device__ __forceinline__ void d_rwkv_out(const Ctx& c, const bf16* __restrict__ proj, const float* __restrict__ ydir, const float* __restrict__ mu_prev, const float* __restrict__ mu_next,
                                           const float* __restrict__ a0, const float* __restrict__ a2, const float* __restrict__ g2, const float* __restrict__ k_a, const float* __restrict__ r_k,
                                           const float* __restrict__ lnx_g, const float* __restrict__ lnx_b, bf16* __restrict__ mix) {
    float* sad = (float*)c.lds; float* sgd = sad + 64; const int ch = c.tid;
    const float mpr = mu_prev[P_R + ch], mnr = mu_next[P_R + ch], mpk = mu_prev[P_KK + ch], mnk = mu_next[P_KK + ch], mpv = mu_prev[P_VV + ch], mnv = mu_next[P_VV + ch];
    const int cx = (ch < 64) ? (P_AD + ch) : (ch < 160 ? P_GD + ch - 64 : 0); const float mpx = mu_prev[cx], mnx = mu_next[cx];
    for (int t = c.bid; t < NTOK; t += c.nb) {
        const int i = t % SEQ; const bf16* p0 = proj + (size_t)t * IN_PAD + C_P;
        const bool hp = i > 0, hn = i < SEQ - 1;
#define SHF(col, mp_, mn_) ({ const float c_ = bf2f(p0[col]); const float pv_ = hp ? bf2f(p0[(col) - IN_PAD]) : 0.f, nx_ = hn ? bf2f(p0[(col) + IN_PAD]) : 0.f; c_ + (mp_) * (pv_ - c_) + (mn_) * (nx_ - c_); })
        if (ch < 64) sad[ch] = SHF(cx, mpx, mnx);
        else if (ch < 160) sgd[ch - 64] = sigmoidf_(SHF(cx, mpx, mnx));
        const float r = SHF(P_R + ch, mpr, mnr), k = SHF(P_KK + ch, mpk, mnk), v = SHF(P_VV + ch, mpv, mnv);
#undef SHF
        __syncthreads();
        asm volatile("" ::: "memory");
        float as0 = a0[ch], as1 = a0[512 + ch];
#pragma unroll 4
        for (int j = 0; j < 32; ++j) { as0 += sad[j] * a2[(size_t)j * 512 + ch]; as1 += sad[32 + j] * a2[(size_t)(32 + j) * 512 + ch]; }
        const float am = 0.5f * (sigmoidf_(as0) + sigmoidf_(as1));
        float g = 0.f;
#pragma unroll 4
        for (int j = 0; j < 96; ++j) g += sgd[j] * g2[(size_t)j * 512 + ch];
        const float y = YSINGLE ? ydir[(size_t)t * 512 + ch] : (ydir[(size_t)t * 512 + ch] + ydir[((size_t)NTOK + t) * 512 + ch]);
        const float mu = wave_sum(y) * (1.f / 64.f); const float dy = y - mu; const float var = wave_sum(dy * dy) * (1.f / 64.f);
        const float yn = dy * rsqrtf(var + GN_EPS) * lnx_g[ch] + lnx_b[ch];
        const float kmean = k * (1.f + (am - 1.f) * k_a[ch]);
        const float bonus = wave_sum(r * kmean * r_k[ch]) * v;
        mix[(size_t)t * DM + 512 + ch] = f2bf((yn + bonus) * g);
        __syncthreads();
    }
}
__device__ __forceinline__ void d_ln1(const Ctx& c, const float* y1, const float* __restrict__ g, const float* __restrict__ bta, float* h1f, bf16* __restrict__ h1b) {
    for (int row = c.gw; row < NTOK; row += c.ngw) {
        const int lane = c.lane;
        const f32x4* xr = (const f32x4*)(y1 + (size_t)row * DM) + lane;
        f32x4 v[4]; float s = 0.f;
#pragma unroll
        for (int j = 0; j < 4; ++j) { v[j] = xr[64 * j]; s += (v[j].x + v[j].y) + (v[j].z + v[j].w); }
        const float mean = wave_sum(s) * (1.f / DM); float s2 = 0.f;
#pragma unroll
        for (int j = 0; j < 4; ++j) { v[j] = v[j] - mean; s2 += (v[j].x * v[j].x + v[j].y * v[j].y) + (v[j].z * v[j].z + v[j].w * v[j].w); }
        const float rstd = rsqrtf(wave_sum(s2) * (1.f / DM) + LN_EPS);
#pragma unroll
        for (int j = 0; j < 4; ++j) { const f32x4 gg = ((const f32x4*)g)[64 * j + lane], bb = ((const f32x4*)bta)[64 * j + lane];
            const f32x4 o = v[j] * rstd * gg + bb;
            ((f32x4*)(h1f + (size_t)row * DM))[64 * j + lane] = o;
            uint2 w; w.x = pk2bf(o.x, o.y); w.y = pk2bf(o.z, o.w); ((uint2*)(h1b + (size_t)row * DM))[64 * j + lane] = w; }
    }
}
__device__ __forceinline__ void d_peer_topk(const Ctx& c, const bf16* __restrict__ qb, const float* __restrict__ keys, int* __restrict__ idx, float* __restrict__ gate) {
    float* keysT = (float*)c.lds; float* sq = keysT + 2 * 128 * 128; float* sc = sq + 256; float* s12 = sc + 256; int* i12 = (int*)(s12 + 32);
    const int tid = c.tid, lane = c.lane, wave = c.wave;
    for (int item = c.bid; item < 8 * 64; item += c.nb) {
        const int h = item & 7, grp = item >> 3;
        __syncthreads();
        for (int e = tid; e < 2 * 128 * 128; e += 512) { const int p = e >> 14, n = (e >> 7) & 127, cc = e & 127; keysT[(p * 128 + cc) * 128 + n] = keys[(size_t)h * 32768 + e]; }
        __syncthreads();
        for (int tt = 0; tt < 512; ++tt) {
            const size_t t = (size_t)grp * 512 + tt;
            if (tid < 256) sq[tid] = bf2f(qb[t * PEER_Q + h * 256 + tid]);
            __syncthreads();
            if (tid < 256) { const int p = tid >> 7, n = tid & 127; float s = 0.f; const float* kt = keysT + p * 16384 + n; const float* qq = sq + p * 128;
                for (int cc = 0; cc < 128; ++cc) s += qq[cc] * kt[cc * 128];
                sc[tid] = s; }
            __syncthreads();
            if (wave < 2) {
                float v0 = sc[wave * 128 + lane], v1 = sc[wave * 128 + 64 + lane];
                for (int r = 0; r < 16; ++r) {
                    float bv; int bi; if (v1 > v0) { bv = v1; bi = lane + 64; } else { bv = v0; bi = lane; }
#pragma unroll
                    for (int o = 1; o < 64; o <<= 1) { const float ov = __shfl_xor(bv, o); const int oi = __shfl_xor(bi, o); if (ov > bv || (ov == bv && oi < bi)) { bv = ov; bi = oi; } }
                    if (lane == 0) { s12[wave * 16 + r] = bv; i12[wave * 16 + r] = bi; }
                    if (bi == lane) v0 = -INFINITY; if (bi == lane + 64) v1 = -INFINITY;
                }
            }
            __syncthreads();
            if (wave == 0) {
                float cv[4];
#pragma unroll
                for (int j = 0; j < 4; ++j) { const int f = lane + 64 * j; cv[j] = s12[f >> 4] + s12[16 + (f & 15)]; }
                float mycs = 0.f; int myid = 0;
                for (int r = 0; r < 16; ++r) {
                    float bv = cv[0]; int bi = lane;
#pragma unroll
                    for (int j = 1; j < 4; ++j) if (cv[j] > bv) { bv = cv[j]; bi = lane + 64 * j; }
#pragma unroll
                    for (int o = 1; o < 64; o <<= 1) { const float ov = __shfl_xor(bv, o); const int oi = __shfl_xor(bi, o); if (ov > bv || (ov == bv && oi < bi)) { bv = ov; bi = oi; } }
                    if (lane == r) { mycs = bv; myid = i12[bi >> 4] * 128 + i12[16 + (bi & 15)]; }
#pragma unroll
                    for (int j = 0; j < 4; ++j) if (bi == lane + 64 * j) cv[j] = -INFINITY;
                }
                float mx = (lane < 16) ? mycs : -INFINITY;
#pragma unroll
                for (int o = 1; o < 64; o <<= 1) mx = fmaxf(mx, __shfl_xor(mx, o));
                const float e = (lane < 16) ? __expf(mycs - mx) : 0.f; const float den = wave_sum(e);
                if (lane < 16) { idx[t * 128 + h * 16 + lane] = myid; gate[t * 128 + h * 16 + lane] = e / den; }
            }
            __syncthreads();
        }
    }
}
__device__ __forceinline__ void d_peer_gather(const Ctx& c, const float* __restrict__ h1f, const int* __restrict__ idx, const float* __restrict__ gate, const float* __restrict__ u, const float* __restrict__ v,
                                              const float* __restrict__ g, const float* __restrict__ bta, float* __restrict__ out) {
    const int lane = c.lane;
    for (int t = c.gw; t < NTOK; t += c.ngw) {
        f32x4 hv[4], f[4];
#pragma unroll
        for (int j = 0; j < 4; ++j) { hv[j] = ((const f32x4*)(h1f + (size_t)t * DM))[64 * j + lane]; f[j] = (f32x4){0.f, 0.f, 0.f, 0.f}; }
        for (int e = 0; e < 128; ++e) {
            const int id = idx[(size_t)t * 128 + e]; const float gt = gate[(size_t)t * 128 + e];
            const f32x4* ur = (const f32x4*)(u + (size_t)id * DM); const f32x4* vr = (const f32x4*)(v + (size_t)id * DM);
            float z = 0.f;
#pragma unroll
            for (int j = 0; j < 4; ++j) { const f32x4 w = ur[64 * j + lane]; z += (w.x * hv[j].x + w.y * hv[j].y) + (w.z * hv[j].z + w.w * hv[j].w); }
            z = wave_sum(z);
            const float act = gt * 0.5f * z * (1.f + erff(z * 0.70710678118654752f));
#pragma unroll
            for (int j = 0; j < 4; ++j) { const f32x4 w = vr[64 * j + lane]; f[j] += act * w; }
        }
        float s = 0.f;
#pragma unroll
        for (int j = 0; j < 4; ++j) { f[j] = DN_ALPHA * hv[j] + f[j]; s += (f[j].x + f[j].y) + (f[j].z + f[j].w); }
        const float mean = wave_sum(s) * (1.f / DM); float s2 = 0.f;
#pragma unroll
        for (int j = 0; j < 4; ++j) { f[j] = f[j] - mean; s2 += (f[j].x * f[j].x + f[j].y * f[j].y) + (f[j].z * f[j].z + f[j].w * f[j].w); }
        const float rstd = rsqrtf(wave_sum(s2) * (1.f / DM) + LN_EPS);
#pragma unroll
        for (int j = 0; j < 4; ++j) { const f32x4 gg = ((const f32x4*)g)[64 * j + lane], bb = ((const f32x4*)bta)[64 * j + lane];
            ((f32x4*)(out + (size_t)t * DM))[64 * j + lane] = f[j] * rstd * gg + bb; }
    }
}
}
namespace pe {
typedef __bf16 bf16x2_t __attribute__((ext_vector_type(2)));
__device__ __forceinline__ float dot2(unsigned a, unsigned b, float c) { return __builtin_amdgcn_fdot2_f32_bf16(__builtin_bit_cast(bf16x2_t, a), __builtin_bit_cast(bf16x2_t, b), c, false); }
__device__ __forceinline__ float gelu_erf(float z) { return 0.5f * z * (1.f + erff(z * 0.70710678118654752f)); }
constexpr int GE = 4;
struct Rows { uint4 a[GE], b[GE]; };
__device__ __forceinline__ void load_rows(Rows& r, const bf16* __restrict__ tab, int i0, int i1, int lane, int g) {
#pragma unroll
    for (int j = 0; j < GE; ++j) { const int e = g * GE + j; const int id = __builtin_amdgcn_readlane((e & 64) ? i1 : i0, e & 63);
        const uint4* p = (const uint4*)(tab + (size_t)id * DM) + lane; r.a[j] = p[0]; r.b[j] = p[64]; }
}
__device__ __forceinline__ void d_peer_gather(const Ctx& c, const bf16* __restrict__ h1b, const int* __restrict__ idx, const float* __restrict__ gate, const bf16* __restrict__ ub, const bf16* __restrict__ vb,
                                              const float* __restrict__ g, const float* __restrict__ bta, float* __restrict__ out) {
    const int lane = c.lane;
    for (int t = c.gw; t < NTOK; t += c.ngw) {
        const uint4* hp = (const uint4*)(h1b + (size_t)t * DM) + lane; const uint4 h0 = hp[0], h1 = hp[64];
        const unsigned hw[8] = {h0.x, h0.y, h0.z, h0.w, h1.x, h1.y, h1.z, h1.w};
        const int i0 = idx[(size_t)t * 128 + lane], i1 = idx[(size_t)t * 128 + 64 + lane];
        const float g0 = gate[(size_t)t * 128 + lane], g1 = gate[(size_t)t * 128 + 64 + lane];
        float f[16];
#pragma unroll
        for (int i = 0; i < 16; ++i) f[i] = 0.f;
        Rows U, V, Un;
        load_rows(U, ub, i0, i1, lane, 0);
        for (int grp = 0; grp < 128 / GE; ++grp) {
            load_rows(V, vb, i0, i1, lane, grp);
            if (grp + 1 < 128 / GE) load_rows(Un, ub, i0, i1, lane, grp + 1);
            float z[GE];
#pragma unroll
            for (int j = 0; j < GE; ++j) { const unsigned uw[8] = {U.a[j].x, U.a[j].y, U.a[j].z, U.a[j].w, U.b[j].x, U.b[j].y, U.b[j].z, U.b[j].w}; float s = 0.f;
#pragma unroll
                for (int i = 0; i < 8; ++i) s = dot2(uw[i], hw[i], s);
                z[j] = s; }
            { const bool b0 = lane & 1; float k0 = b0 ? z[1] : z[0], s0 = b0 ? z[0] : z[1], k1 = b0 ? z[3] : z[2], s1 = b0 ? z[2] : z[3];
              k0 += __shfl_xor(s0, 1); k1 += __shfl_xor(s1, 1);
              const bool b1 = lane & 2; float kk = b1 ? k1 : k0, ss = b1 ? k0 : k1; kk += __shfl_xor(ss, 2);
              kk += __shfl_xor(kk, 4); kk += __shfl_xor(kk, 8); kk += __shfl_xor(kk, 16); kk += __shfl_xor(kk, 32);
              z[0] = kk; }
            const int e_me = grp * GE + (lane & 3);
            const float gt = __shfl((e_me & 64) ? g1 : g0, e_me & 63);
            const float act = gt * gelu_erf(z[0]);
            const unsigned actb = (unsigned)f2bf(act);
#pragma unroll
            for (int j = 0; j < GE; ++j) { const unsigned alo = __builtin_amdgcn_readlane(actb, j), ahi = alo << 16;
                const unsigned vw[8] = {V.a[j].x, V.a[j].y, V.a[j].z, V.a[j].w, V.b[j].x, V.b[j].y, V.b[j].z, V.b[j].w};
#pragma unroll
                for (int i = 0; i < 8; ++i) { f[2 * i] = dot2(vw[i], alo, f[2 * i]); f[2 * i + 1] = dot2(vw[i], ahi, f[2 * i + 1]); } }
            U = Un;
        }
        float s = 0.f;
#pragma unroll
        for (int i = 0; i < 8; ++i) { f[2 * i] += DN_ALPHA * __uint_as_float(hw[i] << 16); f[2 * i + 1] += DN_ALPHA * __uint_as_float(hw[i] & 0xffff0000u); s += f[2 * i] + f[2 * i + 1]; }
        const float mean = wave_sum(s) * (1.f / DM); float s2 = 0.f;
#pragma unroll
        for (int i = 0; i < 16; ++i) { f[i] -= mean; s2 += f[i] * f[i]; }
        const float rstd = rsqrtf(wave_sum(s2) * (1.f / DM) + LN_EPS);
#pragma unroll
        for (int hh = 0; hh < 2; ++hh) {
            const int e0 = hh * 512 + 8 * lane;
            const f32x4 ga = *(const f32x4*)(g + e0), gb = *(const f32x4*)(g + e0 + 4), ba = *(const f32x4*)(bta + e0), bb = *(const f32x4*)(bta + e0 + 4);
            f32x4 oa, ob;
            oa.x = f[hh * 8 + 0] * rstd * ga.x + ba.x; oa.y = f[hh * 8 + 1] * rstd * ga.y + ba.y; oa.z = f[hh * 8 + 2] * rstd * ga.z + ba.z; oa.w = f[hh * 8 + 3] * rstd * ga.w + ba.w;
            ob.x = f[hh * 8 + 4] * rstd * gb.x + bb.x; ob.y = f[hh * 8 + 5] * rstd * gb.y + bb.y; ob.z = f[hh * 8 + 6] * rstd * gb.z + bb.z; ob.w = f[hh * 8 + 7] * rstd * gb.w + bb.w;
            *(f32x4*)(out + (size_t)t * DM + e0) = oa; *(f32x4*)(out + (size_t)t * DM + e0 + 4) = ob;
        }
    }
}
}
namespace pe8 {
typedef float f32x2 __attribute__((ext_vector_type(2)));
__device__ __forceinline__ void d_quant_tables(const Ctx& c, const float* __restrict__ u, const float* __restrict__ v, unsigned* __restrict__ u8, unsigned* __restrict__ v8, float* __restrict__ su, float* __restrict__ sv) {
    const int lane = c.lane;
    for (int r = c.gw; r < 2 * NEXP; r += c.ngw) {
        const bool isv = r >= NEXP; const int row = isv ? r - NEXP : r;
        const f32x4* src = (const f32x4*)((isv ? v : u) + (size_t)row * DM) + lane;
        f32x4 x[4]; float am = 0.f;
#pragma unroll
        for (int j = 0; j < 4; ++j) { x[j] = src[64 * j]; am = fmaxf(am, fmaxf(fmaxf(fabsf(x[j].x), fabsf(x[j].y)), fmaxf(fabsf(x[j].z), fabsf(x[j].w)))); }
#pragma unroll
        for (int o = 1; o < 64; o <<= 1) am = fmaxf(am, __shfl_xor(am, o));
        am = fmaxf(am, 1e-30f);
        if (!isv) { const float sc = am * (1.f / 127.f), is = 127.f / am;
#pragma unroll
            for (int j = 0; j < 4; ++j) { const int a = (int)rintf(x[j].x * is), b = (int)rintf(x[j].y * is), cc = (int)rintf(x[j].z * is), d = (int)rintf(x[j].w * is);
                u8[(size_t)row * 256 + 64 * j + lane] = (unsigned)(a & 255) | ((unsigned)(b & 255) << 8) | ((unsigned)(cc & 255) << 16) | ((unsigned)(d & 255) << 24); }
            if (lane == 0) su[row] = sc; }
        else { const float sc = am * (1.f / 440.f), is = 440.f / am;
#pragma unroll
            for (int j = 0; j < 4; ++j) { int w = 0; w = __builtin_amdgcn_cvt_pk_fp8_f32(x[j].x * is, x[j].y * is, w, false); w = __builtin_amdgcn_cvt_pk_fp8_f32(x[j].z * is, x[j].w * is, w, true);
                v8[(size_t)row * 256 + 64 * j + lane] = (unsigned)w; }
            if (lane == 0) sv[row] = sc; }
    }
}
constexpr int GE = 8;
struct Rows { uint4 a[GE]; };
__device__ __forceinline__ void load_rows(Rows& r, const unsigned* __restrict__ tab, int i0, int i1, int lane, int g) {
#pragma unroll
    for (int j = 0; j < GE; ++j) { const int e = g * GE + j; const int id = __builtin_amdgcn_readlane((e & 64) ? i1 : i0, e & 63); r.a[j] = *((const uint4*)(tab + (size_t)id * 256) + lane); }
}
__device__ __forceinline__ void d_peer_gather(const Ctx& c, const bf16* __restrict__ h1b, const int* __restrict__ idx, const float* __restrict__ gate, const unsigned* __restrict__ u8, const unsigned* __restrict__ v8,
                                              const float* __restrict__ su, const float* __restrict__ sv, const float* __restrict__ g, const float* __restrict__ bta, float* __restrict__ out, const int imask = 0x3fff) {
    const int lane = c.lane;
    for (int t = c.gw; t < NTOK; t += c.ngw) {
        const uint4* hp = (const uint4*)(h1b + (size_t)t * DM) + 2 * lane; const uint4 ha = hp[0], hb = hp[1];
        const unsigned hw[8] = {ha.x, ha.y, ha.z, ha.w, hb.x, hb.y, hb.z, hb.w};
        float hf[16]; float am = 0.f;
#pragma unroll
        for (int i = 0; i < 8; ++i) { hf[2 * i] = __uint_as_float(hw[i] << 16); hf[2 * i + 1] = __uint_as_float(hw[i] & 0xffff0000u); am = fmaxf(am, fmaxf(fabsf(hf[2 * i]), fabsf(hf[2 * i + 1]))); }
#pragma unroll
        for (int o = 1; o < 64; o <<= 1) am = fmaxf(am, __shfl_xor(am, o));
        am = fmaxf(am, 1e-30f);
        const float sh = am * (1.f / 127.f), ish = 127.f / am;
        int hq[4];
#pragma unroll
        for (int w = 0; w < 4; ++w) { const int a = (int)rintf(hf[4 * w] * ish), b = (int)rintf(hf[4 * w + 1] * ish), cc = (int)rintf(hf[4 * w + 2] * ish), d = (int)rintf(hf[4 * w + 3] * ish);
            hq[w] = (int)((unsigned)(a & 255) | ((unsigned)(b & 255) << 8) | ((unsigned)(cc & 255) << 16) | ((unsigned)(d & 255) << 24)); }
        const int i0 = idx[(size_t)t * 128 + lane] & imask, i1 = idx[(size_t)t * 128 + 64 + lane] & imask;
        const float g0 = gate[(size_t)t * 128 + lane], g1 = gate[(size_t)t * 128 + 64 + lane];
        float f[16];
#pragma unroll
        for (int i = 0; i < 16; ++i) f[i] = 0.f;
        Rows U, V, Un;
        load_rows(U, u8, i0, i1, lane, 0);
        float sun, svn;
        { const int e_me = lane & 7; const int id = __shfl((e_me & 64) ? i1 : i0, e_me & 63); sun = su[id]; svn = sv[id]; }
#pragma unroll 1
        for (int grp = 0; grp < 128 / GE; ++grp) {
            load_rows(V, v8, i0, i1, lane, grp);
            const float suc = sun, svc = svn;
            if (grp + 1 < 128 / GE) { load_rows(Un, u8, i0, i1, lane, grp + 1); const int e_n = (grp + 1) * GE + (lane & 7); const int id = __shfl((e_n & 64) ? i1 : i0, e_n & 63); sun = su[id]; svn = sv[id]; }
            int z[GE];
#pragma unroll
            for (int j = 0; j < GE; ++j) { int s = __builtin_amdgcn_sdot4((int)U.a[j].x, hq[0], 0, false); s = __builtin_amdgcn_sdot4((int)U.a[j].y, hq[1], s, false);
                s = __builtin_amdgcn_sdot4((int)U.a[j].z, hq[2], s, false); s = __builtin_amdgcn_sdot4((int)U.a[j].w, hq[3], s, false); z[j] = s; }
            int zz;
            { const bool b0 = lane & 1, b1 = lane & 2, b2 = lane & 4;
              int k0 = b0 ? z[1] : z[0], s0 = b0 ? z[0] : z[1], k1 = b0 ? z[3] : z[2], s1 = b0 ? z[2] : z[3], k2 = b0 ? z[5] : z[4], s2 = b0 ? z[4] : z[5], k3 = b0 ? z[7] : z[6], s3 = b0 ? z[6] : z[7];
              k0 += __shfl_xor(s0, 1); k1 += __shfl_xor(s1, 1); k2 += __shfl_xor(s2, 1); k3 += __shfl_xor(s3, 1);
              int m0 = b1 ? k1 : k0, t0_ = b1 ? k0 : k1, m1 = b1 ? k3 : k2, t1_ = b1 ? k2 : k3;
              m0 += __shfl_xor(t0_, 2); m1 += __shfl_xor(t1_, 2);
              int q0 = b2 ? m1 : m0, r0 = b2 ? m0 : m1; q0 += __shfl_xor(r0, 4);
              q0 += __shfl_xor(q0, 8); q0 += __shfl_xor(q0, 16); q0 += __shfl_xor(q0, 32); zz = q0; }
            const int e_me = grp * GE + (lane & 7);
            const float gt = __shfl((e_me & 64) ? g1 : g0, e_me & 63);
            const float zf = (float)zz * sh * suc;
            const float act = gt * pe::gelu_erf(zf) * svc;
#pragma unroll
            for (int j = 0; j < GE; ++j) { const float aj = __uint_as_float(__builtin_amdgcn_readlane(__float_as_uint(act), j));
                const unsigned vw[4] = {V.a[j].x, V.a[j].y, V.a[j].z, V.a[j].w};
#pragma unroll
                for (int w = 0; w < 4; ++w) { const f32x2 lo = __builtin_amdgcn_cvt_pk_f32_fp8((int)vw[w], false), hi = __builtin_amdgcn_cvt_pk_f32_fp8((int)vw[w], true);
                    f[4 * w] += aj * lo.x; f[4 * w + 1] += aj * lo.y; f[4 * w + 2] += aj * hi.x; f[4 * w + 3] += aj * hi.y; }
                __builtin_amdgcn_sched_barrier(0); }
            U = Un;
        }
        float s = 0.f;
#pragma unroll
        for (int i = 0; i < 16; ++i) { f[i] += DN_ALPHA * hf[i]; s += f[i]; }
        const float mean = wave_sum(s) * (1.f / DM); float s2 = 0.f;
#pragma unroll
        for (int i = 0; i < 16; ++i) { f[i] -= mean; s2 += f[i] * f[i]; }
        const float rstd = rsqrtf(wave_sum(s2) * (1.f / DM) + LN_EPS);
        const int e0 = 16 * lane;
#pragma unroll
        for (int q = 0; q < 4; ++q) { const f32x4 ga = *(const f32x4*)(g + e0 + 4 * q), ba = *(const f32x4*)(bta + e0 + 4 * q); f32x4 o;
            o.x = f[4 * q] * rstd * ga.x + ba.x; o.y = f[4 * q + 1] * rstd * ga.y + ba.y; o.z = f[4 * q + 2] * rstd * ga.z + ba.z; o.w = f[4 * q + 3] * rstd * ga.w + ba.w;
            *(f32x4*)(out + (size_t)t * DM + e0 + 4 * q) = o; }
    }
}
}
namespace px {
typedef float f32x2 __attribute__((ext_vector_type(2)));
typedef unsigned u32x4 __attribute__((ext_vector_type(4)));
constexpr int CW_XRANK = 8192;
__device__ __forceinline__ void d_quant_tables(const Ctx& c, const float* __restrict__ u, const float* __restrict__ v, unsigned* __restrict__ u8, unsigned* __restrict__ v8, float* __restrict__ su, float* __restrict__ sv) {
    const int lane = c.lane;
    for (int r = c.gw; r < 2 * NEXP; r += c.ngw) {
        const bool isv = r >= NEXP; const int row = isv ? r - NEXP : r;
        const f32x4* src = (const f32x4*)((isv ? v : u) + (size_t)row * DM) + lane;
        f32x4 x[4]; float am = 0.f;
#pragma unroll
        for (int j = 0; j < 4; ++j) { x[j] = src[64 * j]; am = fmaxf(am, fmaxf(fmaxf(fabsf(x[j].x), fabsf(x[j].y)), fmaxf(fabsf(x[j].z), fabsf(x[j].w)))); }
#pragma unroll
        for (int o = 1; o < 64; o <<= 1) am = fmaxf(am, __shfl_xor(am, o));
        am = fmaxf(am, 1e-30f);
        if (!isv) { const float sc = am * (1.f / 127.f), is = 127.f / am;
#pragma unroll
            for (int j = 0; j < 4; ++j) { const int a = (int)rintf(x[j].x * is), b = (int)rintf(x[j].y * is), cc = (int)rintf(x[j].z * is), d = (int)rintf(x[j].w * is);
                u8[((size_t)(2 * j + (lane >> 5)) * NEXP + row) * 32 + (lane & 31)] = (unsigned)(a & 255) | ((unsigned)(b & 255) << 8) | ((unsigned)(cc & 255) << 16) | ((unsigned)(d & 255) << 24); }
            if (lane == 0) su[row] = sc; }
        else { const float sc = am * (1.f / 440.f), is = 440.f / am;
#pragma unroll
            for (int j = 0; j < 4; ++j) { int w = 0; w = __builtin_amdgcn_cvt_pk_fp8_f32(x[j].x * is, x[j].y * is, w, false); w = __builtin_amdgcn_cvt_pk_fp8_f32(x[j].z * is, x[j].w * is, w, true);
                v8[((size_t)(2 * j + (lane >> 5)) * NEXP + row) * 32 + (lane & 31)] = (unsigned)w; }
            if (lane == 0) sv[row] = sc; }
    }
}
__device__ __forceinline__ void d_quant_h(const Ctx& c, const bf16* __restrict__ h1b, unsigned* __restrict__ h8, float* __restrict__ shs) {
    const int lane = c.lane;
    for (int t = c.gw; t < NTOK; t += c.ngw) {
        const uint4* hp = (const uint4*)(h1b + (size_t)t * DM) + 2 * lane; const uint4 ha = hp[0], hb = hp[1];
        const unsigned hw[8] = {ha.x, ha.y, ha.z, ha.w, hb.x, hb.y, hb.z, hb.w};
        float hf[16]; float am = 0.f;
#pragma unroll
        for (int i = 0; i < 8; ++i) { hf[2 * i] = __uint_as_float(hw[i] << 16); hf[2 * i + 1] = __uint_as_float(hw[i] & 0xffff0000u); am = fmaxf(am, fmaxf(fabsf(hf[2 * i]), fabsf(hf[2 * i + 1]))); }
#pragma unroll
        for (int o = 1; o < 64; o <<= 1) am = fmaxf(am, __shfl_xor(am, o));
        am = fmaxf(am, 1e-30f);
        const float ish = 127.f / am; u32x4 q;
#pragma unroll
        for (int w = 0; w < 4; ++w) { const int a = (int)rintf(hf[4 * w] * ish), b = (int)rintf(hf[4 * w + 1] * ish), cc = (int)rintf(hf[4 * w + 2] * ish), d = (int)rintf(hf[4 * w + 3] * ish);
            q[w] = (unsigned)(a & 255) | ((unsigned)(b & 255) << 8) | ((unsigned)(cc & 255) << 16) | ((unsigned)(d & 255) << 24); }
        *(u32x4*)(h8 + ((size_t)(lane >> 3) * NTOK + t) * 32 + 4 * (lane & 7)) = q;
        if (lane == 0) shs[t] = am * (1.f / 127.f);
    }
}
struct Grp { int g, r, n; };
__device__ __forceinline__ Grp group_of(const Ctx& c, const unsigned* __restrict__ ctl, int xcc, int rank) {
    unsigned cnt[8]; bool ok = true; unsigned tot = 0;
#pragma unroll
    for (int j = 0; j < 8; ++j) { cnt[j] = __hip_atomic_load(ctl + CW_XRANK + j, __ATOMIC_RELAXED, __HIP_MEMORY_SCOPE_AGENT); ok = ok && cnt[j] > 0; tot += cnt[j]; }
    ok = ok && tot == (unsigned)c.nb && xcc < 8;
    Grp G;
    if (ok) { G.g = xcc; G.r = rank; G.n = (int)(xcc == 0 ? cnt[0] : xcc == 1 ? cnt[1] : xcc == 2 ? cnt[2] : xcc == 3 ? cnt[3] : xcc == 4 ? cnt[4] : xcc == 5 ? cnt[5] : xcc == 6 ? cnt[6] : cnt[7]); }
    else { G.g = c.bid & 7; G.r = c.bid >> 3; G.n = (c.nb - G.g + 7) >> 3; }
    return G;
}
template <int CTRL> __device__ __forceinline__ int dppi(int x) { return __builtin_amdgcn_update_dpp(0, x, CTRL, 0xf, 0xf, true); }
template <int CTRL> __device__ __forceinline__ float dppf(float x) { return __uint_as_float(__builtin_amdgcn_update_dpp(0u, __float_as_uint(x), CTRL, 0xf, 0xf, true)); }
__device__ __forceinline__ int sum8i(int s) { s += dppi<0xB1>(s); s += dppi<0x4E>(s); s += dppi<0x141>(s); return s; }
__device__ __forceinline__ float sum_rw(float x) {
    x += dppf<0x128>(x);
    { auto r = __builtin_amdgcn_permlane16_swap(__float_as_uint(x), __float_as_uint(x), false, false); x = __uint_as_float(r[0]) + __uint_as_float(r[1]); }
    { auto r = __builtin_amdgcn_permlane32_swap(__float_as_uint(x), __float_as_uint(x), false, false); x = __uint_as_float(r[0]) + __uint_as_float(r[1]); }
    return x;
}
struct StIn { u32x4 ia, ib, xa, xb; };
__device__ __forceinline__ void d_g1(const Ctx& c, const Grp G, const unsigned* __restrict__ h8, const int* __restrict__ idx, const unsigned* __restrict__ u8, int* __restrict__ zp) {
    const int lane = c.lane, p = lane & 7, rw = lane >> 3, step = G.n * 8, t0 = G.r * 8 + c.wave;
    const unsigned* ut = u8 + (size_t)G.g * NEXP * 32 + 4 * p;
    const unsigned* hb = h8 + (size_t)G.g * NTOK * 32 + 4 * p;
    auto ld_in = [&](int st, StIn& si) { int t = t0 + (st >> 1) * step; t = t < NTOK ? t : NTOK - 1; const u32x4* ip = (const u32x4*)(idx + (size_t)t * 128 + 16 * rw + 8 * (st & 1)); si.ia = ip[0]; si.ib = ip[1]; si.xa = *(const u32x4*)(hb + (size_t)t * 32); };
    auto ld_rows = [&](const StIn& si, u32x4 (&rows)[8]) {
#pragma unroll
        for (int j = 0; j < 8; ++j) { const unsigned id = j < 4 ? si.ia[j] : si.ib[j - 4]; rows[j] = *(const u32x4*)(ut + (size_t)id * 32); } };
    auto red = [&](const u32x4 (&rows)[8], const StIn& si, int (&z)[8]) {
#pragma unroll
        for (int j = 0; j < 8; ++j) { int s = __builtin_amdgcn_sdot4((int)rows[j][0], (int)si.xa[0], 0, false); s = __builtin_amdgcn_sdot4((int)rows[j][1], (int)si.xa[1], s, false);
            s = __builtin_amdgcn_sdot4((int)rows[j][2], (int)si.xa[2], s, false); s = __builtin_amdgcn_sdot4((int)rows[j][3], (int)si.xa[3], s, false); z[j] = sum8i(s); } };
    StIn S0, S1, S2, S3; u32x4 R0[8], R1[8];
    ld_in(0, S0); ld_in(1, S1); ld_rows(S0, R0);
#pragma unroll 1
    for (int k = 0; t0 + k * step < NTOK; ++k) {
        const int t = t0 + k * step; int z0[8], z1[8];
        ld_in(2 * k + 2, S2); ld_rows(S1, R1); red(R0, S0, z0);
        ld_in(2 * k + 3, S3); ld_rows(S2, R0); red(R1, S1, z1);
        if (p == 0) { u32x4* zo = (u32x4*)(zp + ((size_t)G.g * NTOK + t) * 128 + 16 * rw);
            zo[0] = (u32x4){(unsigned)z0[0], (unsigned)z0[1], (unsigned)z0[2], (unsigned)z0[3]}; zo[1] = (u32x4){(unsigned)z0[4], (unsigned)z0[5], (unsigned)z0[6], (unsigned)z0[7]};
            zo[2] = (u32x4){(unsigned)z1[0], (unsigned)z1[1], (unsigned)z1[2], (unsigned)z1[3]}; zo[3] = (u32x4){(unsigned)z1[4], (unsigned)z1[5], (unsigned)z1[6], (unsigned)z1[7]}; }
        S0 = S2; S1 = S3;
    }
}
__device__ __forceinline__ void d_g2(const Ctx& c, const int* __restrict__ zp, const int* __restrict__ idx, const float* __restrict__ shs, const float* __restrict__ su, const float* __restrict__ sv, float* __restrict__ gate) {
    for (size_t i = (size_t)c.bid * 512 + c.tid; i < (size_t)NTOK * 128; i += (size_t)c.nb * 512) {
        int s = 0;
#pragma unroll
        for (int g = 0; g < 8; ++g) s += zp[(size_t)g * NTOK * 128 + i];
        const int id = idx[i]; const float z = (float)s * shs[i >> 7] * su[id];
        gate[i] = gate[i] * pe::gelu_erf(z) * sv[id];
    }
}
__device__ __forceinline__ void d_g3(const Ctx& c, const Grp G, const bf16* __restrict__ h1b, const int* __restrict__ idx, const float* __restrict__ act, const unsigned* __restrict__ v8, float* __restrict__ y2) {
    const int lane = c.lane, p = lane & 7, rw = lane >> 3, step = G.n * 8, t0 = G.r * 8 + c.wave;
    const unsigned* vt = v8 + (size_t)G.g * NEXP * 32 + 4 * p;
    auto ld_in = [&](int st, StIn& si) { int t = t0 + (st >> 1) * step; t = t < NTOK ? t : NTOK - 1; const size_t o = (size_t)t * 128 + 16 * rw + 8 * (st & 1);
        const u32x4* ip = (const u32x4*)(idx + o); si.ia = ip[0]; si.ib = ip[1]; const u32x4* ap = (const u32x4*)(act + o); si.xa = ap[0]; si.xb = ap[1]; };
    auto ld_rows = [&](const StIn& si, u32x4 (&rows)[8]) {
#pragma unroll
        for (int j = 0; j < 8; ++j) { const unsigned id = j < 4 ? si.ia[j] : si.ib[j - 4]; rows[j] = *(const u32x4*)(vt + (size_t)id * 32); } };
    auto acc = [&](const u32x4 (&rows)[8], const StIn& si, f32x2 (&f2)[8]) {
#pragma unroll
        for (int j = 0; j < 8; ++j) { const float a = __uint_as_float(j < 4 ? si.xa[j] : si.xb[j - 4]); const f32x2 a2 = {a, a};
#pragma unroll
            for (int w = 0; w < 4; ++w) { const f32x2 lo = __builtin_amdgcn_cvt_pk_f32_fp8((int)rows[j][w], false), hi = __builtin_amdgcn_cvt_pk_f32_fp8((int)rows[j][w], true);
                f2[2 * w] = __builtin_elementwise_fma(a2, lo, f2[2 * w]); f2[2 * w + 1] = __builtin_elementwise_fma(a2, hi, f2[2 * w + 1]); }
            __builtin_amdgcn_sched_barrier(0); } };
    StIn S0, S1, S2, S3; u32x4 R0[8], R1[8];
    ld_in(0, S0); ld_in(1, S1); ld_rows(S0, R0);
#pragma unroll 1
    for (int k = 0; t0 + k * step < NTOK; ++k) {
        const int t = t0 + k * step; f32x2 f2[8];
#pragma unroll
        for (int i = 0; i < 8; ++i) f2[i] = (f32x2){0.f, 0.f};
        ld_in(2 * k + 2, S2); ld_rows(S1, R1); acc(R0, S0, f2);
        ld_in(2 * k + 3, S3); ld_rows(S2, R0); acc(R1, S1, f2);
        float f[16];
#pragma unroll
        for (int i = 0; i < 8; ++i) { f[2 * i] = sum_rw(f2[i].x); f[2 * i + 1] = sum_rw(f2[i].y); }
        if (rw == 0) {
            const uint4* hp = (const uint4*)(h1b + (size_t)t * DM + 128 * G.g + 16 * p); const uint4 ha = hp[0], hb = hp[1];
            const unsigned hw[8] = {ha.x, ha.y, ha.z, ha.w, hb.x, hb.y, hb.z, hb.w};
            float* yo = y2 + (size_t)t * DM + 128 * G.g + 16 * p;
#pragma unroll
            for (int q = 0; q < 4; ++q) { f32x4 o;
                o.x = f[4 * q] + DN_ALPHA * __uint_as_float(hw[2 * q] << 16); o.y = f[4 * q + 1] + DN_ALPHA * __uint_as_float(hw[2 * q] & 0xffff0000u);
                o.z = f[4 * q + 2] + DN_ALPHA * __uint_as_float(hw[2 * q + 1] << 16); o.w = f[4 * q + 3] + DN_ALPHA * __uint_as_float(hw[2 * q + 1] & 0xffff0000u);
                *(f32x4*)(yo + 4 * q) = o; }
        }
        S0 = S2; S1 = S3;
    }
}
__device__ __forceinline__ void d_g4(const Ctx& c, const float* __restrict__ y2, const float* __restrict__ g, const float* __restrict__ bta, float* __restrict__ out) {
    const int lane = c.lane;
    for (int row = c.gw; row < NTOK; row += c.ngw) {
        const f32x4* xr = (const f32x4*)(y2 + (size_t)row * DM) + lane;
        f32x4 v[4]; float s = 0.f;
#pragma unroll
        for (int j = 0; j < 4; ++j) { v[j] = xr[64 * j]; s += (v[j].x + v[j].y) + (v[j].z + v[j].w); }
        const float mean = wave_sum(s) * (1.f / DM); float s2 = 0.f;
#pragma unroll
        for (int j = 0; j < 4; ++j) { v[j] = v[j] - mean; s2 += (v[j].x * v[j].x + v[j].y * v[j].y) + (v[j].z * v[j].z + v[j].w * v[j].w); }
        const float rstd = rsqrtf(wave_sum(s2) * (1.f / DM) + LN_EPS);
#pragma unroll
        for (int j = 0; j < 4; ++j) { const f32x4 gg = ((const f32x4*)g)[64 * j + lane], bb = ((const f32x4*)bta)[64 * j + lane];
            ((f32x4*)(out + (size_t)row * DM))[64 * j + lane] = v[j] * rstd * gg + bb; }
    }
}
}
namespace rw {
typedef short bf16x8 __attribute__((ext_vector_type(8)));
typedef short s16x4 __attribute__((ext_vector_type(4)));
typedef float f32x16 __attribute__((ext_vector_type(16)));
typedef float f32x2_t __attribute__((ext_vector_type(2)));
typedef __bf16 bf16x2_t __attribute__((ext_vector_type(2)));
typedef unsigned u32x4 __attribute__((ext_vector_type(4)));
typedef unsigned u32x2 __attribute__((ext_vector_type(2)));
typedef LAS unsigned char* lptr;
#define MFMA32(a, b, c) __builtin_amdgcn_mfma_f32_32x32x16_bf16((a), (b), (c), 0, 0, 0)
#define DI __device__ __forceinline__
constexpr int UNIT_BYTES = 10 * 2048;
constexpr int STG_STRIDE = 392;
constexpr int CST_OFF = 131072, GC_OFF = 131072 + 4096;

DI int crow(int i, int h) { return (i & 3) + 8 * (i >> 2) + 4 * h; }
DI unsigned cvtpk(float lo, float hi) { f32x2_t v = {lo, hi}; bf16x2_t b = __builtin_convertvector(v, bf16x2_t); return __builtin_bit_cast(unsigned, b); }
DI bf16x8 pack(const f32x16& x, int s) { u32x4 p; p[0] = cvtpk(x[8 * s], x[8 * s + 1]); p[1] = cvtpk(x[8 * s + 2], x[8 * s + 3]); p[2] = cvtpk(x[8 * s + 4], x[8 * s + 5]); p[3] = cvtpk(x[8 * s + 6], x[8 * s + 7]); return __builtin_bit_cast(bf16x8, p); }
DI bf16x8 frag4(unsigned a, unsigned b, unsigned c, unsigned d) { u32x4 p = {a, b, c, d}; return __builtin_bit_cast(bf16x8, p); }
DI float lo_f(unsigned w) { return __uint_as_float(w << 16); }
DI float hi_f(unsigned w) { return __uint_as_float(w & 0xffff0000u); }
DI int img_off(int row, int slot) { return row * 128 + ((slot ^ ((((row >> 1) & 1) << 3) | ((row >> 2) & 3))) << 3); }
DI s16x4 tr_read(lptr p) { return __builtin_bit_cast(s16x4, __builtin_amdgcn_ds_read_tr16_b64_v4i16((LAS s16x4*)p)); }
DI bf16x8 trfrag(lptr img, int tau, int s, int lane) {
    const int h = lane >> 5, gg = (lane >> 4) & 1, l16 = lane & 15, q = l16 >> 2, p = l16 & 3, slot = 8 * tau + 4 * gg + p, r0 = 16 * s + 4 * h + q;
    const s16x4 lo = tr_read(img + img_off(r0, slot)), hi = tr_read(img + img_off(r0 + 8, slot));
    return __builtin_shufflevector(lo, hi, 0, 1, 2, 3, 4, 5, 6, 7);
}
template <int CTRL, int RMASK> DI float dpp0(float x) { return __uint_as_float(__builtin_amdgcn_update_dpp(0u, __float_as_uint(x), CTRL, RMASK, 0xf, false)); }
DI float prefix32(float x) {
    x += dpp0<0x111, 0xf>(x); x += dpp0<0x112, 0xf>(x); x += dpp0<0x114, 0xf>(x); x += dpp0<0x118, 0xf>(x);
    x += dpp0<0x142, 0xa>(x);
    return x;
}
DI float fsig(float x) { return __builtin_amdgcn_rcpf(1.f + __expf(-x)); }
DI void store_tile(unsigned char* dst, const f32x16& x, int lane) {
    u32x4 a, b; a[0] = cvtpk(x[0], x[1]); a[1] = cvtpk(x[2], x[3]); a[2] = cvtpk(x[4], x[5]); a[3] = cvtpk(x[6], x[7]);
    b[0] = cvtpk(x[8], x[9]); b[1] = cvtpk(x[10], x[11]); b[2] = cvtpk(x[12], x[13]); b[3] = cvtpk(x[14], x[15]);
    u32x4* d = (u32x4*)(dst + lane * 32); d[0] = a; d[1] = b;
}

DI void d_lowrank_t(const Ctx& c, const float* __restrict__ w2, const float* __restrict__ a2, bf16* __restrict__ w2t, bf16* __restrict__ a2t) {
    for (int id = c.bid * 512 + c.tid; id < 2 * 512 * 32; id += c.nb * 512) { const int j = id & 31, ch = (id >> 5) & 511, d = id >> 14;
        w2t[id] = f2bf(w2[(size_t)(d * 32 + j) * 512 + ch]); a2t[id] = f2bf(a2[(size_t)(d * 32 + j) * 512 + ch]); }
}

DI void d_g2_t(const Ctx& c, const float* __restrict__ g2, bf16* __restrict__ g2t) {
    for (int id = c.bid * 512 + c.tid; id < 512 * 96; id += c.nb * 512) { const int j = id % 96, ch = id / 96; g2t[id] = f2bf(g2[(size_t)j * 512 + ch]); }
}
constexpr int O_MPV = 0, O_MNV = 512, O_LG = 1024, O_LB = 1536, O_MPG = 2048, O_MNG = 2144, O_A0 = 2240, O_KA = 3264, O_RK = 3776, O_MPR = 4288, O_MNR = 4800, O_MPK = 5312, O_MNK = 5824, O_MPA = 6336, O_MNA = 6400, O_END = 6464;
DI void d_out(const Ctx& c, const bf16* __restrict__ proj_, const float* __restrict__ ybuf_, const float* __restrict__ mu_prev, const float* __restrict__ mu_next,
              const float* __restrict__ a0, const float* __restrict__ k_a, const float* __restrict__ r_k, const bf16* __restrict__ a2t_, const bf16* __restrict__ g2t_,
              const float* __restrict__ lnx_g, const float* __restrict__ lnx_b, bf16* __restrict__ mix_) {
    const int lane0 = c.lane;
    LAS float* cs0 = (LAS float*)((lptr)c.lds);
    __syncthreads();
    for (int i = c.tid; i < O_END; i += 512) { float v;
        if (i < O_MNV) v = mu_prev[P_VV + i]; else if (i < O_LG) v = mu_next[P_VV + i - O_MNV]; else if (i < O_LB) v = lnx_g[i - O_LG]; else if (i < O_MPG) v = lnx_b[i - O_LB];
        else if (i < O_MNG) v = mu_prev[P_GD + i - O_MPG]; else if (i < O_A0) v = mu_next[P_GD + i - O_MNG]; else if (i < O_KA) v = a0[i - O_A0]; else if (i < O_RK) v = k_a[i - O_KA];
        else if (i < O_MPR) v = r_k[i - O_RK]; else if (i < O_MNR) v = mu_prev[P_R + i - O_MPR]; else if (i < O_MPK) v = mu_next[P_R + i - O_MNR]; else if (i < O_MNK) v = mu_prev[P_KK + i - O_MPK];
        else if (i < O_MPA) v = mu_next[P_KK + i - O_MNK]; else if (i < O_MNA) v = mu_prev[P_AD + i - O_MPA]; else v = mu_next[P_AD + i - O_MNA];
        cs0[i] = v; }
    if (c.tid == 0) { LAS unsigned long long* pp_ = (LAS unsigned long long*)(cs0 + O_END); pp_[0] = (unsigned long long)proj_; pp_[1] = (unsigned long long)ybuf_; pp_[2] = (unsigned long long)mix_; pp_[3] = (unsigned long long)a2t_; pp_[4] = (unsigned long long)g2t_; }
    __syncthreads();
    for (int wt = c.gw; wt < (NTOK / 32) * 2; wt += c.ngw) {
        int lane = lane0; asm volatile("" : "+v"(lane));
        const int n = lane & 31, hh = lane >> 5;
        LAS float* cs = cs0 + (lane - lane0);
        const LAS unsigned long long* pl_ = (const LAS unsigned long long*)(cs + O_END);
        const bf16* proj = (const bf16*)pl_[0]; const float* ybuf = (const float*)pl_[1]; bf16* mix = (bf16*)pl_[2]; const bf16* a2t = (const bf16*)pl_[3]; const bf16* g2t = (const bf16*)pl_[4];
        const int tile = wt >> 1, hg = wt & 1, t0 = tile * 32, tg = t0 + n, ti = tg % SEQ;
        const bool hp = ti > 0, hn = ti < SEQ - 1; const int po = hp ? IN_PAD : 0, no_ = hn ? IN_PAD : 0;
        const bf16* prow = proj + (size_t)tg * IN_PAD + C_P;
        bf16x8 sgf[6], adf[4];
#pragma unroll
        for (int ks = 0; ks < 10; ++ks) { const int col = ks < 6 ? P_GD + 16 * ks + 8 * hh : P_AD + 16 * (ks - 6) + 8 * hh; const int mo = ks < 6 ? O_MPG + 16 * ks + 8 * hh : O_MPA + 16 * (ks - 6) + 8 * hh, no = ks < 6 ? mo + 96 : mo + 64;
            const bf16* pc_ = prow + col;
            const u32x4 cc = *(const u32x4*)pc_, pp = *(const u32x4*)(pc_ - po), nn = *(const u32x4*)(pc_ + no_);
            const unsigned cw[4] = {cc[0], cc[1], cc[2], cc[3]}, pw[4] = {hp ? pp[0] : 0u, hp ? pp[1] : 0u, hp ? pp[2] : 0u, hp ? pp[3] : 0u}, nw[4] = {hn ? nn[0] : 0u, hn ? nn[1] : 0u, hn ? nn[2] : 0u, hn ? nn[3] : 0u}; unsigned o[4];
#pragma unroll
            for (int e = 0; e < 4; ++e) { const float c0 = lo_f(cw[e]), c1 = hi_f(cw[e]);
                float x0 = c0 + cs[mo + 2 * e] * (lo_f(pw[e]) - c0) + cs[no + 2 * e] * (lo_f(nw[e]) - c0), x1 = c1 + cs[mo + 2 * e + 1] * (hi_f(pw[e]) - c1) + cs[no + 2 * e + 1] * (hi_f(nw[e]) - c1);
                if (ks < 6) { x0 = fsig(x0); x1 = fsig(x1); }
                o[e] = cvtpk(x0, x1); }
            if (ks < 6) sgf[ks] = frag4(o[0], o[1], o[2], o[3]); else adf[ks - 6] = frag4(o[0], o[1], o[2], o[3]);
            __builtin_amdgcn_sched_barrier(0); }
#pragma unroll 1
        for (int hq = 0; hq < 4; ++hq) {
            const int hd = hg * 4 + hq;
            float bs = 0.f;
#pragma unroll
            for (int ct = 0; ct < 2; ++ct) {
                f32x16 a0t = {0.f}, a1t = {0.f}; const int chrow = 64 * hd + 32 * ct + n;
                const bf16* ar0 = a2t + (size_t)chrow * 32 + 8 * hh; const bf16* ar1 = a2t + (size_t)(512 + chrow) * 32 + 8 * hh;
                a0t = MFMA32(*(const bf16x8*)ar0, adf[0], a0t); a0t = MFMA32(*(const bf16x8*)(ar0 + 16), adf[1], a0t);
                a1t = MFMA32(*(const bf16x8*)ar1, adf[2], a1t); a1t = MFMA32(*(const bf16x8*)(ar1 + 16), adf[3], a1t);
#pragma unroll
                for (int q = 0; q < 4; ++q) { const int ch = 64 * hd + 32 * ct + 8 * q + 4 * hh; const bf16* rp_ = prow + P_R + ch; const bf16* kp_ = prow + P_KK + ch; const u32x2 z2 = {0u, 0u};
                    const u32x2 rc = *(const u32x2*)rp_; u32x2 rpv = *(const u32x2*)(rp_ - po), rnx = *(const u32x2*)(rp_ + no_); rpv = hp ? rpv : z2; rnx = hn ? rnx : z2;
                    const u32x2 kc = *(const u32x2*)kp_; u32x2 kpv = *(const u32x2*)(kp_ - po), knx = *(const u32x2*)(kp_ + no_); kpv = hp ? kpv : z2; knx = hn ? knx : z2;
                    const float rcf[4] = {lo_f(rc.x), hi_f(rc.x), lo_f(rc.y), hi_f(rc.y)}, rpf[4] = {lo_f(rpv.x), hi_f(rpv.x), lo_f(rpv.y), hi_f(rpv.y)}, rnf[4] = {lo_f(rnx.x), hi_f(rnx.x), lo_f(rnx.y), hi_f(rnx.y)};
                    const float kcf[4] = {lo_f(kc.x), hi_f(kc.x), lo_f(kc.y), hi_f(kc.y)}, kpf[4] = {lo_f(kpv.x), hi_f(kpv.x), lo_f(kpv.y), hi_f(kpv.y)}, knf[4] = {lo_f(knx.x), hi_f(knx.x), lo_f(knx.y), hi_f(knx.y)};
#pragma unroll
                    for (int e = 0; e < 4; ++e) { const int cx = ch + e;
                        const float rf = rcf[e] + cs[O_MPR + cx] * (rpf[e] - rcf[e]) + cs[O_MNR + cx] * (rnf[e] - rcf[e]);
                        const float kf = kcf[e] + cs[O_MPK + cx] * (kpf[e] - kcf[e]) + cs[O_MNK + cx] * (knf[e] - kcf[e]);
                        const float am = 0.5f * (fsig(a0t[4 * q + e] + cs[O_A0 + cx]) + fsig(a1t[4 * q + e] + cs[O_A0 + 512 + cx]));
                        bs += rf * kf * (1.f + (am - 1.f) * cs[O_KA + cx]) * cs[O_RK + cx]; }
                    __builtin_amdgcn_sched_barrier(0); }
            }
            bs += __shfl_xor(bs, 32);
            f32x16 gt[2];
#pragma unroll
            for (int ct = 0; ct < 2; ++ct) { f32x16 acc = {0.f}; const bf16* grow = g2t + (size_t)(64 * hd + 32 * ct + n) * 96 + 8 * hh;
#pragma unroll
                for (int ks = 0; ks < 6; ++ks) acc = MFMA32(*(const bf16x8*)(grow + 16 * ks), sgf[ks], acc);
                gt[ct] = acc; }
            float yv[32]; float s1 = 0.f;
#pragma unroll
            for (int ct = 0; ct < 2; ++ct)
#pragma unroll
                for (int q = 0; q < 4; ++q) { const f32x4 y4 = *(const f32x4*)(ybuf + (size_t)tg * 512 + 64 * hd + 32 * ct + 8 * q + 4 * hh);
                    yv[16 * ct + 4 * q] = y4.x; yv[16 * ct + 4 * q + 1] = y4.y; yv[16 * ct + 4 * q + 2] = y4.z; yv[16 * ct + 4 * q + 3] = y4.w; s1 += (y4.x + y4.y) + (y4.z + y4.w); }
            s1 += __shfl_xor(s1, 32);
            const float mean = s1 * (1.f / 64.f); float s2 = 0.f;
#pragma unroll
            for (int i = 0; i < 32; ++i) { yv[i] -= mean; s2 += yv[i] * yv[i]; }
            s2 += __shfl_xor(s2, 32);
            const float rstd = rsqrtf(s2 * (1.f / 64.f) + GN_EPS);
#pragma unroll
            for (int ct = 0; ct < 2; ++ct)
#pragma unroll
                for (int q = 0; q < 4; ++q) { const int ch = 64 * hd + 32 * ct + 8 * q + 4 * hh; const bf16* vp = prow + P_VV + ch;
                    const u32x2 z2 = {0u, 0u}; const u32x2 vc = *(const u32x2*)vp; u32x2 vpv = *(const u32x2*)(vp - po), vnx = *(const u32x2*)(vp + no_); vpv = hp ? vpv : z2; vnx = hn ? vnx : z2;
                    const float vcf[4] = {lo_f(vc.x), hi_f(vc.x), lo_f(vc.y), hi_f(vc.y)}, vpf[4] = {lo_f(vpv.x), hi_f(vpv.x), lo_f(vpv.y), hi_f(vpv.y)}, vnf[4] = {lo_f(vnx.x), hi_f(vnx.x), lo_f(vnx.y), hi_f(vnx.y)};
                    float o[4];
#pragma unroll
                    for (int e = 0; e < 4; ++e) { const float vf = vcf[e] + cs[O_MPV + ch + e] * (vpf[e] - vcf[e]) + cs[O_MNV + ch + e] * (vnf[e] - vcf[e]);
                        o[e] = (yv[16 * ct + 4 * q + e] * rstd * cs[O_LG + ch + e] + cs[O_LB + ch + e] + bs * vf) * gt[ct][4 * q + e]; }
                    *(u32x2*)(mix + (size_t)tg * DM + 512 + ch) = (u32x2){cvtpk(o[0], o[1]), cvtpk(o[2], o[3])}; }
            __builtin_amdgcn_sched_barrier(0);
        }
    }
}
DI void d_prep(const Ctx& c, int d, const bf16* __restrict__ proj, const float* __restrict__ mu_prev, const float* __restrict__ mu_next,
               const float* __restrict__ w0, const float* __restrict__ a0, const float* __restrict__ k_k, const float* __restrict__ k_a,
               const bf16* __restrict__ w2t, const bf16* __restrict__ a2t, unsigned char* __restrict__ UO, float* __restrict__ ybuf) {
    const int lane = c.lane, n = lane & 31, h = lane >> 5, hd = c.bid & 7;
    lptr L = (lptr)c.lds + c.wave * 16384;
    LAS float* cst = (LAS float*)((lptr)c.lds + CST_OFF);
    LAS float* gC = (LAS float*)((lptr)c.lds + GC_OFF) + c.wave * 64;
    __syncthreads();
    for (int i = c.tid; i < 768; i += 512) { float v;
        if (i < 640) { const int vec = i >> 6, ch = i & 63, gch = 64 * hd + ch;
            v = vec == 0 ? mu_prev[P_R + gch] : vec == 1 ? mu_next[P_R + gch] : vec == 2 ? mu_prev[P_KK + gch] : vec == 3 ? mu_next[P_KK + gch] : vec == 4 ? mu_prev[P_VV + gch] : vec == 5 ? mu_next[P_VV + gch]
              : vec == 6 ? w0[d * 512 + gch] : vec == 7 ? a0[d * 512 + gch] : vec == 8 ? k_k[gch] : k_a[gch]; }
        else { const int vec = (i - 640) >> 5, j = i & 31; const int col = (vec < 2 ? P_WD : P_AD) + 32 * d + j; v = (vec & 1) ? mu_next[col] : mu_prev[col]; }
        cst[i] = v; }
    __syncthreads();
    const int nper = (c.nb >> 3) * 8;
    for (int u = (c.bid >> 3) * 8 + c.wave; u < 1024; u += nper) {
        const int b = u >> 7, c32 = u & 127;
        const int tok0 = d ? SEQ - 32 * (c32 + 1) : 32 * c32;
        const bf16* prow = proj + (size_t)b * SEQ * IN_PAD + C_P;
#pragma unroll 1
        for (int it = 0; it < 13; ++it) { const int pid = it * 64 + lane; if (pid < 816) { const int rho = pid / 24, w = pid % 24, mat = w >> 3, pc = w & 7, tok = tok0 - 1 + rho;
                uint4 val = make_uint4(0, 0, 0, 0);
                if (tok >= 0 && tok < SEQ) val = *(const uint4*)(prow + (size_t)tok * IN_PAD + mat * 512 + 64 * hd + pc * 8);
                LAS u32x2* dp = (LAS u32x2*)(L + rho * STG_STRIDE + mat * 128 + pc * 16); dp[0] = (u32x2){val.x, val.y}; dp[1] = (u32x2){val.z, val.w}; } }
        const int rho = d ? 32 - n : n + 1, tok = tok0 - 1 + rho;
        bf16x8 wdf[2], adf[2];
        {
            const bool hp = tok > 0, hn = tok < SEQ - 1;
#pragma unroll
            for (int s = 0; s < 2; ++s) {
                const bf16* pc_ = prow + (size_t)tok * IN_PAD + 32 * d + 16 * s + 8 * h;
                const uint4 z4 = make_uint4(0, 0, 0, 0);
                const uint4 wc = *(const uint4*)(pc_ + P_WD), ac = *(const uint4*)(pc_ + P_AD);
                const uint4 wp = hp ? *(const uint4*)(pc_ + P_WD - IN_PAD) : z4, ap = hp ? *(const uint4*)(pc_ + P_AD - IN_PAD) : z4;
                const uint4 wn = hn ? *(const uint4*)(pc_ + P_WD + IN_PAD) : z4, an = hn ? *(const uint4*)(pc_ + P_AD + IN_PAD) : z4;
                const unsigned wcw[4] = {wc.x, wc.y, wc.z, wc.w}, wpw[4] = {wp.x, wp.y, wp.z, wp.w}, wnw[4] = {wn.x, wn.y, wn.z, wn.w};
                const unsigned acw[4] = {ac.x, ac.y, ac.z, ac.w}, apw[4] = {ap.x, ap.y, ap.z, ap.w}, anw[4] = {an.x, an.y, an.z, an.w};
                unsigned wo[4], ao[4];
#pragma unroll
                for (int e = 0; e < 4; ++e) { const int j = 16 * s + 8 * h + 2 * e;
                    const float mpw0 = cst[640 + j], mpw1 = cst[640 + j + 1], mnw0 = cst[672 + j], mnw1 = cst[672 + j + 1], mpa0 = cst[704 + j], mpa1 = cst[704 + j + 1], mna0 = cst[736 + j], mna1 = cst[736 + j + 1];
                    float c0 = lo_f(wcw[e]), c1 = hi_f(wcw[e]);
                    float x0 = c0 + mpw0 * (lo_f(wpw[e]) - c0) + mnw0 * (lo_f(wnw[e]) - c0), x1 = c1 + mpw1 * (hi_f(wpw[e]) - c1) + mnw1 * (hi_f(wnw[e]) - c1);
                    x0 = 1.f - 2.f * __builtin_amdgcn_rcpf(__expf(2.f * x0) + 1.f); x1 = 1.f - 2.f * __builtin_amdgcn_rcpf(__expf(2.f * x1) + 1.f);
                    wo[e] = cvtpk(x0, x1);
                    c0 = lo_f(acw[e]); c1 = hi_f(acw[e]);
                    x0 = c0 + mpa0 * (lo_f(apw[e]) - c0) + mna0 * (lo_f(anw[e]) - c0); x1 = c1 + mpa1 * (hi_f(apw[e]) - c1) + mna1 * (hi_f(anw[e]) - c1);
                    ao[e] = cvtpk(x0, x1); }
                wdf[s] = frag4(wo[0], wo[1], wo[2], wo[3]); adf[s] = frag4(ao[0], ao[1], ao[2], ao[3]);
                __builtin_amdgcn_sched_barrier(0);
            }
        }
        float lw[32], av[32];
        {
            const f32x16 zz = {0.f};
            int opq = 0; asm volatile("" : "+v"(opq));
#pragma unroll
            for (int tau = 0; tau < 2; ++tau) {
                const bf16* wrow = w2t + ((d * 512 + 64 * hd + 32 * tau + n + opq) * 32 + 8 * (h + opq));
                const bf16* arow = a2t + ((d * 512 + 64 * hd + 32 * tau + n + opq) * 32 + 8 * (h + opq));
                const bf16x8 wa0 = *(const bf16x8*)wrow, wa1 = *(const bf16x8*)(wrow + 16), aa0 = *(const bf16x8*)arow, aa1 = *(const bf16x8*)(arow + 16);
                f32x16 cw = MFMA32(wa0, wdf[0], zz); cw = MFMA32(wa1, wdf[1], cw);
                f32x16 ca = MFMA32(aa0, adf[0], zz); ca = MFMA32(aa1, adf[1], ca);
#pragma unroll
                for (int i = 0; i < 16; ++i) { const int ch = 32 * tau + 8 * (i >> 2) + 4 * h + (i & 3);
                    lw[16 * tau + i] = -0.60653066f * fsig(cw[i] + cst[6 * 64 + ch]); av[16 * tau + i] = fsig(ca[i] + cst[7 * 64 + ch]); }
                __builtin_amdgcn_sched_barrier(0);
            }
        }
        unsigned ge[32], avp[16];
#pragma unroll
        for (int m = 0; m < 32; ++m) { const float clm = prefix32(lw[m]); const float eg = __expf(clm); ge[m] = cvtpk(eg, eg * __expf(-lw[m])); if (n == 31) gC[8 * (m >> 2) + 4 * h + (m & 3)] = eg; }
#pragma unroll
        for (int m = 0; m < 16; ++m) avp[m] = cvtpk(av[2 * m], av[2 * m + 1]);
        __builtin_amdgcn_sched_barrier(0);
        unsigned pA[16], pB[16], pK[16], pR[16], pV[16];
        {
            unsigned kfp[16]; float ss = 0.f;
            lptr sb = L + rho * STG_STRIDE + 8 * h;
#pragma unroll
            for (int q = 0; q < 8; ++q) {
                const u32x2 cu = *(LAS u32x2*)(sb + 128 + 16 * q), pu_ = *(LAS u32x2*)(sb + 128 + 16 * q - STG_STRIDE), nu = *(LAS u32x2*)(sb + 128 + 16 * q + STG_STRIDE);
                const float cc[4] = {lo_f(cu.x), hi_f(cu.x), lo_f(cu.y), hi_f(cu.y)}, pp[4] = {lo_f(pu_.x), hi_f(pu_.x), lo_f(pu_.y), hi_f(pu_.y)}, nn[4] = {lo_f(nu.x), hi_f(nu.x), lo_f(nu.y), hi_f(nu.y)};
                float xk[4];
#pragma unroll
                for (int e = 0; e < 4; ++e) { const int ch = 8 * q + 4 * h + e; const float x = cc[e] + cst[2 * 64 + ch] * (pp[e] - cc[e]) + cst[3 * 64 + ch] * (nn[e] - cc[e]);
                    xk[e] = x; const float kr_ = x * cst[8 * 64 + ch]; ss += kr_ * kr_; }
                kfp[2 * q] = cvtpk(xk[0], xk[1]); kfp[2 * q + 1] = cvtpk(xk[2], xk[3]);
                __builtin_amdgcn_sched_barrier(0);
            }
            ss += __shfl_xor(ss, 32);
            const float inv = rsqrtf(fmaxf(ss, 1e-24f));
#pragma unroll
            for (int q = 0; q < 8; ++q) {
                const u32x2 cu = *(LAS u32x2*)(sb + 16 * q), pu_ = *(LAS u32x2*)(sb + 16 * q - STG_STRIDE), nu = *(LAS u32x2*)(sb + 16 * q + STG_STRIDE);
                const u32x2 cv = *(LAS u32x2*)(sb + 256 + 16 * q), pv_ = *(LAS u32x2*)(sb + 256 + 16 * q - STG_STRIDE), nv_ = *(LAS u32x2*)(sb + 256 + 16 * q + STG_STRIDE);
                const float rc[4] = {lo_f(cu.x), hi_f(cu.x), lo_f(cu.y), hi_f(cu.y)}, rp[4] = {lo_f(pu_.x), hi_f(pu_.x), lo_f(pu_.y), hi_f(pu_.y)}, rn[4] = {lo_f(nu.x), hi_f(nu.x), lo_f(nu.y), hi_f(nu.y)};
                const float vc[4] = {lo_f(cv.x), hi_f(cv.x), lo_f(cv.y), hi_f(cv.y)}, vp[4] = {lo_f(pv_.x), hi_f(pv_.x), lo_f(pv_.y), hi_f(pv_.y)}, vn[4] = {lo_f(nv_.x), hi_f(nv_.x), lo_f(nv_.y), hi_f(nv_.y)};
                float oa[4], ob[4], ok[4], orr[4], ov[4];
#pragma unroll
                for (int e = 0; e < 4; ++e) { const int ch = 8 * q + 4 * h + e, m = 4 * q + e;
                    const float rf = rc[e] + cst[0 * 64 + ch] * (rp[e] - rc[e]) + cst[1 * 64 + ch] * (rn[e] - rc[e]);
                    const float vf = vc[e] + cst[4 * 64 + ch] * (vp[e] - vc[e]) + cst[5 * 64 + ch] * (vn[e] - vc[e]);
                    const float eg = lo_f(ge[m]), ieg = __builtin_amdgcn_rcpf(eg), egm1 = hi_f(ge[m]);
                    const float kfm = (m & 1) ? hi_f(kfp[m >> 1]) : lo_f(kfp[m >> 1]), avm = (m & 1) ? hi_f(avp[m >> 1]) : lo_f(avp[m >> 1]);
                    const float kkn = kfm * cst[8 * 64 + ch] * inv;
                    oa[e] = -kkn * egm1; ob[e] = kkn * avm * ieg; ok[e] = kfm * (1.f + (avm - 1.f) * cst[9 * 64 + ch]) * ieg; orr[e] = rf * eg; ov[e] = vf; }
                pA[2 * q] = cvtpk(oa[0], oa[1]); pA[2 * q + 1] = cvtpk(oa[2], oa[3]); pB[2 * q] = cvtpk(ob[0], ob[1]); pB[2 * q + 1] = cvtpk(ob[2], ob[3]);
                pK[2 * q] = cvtpk(ok[0], ok[1]); pK[2 * q + 1] = cvtpk(ok[2], ok[3]); pR[2 * q] = cvtpk(orr[0], orr[1]); pR[2 * q + 1] = cvtpk(orr[2], orr[3]);
                pV[2 * q] = cvtpk(ov[0], ov[1]); pV[2 * q + 1] = cvtpk(ov[2], ov[3]);
                __builtin_amdgcn_sched_barrier(0);
            }
        }
        __builtin_amdgcn_fence(__ATOMIC_RELEASE, "workgroup"); __builtin_amdgcn_wave_barrier();
#pragma unroll
        for (int q = 0; q < 8; ++q) { const int off = img_off(n, 2 * q + h);
            *(LAS u32x2*)(L + off) = (u32x2){pA[2 * q], pA[2 * q + 1]}; *(LAS u32x2*)(L + 4096 + off) = (u32x2){pB[2 * q], pB[2 * q + 1]};
            *(LAS u32x2*)(L + 8192 + off) = (u32x2){pK[2 * q], pK[2 * q + 1]}; *(LAS u32x2*)(L + 12288 + off) = (u32x2){pV[2 * q], pV[2 * q + 1]}; }
        __builtin_amdgcn_fence(__ATOMIC_RELEASE, "workgroup"); __builtin_amdgcn_wave_barrier();
        const f32x16 Z16 = {0.f};
        f32x16 Lab = Z16, LabT = Z16, LakT = Z16, MrbT = Z16, MrkT = Z16;
#pragma unroll
        for (int ks = 0; ks < 4; ++ks) {
            const bf16x8 fA = frag4(pA[4 * ks], pA[4 * ks + 1], pA[4 * ks + 2], pA[4 * ks + 3]), fB = frag4(pB[4 * ks], pB[4 * ks + 1], pB[4 * ks + 2], pB[4 * ks + 3]);
            const bf16x8 fK = frag4(pK[4 * ks], pK[4 * ks + 1], pK[4 * ks + 2], pK[4 * ks + 3]), fR = frag4(pR[4 * ks], pR[4 * ks + 1], pR[4 * ks + 2], pR[4 * ks + 3]);
            Lab = MFMA32(fA, fB, Lab); LabT = MFMA32(fB, fA, LabT); LakT = MFMA32(fK, fA, LakT); MrbT = MFMA32(fB, fR, MrbT); MrkT = MFMA32(fK, fR, MrkT);
        }
#pragma unroll
        for (int i = 0; i < 16; ++i) { const int rr = crow(i, h);
            Lab[i] = (n < rr) ? Lab[i] : 0.f; LabT[i] = (rr < n) ? LabT[i] : 0.f; LakT[i] = (rr < n) ? LakT[i] : 0.f;
            MrbT[i] = (rr <= n) ? MrbT[i] : 0.f; MrkT[i] = (rr <= n) ? MrkT[i] : 0.f; }
        const bf16x8 pLk0 = pack(LakT, 0), pLk1 = pack(LakT, 1), pMb0 = pack(MrbT, 0), pMb1 = pack(MrbT, 1), pMk0 = pack(MrkT, 0), pMk1 = pack(MrkT, 1);
        __builtin_amdgcn_sched_barrier(0);
        f32x16 Pc = Lab, Ptc = LabT, Rtc = LabT;
#pragma unroll
        for (int i = 0; i < 16; ++i) Rtc[i] += (crow(i, h) == n) ? 1.f : 0.f;
#pragma unroll
        for (int lvl = 0; lvl < 4; ++lvl) {
            const bf16x8 pP0 = pack(Pc, 0), pP1 = pack(Pc, 1), pT0 = pack(Ptc, 0), pT1 = pack(Ptc, 1);
            f32x16 nPc = MFMA32(pT0, pP0, Z16); nPc = MFMA32(pT1, pP1, nPc);
            if (lvl < 3) { f32x16 nPt = MFMA32(pP0, pT0, Z16); nPt = MFMA32(pP1, pT1, nPt); Ptc = nPt; }
            const bf16x8 pN0 = pack(nPc, 0), pN1 = pack(nPc, 1), pR0 = pack(Rtc, 0), pR1 = pack(Rtc, 1);
            Rtc = MFMA32(pN0, pR0, Rtc); Rtc = MFMA32(pN1, pR1, Rtc);
            Pc = nPc;
        }
        const bf16x8 pT0 = pack(Rtc, 0), pT1 = pack(Rtc, 1);
        bf16x8 vt[2][2];
#pragma unroll
        for (int tau = 0; tau < 2; ++tau) { vt[tau][0] = trfrag(L + 12288, tau, 0, lane); vt[tau][1] = trfrag(L + 12288, tau, 1, lane); }
        bf16x8 pW1[2][2], pW2[2][2];
#pragma unroll
        for (int tau = 0; tau < 2; ++tau) {
            f32x16 lv = MFMA32(pLk0, vt[tau][0], Z16); lv = MFMA32(pLk1, vt[tau][1], lv);
            const bf16x8 a0f = trfrag(L, tau, 0, lane), a1f = trfrag(L, tau, 1, lane);
            f32x16 w1 = MFMA32(pT0, a0f, Z16); w1 = MFMA32(pT1, a1f, w1);
            const bf16x8 l0 = pack(lv, 0), l1 = pack(lv, 1);
            f32x16 w2_ = MFMA32(pT0, l0, Z16); w2_ = MFMA32(pT1, l1, w2_);
            pW1[tau][0] = pack(w1, 0); pW1[tau][1] = pack(w1, 1); pW2[tau][0] = pack(w2_, 0); pW2[tau][1] = pack(w2_, 1);
        }
        int opq2 = 0; asm volatile("" : "+v"(opq2));
        const int lane_o = lane + opq2, n_o = n + opq2;
        unsigned char* uo = UO + ((size_t)(b * 8 + hd) * 128 + c32) * UNIT_BYTES;
#pragma unroll
        for (int kap = 0; kap < 2; ++kap) { f32x16 q1;
#pragma unroll
            for (int i = 0; i < 16; ++i) q1[i] = (i & 1) ? hi_f(pR[8 * kap + (i >> 1)]) : lo_f(pR[8 * kap + (i >> 1)]);
            q1 = MFMA32(pW1[kap][0], pMb0, q1); q1 = MFMA32(pW1[kap][1], pMb1, q1);
            store_tile(uo + kap * 2048, q1, lane_o); }
#pragma unroll
        for (int tau = 0; tau < 2; ++tau) { f32x16 q2 = MFMA32(pMb0, pW2[tau][0], Z16); q2 = MFMA32(pMb1, pW2[tau][1], q2); q2 = MFMA32(pMk0, vt[tau][0], q2); q2 = MFMA32(pMk1, vt[tau][1], q2);
#pragma unroll
            for (int i = 0; i < 16; ++i) { const int s = crow(i, h), tk = d ? tok0 + 31 - s : tok0 + s; float* yp = ybuf + ((size_t)b * SEQ + tk) * 512 + 64 * hd + 32 * tau + n_o;
                if (d) *yp += q2[i]; else *yp = q2[i]; } }
        __builtin_amdgcn_fence(__ATOMIC_RELEASE, "workgroup"); __builtin_amdgcn_wave_barrier();
#pragma unroll
        for (int tp = 0; tp < 2; ++tp) {
            const bf16x8 b0f = trfrag(L + 4096, tp, 0, lane), b1f = trfrag(L + 4096, tp, 1, lane), k0f = trfrag(L + 8192, tp, 0, lane), k1f = trfrag(L + 8192, tp, 1, lane);
            const float gcl = gC[32 * tp + n];
#pragma unroll
            for (int kap = 0; kap < 2; ++kap) { f32x16 g = MFMA32(pW1[kap][0], b0f, Z16); g = MFMA32(pW1[kap][1], b1f, g);
#pragma unroll
                for (int i = 0; i < 16; ++i) g[i] = (g[i] + ((kap == tp && crow(i, h) == n) ? 1.f : 0.f)) * gcl;
                store_tile(uo + (2 + 2 * kap + tp) * 2048, g, lane_o); }
#pragma unroll
            for (int tau = 0; tau < 2; ++tau) { f32x16 ht = MFMA32(b0f, pW2[tau][0], Z16); ht = MFMA32(b1f, pW2[tau][1], ht); ht = MFMA32(k0f, vt[tau][0], ht); ht = MFMA32(k1f, vt[tau][1], ht);
#pragma unroll
                for (int i = 0; i < 16; ++i) ht[i] *= gC[32 * tp + crow(i, h)];
                store_tile(uo + (6 + 2 * tp + tau) * 2048, ht, lane_o); }
        }
        __builtin_amdgcn_fence(__ATOMIC_RELEASE, "workgroup"); __builtin_amdgcn_wave_barrier();
    }
}

DI void d_seq(const Ctx& c, int d, const unsigned char* __restrict__ UO, float* __restrict__ ybuf, const bool dry) {
    if (c.wave >= 2) return;
    const int lane = c.lane, n = lane & 31, h = lane >> 5, tau = c.wave;
    for (int chain = c.bid; chain < 64; chain += c.nb) {
        const int b = chain >> 3, hd = chain & 7;
        const unsigned char* ub = UO + (size_t)chain * 128 * UNIT_BYTES + lane * 32;
        const f32x16 Z16 = {0.f};
        f32x16 X0 = Z16, X1 = Z16;
        u32x4 T[8][2];
        auto loadu = [&](int c32) {
            const unsigned char* p = ub + (size_t)c32 * UNIT_BYTES;
#pragma unroll
            for (int k = 0; k < 6; ++k) { T[k][0] = *(const u32x4*)(p + k * 2048); T[k][1] = *(const u32x4*)(p + k * 2048 + 16); }
#pragma unroll
            for (int tp = 0; tp < 2; ++tp) { T[6 + tp][0] = *(const u32x4*)(p + (6 + 2 * tp + tau) * 2048); T[6 + tp][1] = *(const u32x4*)(p + (6 + 2 * tp + tau) * 2048 + 16); }
        };
        loadu(0);
#pragma unroll 1
        for (int c32 = 0; c32 < 128; ++c32) {
            const int tok0 = d ? SEQ - 32 * (c32 + 1) : 32 * c32;
            float* yb = ybuf + ((size_t)b * SEQ) * 512 + 64 * hd + 32 * tau + n;
            f32x16 y;
#pragma unroll
            for (int i = 0; i < 16; ++i) { const int s = crow(i, h), tk = d ? tok0 + 31 - s : tok0 + s; y[i] = yb[(size_t)tk * 512]; }
            const bf16x8 x00 = pack(X0, 0), x01 = pack(X0, 1), x10 = pack(X1, 0), x11 = pack(X1, 1);
            f32x16 n0, n1;
#pragma unroll
            for (int i = 0; i < 8; ++i) { n0[2 * i] = lo_f(T[6][i >> 2][i & 3]); n0[2 * i + 1] = hi_f(T[6][i >> 2][i & 3]); n1[2 * i] = lo_f(T[7][i >> 2][i & 3]); n1[2 * i + 1] = hi_f(T[7][i >> 2][i & 3]); }
#define FR(t, s) __builtin_bit_cast(bf16x8, T[t][s])
            n0 = MFMA32(FR(2, 0), x00, n0); n1 = MFMA32(FR(3, 0), x00, n1);
            n0 = MFMA32(FR(2, 1), x01, n0); n1 = MFMA32(FR(3, 1), x01, n1);
            n0 = MFMA32(FR(4, 0), x10, n0); n1 = MFMA32(FR(5, 0), x10, n1);
            n0 = MFMA32(FR(4, 1), x11, n0); n1 = MFMA32(FR(5, 1), x11, n1);
            y = MFMA32(FR(0, 0), x00, y); y = MFMA32(FR(0, 1), x01, y); y = MFMA32(FR(1, 0), x10, y); y = MFMA32(FR(1, 1), x11, y);
#undef FR
            if (c32 + 1 < 128) loadu(c32 + 1);
#pragma unroll
            for (int i = 0; i < 16; ++i) { const int s = crow(i, h), tk = d ? tok0 + 31 - s : tok0 + s; if (!dry) yb[(size_t)tk * 512] = y[i]; else if (y[i] == 1.2345e33f) yb[0] = 0.f; }
            X0 = n0; X1 = n1;
        }
    }
}
#undef DI
}

namespace pk {
typedef short bf16x8 __attribute__((ext_vector_type(8)));
typedef float f32x16 __attribute__((ext_vector_type(16)));
typedef unsigned u32x4 __attribute__((ext_vector_type(4)));
typedef LAS unsigned char* lptr;
#define DI __device__ __forceinline__
DI float fmx(float a, float b) { float r; asm("v_max_f32 %0, %1, %2" : "=v"(r) : "v"(a), "v"(b)); return r; }
DI float fmn(float a, float b) { float r; asm("v_min_f32 %0, %1, %2" : "=v"(r) : "v"(a), "v"(b)); return r; }
DI void ce(float& hi, float& lo) { const float a = fmx(hi, lo), b = fmn(hi, lo); hi = a; lo = b; }
template <int N> DI void sort_desc(float (&v)[N]) {
#pragma unroll
    for (int k = 2; k <= N; k <<= 1)
#pragma unroll
        for (int j = k >> 1; j > 0; j >>= 1)
#pragma unroll
            for (int i = 0; i < N; ++i) { const int l = i ^ j; if (l > i) { if ((i & k) == 0) ce(v[i], v[l]); else ce(v[l], v[i]); } }
}
DI void merge16(float (&v)[16]) {
#pragma unroll
    for (int j = 8; j > 0; j >>= 1)
#pragma unroll
        for (int i = 0; i < 16; ++i) { const int l = i ^ j; if (l > i) ce(v[i], v[l]); }
}
DI void top_merge(float (&a)[16], const float (&b)[16]) {
#pragma unroll
    for (int i = 0; i < 16; ++i) a[i] = fmx(a[i], b[15 - i]);
    merge16(a);
}
DI float setcode(float v, unsigned code, unsigned mask) { return __uint_as_float((__float_as_uint(v) & ~mask) | code); }

DI void d_peer_topk(const Ctx& c, const bf16* __restrict__ qb, const float* __restrict__ keys, int* __restrict__ idx, float* __restrict__ gate) {
    const int lane = c.lane, n = lane & 31, hh = lane >> 5, hd = c.bid & 7;
    lptr KL = (lptr)c.lds;
    lptr TB = (lptr)c.lds + 65536 + c.wave * 2048;
    __syncthreads();
    for (int e = c.tid; e < 2 * 128 * 16; e += 512) {
        const int row = e >> 4, ch = e & 15; const float* src = keys + (size_t)hd * 32768 + row * 128 + ch * 8;
        const f32x4 a = *(const f32x4*)src, b = *(const f32x4*)(src + 4);
        u32x4 w; w[0] = pk2bf(a.x, a.y); w[1] = pk2bf(a.z, a.w); w[2] = pk2bf(b.x, b.y); w[3] = pk2bf(b.z, b.w);
        *(LAS u32x4*)(KL + row * 256 + ((ch ^ (row & 15)) << 4)) = w; }
    __syncthreads();
    const int nper = (c.nb >> 3) * 8;
    for (int tile = (c.bid >> 3) * 8 + c.wave; tile < NTOK / 32; tile += nper) {
        const int t0 = tile * 32;
        float sp[2][16];
#pragma unroll
        for (int p = 0; p < 2; ++p) {
            bf16x8 qf[8];
            { const bf16* qrow = qb + (size_t)(t0 + n) * PEER_Q + hd * 256 + p * 128 + 8 * hh;
#pragma unroll
              for (int ks = 0; ks < 8; ++ks) qf[ks] = *(const bf16x8*)(qrow + 16 * ks); }
            float top[16];
#pragma unroll
            for (int j = 0; j < 4; ++j) {
                f32x16 acc = {0.f};
                const int row = p * 128 + 32 * j + n;
#pragma unroll
                for (int ks = 0; ks < 8; ++ks) { const bf16x8 kfr = *(LAS bf16x8*)(KL + row * 256 + (((2 * ks + hh) ^ (row & 15)) << 4));
                    acc = __builtin_amdgcn_mfma_f32_32x32x16_bf16(kfr, qf[ks], acc, 0, 0, 0); }
                float g[16];
#pragma unroll
                for (int i = 0; i < 16; ++i) { const int key = 32 * j + (i & 3) + 8 * (i >> 2) + 4 * hh; g[i] = setcode(acc[i], 127u - (unsigned)key, 127u); }
                sort_desc<16>(g);
                if (j == 0) {
#pragma unroll
                    for (int i = 0; i < 16; ++i) top[i] = g[i];
                } else top_merge(top, g);
            }
            float oth[16];
#pragma unroll
            for (int i = 0; i < 16; ++i) oth[i] = __shfl_xor(top[i], 32);
            top_merge(top, oth);
#pragma unroll
            for (int i = 0; i < 16; ++i) sp[p][i] = top[i];
        }
        {
            unsigned w[8];
#pragma unroll
            for (int q = 0; q < 8; ++q) { const int p = q >> 2, a0 = (q & 3) * 4; w[q] = 0;
#pragma unroll
                for (int e = 0; e < 4; ++e) w[q] |= (127u - (__float_as_uint(sp[p][a0 + e]) & 127u)) << (8 * e); }
            *(LAS u32x4*)(TB + lane * 32) = (u32x4){w[0], w[1], w[2], w[3]}; *(LAS u32x4*)(TB + lane * 32 + 16) = (u32x4){w[4], w[5], w[6], w[7]};
        }
        float cd[64];
        {
            int cnt = 0;
#pragma unroll
            for (int a = 0; a < 16; ++a)
#pragma unroll
                for (int b = 0; b < 16; ++b) if ((a + 1) * (b + 1) <= 16) { cd[cnt] = setcode(sp[0][a] + sp[1][b], 255u - (unsigned)(a * 16 + b), 255u); ++cnt; }
#pragma unroll
            for (int i = 50; i < 64; ++i) cd[i] = -INFINITY;
        }
        sort_desc<64>(cd);
        const float mx = cd[0]; float ex[16]; float den = 0.f;
#pragma unroll
        for (int k = 0; k < 16; ++k) { ex[k] = __expf(cd[k] - mx); den += ex[k]; }
        const float rden = 1.f / den;
        const size_t ob = (size_t)(t0 + n) * 128 + hd * 16;
        if (hh == 0) {
            int id[16];
#pragma unroll
            for (int k = 0; k < 16; ++k) { const unsigned flat = 255u - (__float_as_uint(cd[k]) & 255u); const unsigned i1 = *(LAS unsigned char*)(TB + lane * 32 + (flat >> 4)), i2 = *(LAS unsigned char*)(TB + lane * 32 + 16 + (flat & 15)); id[k] = (int)(i1 * 128 + i2); }
#pragma unroll
            for (int k = 0; k < 4; ++k) *(int4*)(idx + ob + 4 * k) = make_int4(id[4 * k], id[4 * k + 1], id[4 * k + 2], id[4 * k + 3]);
        } else {
#pragma unroll
            for (int k = 0; k < 4; ++k) *(f32x4*)(gate + ob + 4 * k) = (f32x4){ex[4 * k] * rden, ex[4 * k + 1] * rden, ex[4 * k + 2] * rden, ex[4 * k + 3] * rden};
        }
    }
}
#undef DI
}
namespace at {
typedef short bf16x8 __attribute__((ext_vector_type(8)));
typedef float f32x16 __attribute__((ext_vector_type(16)));
typedef unsigned u32x2 __attribute__((ext_vector_type(2)));
typedef unsigned u32x4 __attribute__((ext_vector_type(4)));
#define DI __device__ __forceinline__
DI void d_vt(const Ctx& c, const bf16* __restrict__ proj, bf16* __restrict__ vT) {
    LAS bf16* tl = (LAS bf16*)((LAS unsigned char*)c.lds) + c.wave * (64 * 66);
    const int lane = c.lane;
    for (int wt = c.gw; wt < BATCH * 2 * (SEQ / 64); wt += c.ngw) {
        const int tk0 = (wt % (SEQ / 64)) * 64, kvh = (wt / (SEQ / 64)) & 1, b = wt / (2 * (SEQ / 64));
        const u32x4* src = (const u32x4*)(proj + ((size_t)b * SEQ + tk0 + lane) * IN_PAD + C_V + kvh * 64);
#pragma unroll
        for (int q = 0; q < 8; ++q) { const u32x4 w = src[q];
#pragma unroll
            for (int e = 0; e < 4; ++e) *(LAS unsigned*)(tl + lane * 66 + q * 8 + 2 * e) = w[e]; }
        __builtin_amdgcn_fence(__ATOMIC_RELEASE, "workgroup"); __builtin_amdgcn_wave_barrier();
        unsigned o[32];
#pragma unroll
        for (int t = 0; t < 32; ++t) o[t] = (unsigned)tl[(2 * t) * 66 + lane] | ((unsigned)tl[(2 * t + 1) * 66 + lane] << 16);
        u32x4* dst = (u32x4*)(vT + ((size_t)(b * 2 + kvh) * 64 + lane) * SEQ + tk0);
#pragma unroll
        for (int q = 0; q < 8; ++q) dst[q] = (u32x4){o[4 * q], o[4 * q + 1], o[4 * q + 2], o[4 * q + 3]};
        __builtin_amdgcn_fence(__ATOMIC_RELEASE, "workgroup"); __builtin_amdgcn_wave_barrier();
    }
}
DI unsigned cvtpk(float lo, float hi) { typedef float f2 __attribute__((ext_vector_type(2))); typedef __bf16 b2 __attribute__((ext_vector_type(2))); f2 v = {lo, hi}; b2 r = __builtin_convertvector(v, b2); return __builtin_bit_cast(unsigned, r); }
DI bf16x8 pack(const f32x16& x, int s) { u32x4 p; p[0] = cvtpk(x[8 * s], x[8 * s + 1]); p[1] = cvtpk(x[8 * s + 2], x[8 * s + 3]); p[2] = cvtpk(x[8 * s + 4], x[8 * s + 5]); p[3] = cvtpk(x[8 * s + 6], x[8 * s + 7]); return __builtin_bit_cast(bf16x8, p); }
DI void d_attn(const Ctx& c, const bf16* __restrict__ qr, const bf16* __restrict__ kr, const bf16* __restrict__ vT, const float* __restrict__ sink, bf16* __restrict__ mix) {
    const int lane0 = c.lane;
    constexpr float C2 = 0.125f * 1.4426950408889634f, L2E = 1.4426950408889634f;
    for (int u = c.gw; u < BATCH * (SEQ / 32) * 8; u += c.ngw) {
        int lane = lane0; asm volatile("" : "+v"(lane));
        const int n = lane & 31, hh = lane >> 5;
        const int hq = u & 7, qt = (u >> 3) & (SEQ / 32 - 1), b = u >> 10, kvh = hq >> 2, q0 = qt * 32;
        bf16x8 qf[4];
        { const bf16* qp = qr + ((size_t)b * SEQ + q0 + n) * 512 + hq * 64 + 8 * hh;
#pragma unroll
          for (int ks = 0; ks < 4; ++ks) qf[ks] = *(const bf16x8*)(qp + 16 * ks); }
        float m = sink[hq] * L2E, l = hh ? 0.f : 1.f;
        f32x16 O0 = {0.f}, O1 = {0.f};
        const bf16* kbase = kr + ((size_t)b * SEQ + n) * 128 + kvh * 64 + 8 * hh;
        const bf16* vbase = vT + ((size_t)(b * 2 + kvh) * 64 + n) * SEQ + 4 * hh;
#pragma unroll 1
        for (int j = 0; j < 9; ++j) {
            const int kt0 = q0 - 128 + 32 * j;
            if (kt0 < 0 || kt0 >= SEQ) continue;
            const bf16* kp = kbase + (size_t)kt0 * 128;
            f32x16 S = {0.f};
#pragma unroll
            for (int ks = 0; ks < 4; ++ks) S = __builtin_amdgcn_mfma_f32_32x32x16_bf16(*(const bf16x8*)(kp + 16 * ks), qf[ks], S, 0, 0, 0);
            bf16x8 vf[2][2];
#pragma unroll
            for (int dt = 0; dt < 2; ++dt)
#pragma unroll
                for (int s = 0; s < 2; ++s) { const bf16* vp = vbase + (size_t)(32 * dt) * SEQ + kt0 + 16 * s; const u32x2 a = *(const u32x2*)vp, bq = *(const u32x2*)(vp + 8);
                    vf[dt][s] = __builtin_bit_cast(bf16x8, (u32x4){a[0], a[1], bq[0], bq[1]}); }
            float mt = -INFINITY;
#pragma unroll
            for (int i = 0; i < 16; ++i) { const int rr = (i & 3) + 8 * (i >> 2) + 4 * hh; float s = S[i] * C2;
                if (j == 0) s = (rr < n) ? -INFINITY : s;
                if (j == 8) s = (rr > n) ? -INFINITY : s;
                S[i] = s; mt = fmaxf(mt, s); }
            mt = fmaxf(mt, __shfl_xor(mt, 32));
            const float mn = fmaxf(m, mt), alpha = __builtin_amdgcn_exp2f(m - mn);
            m = mn; l *= alpha;
#pragma unroll
            for (int i = 0; i < 16; ++i) { O0[i] *= alpha; O1[i] *= alpha; const float p = __builtin_amdgcn_exp2f(S[i] - mn); S[i] = p; l += p; }
            const bf16x8 p0 = pack(S, 0), p1 = pack(S, 1);
            O0 = __builtin_amdgcn_mfma_f32_32x32x16_bf16(vf[0][0], p0, O0, 0, 0, 0); O0 = __builtin_amdgcn_mfma_f32_32x32x16_bf16(vf[0][1], p1, O0, 0, 0, 0);
            O1 = __builtin_amdgcn_mfma_f32_32x32x16_bf16(vf[1][0], p0, O1, 0, 0, 0); O1 = __builtin_amdgcn_mfma_f32_32x32x16_bf16(vf[1][1], p1, O1, 0, 0, 0);
        }
        l += __shfl_xor(l, 32);
        const float inv = 1.f / l;
        bf16* op = mix + ((size_t)b * SEQ + q0 + n) * DM + hq * 64 + 4 * hh;
#pragma unroll
        for (int g = 0; g < 4; ++g) { *(u32x2*)(op + 8 * g) = (u32x2){cvtpk(O0[4 * g] * inv, O0[4 * g + 1] * inv), cvtpk(O0[4 * g + 2] * inv, O0[4 * g + 3] * inv)};
            *(u32x2*)(op + 32 + 8 * g) = (u32x2){cvtpk(O1[4 * g] * inv, O1[4 * g + 1] * inv), cvtpk(O1[4 * g + 2] * inv, O1[4 * g + 3] * inv)}; }
    }
}
#undef DI
}
namespace pg8 {
struct EpiResF32 {
    static constexpr bool PERM = false, AFTER_DRAIN = false;
    const float* base; float* out; int ldc; float alpha;
    __device__ __forceinline__ void operator()(const f32x4 (&acc)[2][2][4][2], const Unit& u, int wr, int wc, int fr, int fq) const {
        const int col0 = u.pn * BM + wc * 32 + 4 * fq;
#pragma unroll
        for (int ai = 0; ai < 2; ++ai)
#pragma unroll
            for (int m = 0; m < 4; ++m) { const int r = ai * HALF + wr * 64 + m * 16 + fr; const size_t off = (size_t)(u.pm * BM + r) * ldc + col0;
#pragma unroll
                for (int bj = 0; bj < 2; ++bj)
#pragma unroll
                    for (int n = 0; n < 2; ++n) { const f32x4 bs = *(const f32x4*)(base + off + bj * HALF + n * 16); *(f32x4*)(out + off + bj * HALF + n * 16) = bs * alpha + acc[ai][bj][m][n]; } }
    }
};
}
#define XB_TMO      128
#define XB_XCNT(j)  (256  + 64 * (j))
#define XB_XSUB(j)  (1280 + 64 * (j))
#define XB_XGEN(j)  (2304 + 64 * (j))
#define XB_TOP      3328
#define XB_TOPGEN   3392
#define XCD_BAR_WORDS 3456
#define XB_SPIN_CAP (1u << 18)

__device__ __forceinline__ unsigned xb_ld(unsigned* p)              { return __hip_atomic_load(p, __ATOMIC_RELAXED, __HIP_MEMORY_SCOPE_AGENT); }
__device__ __forceinline__ unsigned xb_add(unsigned* p, unsigned v) { return __hip_atomic_fetch_add(p, v, __ATOMIC_RELAXED, __HIP_MEMORY_SCOPE_AGENT); }
__device__ __forceinline__ unsigned xb_xcc_id() { return (unsigned)__builtin_amdgcn_s_getreg((3 << 11) | 20) & 0xFu; }
#define XB_SPIN(cond, bar) do { unsigned _sp = 0; while (cond) { __builtin_amdgcn_s_sleep(1); \
    if ((++_sp & 255u) == 0u) { if (xb_ld(&(bar)[XB_TMO])) break; if (_sp > XB_SPIN_CAP) { atomicAdd(&(bar)[XB_TMO], 1u); break; } } } } while (0)

struct XcdBarrier {
    unsigned* bar; unsigned x;
    volatile LAS unsigned* st;
};

__device__ __forceinline__ XcdBarrier xcd_barrier_post(unsigned* bar, volatile LAS unsigned* st, int tid) {
    XcdBarrier b; b.bar = bar; b.x = xb_xcc_id(); b.st = st;
    if (tid == 0) (void)xb_add(&bar[XB_XCNT(b.x)], 1u);
    return b;
}
__device__ __forceinline__ void xcd_barrier_complete(unsigned* bar, unsigned x, unsigned& nloc, unsigned& nx) {
    const unsigned G = gridDim.x * gridDim.y * gridDim.z;
    unsigned sum, cnt, mine, sp = 0u;
    for (;;) {
        sum = 0u; cnt = 0u; mine = 0u;
#pragma unroll
        for (unsigned j = 0; j < 16; ++j) { const unsigned c = xb_ld(&bar[XB_XCNT(j)]); sum += c; cnt += (c > 0u) ? 1u : 0u; mine = (j == x) ? c : mine; }
        if (sum == G) break;
        __builtin_amdgcn_s_sleep(1);
        if ((++sp & 255u) == 0u) { if (xb_ld(&bar[XB_TMO])) break; if (sp > XB_SPIN_CAP) { atomicAdd(&bar[XB_TMO], 1u); break; } }
    }
    nloc = mine > 0u ? mine : 1u; nx = cnt > 0u ? cnt : 1u;
}

__device__ __forceinline__ void xcd_barrier(const XcdBarrier& b, int tid) {
    asm volatile("s_waitcnt vmcnt(0)" ::: "memory");
    __syncthreads();
    if (tid == 0) {
        unsigned* bar = b.bar;
        __builtin_amdgcn_s_waitcnt(0);
        unsigned nloc = b.st[0], nx = b.st[1];
        if (nloc == 0u) { xcd_barrier_complete(bar, b.x, nloc, nx); b.st[0] = nloc; b.st[1] = nx; }
        const unsigned old = xb_add(&bar[XB_XSUB(b.x)], 1u);
        const unsigned gen = old / nloc;
        if (old + 1u == (gen + 1u) * nloc) {
            __builtin_amdgcn_fence(__ATOMIC_RELEASE, "agent");
            asm volatile("s_waitcnt vmcnt(0)" ::: "memory");
            const unsigned og = xb_add(&bar[XB_TOP], 1u);
            const unsigned tg = og / nx;
            if (og + 1u == (tg + 1u) * nx) xb_add(&bar[XB_TOPGEN], 1u);
            else XB_SPIN(xb_ld(&bar[XB_TOPGEN]) == tg, bar);
            __builtin_amdgcn_fence(__ATOMIC_ACQUIRE, "agent");
            xb_add(&bar[XB_XGEN(b.x)], 1u);
            asm volatile("s_waitcnt vmcnt(0)" ::: "memory");
        } else {
            XB_SPIN(xb_ld(&bar[XB_XGEN(b.x)]) == gen, bar);
            __builtin_amdgcn_fence(__ATOMIC_ACQUIRE, "agent");
            asm volatile("s_waitcnt vmcnt(0)" ::: "memory");
        }
    }
    __syncthreads();
}

constexpr size_t MiB = 1u << 20;
constexpr int LDS_BYTES = 147456;
constexpr int NPHASE = 15;
struct Params { const float* in[24]; float* out; unsigned char* ws; int ph_lo, ph_hi; };

__global__ void __launch_bounds__(512, 2) mega(Params p) {
    extern __shared__ __attribute__((aligned(16))) unsigned char lds[];
    cg::grid_group grid = cg::this_grid();
    Ctx c; c.wave = __builtin_amdgcn_readfirstlane(threadIdx.x >> 6); c.lane = (int)__builtin_amdgcn_mbcnt_hi(~0u, __builtin_amdgcn_mbcnt_lo(~0u, 0u)); c.tid = c.wave * 64 + c.lane; c.bid = blockIdx.x; c.nb = gridDim.x; c.gw = c.bid * 8 + c.wave; c.ngw = c.nb * 8; c.lds = lds;
#define LND(ptr) ((ptr) + ({ int z_ = 0; asm volatile("" : "+s"(z_)); z_; }))
#define WSP(T, mb) ((T*)(LND(p.ws) + (size_t)(mb) * MiB))
#define x_in LND(p.in[0])
#define w_in LND(p.in[1])
#define mu_prev LND(p.in[2])
#define mu_next LND(p.in[3])
#define w0 LND(p.in[4])
#define w2 LND(p.in[5])
#define a0 LND(p.in[6])
#define a2 LND(p.in[7])
#define g2 LND(p.in[8])
#define k_k LND(p.in[9])
#define k_a LND(p.in[10])
#define r_k LND(p.in[11])
#define lnx_g LND(p.in[12])
#define lnx_b LND(p.in[13])
#define sink LND(p.in[14])
#define w_out LND(p.in[15])
#define ln1_g LND(p.in[16])
#define ln1_b LND(p.in[17])
#define wq LND(p.in[18])
#define keys LND(p.in[19])
#define pu LND(p.in[20])
#define pv LND(p.in[21])
#define ln2_g LND(p.in[22])
#define ln2_b LND(p.in[23])
#define out LND(p.out)
#define rope WSP(float2, 1)
#define w2t WSP(bf16, 2)
#define a2t ((bf16*)(LND(p.ws) + 2 * MiB + 65536))
#define g2t ((bf16*)(LND(p.ws) + 2 * MiB + 131072))
#define bscp WSP(float, 3)
#define w_in_t WSP(bf16, 4)
#define w_out_t WSP(bf16, 10)
#define wq_t WSP(bf16, 12)
#define xb WSP(bf16, 16)
#define qr WSP(bf16, 464)
#define kr WSP(bf16, 496)
#define vTp WSP(bf16, 504)
#define ybuf WSP(float, 16)
#define ub WSP(bf16, 16)
#define u8t WSP(unsigned, 16)
#define v8t WSP(unsigned, 32)
#define su8 WSP(float, 48)
#define shs WSP(float, 50)
#define h8s WSP(unsigned, 240)
#define zpp WSP(int, 304)
#define sv8 WSP(float, 49)
#define vb WSP(bf16, 48)
#define proj WSP(bf16, 80)
#define y1 WSP(float, 80)
#define idx WSP(int, 208)
#define gate WSP(float, 224)
#define mix WSP(bf16, 240)
#define UO WSP(unsigned char, 304)
#define qb WSP(bf16, 304)
#define h1b WSP(bf16, 432)
    volatile LAS unsigned* bst = (volatile LAS unsigned*)((LAS unsigned char*)lds + (LDS_BYTES - 64));
    if (c.tid < 3) bst[c.tid] = 0u;
    __syncthreads();
    const XcdBarrier bar = xcd_barrier_post((unsigned*)p.ws, bst, c.tid);
    if (c.tid == 0) bst[2] = xb_add((unsigned*)p.ws + px::CW_XRANK + (bar.x & 7u), 1u);
    __syncthreads();
    const int my_xcc = (int)bar.x, my_rank = (int)bst[2];
    const int lo = p.ph_lo, hi = p.ph_hi;
#ifndef PH_MASK
#define PH_MASK 0xFFFFFFFFu
#endif
#define IN(k) (((PH_MASK >> (k)) & 1) && lo <= (k) && (k) < hi)
#define RELANE() do { c.lane = (int)__builtin_amdgcn_mbcnt_hi(~0u, __builtin_amdgcn_mbcnt_lo(~0u, 0u)); c.tid = c.wave * 64 + c.lane; } while (0)
#define GBAR() do { RELANE(); xcd_barrier(bar, c.tid); } while (0)
#define SEAM(k) do { if (IN(k) && IN((k) + 1)) { if ((k) == 0) grid.sync(); else GBAR(); } RELANE(); } while (0)
#ifndef PROBE_IMASK
#define PROBE_IMASK 0x3fff
#endif
#ifndef REPEAT_MASK
#define REPEAT_MASK 0
#endif
#define PHASE(k, ...) do { if (IN(k)) { RELANE(); { const bool DRY = false; (void)DRY; __VA_ARGS__; } if ((REPEAT_MASK >> (k)) & 1) { GBAR(); RELANE(); const bool DRY = true; (void)DRY; __VA_ARGS__; } } SEAM(k); } while (0)
#define GEMM_PHASE(EPI, A_, Bt_, N_, ...) do { pg8::Gemm g{A_, Bt_, NTOK, N_, DM}; pg8::StaticOrder S; S.init(NTOK, N_, c.nb, c.bid); EPI E{__VA_ARGS__}; \
        pg8::gemm_phase<EPI, pg8::StaticOrder, true, true>((PG8_LAS unsigned char*)lds, g, S, E, c.wave); } while (0)
    const int NSEQ = 64; Ctx c2 = c; c2.bid = c.bid - NSEQ; c2.nb = c.nb - NSEQ; c2.gw = c2.bid * 8 + c.wave; c2.ngw = c2.nb * 8;
#define SHADOW(seq_call, ...) do { if (c.bid < NSEQ || c.nb <= NSEQ) { seq_call; } if (c.bid >= NSEQ) { c2.lane = c.lane; c2.tid = c.tid; __VA_ARGS__; } else if (c.nb <= NSEQ) { c2 = c; __VA_ARGS__; } } while (0)
    PHASE(0, nv::d_cvt_bf16(c, x_in, xb, (size_t)NTOK * DM / 4); nv::d_transpose_w(c, w_in, DM, IN_COLS, IN_PAD, w_in_t); nv::d_transpose_w(c, w_out, DM, DM, DM, w_out_t);
             nv::d_transpose_w(c, wq, DM, PEER_Q, PEER_Q, wq_t); nv::d_rope_table(c, rope); rw::d_lowrank_t(c, w2, a2, w2t, a2t); rw::d_g2_t(c, g2, g2t));
    PHASE(1, GEMM_PHASE(pg8::EpiBf16<0>, xb, w_in_t, IN_PAD, proj, IN_PAD, nullptr, 0, 0, 1.f));
    PHASE(2, rw::d_prep(c, 0, proj, mu_prev, mu_next, w0, a0, k_k, k_a, w2t, a2t, UO, ybuf));
    PHASE(3, SHADOW(rw::d_seq(c, 0, UO, ybuf, DRY), nv::d_rotary(c2, proj, rope, qr, kr); at::d_vt(c2, proj, vTp)));
    PHASE(4, rw::d_prep(c, 1, proj, mu_prev, mu_next, w0, a0, k_k, k_a, w2t, a2t, UO, ybuf));
    PHASE(5, SHADOW(rw::d_seq(c, 1, UO, ybuf, DRY), at::d_attn(c2, qr, kr, vTp, sink, mix)));
    PHASE(6, rw::d_out(c, proj, ybuf, mu_prev, mu_next, a0, k_a, r_k, a2t, g2t, lnx_g, lnx_b, mix));
    PHASE(7, GEMM_PHASE(pg8::EpiResF32, mix, w_out_t, DM, x_in, y1, DM, DN_ALPHA));
    PHASE(8, { float* y1p = y1; nv::d_ln1(c, y1p, ln1_g, ln1_b, DRY ? (float*)qb : y1p, DRY ? (bf16*)qb : h1b); } px::d_quant_tables(c, pu, pv, u8t, v8t, su8, sv8));
    PHASE(9, GEMM_PHASE(pg8::EpiBf16<0>, h1b, wq_t, PEER_Q, qb, PEER_Q, nullptr, 0, 0, 1.f));
    PHASE(10, pk::d_peer_topk(c, qb, keys, idx, gate); px::d_quant_h(c, h1b, h8s, shs));
    PHASE(11, { const px::Grp G = px::group_of(c, (const unsigned*)p.ws, my_xcc, my_rank); px::d_g1(c, G, h8s, idx, u8t, zpp); });
    PHASE(12, px::d_g2(c, zpp, idx, shs, su8, sv8, gate));
    PHASE(13, { const px::Grp G = px::group_of(c, (const unsigned*)p.ws, my_xcc, my_rank); px::d_g3(c, G, h1b, idx, gate, v8t, y1); });
    PHASE(14, px::d_g4(c, y1, ln2_g, ln2_b, out));
#undef IN
#undef SEAM
}
#undef x_in
#undef out
#undef proj
#undef mix
#undef idx
#undef gate
#undef keys
#undef rope
#undef w0
#undef w2
#undef a0
#undef a2
#undef g2
#undef sink
#undef qr
#undef kr
#undef ub
#undef vb
#undef qb
#undef xb
#undef y1
#undef UO
#undef ybuf
#undef pu
#undef pv

#ifndef N_LAUNCHES
#define N_LAUNCHES 1
#endif
extern "C" void kernel_launch(void* const* d_in, const int* in_sizes, int n_in, void* d_out, int out_size, void* d_ws, size_t ws_size, hipStream_t stream) {
    static int grid = 0;
    if (grid == 0) {
        if (n_in != 24 || in_sizes[0] != NTOK * DM || out_size != NTOK * DM || ws_size < 512 * MiB) { fprintf(stderr, "kernel_launch: unexpected shapes/ws (n_in %d, ws %zu)\n", n_in, ws_size); grid = -1; return; }
        int dev = 0, cus = 0, per_cu = 0;
        if (hipGetDevice(&dev) != hipSuccess || hipDeviceGetAttribute(&cus, hipDeviceAttributeMultiprocessorCount, dev) != hipSuccess) { grid = -1; return; }
        if (hipFuncSetAttribute((const void*)mega, hipFuncAttributeMaxDynamicSharedMemorySize, LDS_BYTES) != hipSuccess) { fprintf(stderr, "kernel_launch: hipFuncSetAttribute failed\n"); grid = -1; return; }
        if (hipOccupancyMaxActiveBlocksPerMultiprocessor(&per_cu, (const void*)mega, 512, LDS_BYTES) != hipSuccess || per_cu < 1) { fprintf(stderr, "kernel_launch: occupancy query failed (%d)\n", per_cu); (void)hipGetLastError(); grid = -1; return; }
        grid = cus * per_cu;
        fprintf(stderr, "kernel_launch: cus %d per_cu %d grid %d\n", cus, per_cu, grid);
    }
    if (grid < 0) return;
    if (hipMemsetAsync(d_ws, 0, 65536, stream) != hipSuccess) { fprintf(stderr, "kernel_launch: memset failed\n"); return; }
    Params p{};
    for (int i = 0; i < 24; ++i) p.in[i] = (const float*)d_in[i];
    p.out = (float*)d_out; p.ws = (unsigned char*)d_ws;
#if N_LAUNCHES == 1
    p.ph_lo = 0; p.ph_hi = NPHASE;
    void* args[] = {&p};
    hipError_t e = hipLaunchCooperativeKernel((const void*)mega, dim3(grid), dim3(512), args, LDS_BYTES, stream);
    if (e != hipSuccess) fprintf(stderr, "cooperative launch failed: %s (grid %d)\n", hipGetErrorString(e), grid);
#else
    for (int k = 0; k < NPHASE; ++k) { p.ph_lo = k; p.ph_hi = k + 1; hipLaunchKernelGGL(mega, dim3(grid), dim3(512), LDS_BYTES, stream, p); }
#endif
}
```
